# Optimizing an MI355X kernel written in HIP

```python
import jax, jax.numpy as jnp
from jax import lax
import numpy as np

D_MODEL = 2048
BATCH = 1
SEQ = 16384
DEPTH = 2

CHUNK = 64
QBLOCK = 128
N_BRANCHES = 4
BRANCH_W = D_MODEL // 4

HG_HEADS = 4
RW_HEADS = 8
RW_DIM = BRANCH_W // RW_HEADS
RW_DECAY_RANK = 32
RW_ICLR_RANK = 32
RW_GATE_RANK = 96
SB_HEADS = 4
SB_DIM = BRANCH_W // SB_HEADS
GLA_HEADS = 4
GLA_DK = 64
GLA_DV = 128
GLA_GATE_RANK = 16
GLA_TAU = 16.0

N_EXPERTS = 64
TOP_K = 8
N_GROUPS = 8
TOPK_GROUPS = 4
EXPERT_W = 512
ROUTED_SCALE = 2.5
DISPATCH_BLOCK = 128

DEEPNORM_ALPHA = (2 * DEPTH) ** 0.25
DEEPNORM_BETA = (8 * DEPTH) ** -0.25
LN_EPS = 1e-5
RW_GN_EPS = 64e-5

HG_SIZES = (BRANCH_W, BRANCH_W, BRANCH_W, BRANCH_W)
RW_SIZES = (BRANCH_W, BRANCH_W, BRANCH_W, RW_DECAY_RANK, RW_ICLR_RANK, RW_GATE_RANK)
SB_SIZES = (BRANCH_W, BRANCH_W, BRANCH_W)
GLA_SIZES = (GLA_HEADS * GLA_DK, GLA_HEADS * GLA_DK, GLA_HEADS * GLA_DV, GLA_GATE_RANK, BRANCH_W)
GATE_SIZE = N_BRANCHES * D_MODEL
BRANCH_SIZES = (sum(HG_SIZES), sum(RW_SIZES), sum(SB_SIZES), sum(GLA_SIZES), GATE_SIZE)
IN_WIDTH = sum(BRANCH_SIZES)

kernel_name = 'hybrid_gated_mixers_moe_deepnorm'


def split_cols(a, sizes):
    return jnp.split(a, np.cumsum(sizes)[:-1].tolist(), axis=-1)


def split_heads(a, n_heads):
    b, t, c = a.shape
    return a.reshape(b, t, n_heads, c // n_heads).transpose(0, 2, 1, 3)


def merge_heads(a):
    b, h, t, d = a.shape
    return a.transpose(0, 2, 1, 3).reshape(b, t, h * d)


def layer_norm(x, w, b):
    x32 = x.astype(jnp.float32)
    mu = jnp.mean(x32, axis=-1, keepdims=True)
    var = jnp.mean(jnp.square(x32 - mu), axis=-1, keepdims=True)
    return ((x32 - mu) * lax.rsqrt(var + LN_EPS) * w + b).astype(x.dtype)


def head_rms_norm(o, gain):
    o32 = o.astype(jnp.float32)
    o32 = o32 * lax.rsqrt(jnp.mean(jnp.square(o32), axis=-1, keepdims=True) + LN_EPS)
    return (merge_heads(o32) * gain).astype(o.dtype)


def head_group_norm(o, w, b, eps):
    o32 = o.astype(jnp.float32)
    mu = jnp.mean(o32, axis=-1, keepdims=True)
    var = jnp.mean(jnp.square(o32 - mu), axis=-1, keepdims=True)
    return merge_heads((o32 - mu) * lax.rsqrt(var + eps)) * w + b


def shift_lerp(z, mu):
    prev = jnp.pad(z, ((0, 0), (1, 0), (0, 0)))[:, :-1]
    return z + (prev - z) * mu


def chunked_gated_linear_attention(q, k, v, log_decay):
    b, h, t, dk = q.shape
    dv = v.shape[-1]
    n = t // CHUNK
    f32 = jnp.float32

    def chunks(a):
        return jnp.moveaxis(a.astype(f32).reshape(b, h, n, CHUNK, a.shape[-1]), 2, 0)

    qc, kc, vc = chunks(q), chunks(k), chunks(v)
    bc = jnp.cumsum(chunks(log_decay), axis=3)
    causal = jnp.tril(jnp.ones((CHUNK, CHUNK), bool))[:, :, None]

    def step(state, inp):
        q_i, k_i, v_i, b_i = inp
        o_inter = jnp.einsum('bhtk,bhkv->bhtv', q_i * jnp.exp(b_i), state)
        rel = jnp.where(causal, b_i[:, :, :, None, :] - b_i[:, :, None, :, :], -jnp.inf)
        scores = jnp.einsum('bhtsk,bhsk->bhts', q_i[:, :, :, None, :] * jnp.exp(rel), k_i)
        o_intra = jnp.einsum('bhts,bhsv->bhtv', scores, v_i)
        b_last = b_i[:, :, -1, :]
        state = jnp.exp(b_last)[..., None] * state + jnp.einsum(
            'bhsk,bhsv->bhkv', k_i * jnp.exp(b_last[:, :, None, :] - b_i), v_i)
        return state, o_inter + o_intra

    s0 = jnp.zeros((b, h, dk, dv), f32)
    _, o = lax.scan(step, s0, (qc, kc, vc, bc))
    return jnp.moveaxis(o, 0, 2).reshape(b, h, t, dv).astype(v.dtype)


def rwkv7_recurrence(r, decay, k, v, a, bvec):
    bsz, h, t, n = r.shape

    def step(state, inp):
        r_t, w_t, k_t, v_t, a_t, b_t = inp
        sa = jnp.einsum('bhvk,bhk->bhv', state, a_t)
        state = (state * w_t[:, :, None, :] + sa[..., None] * b_t[:, :, None, :]
                 + v_t[..., None] * k_t[:, :, None, :])
        return state, jnp.einsum('bhvk,bhk->bhv', state, r_t)

    seq = tuple(jnp.moveaxis(a_.astype(jnp.float32), 2, 0) for a_ in (r, decay, k, v, a, bvec))
    s0 = jnp.zeros((bsz, h, n, n), jnp.float32)
    _, o = lax.scan(step, s0, seq)
    return jnp.moveaxis(o, 0, 2)


def stick_breaking_attention(q, k, v):
    b, h, t, d = q.shape
    nq = t // QBLOCK
    qb = jnp.moveaxis(q.reshape(b, h, nq, QBLOCK, d), 2, 0)
    kpos = jnp.arange(t)
    scale = d ** -0.5

    def one_block(args):
        q_i, blk = args
        qpos = blk * QBLOCK + jnp.arange(QBLOCK)
        z = jnp.einsum('bhqd,bhkd->bhqk', q_i, k).astype(jnp.float32) * scale
        strict = kpos[None, :] < qpos[:, None]
        log_keep = jnp.where(strict, jax.nn.log_sigmoid(-z), 0.0)
        later = lax.cumsum(log_keep, axis=3, reverse=True) - log_keep
        weights = jnp.where(strict, jnp.exp(jax.nn.log_sigmoid(z) + later), 0.0)
        return jnp.einsum('bhqk,bhkd->bhqd', weights.astype(v.dtype), v)

    o = lax.map(one_block, (qb, jnp.arange(nq)))
    return jnp.moveaxis(o, 0, 2).reshape(b, h, t, d)


def hgrn2_branch(z, lower_bound, norm_w):
    q, f_logit, i, g = split_cols(z, HG_SIZES)
    one_minus_f = (1.0 - lower_bound) * jax.nn.sigmoid(-f_logit.astype(jnp.float32))
    log_f = jnp.log1p(-one_minus_f)
    o = chunked_gated_linear_attention(
        split_heads(jax.nn.silu(q), HG_HEADS), split_heads(one_minus_f, HG_HEADS),
        split_heads(i, HG_HEADS), split_heads(log_f, HG_HEADS))
    return head_rms_norm(o, norm_w) * jax.nn.silu(g)


def rwkv7_branch(z, mu, w0, w2, a0, a2, g2, k_k, k_a, r_k, ln_w, ln_b):
    f32 = jnp.float32
    r, k, v, lw, la, lg = split_cols(shift_lerp(z, mu), RW_SIZES)
    w_raw = -jax.nn.softplus(-(w0 + jnp.tanh(lw) @ w2).astype(f32)) - 0.5
    decay = jnp.exp(-jnp.exp(w_raw))
    iclr = jax.nn.sigmoid((a0 + la @ a2).astype(f32))
    gate = jax.nn.sigmoid(lg) @ g2
    kk = split_heads((k * k_k).astype(f32), RW_HEADS)
    kk = kk / jnp.maximum(jnp.linalg.norm(kk, axis=-1, keepdims=True), 1e-12)
    k_mod = k.astype(f32) * (1.0 + (iclr - 1.0) * k_a)
    r_h = split_heads(r.astype(f32), RW_HEADS)
    k_h = split_heads(k_mod, RW_HEADS)
    v_h = split_heads(v.astype(f32), RW_HEADS)
    o = rwkv7_recurrence(r_h, split_heads(decay, RW_HEADS), k_h, v_h,
                         -kk, kk * split_heads(iclr, RW_HEADS))
    o = head_group_norm(o, ln_w, ln_b, RW_GN_EPS)
    bonus = merge_heads(jnp.sum(r_h * k_h * r_k.reshape(RW_HEADS, 1, RW_DIM), axis=-1, keepdims=True) * v_h)
    return ((o + bonus) * gate).astype(z.dtype)


def stick_breaking_branch(z):
    q, k, v = split_cols(z, SB_SIZES)
    o = stick_breaking_attention(split_heads(q, SB_HEADS), split_heads(k, SB_HEADS), split_heads(v, SB_HEADS))
    return merge_heads(o)


def gla_branch(z, g2, gb, norm_w):
    q, k, v, lg, r = split_cols(z, GLA_SIZES)
    log_alpha = jax.nn.log_sigmoid((lg @ g2 + gb).astype(jnp.float32)) / GLA_TAU
    o = chunked_gated_linear_attention(
        split_heads(q, GLA_HEADS) * GLA_DK ** -0.5, split_heads(k, GLA_HEADS),
        split_heads(v, GLA_HEADS), split_heads(log_alpha, GLA_HEADS))
    return head_rms_norm(o, norm_w) * jax.nn.silu(r)


def hybrid_token_mixing(x, w_in, lower_bound, hg_norm_w, rw_mu, rw_w0, rw_w2, rw_a0, rw_a2,
                        rw_g2, rw_kk, rw_ka, rw_rk, rw_ln_w, rw_ln_b, gla_g2, gla_gb,
                        gla_norm_w, w_br, w_out):
    z = x @ w_in
    z_hg, z_rw, z_sb, z_gla, gate_logits = split_cols(z, BRANCH_SIZES)
    branch_outs = (
        hgrn2_branch(z_hg, lower_bound, hg_norm_w),
        rwkv7_branch(z_rw, rw_mu, rw_w0, rw_w2, rw_a0, rw_a2, rw_g2, rw_kk, rw_ka, rw_rk, rw_ln_w, rw_ln_b),
        stick_breaking_branch(z_sb),
        gla_branch(z_gla, gla_g2, gla_gb, gla_norm_w),
    )
    merged = jnp.zeros_like(x)
    for g in range(N_BRANCHES):
        gate = jax.nn.sigmoid(gate_logits[..., g * D_MODEL:(g + 1) * D_MODEL])
        merged = merged + gate * (branch_outs[g] @ w_br[g])
    return (merged @ w_out).astype(x.dtype)


def moe_ffn(x, w_router, router_bias, we_gate, we_up, we_down, ws_gate, ws_up, ws_down):
    b, t, d = x.shape
    n_tok = b * t
    xt = x.reshape(n_tok, d)
    f32 = jnp.float32
    scores = jax.nn.sigmoid(jnp.dot(xt.astype(f32), w_router.astype(f32)))
    biased = scores + router_bias.astype(f32)
    group_score = lax.top_k(biased.reshape(n_tok, N_GROUPS, N_EXPERTS // N_GROUPS), 2)[0].sum(-1)
    _, top_groups = lax.top_k(group_score, TOPK_GROUPS)
    group_ok = jnp.any(top_groups[:, :, None] == jnp.arange(N_GROUPS)[None, None, :], axis=1)
    expert_ok = jnp.repeat(group_ok, N_EXPERTS // N_GROUPS, axis=1)
    _, idx = lax.top_k(jnp.where(expert_ok, biased, -jnp.inf), TOP_K)
    w_sel = jnp.take_along_axis(scores, idx, axis=1)
    w_sel = ROUTED_SCALE * w_sel / jnp.sum(w_sel, axis=1, keepdims=True)

    n_slots = n_tok * TOP_K
    flat_e = idx.reshape(-1)
    order = jnp.argsort(flat_e)
    e_sorted = flat_e[order]
    tok_sorted = (order // TOP_K).astype(jnp.int32)
    w_sorted = w_sel.reshape(-1)[order]
    counts = jnp.bincount(flat_e, length=N_EXPERTS)
    padded = (counts + DISPATCH_BLOCK - 1) // DISPATCH_BLOCK * DISPATCH_BLOCK
    pad_end = jnp.cumsum(padded)
    pad_start = pad_end - padded
    start = jnp.cumsum(counts) - counts
    dest = pad_start[e_sorted] + jnp.arange(n_slots) - start[e_sorted]
    n_blocks = -(-n_slots // DISPATCH_BLOCK) + N_EXPERTS
    rows = n_blocks * DISPATCH_BLOCK
    row_tok = jnp.zeros((rows,), jnp.int32).at[dest].set(tok_sorted)
    row_w = jnp.zeros((rows,), f32).at[dest].set(w_sorted)
    block_expert = jnp.minimum(
        jnp.searchsorted(pad_end, jnp.arange(n_blocks) * DISPATCH_BLOCK, side='right'), N_EXPERTS - 1)

    def block_step(acc, inp):
        tok_b, w_b, e = inp
        xb = xt[tok_b]
        hb = jax.nn.silu(xb @ we_gate[e]) * (xb @ we_up[e])
        yb = (hb @ we_down[e]) * w_b[:, None].astype(xt.dtype)
        return acc.at[tok_b].add(yb.astype(acc.dtype)), None

    routed, _ = lax.scan(block_step, jnp.zeros_like(xt),
                         (row_tok.reshape(n_blocks, DISPATCH_BLOCK),
                          row_w.reshape(n_blocks, DISPATCH_BLOCK), block_expert))
    shared = (jax.nn.silu(xt @ ws_gate) * (xt @ ws_up)) @ ws_down
    return (routed + shared).reshape(b, t, d).astype(x.dtype)


def setup_inputs(seed: int = 0) -> dict:
    key = jax.random.key(seed)
    ks = iter(jax.random.split(key, 48))
    L, D, W, E, F = DEPTH, D_MODEL, BRANCH_W, N_EXPERTS, EXPERT_W

    def nrm(shape, scale):
        return scale * jax.random.normal(next(ks), shape, jnp.float32)

    def gain(shape):
        return 1.0 + nrm(shape, 0.05)

    return {
        'x': nrm((BATCH, SEQ, D), 1.0),
        'w_in': nrm((L, D, IN_WIDTH), D ** -0.5),
        'hg_lb_logits': nrm((L, W), 0.5),
        'hg_norm_w': gain((L, W)),
        'rw_mu': jax.random.uniform(next(ks), (L, sum(RW_SIZES)), jnp.float32),
        'rw_w0': -2.0 + nrm((L, W), 0.5),
        'rw_w2': nrm((L, RW_DECAY_RANK, W), RW_DECAY_RANK ** -0.5),
        'rw_a0': nrm((L, W), 0.1),
        'rw_a2': nrm((L, RW_ICLR_RANK, W), RW_ICLR_RANK ** -0.5),
        'rw_g2': nrm((L, RW_GATE_RANK, W), RW_GATE_RANK ** -0.5),
        'rw_kk': 0.85 + nrm((L, W), 0.05),
        'rw_ka': 1.0 + nrm((L, W), 0.05),
        'rw_rk': nrm((L, W), 0.1),
        'rw_ln_w': gain((L, W)),
        'rw_ln_b': nrm((L, W), 0.02),
        'gla_g2': nrm((L, GLA_GATE_RANK, GLA_HEADS * GLA_DK), GLA_GATE_RANK ** -0.5),
        'gla_gb': nrm((L, GLA_HEADS * GLA_DK), 0.1),
        'gla_norm_w': gain((L, W)),
        'w_br': nrm((L, N_BRANCHES, W, D), W ** -0.5),
        'w_out': nrm((L, D, D), DEEPNORM_BETA * D ** -0.5),
        'ln1_w': gain((L, D)),
        'ln1_b': nrm((L, D), 0.02),
        'w_router': nrm((L, D, E), D ** -0.5),
        'router_bias': nrm((L, E), 0.01),
        'we_gate': nrm((L, E, D, F), D ** -0.5),
        'we_up': nrm((L, E, D, F), D ** -0.5),
        'we_down': nrm((L, E, F, D), DEEPNORM_BETA * F ** -0.5),
        'ws_gate': nrm((L, D, F), D ** -0.5),
        'ws_up': nrm((L, D, F), D ** -0.5),
        'ws_down': nrm((L, F, D), DEEPNORM_BETA * F ** -0.5),
        'ln2_w': gain((L, D)),
        'ln2_b': nrm((L, D), 0.02),
    }


def reference(x, w_in, hg_lb_logits, hg_norm_w, rw_mu, rw_w0, rw_w2, rw_a0, rw_a2, rw_g2,
              rw_kk, rw_ka, rw_rk, rw_ln_w, rw_ln_b, gla_g2, gla_gb, gla_norm_w, w_br, w_out,
              ln1_w, ln1_b, w_router, router_bias, we_gate, we_up, we_down, ws_gate, ws_up,
              ws_down, ln2_w, ln2_b):
    p = jax.nn.softmax(hg_lb_logits.astype(jnp.float32), axis=0)
    cum = jnp.cumsum(p, axis=0)
    lower_bounds = cum - cum[0:1]
    for l in range(DEPTH):
        mix = hybrid_token_mixing(x, w_in[l], lower_bounds[l], hg_norm_w[l], rw_mu[l], rw_w0[l],
                                  rw_w2[l], rw_a0[l], rw_a2[l], rw_g2[l], rw_kk[l], rw_ka[l],
                                  rw_rk[l], rw_ln_w[l], rw_ln_b[l], gla_g2[l], gla_gb[l],
                                  gla_norm_w[l], w_br[l], w_out[l])
        x = layer_norm(DEEPNORM_ALPHA * x + mix, ln1_w[l], ln1_b[l])
        ffn = moe_ffn(x, w_router[l], router_bias[l], we_gate[l], we_up[l], we_down[l],
                      ws_gate[l], ws_up[l], ws_down[l])
        x = layer_norm(DEEPNORM_ALPHA * x + ffn, ln2_w[l], ln2_b[l])
    return x
```

```cpp
#include <hip/hip_runtime.h>
#include <stdint.h>
#include <stdio.h>
#include <string.h>

typedef unsigned short bf16_t;

constexpr int T = 16384, D = 2048, ZW = 15024, ZLD = 15104, NE = 64, FW = 512;
constexpr int HG_Q = 0, HG_F = 512, HG_I = 1024, HG_G = 1536;
constexpr int RW_R = 2048, RW_K = 2560, RW_V = 3072, RW_LW = 3584;
constexpr int SB_Q = 3744, SB_K = 4256, SB_V = 4768;
constexpr int GL_Q = 5280, GL_K = 5536, GL_V = 5792, GL_LG = 6304, GL_R = 6320;
constexpr int GATE0 = 6832;
constexpr float ALPHA = 1.4142135623730951f;
constexpr int MAXPANELS = 640;
constexpr int MAXROWS = MAXPANELS * 256;

__device__ __forceinline__ float bf2f(bf16_t v) { return __uint_as_float(((unsigned)v) << 16); }
__device__ __forceinline__ bf16_t f2bf(float f) { unsigned u = __float_as_uint(f); u += 0x7FFFu + ((u >> 16) & 1u); return (bf16_t)(u >> 16); }
__device__ __forceinline__ float sigmoidf_(float x) { return 1.0f / (1.0f + expf(-x)); }
__device__ __forceinline__ float softplusf_(float x) { return fmaxf(x, 0.f) + log1pf(expf(-fabsf(x))); }
__device__ __forceinline__ float siluf_(float x) { return x / (1.0f + expf(-x)); }

template <int CTRL> __device__ __forceinline__ float dppmov(float x) {
    return __builtin_bit_cast(float, __builtin_amdgcn_update_dpp(0, __builtin_bit_cast(int, x), CTRL, 0xF, 0xF, true));
}
__device__ __forceinline__ float rdlane(float x, int l) { return __builtin_bit_cast(float, __builtin_amdgcn_readlane(__builtin_bit_cast(int, x), l)); }
__device__ __forceinline__ float wave_sum(float x) {
    x += dppmov<0xB1>(x);
    x += dppmov<0x4E>(x);
    x += dppmov<0x141>(x);
    x += dppmov<0x140>(x);
    return (rdlane(x, 0) + rdlane(x, 16)) + (rdlane(x, 32) + rdlane(x, 48));
}

struct EpiZ { bf16_t* z; __device__ void operator()(int m, int n, float a0, float) const { z[(size_t)m * ZLD + n] = f2bf(a0); } };
struct EpiGate { const bf16_t* z; float* merged; bf16_t* mergedb; int g; int pad_;
    __device__ void operator()(int m, int n, float a0, float) const {
        const float gl = bf2f(z[(size_t)m * ZLD + GATE0 + g * D + n]);
        float v = sigmoidf_(gl) * a0;
        const size_t o = (size_t)m * D + n;
        if (g > 0) v += merged[o];
        merged[o] = v;
        if (g == 3) mergedb[o] = f2bf(v);
    } };
struct EpiRes { const float* xin; float* pre; __device__ void operator()(int m, int n, float a0, float) const { const size_t o = (size_t)m * D + n; pre[o] = ALPHA * xin[o] + a0; } };
struct EpiSwiglu { bf16_t* h; __device__ void operator()(int m, int n, float a0, float a1) const { h[(size_t)m * FW + n] = f2bf(siluf_(a0) * a1); } };
struct EpiDown { bf16_t* y; const float* row_w; __device__ void operator()(int m, int n, float a0, float) const { y[(size_t)m * D + n] = f2bf(a0 * row_w[m]); } };

template <class Epi> struct GemmArgs { const bf16_t* A; const int* rowmap; const float *B0, *B1, *B0s, *B1s; size_t estride; const int* panel_expert; const int* npanels; int lda, ldb, N, K; Epi epi; };
template <class Epi, bool DUAL>
__global__ __launch_bounds__(256) void k_ngemm(const GemmArgs<Epi> ga) {
    const bf16_t* __restrict__ A = ga.A; const int* __restrict__ rowmap = ga.rowmap; const float* __restrict__ B0 = ga.B0; const float* __restrict__ B1 = ga.B1;
    const float* __restrict__ B0s = ga.B0s; const float* __restrict__ B1s = ga.B1s; const size_t estride = ga.estride;
    const int* __restrict__ panel_expert = ga.panel_expert; const int* __restrict__ npanels = ga.npanels; const int lda = ga.lda, ldb = ga.ldb, N = ga.N, K = ga.K; const Epi epi = ga.epi;
    __shared__ float As[16][132];
    __shared__ float Bs0[16][132];
    __shared__ float Bs1[DUAL ? 16 : 1][132];
    const int tid = threadIdx.x, tx = tid & 15, ty = tid >> 4;
    const int m0 = blockIdx.x * 128, n0 = blockIdx.y * 128;
    const float* Bp0 = B0; const float* Bp1 = B1;
    if (panel_expert) {
        const int p = m0 >> 8;
        if (p >= *npanels) return;
        const int e = panel_expert[p];
        if (e < NE) { Bp0 = B0 + (size_t)e * estride; if constexpr (DUAL) Bp1 = B1 + (size_t)e * estride; }
        else { Bp0 = B0s; if constexpr (DUAL) Bp1 = B1s; }
    }
    float acc0[8][8], acc1[DUAL ? 8 : 1][8];
#pragma unroll
    for (int i = 0; i < 8; ++i)
#pragma unroll
        for (int j = 0; j < 8; ++j) { acc0[i][j] = 0.f; if constexpr (DUAL) acc1[i][j] = 0.f; }
    const int arow = tid >> 1, akh = tid & 1;
    const int am = m0 + arow;
    const size_t asrc = (size_t)(rowmap ? rowmap[am] : am) * lda + akh * 8;
    const int bk = tid >> 4, bn = (tid & 15) * 8;
    for (int k0 = 0; k0 < K; k0 += 16) {
        const uint4 av = *(const uint4*)(A + asrc + k0);
        const unsigned aw[4] = {av.x, av.y, av.z, av.w};
#pragma unroll
        for (int j = 0; j < 4; ++j) { As[akh * 8 + 2 * j][arow] = __uint_as_float(aw[j] << 16); As[akh * 8 + 2 * j + 1][arow] = __uint_as_float(aw[j] & 0xffff0000u); }
#pragma unroll
        for (int q = 0; q < 2; ++q) {
            const int n = n0 + bn + q * 4;
            float4 v0 = make_float4(0.f, 0.f, 0.f, 0.f), v1 = v0;
            if (n < N) { v0 = *(const float4*)(Bp0 + (size_t)(k0 + bk) * ldb + n); if constexpr (DUAL) v1 = *(const float4*)(Bp1 + (size_t)(k0 + bk) * ldb + n); }
            *(float4*)&Bs0[bk][bn + q * 4] = v0;
            if constexpr (DUAL) *(float4*)&Bs1[bk][bn + q * 4] = v1;
        }
        __syncthreads();
#pragma unroll
        for (int k = 0; k < 16; ++k) {
            float a[8], b[8], c[8];
            *(float4*)&a[0] = *(const float4*)&As[k][ty * 8]; *(float4*)&a[4] = *(const float4*)&As[k][ty * 8 + 4];
            *(float4*)&b[0] = *(const float4*)&Bs0[k][tx * 8]; *(float4*)&b[4] = *(const float4*)&Bs0[k][tx * 8 + 4];
            if constexpr (DUAL) { *(float4*)&c[0] = *(const float4*)&Bs1[k][tx * 8]; *(float4*)&c[4] = *(const float4*)&Bs1[k][tx * 8 + 4]; }
#pragma unroll
            for (int i = 0; i < 8; ++i)
#pragma unroll
                for (int j = 0; j < 8; ++j) { acc0[i][j] += a[i] * b[j]; if constexpr (DUAL) acc1[i][j] += a[i] * c[j]; }
        }
        __syncthreads();
    }
#pragma unroll
    for (int i = 0; i < 8; ++i)
#pragma unroll
        for (int j = 0; j < 8; ++j) { const int m = m0 + ty * 8 + i, n = n0 + tx * 8 + j; if (n < N) { float a1 = 0.f; if constexpr (DUAL) a1 = acc1[i][j]; epi(m, n, acc0[i][j], a1); } }
}

__global__ void k_cvt_bf16(const float* __restrict__ src, bf16_t* __restrict__ dst, size_t n) {
    for (size_t i = (size_t)blockIdx.x * blockDim.x + threadIdx.x; i < n; i += (size_t)gridDim.x * blockDim.x) dst[i] = f2bf(src[i]);
}

__global__ __launch_bounds__(256) void k_ln(const float* __restrict__ pre, const float* __restrict__ w, const float* __restrict__ b,
                                            float* __restrict__ outf, bf16_t* __restrict__ outb) {
    const int lane = threadIdx.x & 63;
    const int row = blockIdx.x * 4 + (threadIdx.x >> 6);
    const float* p = pre + (size_t)row * D;
    float v[32]; float s = 0.f;
#pragma unroll
    for (int i = 0; i < 8; ++i) { const float4 x = *(const float4*)(p + i * 256 + lane * 4); v[4 * i] = x.x; v[4 * i + 1] = x.y; v[4 * i + 2] = x.z; v[4 * i + 3] = x.w; s += (x.x + x.y) + (x.z + x.w); }
    const float mu = wave_sum(s) * (1.0f / D);
    float q = 0.f;
#pragma unroll
    for (int i = 0; i < 32; ++i) { const float d = v[i] - mu; q += d * d; }
    const float rstd = rsqrtf(wave_sum(q) * (1.0f / D) + 1e-5f);
#pragma unroll
    for (int i = 0; i < 8; ++i) {
        const int c = i * 256 + lane * 4;
        const float4 ww = *(const float4*)(w + c), bb = *(const float4*)(b + c);
        float4 o; o.x = (v[4 * i] - mu) * rstd * ww.x + bb.x; o.y = (v[4 * i + 1] - mu) * rstd * ww.y + bb.y; o.z = (v[4 * i + 2] - mu) * rstd * ww.z + bb.z; o.w = (v[4 * i + 3] - mu) * rstd * ww.w + bb.w;
        *(float4*)(outf + (size_t)row * D + c) = o;
        if (outb) { bf16_t* ob = outb + (size_t)row * D + c; ob[0] = f2bf(o.x); ob[1] = f2bf(o.y); ob[2] = f2bf(o.z); ob[3] = f2bf(o.w); }
    }
}

struct PrepArgs {
    const bf16_t* z;
    const float *hg_lb_logits, *rw_mu, *rw_w0, *rw_w2, *rw_a0, *rw_a2, *rw_g2, *rw_kk, *rw_ka, *rw_rk, *gla_g2, *gla_gb;
    float *rR, *rW, *rK, *rV, *rA, *rB, *rGate, *rBonus;
    float *hQ, *hW, *hK, *hV;
    float *gQ, *gW, *gK, *gV;
    int layer, pad_;
};
__global__ __launch_bounds__(512) void k_prep(PrepArgs p) {
    __shared__ float lr[160];
    __shared__ float glg[16];
    const int c = threadIdx.x, L = p.layer;
    const float mu_r = p.rw_mu[L * 1696 + c], mu_k = p.rw_mu[L * 1696 + 512 + c], mu_v = p.rw_mu[L * 1696 + 1024 + c];
    const float w0 = p.rw_w0[L * 512 + c], a0 = p.rw_a0[L * 512 + c], kkc = p.rw_kk[L * 512 + c], kac = p.rw_ka[L * 512 + c], rkc = p.rw_rk[L * 512 + c];
    float lb = 0.f;
    if (L == 1) { const float l0 = p.hg_lb_logits[c], l1 = p.hg_lb_logits[512 + c]; const float m = fmaxf(l0, l1); const float e0 = expf(l0 - m), e1 = expf(l1 - m); lb = e1 / (e0 + e1); }
    const float* w2 = p.rw_w2 + (size_t)L * 32 * 512; const float* a2 = p.rw_a2 + (size_t)L * 32 * 512; const float* g2 = p.rw_g2 + (size_t)L * 96 * 512;
    const float* gg2 = p.gla_g2 + (size_t)L * 16 * 256; const float gbc = (c < 256) ? p.gla_gb[L * 256 + c] : 0.f;
    for (int t = blockIdx.x; t < T; t += gridDim.x) {
        const bf16_t* zc = p.z + (size_t)t * ZLD;
        const bf16_t* zp = p.z + (size_t)(t > 0 ? t - 1 : 0) * ZLD;
        __syncthreads();
        if (c < 160) {
            const float cur = bf2f(zc[RW_LW + c]); const float prev = (t > 0) ? bf2f(zp[RW_LW + c]) : 0.f;
            const float zs = cur + (prev - cur) * p.rw_mu[L * 1696 + 1536 + c];
            lr[c] = (c < 32) ? tanhf(zs) : (c < 64 ? zs : sigmoidf_(zs));
        } else if (c >= 192 && c < 208) glg[c - 192] = bf2f(zc[GL_LG + (c - 192)]);
        __syncthreads();
        float r, k, v;
        { const float cr = bf2f(zc[RW_R + c]), ck = bf2f(zc[RW_K + c]), cv = bf2f(zc[RW_V + c]);
          const float pr = (t > 0) ? bf2f(zp[RW_R + c]) : 0.f, pk = (t > 0) ? bf2f(zp[RW_K + c]) : 0.f, pv = (t > 0) ? bf2f(zp[RW_V + c]) : 0.f;
          r = cr + (pr - cr) * mu_r; k = ck + (pk - ck) * mu_k; v = cv + (pv - cv) * mu_v; }
        float accW = w0, accA = a0, accG = 0.f;
#pragma unroll 8
        for (int j = 0; j < 32; ++j) { accW += lr[j] * w2[j * 512 + c]; accA += lr[32 + j] * a2[j * 512 + c]; }
#pragma unroll 8
        for (int j = 0; j < 96; ++j) accG += lr[64 + j] * g2[j * 512 + c];
        const float w_raw = -softplusf_(-accW) - 0.5f;
        const float decay = expf(-expf(w_raw));
        const float iclr = sigmoidf_(accA);
        const float kk = k * kkc;
        const float nrm = sqrtf(wave_sum(kk * kk));
        const float kkn = kk / fmaxf(nrm, 1e-12f);
        const float kmod = k * (1.0f + (iclr - 1.0f) * kac);
        const float bon = wave_sum(r * kmod * rkc) * v;
        const size_t o = (size_t)t * 512 + c;
        p.rR[o] = r; p.rW[o] = decay; p.rK[o] = kmod; p.rV[o] = v; p.rA[o] = -kkn; p.rB[o] = kkn * iclr; p.rGate[o] = accG; p.rBonus[o] = bon;
        { const float q = bf2f(zc[HG_Q + c]), f = bf2f(zc[HG_F + c]), i = bf2f(zc[HG_I + c]);
          const float omf = (1.0f - lb) * sigmoidf_(-f);
          p.hQ[o] = siluf_(q); p.hW[o] = 1.0f - omf; p.hK[o] = omf; p.hV[o] = i; }
        p.gV[o] = bf2f(zc[GL_V + c]);
        if (c < 256) {
            float acc = gbc;
#pragma unroll
            for (int j = 0; j < 16; ++j) acc += glg[j] * gg2[j * 256 + c];
            const float log_alpha = -softplusf_(-acc) * (1.0f / 16.0f);
            const size_t og = (size_t)t * 256 + c;
            p.gQ[og] = bf2f(zc[GL_Q + c]) * 0.125f; p.gW[og] = expf(log_alpha); p.gK[og] = bf2f(zc[GL_K + c]);
        }
    }
}

template <int KPL, bool HAS_SA>
__global__ __launch_bounds__(64) void k_rowrec(const float* __restrict__ Q, const float* __restrict__ Wd, const float* __restrict__ Kk, const float* __restrict__ V,
                                               const float* __restrict__ Aa, const float* __restrict__ Bb, float* __restrict__ O, int sq, int DV) {
    constexpr int DK = 64 * KPL;
    const int row = blockIdx.x, h = row / DV, lane = threadIdx.x;
    float S[KPL];
#pragma unroll
    for (int i = 0; i < KPL; ++i) S[i] = 0.f;
    const size_t qoff = (size_t)h * DK + lane;
    float obuf = 0.f;
    for (int t0 = 0; t0 < T; t0 += 8) {
        float q_[8][KPL], w_[8][KPL], k_[8][KPL], a_[8][KPL], b_[8][KPL], v_[8];
#pragma unroll
        for (int u = 0; u < 8; ++u) {
            const size_t base = (size_t)(t0 + u) * sq + qoff;
#pragma unroll
            for (int i = 0; i < KPL; ++i) {
                q_[u][i] = Q[base + 64 * i]; w_[u][i] = Wd[base + 64 * i]; k_[u][i] = Kk[base + 64 * i];
                if (HAS_SA) { a_[u][i] = Aa[base + 64 * i]; b_[u][i] = Bb[base + 64 * i]; } else { a_[u][i] = 0.f; b_[u][i] = 0.f; }
            }
            v_[u] = V[(size_t)(t0 + u) * 512 + row];
        }
#pragma unroll
        for (int u = 0; u < 8; ++u) {
            float sa = 0.f;
            if (HAS_SA) { float d = 0.f;
#pragma unroll
                for (int i = 0; i < KPL; ++i) d += S[i] * a_[u][i];
                sa = wave_sum(d); }
            float d2 = 0.f;
#pragma unroll
            for (int i = 0; i < KPL; ++i) { S[i] = S[i] * w_[u][i] + sa * b_[u][i] + v_[u] * k_[u][i]; d2 += S[i] * q_[u][i]; }
            const float o = wave_sum(d2);
            const int t = t0 + u;
            obuf = (lane == (t & 63)) ? o : obuf;
            if ((t & 63) == 63) O[(size_t)(t - 63 + lane) * 512 + row] = obuf;
        }
    }
}

__global__ __launch_bounds__(512) void k_finish_rms(const float* __restrict__ oraw, const float* __restrict__ gain, const bf16_t* __restrict__ z, bf16_t* __restrict__ bo, int gcol, int pad_) {
    __shared__ float part[8];
    const int c = threadIdx.x, wv = c >> 6;
    for (int t = blockIdx.x; t < T; t += gridDim.x) {
        const float o = oraw[(size_t)t * 512 + c];
        const float ss = wave_sum(o * o);
        __syncthreads();
        if ((c & 63) == 0) part[wv] = ss;
        __syncthreads();
        const float tot = part[(c >> 7) * 2] + part[(c >> 7) * 2 + 1];
        const float rs = rsqrtf(tot * (1.0f / 128.0f) + 1e-5f);
        const float g = bf2f(z[(size_t)t * ZLD + gcol + c]);
        bo[(size_t)t * 512 + c] = f2bf(o * rs * gain[c] * siluf_(g));
    }
}
__global__ __launch_bounds__(512) void k_finish_rw(const float* __restrict__ oraw, const float* __restrict__ lnw, const float* __restrict__ lnb,
                                                   const float* __restrict__ bonus, const float* __restrict__ gate, bf16_t* __restrict__ bo) {
    const int c = threadIdx.x;
    for (int t = blockIdx.x; t < T; t += gridDim.x) {
        const size_t o_ = (size_t)t * 512 + c;
        const float o = oraw[o_];
        const float mu = wave_sum(o) * (1.0f / 64.0f);
        const float d = o - mu;
        const float var = wave_sum(d * d) * (1.0f / 64.0f);
        const float y = d * rsqrtf(var + 64e-5f) * lnw[c] + lnb[c];
        bo[o_] = f2bf((y + bonus[o_]) * gate[o_]);
    }
}

__global__ __launch_bounds__(64) void k_sb_naive(const bf16_t* __restrict__ z, bf16_t* __restrict__ bo) {
    __shared__ float qs[128];
    const int h = blockIdx.x & 3, t = blockIdx.x >> 2, lane = threadIdx.x;
    const bf16_t* qp = z + (size_t)t * ZLD + SB_Q + h * 128;
    qs[lane] = bf2f(qp[lane]); qs[lane + 64] = bf2f(qp[lane + 64]);
    __syncthreads();
    float o0 = 0.f, o1 = 0.f, R = 0.f;
    const float scale = 0.08838834764831845f;
    for (int s_hi = t - 1; s_hi >= 0; s_hi -= 64) {
        const int s = s_hi - lane;
        const bool valid = s >= 0;
        float zz = 0.f;
        if (valid) {
            const bf16_t* kp = z + (size_t)s * ZLD + SB_K + h * 128;
            float acc = 0.f;
#pragma unroll 4
            for (int d8 = 0; d8 < 16; ++d8) {
                const uint4 kv = *(const uint4*)(kp + d8 * 8);
                const unsigned kw[4] = {kv.x, kv.y, kv.z, kv.w};
#pragma unroll
                for (int j = 0; j < 4; ++j) { acc += qs[d8 * 8 + 2 * j] * __uint_as_float(kw[j] << 16); acc += qs[d8 * 8 + 2 * j + 1] * __uint_as_float(kw[j] & 0xffff0000u); }
            }
            zz = acc * scale;
        }
        const float lk = valid ? -softplusf_(zz) : 0.f;
        float incl = lk;
#pragma unroll
        for (int off = 1; off < 64; off <<= 1) { const float y = __shfl_up(incl, off); if (lane >= off) incl += y; }
        const float logw = zz + lk + R + (incl - lk);
        const float w = valid ? expf(logw) : 0.f;
        const int nvalid = (s_hi + 1 < 64) ? s_hi + 1 : 64;
        for (int j = 0; j < nvalid; ++j) {
            const float wj = __shfl(w, j);
            const bf16_t* vp = z + (size_t)(s_hi - j) * ZLD + SB_V + h * 128;
            o0 += wj * bf2f(vp[lane]); o1 += wj * bf2f(vp[lane + 64]);
        }
        R += __shfl(incl, 63);
        if (R < -104.0f) break;
    }
    bo[(size_t)t * 512 + h * 128 + lane] = f2bf(o0); bo[(size_t)t * 512 + h * 128 + 64 + lane] = f2bf(o1);
}

__global__ __launch_bounds__(512) void k_router(const float* __restrict__ x1, const float* __restrict__ wr, const float* __restrict__ rbias,
                                                int* __restrict__ idx, float* __restrict__ wsel, int* __restrict__ hist) {
    __shared__ int hs[64];
    const int tid = threadIdx.x, lane = tid & 63, wv = __builtin_amdgcn_readfirstlane(tid >> 6);
    if (tid < 64) hs[tid] = 0;
    __syncthreads();
    const float bias = rbias[lane];
    for (int it = 0; it < 2; ++it) {
        const int tb = blockIdx.x * 64 + wv * 8 + it * 4;
        float acc[4] = {0.f, 0.f, 0.f, 0.f};
        const float* xp = x1 + (size_t)tb * D;
        for (int k0 = 0; k0 < D; k0 += 4) {
            float wv4[4];
#pragma unroll
            for (int j = 0; j < 4; ++j) wv4[j] = wr[(size_t)(k0 + j) * 64 + lane];
#pragma unroll
            for (int q = 0; q < 4; ++q) {
                const float4 xv = *(const float4*)(xp + (size_t)q * D + k0);
                acc[q] += xv.x * wv4[0]; acc[q] += xv.y * wv4[1]; acc[q] += xv.z * wv4[2]; acc[q] += xv.w * wv4[3];
            }
        }
#pragma unroll
        for (int q = 0; q < 4; ++q) {
            const int t = tb + q;
            const float score = sigmoidf_(acc[q]);
            const float biased = score + bias;
            float m1 = biased;
            m1 = fmaxf(m1, __shfl_xor(m1, 1)); m1 = fmaxf(m1, __shfl_xor(m1, 2)); m1 = fmaxf(m1, __shfl_xor(m1, 4));
            int am = (biased == m1) ? lane : 64;
            am = min(am, __shfl_xor(am, 1)); am = min(am, __shfl_xor(am, 2)); am = min(am, __shfl_xor(am, 4));
            float m2 = (lane == am) ? -INFINITY : biased;
            m2 = fmaxf(m2, __shfl_xor(m2, 1)); m2 = fmaxf(m2, __shfl_xor(m2, 2)); m2 = fmaxf(m2, __shfl_xor(m2, 4));
            const float gs = m1 + m2;
            const int g = lane >> 3;
            int grank = 0;
#pragma unroll
            for (int g2 = 0; g2 < 8; ++g2) { const float o = __shfl(gs, g2 * 8); grank += (o > gs || (o == gs && g2 < g)) ? 1 : 0; }
            const bool gok = grank < 4;
            const float masked = gok ? biased : -INFINITY;
            int rank = 0;
            for (int e2 = 0; e2 < 64; ++e2) { const float o = rdlane(masked, e2); rank += (o > masked || (o == masked && e2 < lane)) ? 1 : 0; }
            const bool sel = rank < 8;
            const float ssum = wave_sum(sel ? score : 0.f);
            if (sel) { idx[(size_t)t * 8 + rank] = lane; wsel[(size_t)t * 8 + rank] = 2.5f * score / ssum; atomicAdd(&hs[lane], 1); }
        }
    }
    __syncthreads();
    if (tid < 64) hist[blockIdx.x * 64 + tid] = hs[tid];
}

__global__ __launch_bounds__(512) void k_dispatch(const int* __restrict__ idx, const float* __restrict__ wsel, const int* __restrict__ hist,
                                                  int* __restrict__ row_tok, float* __restrict__ row_w, int* __restrict__ slotpos,
                                                  int* __restrict__ panel_expert, int* __restrict__ npanels) {
    __shared__ int tot[64], bef[64], pstart[64], es[512];
    __shared__ int np_s;
    const int tid = threadIdx.x, blk = blockIdx.x;
    if (tid < 64) { int b = 0, s = 0; for (int j = 0; j < 256; ++j) { const int c = hist[j * 64 + tid]; if (j < blk) b += c; s += c; } tot[tid] = s; bef[tid] = b; }
    __syncthreads();
    if (tid == 0) { int acc = 0; for (int e = 0; e < 64; ++e) { pstart[e] = acc; acc += (tot[e] + 255) / 256 * 256; } np_s = acc / 256; }
    const int t = blk * 64 + (tid >> 3), k = tid & 7;
    const int e = idx[(size_t)t * 8 + k];
    es[tid] = e;
    __syncthreads();
    int rank = 0;
    for (int j = 0; j < tid; ++j) rank += (es[j] == e) ? 1 : 0;
    const int pos = pstart[e] + bef[e] + rank;
    row_tok[pos] = t; row_w[pos] = wsel[(size_t)t * 8 + k]; slotpos[(size_t)t * 8 + k] = pos;
    const int NP = np_s;
    if (blk < 64) {
        const int ee = blk, st = pstart[ee], cnt = tot[ee], pad = (cnt + 255) / 256 * 256;
        for (int r = st + cnt + tid; r < st + pad; r += 512) { row_tok[r] = 0; row_w[r] = 0.f; }
        for (int pp = st / 256 + tid; pp < (st + pad) / 256; pp += 512) panel_expert[pp] = ee;
    }
    if (tid < 64) { const int tt = blk * 64 + tid; row_tok[NP * 256 + tt] = tt; row_w[NP * 256 + tt] = 1.0f; }
    if (blk == 0) { if (tid < 64) panel_expert[NP + tid] = 64; if (tid == 0) npanels[0] = NP + 64; }
}

__global__ __launch_bounds__(256) void k_combine_ln(const float* __restrict__ x1, const bf16_t* __restrict__ y, const int* __restrict__ slotpos, const int* __restrict__ npanels,
                                                    const float* __restrict__ w, const float* __restrict__ b, float* __restrict__ outf, bf16_t* __restrict__ outb) {
    const int lane = threadIdx.x & 63;
    const int t = blockIdx.x * 4 + (threadIdx.x >> 6);
    const int shared_row = (npanels[0] - 64) * 256 + t;
    int rows[9];
#pragma unroll
    for (int k = 0; k < 8; ++k) rows[k] = slotpos[(size_t)t * 8 + k];
    rows[8] = shared_row;
    float v[32]; float s = 0.f;
#pragma unroll
    for (int i = 0; i < 8; ++i) {
        const int c = i * 256 + lane * 4;
        const float4 x = *(const float4*)(x1 + (size_t)t * D + c);
        float a0 = 0.f, a1 = 0.f, a2 = 0.f, a3 = 0.f;
#pragma unroll
        for (int k = 0; k < 9; ++k) { const uint2 u = *(const uint2*)(y + (size_t)rows[k] * D + c);
            a0 += __uint_as_float(u.x << 16); a1 += __uint_as_float(u.x & 0xffff0000u); a2 += __uint_as_float(u.y << 16); a3 += __uint_as_float(u.y & 0xffff0000u); }
        v[4 * i] = ALPHA * x.x + a0; v[4 * i + 1] = ALPHA * x.y + a1; v[4 * i + 2] = ALPHA * x.z + a2; v[4 * i + 3] = ALPHA * x.w + a3;
        s += (v[4 * i] + v[4 * i + 1]) + (v[4 * i + 2] + v[4 * i + 3]);
    }
    const float mu = wave_sum(s) * (1.0f / D);
    float q = 0.f;
#pragma unroll
    for (int i = 0; i < 32; ++i) { const float d = v[i] - mu; q += d * d; }
    const float rstd = rsqrtf(wave_sum(q) * (1.0f / D) + 1e-5f);
#pragma unroll
    for (int i = 0; i < 8; ++i) {
        const int c = i * 256 + lane * 4;
        const float4 ww = *(const float4*)(w + c), bb = *(const float4*)(b + c);
        float4 o; o.x = (v[4 * i] - mu) * rstd * ww.x + bb.x; o.y = (v[4 * i + 1] - mu) * rstd * ww.y + bb.y; o.z = (v[4 * i + 2] - mu) * rstd * ww.z + bb.z; o.w = (v[4 * i + 3] - mu) * rstd * ww.w + bb.w;
        *(float4*)(outf + (size_t)t * D + c) = o;
        if (outb) { bf16_t* ob = outb + (size_t)t * D + c; ob[0] = f2bf(o.x); ob[1] = f2bf(o.y); ob[2] = f2bf(o.z); ob[3] = f2bf(o.w); }
    }
}


template <class Epi, bool DUAL>
static void launch_ngemm(hipStream_t stream, int mtiles, int ntiles, const bf16_t* A, int lda, const int* rowmap, const float* B0, const float* B1, int ldb,
                         const float* B0s, const float* B1s, size_t estride, const int* panel_expert, const int* npanels, int N, int K, const Epi& epi) {
    GemmArgs<Epi> ga; memset(&ga, 0, sizeof ga);
    ga.A = A; ga.rowmap = rowmap; ga.B0 = B0; ga.B1 = B1; ga.B0s = B0s; ga.B1s = B1s; ga.estride = estride; ga.panel_expert = panel_expert; ga.npanels = npanels;
    ga.lda = lda; ga.ldb = ldb; ga.N = N; ga.K = K; memcpy(&ga.epi, &epi, sizeof(Epi));
    k_ngemm<Epi, DUAL><<<dim3(mtiles, ntiles), 256, 0, stream>>>(ga);
}
template <class E> static E zeroed() { E e; memset(&e, 0, sizeof e); return e; }
extern "C" void kernel_launch(void* const* d_in, const int* in_sizes, int n_in, void* d_out, int out_size, void* d_ws, size_t ws_size, hipStream_t stream) {
    const float* x_in = (const float*)d_in[0];
    const float* w_in = (const float*)d_in[1];
    const float* hg_lb = (const float*)d_in[2];
    const float* hg_norm_w = (const float*)d_in[3];
    const float* rw_mu = (const float*)d_in[4];
    const float* rw_w0 = (const float*)d_in[5];
    const float* rw_w2 = (const float*)d_in[6];
    const float* rw_a0 = (const float*)d_in[7];
    const float* rw_a2 = (const float*)d_in[8];
    const float* rw_g2 = (const float*)d_in[9];
    const float* rw_kk = (const float*)d_in[10];
    const float* rw_ka = (const float*)d_in[11];
    const float* rw_rk = (const float*)d_in[12];
    const float* rw_ln_w = (const float*)d_in[13];
    const float* rw_ln_b = (const float*)d_in[14];
    const float* gla_g2 = (const float*)d_in[15];
    const float* gla_gb = (const float*)d_in[16];
    const float* gla_norm_w = (const float*)d_in[17];
    const float* w_br = (const float*)d_in[18];
    const float* w_out = (const float*)d_in[19];
    const float* ln1_w = (const float*)d_in[20];
    const float* ln1_b = (const float*)d_in[21];
    const float* w_router = (const float*)d_in[22];
    const float* router_bias = (const float*)d_in[23];
    const float* we_gate = (const float*)d_in[24];
    const float* we_up = (const float*)d_in[25];
    const float* we_down = (const float*)d_in[26];
    const float* ws_gate = (const float*)d_in[27];
    const float* ws_up = (const float*)d_in[28];
    const float* ws_down = (const float*)d_in[29];
    const float* ln2_w = (const float*)d_in[30];
    const float* ln2_b = (const float*)d_in[31];

    char* base = (char*)d_ws; size_t off = 0;
    auto take = [&](size_t bytes) { char* p = base + off; off += (bytes + 255) & ~(size_t)255; return p; };
    const size_t MiB = 1024 * 1024;
    char* regY = take((size_t)MAXROWS * D * 2 > ((size_t)T * ZLD * 2 + 8 * (size_t)T * 512 * 4) ? (size_t)MAXROWS * D * 2 : ((size_t)T * ZLD * 2 + 8 * (size_t)T * 512 * 4 + 4096));
    bf16_t* z = (bf16_t*)regY;
    float* rwa = (float*)(regY + (((size_t)T * ZLD * 2 + 255) & ~(size_t)255));
    float *rR = rwa, *rW = rwa + (size_t)T * 512, *rK = rwa + 2 * (size_t)T * 512, *rV = rwa + 3 * (size_t)T * 512, *rA = rwa + 4 * (size_t)T * 512, *rB = rwa + 5 * (size_t)T * 512,
          *rGate = rwa + 6 * (size_t)T * 512, *rBonus = rwa + 7 * (size_t)T * 512;
    bf16_t* ybuf = (bf16_t*)regY;
    bf16_t* xb = (bf16_t*)take((size_t)T * D * 2);
    float* hQ = (float*)take((size_t)T * 512 * 4); float* hW = (float*)take((size_t)T * 512 * 4); float* hK = (float*)take((size_t)T * 512 * 4); float* hV = (float*)take((size_t)T * 512 * 4);
    float* gQ = (float*)take((size_t)T * 256 * 4); float* gW = (float*)take((size_t)T * 256 * 4); float* gK = (float*)take((size_t)T * 256 * 4); float* gV = (float*)take((size_t)T * 512 * 4);
    float* oraw = (float*)take(3 * (size_t)T * 512 * 4);
    bf16_t* bo = (bf16_t*)take(4 * (size_t)T * 512 * 2);
    float* merged = (float*)take((size_t)T * D * 4);
    bf16_t* mergedb = (bf16_t*)take((size_t)T * D * 2);
    float* pre = (float*)take((size_t)T * D * 4);
    float* x1 = (float*)take((size_t)T * D * 4);
    bf16_t* x1b = (bf16_t*)take((size_t)T * D * 2);
    bf16_t* hbuf = (bf16_t*)take((size_t)MAXROWS * FW * 2);
    float* x2 = (float*)take((size_t)T * D * 4);
    int* idx = (int*)take((size_t)T * 8 * 4); float* wsel = (float*)take((size_t)T * 8 * 4); int* hist = (int*)take(256 * 64 * 4);
    int* row_tok = (int*)take((size_t)MAXROWS * 4); float* row_w = (float*)take((size_t)MAXROWS * 4); int* slotpos = (int*)take((size_t)T * 8 * 4);
    int* panel_expert = (int*)take(MAXPANELS * 4); int* npanels = (int*)take(256);
    if (off > ws_size) { fprintf(stderr, "workspace too small: need %zu MiB, have %zu MiB\n", off / MiB, ws_size / MiB); return; }

    for (int L = 0; L < 2; ++L) {
        const float* xin = (L == 0) ? x_in : x2;
        float* xout = (L == 0) ? x2 : (float*)d_out;
        if (L == 0) k_cvt_bf16<<<2048, 256, 0, stream>>>(x_in, xb, (size_t)T * D);
        { EpiZ e = zeroed<EpiZ>(); e.z = z; launch_ngemm<EpiZ, false>(stream, T / 128, (ZW + 127) / 128, xb, D, nullptr, w_in + (size_t)L * D * ZW, nullptr, ZW, nullptr, nullptr, 0, nullptr, nullptr, ZW, D, e); }
        PrepArgs pa; memset(&pa, 0, sizeof pa); pa.z = z; pa.layer = L; pa.hg_lb_logits = hg_lb; pa.rw_mu = rw_mu; pa.rw_w0 = rw_w0; pa.rw_w2 = rw_w2; pa.rw_a0 = rw_a0; pa.rw_a2 = rw_a2; pa.rw_g2 = rw_g2;
        pa.rw_kk = rw_kk; pa.rw_ka = rw_ka; pa.rw_rk = rw_rk; pa.gla_g2 = gla_g2; pa.gla_gb = gla_gb;
        pa.rR = rR; pa.rW = rW; pa.rK = rK; pa.rV = rV; pa.rA = rA; pa.rB = rB; pa.rGate = rGate; pa.rBonus = rBonus;
        pa.hQ = hQ; pa.hW = hW; pa.hK = hK; pa.hV = hV; pa.gQ = gQ; pa.gW = gW; pa.gK = gK; pa.gV = gV;
        k_prep<<<2048, 512, 0, stream>>>(pa);
        float* oH = oraw; float* oR = oraw + (size_t)T * 512; float* oG = oraw + 2 * (size_t)T * 512;
        k_rowrec<2, false><<<512, 64, 0, stream>>>(hQ, hW, hK, hV, nullptr, nullptr, oH, 512, 128);
        k_rowrec<1, true><<<512, 64, 0, stream>>>(rR, rW, rK, rV, rA, rB, oR, 512, 64);
        k_rowrec<1, false><<<512, 64, 0, stream>>>(gQ, gW, gK, gV, nullptr, nullptr, oG, 256, 128);
        k_sb_naive<<<4 * T, 64, 0, stream>>>(z, bo + 2 * (size_t)T * 512);
        k_finish_rms<<<2048, 512, 0, stream>>>(oH, hg_norm_w + L * 512, z, bo, HG_G, 0);
        k_finish_rw<<<2048, 512, 0, stream>>>(oR, rw_ln_w + L * 512, rw_ln_b + L * 512, rBonus, rGate, bo + (size_t)T * 512);
        k_finish_rms<<<2048, 512, 0, stream>>>(oG, gla_norm_w + L * 512, z, bo + 3 * (size_t)T * 512, GL_R, 0);
        for (int g = 0; g < 4; ++g)
            { EpiGate e = zeroed<EpiGate>(); e.z = z; e.merged = merged; e.mergedb = mergedb; e.g = g; launch_ngemm<EpiGate, false>(stream, T / 128, D / 128, bo + (size_t)g * T * 512, 512, nullptr, w_br + ((size_t)L * 4 + g) * 512 * D, nullptr, D, nullptr, nullptr, 0, nullptr, nullptr, D, 512, e); }
        { EpiRes e = zeroed<EpiRes>(); e.xin = xin; e.pre = pre; launch_ngemm<EpiRes, false>(stream, T / 128, D / 128, mergedb, D, nullptr, w_out + (size_t)L * D * D, nullptr, D, nullptr, nullptr, 0, nullptr, nullptr, D, D, e); }
        k_ln<<<T / 4, 256, 0, stream>>>(pre, ln1_w + L * D, ln1_b + L * D, x1, x1b);
        k_router<<<256, 512, 0, stream>>>(x1, w_router + (size_t)L * D * NE, router_bias + L * NE, idx, wsel, hist);
        k_dispatch<<<256, 512, 0, stream>>>(idx, wsel, hist, row_tok, row_w, slotpos, panel_expert, npanels);
        { EpiSwiglu e = zeroed<EpiSwiglu>(); e.h = hbuf; launch_ngemm<EpiSwiglu, true>(stream, MAXROWS / 128, FW / 128, x1b, D, row_tok, we_gate + (size_t)L * NE * D * FW, we_up + (size_t)L * NE * D * FW, FW,
            ws_gate + (size_t)L * D * FW, ws_up + (size_t)L * D * FW, (size_t)D * FW, panel_expert, npanels, FW, D, e); }
        { EpiDown e = zeroed<EpiDown>(); e.y = ybuf; e.row_w = row_w; launch_ngemm<EpiDown, false>(stream, MAXROWS / 128, D / 128, hbuf, FW, nullptr, we_down + (size_t)L * NE * FW * D, nullptr, D,
            ws_down + (size_t)L * FW * D, nullptr, (size_t)FW * D, panel_expert, npanels, D, FW, e); }
        k_combine_ln<<<T / 4, 256, 0, stream>>>(x1, ybuf, slotpos, npanels, ln2_w + L * D, ln2_b + L * D, xout, (L == 0) ? xb : nullptr);
    }
}
```

```cpp
#include <hip/hip_runtime.h>
#include <stdint.h>
#include <stdio.h>
#include <string.h>

typedef unsigned short bf16_t;

constexpr int T = 16384, D = 2048, ZW = 15024, ZLD = 15104, NE = 64, FW = 512;
constexpr int HG_Q = 0, HG_F = 512, HG_I = 1024, HG_G = 1536;
constexpr int RW_R = 2048, RW_K = 2560, RW_V = 3072, RW_LW = 3584;
constexpr int SB_Q = 3744, SB_K = 4256, SB_V = 4768;
constexpr int GL_Q = 5280, GL_K = 5536, GL_V = 5792, GL_LG = 6304, GL_R = 6320;
constexpr int GATE0 = 6832;
constexpr float ALPHA = 1.4142135623730951f;
constexpr int MAXPANELS = 640;
constexpr int MAXROWS = MAXPANELS * 256;

__device__ __forceinline__ float bf2f(bf16_t v) { return __uint_as_float(((unsigned)v) << 16); }
__device__ __forceinline__ bf16_t f2bf(float f) { unsigned u = __float_as_uint(f); u += 0x7FFFu + ((u >> 16) & 1u); return (bf16_t)(u >> 16); }
__device__ __forceinline__ float sigmoidf_(float x) { return 1.0f / (1.0f + expf(-x)); }
__device__ __forceinline__ float softplusf_(float x) { return fmaxf(x, 0.f) + log1pf(expf(-fabsf(x))); }
__device__ __forceinline__ float siluf_(float x) { return x / (1.0f + expf(-x)); }

template <int CTRL> __device__ __forceinline__ float dppmov(float x) {
    return __builtin_bit_cast(float, __builtin_amdgcn_update_dpp(0, __builtin_bit_cast(int, x), CTRL, 0xF, 0xF, true));
}
__device__ __forceinline__ float rdlane(float x, int l) { return __builtin_bit_cast(float, __builtin_amdgcn_readlane(__builtin_bit_cast(int, x), l)); }
__device__ __forceinline__ float wave_sum(float x) {
    x += dppmov<0xB1>(x);
    x += dppmov<0x4E>(x);
    x += dppmov<0x141>(x);
    x += dppmov<0x140>(x);
    return (rdlane(x, 0) + rdlane(x, 16)) + (rdlane(x, 32) + rdlane(x, 48));
}

struct EpiZ { bf16_t* z; __device__ void operator()(int m, int n, float a0, float) const { z[(size_t)m * ZLD + n] = f2bf(a0); } };
struct EpiGate { const bf16_t* z; float* merged; bf16_t* mergedb; int g; int pad_;
    __device__ void operator()(int m, int n, float a0, float) const {
        const float gl = bf2f(z[(size_t)m * ZLD + GATE0 + g * D + n]);
        float v = sigmoidf_(gl) * a0;
        const size_t o = (size_t)m * D + n;
        if (g > 0) v += merged[o];
        merged[o] = v;
        if (g == 3) mergedb[o] = f2bf(v);
    } };
struct EpiRes { const float* xin; float* pre; __device__ void operator()(int m, int n, float a0, float) const { const size_t o = (size_t)m * D + n; pre[o] = ALPHA * xin[o] + a0; } };
struct EpiSwiglu { bf16_t* h; __device__ void operator()(int m, int n, float a0, float a1) const { h[(size_t)m * FW + n] = f2bf(siluf_(a0) * a1); } };
struct EpiDown { bf16_t* y; const float* row_w; __device__ void operator()(int m, int n, float a0, float) const { y[(size_t)m * D + n] = f2bf(a0 * row_w[m]); } };

template <class Epi> struct GemmArgs { const bf16_t* A; const int* rowmap; const float *B0, *B1, *B0s, *B1s; size_t estride; const int* panel_expert; const int* npanels; int lda, ldb, N, K; Epi epi; };
template <class Epi, bool DUAL>
__global__ __launch_bounds__(256) void k_ngemm(const GemmArgs<Epi> ga) {
    const bf16_t* __restrict__ A = ga.A; const int* __restrict__ rowmap = ga.rowmap; const float* __restrict__ B0 = ga.B0; const float* __restrict__ B1 = ga.B1;
    const float* __restrict__ B0s = ga.B0s; const float* __restrict__ B1s = ga.B1s; const size_t estride = ga.estride;
    const int* __restrict__ panel_expert = ga.panel_expert; const int* __restrict__ npanels = ga.npanels; const int lda = ga.lda, ldb = ga.ldb, N = ga.N, K = ga.K; const Epi epi = ga.epi;
    __shared__ float As[16][132];
    __shared__ float Bs0[16][132];
    __shared__ float Bs1[DUAL ? 16 : 1][132];
    const int tid = threadIdx.x, tx = tid & 15, ty = tid >> 4;
    const int m0 = blockIdx.x * 128, n0 = blockIdx.y * 128;
    const float* Bp0 = B0; const float* Bp1 = B1;
    if (panel_expert) {
        const int p = m0 >> 8;
        if (p >= *npanels) return;
        const int e = panel_expert[p];
        if (e < NE) { Bp0 = B0 + (size_t)e * estride; if constexpr (DUAL) Bp1 = B1 + (size_t)e * estride; }
        else { Bp0 = B0s; if constexpr (DUAL) Bp1 = B1s; }
    }
    float acc0[8][8], acc1[DUAL ? 8 : 1][8];
#pragma unroll
    for (int i = 0; i < 8; ++i)
#pragma unroll
        for (int j = 0; j < 8; ++j) { acc0[i][j] = 0.f; if constexpr (DUAL) acc1[i][j] = 0.f; }
    const int arow = tid >> 1, akh = tid & 1;
    const int am = m0 + arow;
    const size_t asrc = (size_t)(rowmap ? rowmap[am] : am) * lda + akh * 8;
    const int bk = tid >> 4, bn = (tid & 15) * 8;
    for (int k0 = 0; k0 < K; k0 += 16) {
        const uint4 av = *(const uint4*)(A + asrc + k0);
        const unsigned aw[4] = {av.x, av.y, av.z, av.w};
#pragma unroll
        for (int j = 0; j < 4; ++j) { As[akh * 8 + 2 * j][arow] = __uint_as_float(aw[j] << 16); As[akh * 8 + 2 * j + 1][arow] = __uint_as_float(aw[j] & 0xffff0000u); }
#pragma unroll
        for (int q = 0; q < 2; ++q) {
            const int n = n0 + bn + q * 4;
            float4 v0 = make_float4(0.f, 0.f, 0.f, 0.f), v1 = v0;
            if (n < N) { v0 = *(const float4*)(Bp0 + (size_t)(k0 + bk) * ldb + n); if constexpr (DUAL) v1 = *(const float4*)(Bp1 + (size_t)(k0 + bk) * ldb + n); }
            *(float4*)&Bs0[bk][bn + q * 4] = v0;
            if constexpr (DUAL) *(float4*)&Bs1[bk][bn + q * 4] = v1;
        }
        __syncthreads();
#pragma unroll
        for (int k = 0; k < 16; ++k) {
            float a[8], b[8], c[8];
            *(float4*)&a[0] = *(const float4*)&As[k][ty * 8]; *(float4*)&a[4] = *(const float4*)&As[k][ty * 8 + 4];
            *(float4*)&b[0] = *(const float4*)&Bs0[k][tx * 8]; *(float4*)&b[4] = *(const float4*)&Bs0[k][tx * 8 + 4];
            if constexpr (DUAL) { *(float4*)&c[0] = *(const float4*)&Bs1[k][tx * 8]; *(float4*)&c[4] = *(const float4*)&Bs1[k][tx * 8 + 4]; }
#pragma unroll
            for (int i = 0; i < 8; ++i)
#pragma unroll
                for (int j = 0; j < 8; ++j) { acc0[i][j] += a[i] * b[j]; if constexpr (DUAL) acc1[i][j] += a[i] * c[j]; }
        }
        __syncthreads();
    }
#pragma unroll
    for (int i = 0; i < 8; ++i)
#pragma unroll
        for (int j = 0; j < 8; ++j) { const int m = m0 + ty * 8 + i, n = n0 + tx * 8 + j; if (n < N) { float a1 = 0.f; if constexpr (DUAL) a1 = acc1[i][j]; epi(m, n, acc0[i][j], a1); } }
}


#define LAS __attribute__((address_space(3)))
namespace pg8 {
typedef short bf16x8 __attribute__((ext_vector_type(8)));
typedef float f32x4 __attribute__((ext_vector_type(4)));
typedef unsigned u32x4 __attribute__((ext_vector_type(4)));
typedef unsigned u32x2 __attribute__((ext_vector_type(2)));
constexpr int BM = 256, BK = 64, HALF = 128, HTB = HALF * BK * 2, STAGE_BYTES = 8 * HTB, NXCD = 8, WGM = 8;
constexpr int GTAB_BYTES = 512 * 16;
__host__ __device__ __forceinline__ int lds_byte(int r, int c) { const int st = (r >> 4) * 2 + (c >> 5), rr = r & 15, cc = c & 31, ob = rr * 64 + cc * 2; return st * 1024 + (ob ^ (((ob >> 9) & 1) << 5)); }
__host__ __device__ __forceinline__ void stage_rc(int b, int& R, int& C) { const int st = b / 1024, sb = b % 1024, swz = sb ^ (((sb >> 9) & 1) << 5); R = (st >> 1) * 16 + swz / 64; C = (st & 1) * 32 + (swz % 64) / 2; }
__host__ __device__ __forceinline__ int perm32(int rho) { const int n = rho >> 4, i = rho & 15; return 8 * (i >> 2) + 4 * n + (i & 3); }
struct Unit { int pm, pn, e; };
__device__ __forceinline__ unsigned cvt_pk_bf16(float lo, float hi) { unsigned r; asm volatile("v_cvt_pk_bf16_f32 %0, %1, %2" : "=v"(r) : "v"(lo), "v"(hi)); return r; }

struct StaticOrder {
    const bf16_t* A; const bf16_t* Bt; int K; int nM, nN, nwg, G, c;
    __device__ void init(const bf16_t* A_, const bf16_t* Bt_, int M, int N, int K_, int G_, int c_) { A = A_; Bt = Bt_; K = K_; nM = M / BM; nN = N / BM; nwg = nM * nN; G = G_; c = c_; }
    __device__ bool next(int i, Unit& u) const {
        const int L = i * G + c; if (L >= nwg) return false;
        int wgid = L; { const int q = nwg / NXCD, r = nwg % NXCD, xcd = wgid % NXCD, off = wgid / NXCD; wgid = (xcd < r ? xcd * (q + 1) : r * (q + 1) + (xcd - r) * q) + off; }
        const int nig = WGM * nN, gid = wgid / nig, fm = gid * WGM, gsz = (nM - fm) < WGM ? (nM - fm) : WGM;
        u.pm = fm + ((wgid % nig) % gsz); u.pn = (wgid % nig) / gsz; u.e = 0; return true;
    }
    __device__ __forceinline__ const char* a_base(const Unit& u) const { return (const char*)A + (size_t)u.pm * 256 * K * 2; }
    __device__ __forceinline__ const char* b_base(const Unit& u) const { return (const char*)Bt + (size_t)u.pn * 256 * K * 2; }
    __device__ __forceinline__ const int* rowmap() const { return nullptr; }
};
struct MoeOrder {
    const bf16_t* A; const bf16_t* Bt; const int* panel_expert; const int* rmap; size_t estride; int K, NT, total, G, c;
    __device__ void init(const bf16_t* A_, const bf16_t* Bt_, size_t estride_, const int* pe, const int* rmap_, int npanels, int NT_, int K_, int G_, int c_) {
        A = A_; Bt = Bt_; estride = estride_; panel_expert = pe; rmap = rmap_; K = K_; NT = NT_; total = npanels * NT_; G = G_;
        c = (c_ & 7) * (G_ >> 3) + (c_ >> 3);
    }
    __device__ bool next(int i, Unit& u) const {
        const int L = i * G + c; if (L >= total) return false;
        u.pm = L / NT; u.pn = L % NT; u.e = panel_expert[u.pm]; return true;
    }
    __device__ __forceinline__ const char* a_base(const Unit& u) const { return rmap ? (const char*)A : (const char*)A + (size_t)u.pm * 256 * K * 2; }
    __device__ __forceinline__ const char* b_base(const Unit& u) const { return (const char*)(Bt + (size_t)u.e * estride) + (size_t)u.pn * 256 * K * 2; }
    __device__ __forceinline__ const int* rowmap() const { return rmap; }
};

struct EpiZ16 {
    static constexpr bool PERM = true;
    bf16_t* O; int ldc; int pad_;
    __device__ __forceinline__ void operator()(const f32x4 (&acc)[2][2][4][2], const Unit& u, int wr, int wc, int fr, int fq) const {
        const int row0 = u.pm * BM + wr * 64 + fr, col0 = u.pn * BM + wc * 32 + 8 * fq;
#pragma unroll
        for (int ai = 0; ai < 2; ++ai)
#pragma unroll
            for (int m = 0; m < 4; ++m) { bf16_t* rowp = O + (size_t)(row0 + ai * HALF + m * 16) * ldc + col0;
#pragma unroll
                for (int bj = 0; bj < 2; ++bj) { const f32x4 v0 = acc[ai][bj][m][0], v1 = acc[ai][bj][m][1];
                    u32x4 w; w.x = cvt_pk_bf16(v0[0], v0[1]); w.y = cvt_pk_bf16(v0[2], v0[3]); w.z = cvt_pk_bf16(v1[0], v1[1]); w.w = cvt_pk_bf16(v1[2], v1[3]);
                    *(u32x4*)(rowp + bj * HALF) = w; } }
    }
};
struct EpiGateAcc {
    static constexpr bool PERM = false;
    const bf16_t* zg; float* merged; bf16_t* mergedb; int g; int pad_;
    __device__ __forceinline__ void operator()(const f32x4 (&acc)[2][2][4][2], const Unit& u, int wr, int wc, int fr, int fq) const {
        const int row0 = u.pm * BM + wr * 64 + fr, col0 = u.pn * BM + wc * 32 + 4 * fq;
#pragma unroll
        for (int ai = 0; ai < 2; ++ai)
#pragma unroll
            for (int m = 0; m < 4; ++m) { const size_t row = (size_t)(row0 + ai * HALF + m * 16);
#pragma unroll
                for (int bj = 0; bj < 2; ++bj)
#pragma unroll
                    for (int n = 0; n < 2; ++n) { const int col = col0 + bj * HALF + n * 16;
                        const u32x2 gz = *(const u32x2*)(zg + row * ZLD + col);
                        f32x4 gl; gl[0] = __uint_as_float(gz.x << 16); gl[1] = __uint_as_float(gz.x & 0xffff0000u); gl[2] = __uint_as_float(gz.y << 16); gl[3] = __uint_as_float(gz.y & 0xffff0000u);
                        f32x4 v = acc[ai][bj][m][n];
#pragma unroll
                        for (int j = 0; j < 4; ++j) v[j] *= 1.0f / (1.0f + __expf(-gl[j]));
                        float* mp = merged + row * D + col;
                        if (g > 0) v += *(const f32x4*)mp;
                        if (g < 3) *(f32x4*)mp = v;
                        else { u32x2 w; w.x = cvt_pk_bf16(v[0], v[1]); w.y = cvt_pk_bf16(v[2], v[3]); *(u32x2*)(mergedb + row * D + col) = w; } } }
    }
};
struct EpiResid {
    static constexpr bool PERM = false;
    const float* xin; float* pre;
    __device__ __forceinline__ void operator()(const f32x4 (&acc)[2][2][4][2], const Unit& u, int wr, int wc, int fr, int fq) const {
        const int row0 = u.pm * BM + wr * 64 + fr, col0 = u.pn * BM + wc * 32 + 4 * fq;
#pragma unroll
        for (int ai = 0; ai < 2; ++ai)
#pragma unroll
            for (int m = 0; m < 4; ++m) { const size_t ro = (size_t)(row0 + ai * HALF + m * 16) * D + col0;
#pragma unroll
                for (int bj = 0; bj < 2; ++bj)
#pragma unroll
                    for (int n = 0; n < 2; ++n) { const f32x4 xv = *(const f32x4*)(xin + ro + bj * HALF + n * 16); *(f32x4*)(pre + ro + bj * HALF + n * 16) = xv * ALPHA + acc[ai][bj][m][n]; } }
    }
};
struct EpiSwi {
    static constexpr bool PERM = true;
    bf16_t* h;
    __device__ __forceinline__ void operator()(const f32x4 (&acc)[2][2][4][2], const Unit& u, int wr, int wc, int fr, int fq) const {
        const int row0 = u.pm * BM + wr * 64 + fr, col0 = u.pn * HALF + wc * 32 + 8 * fq;
#pragma unroll
        for (int ai = 0; ai < 2; ++ai)
#pragma unroll
            for (int m = 0; m < 4; ++m) { float o[8];
#pragma unroll
                for (int n = 0; n < 2; ++n)
#pragma unroll
                    for (int j = 0; j < 4; ++j) { const float gt = acc[ai][0][m][n][j], up = acc[ai][1][m][n][j]; o[4 * n + j] = gt / (1.0f + __expf(-gt)) * up; }
                u32x4 w; w.x = cvt_pk_bf16(o[0], o[1]); w.y = cvt_pk_bf16(o[2], o[3]); w.z = cvt_pk_bf16(o[4], o[5]); w.w = cvt_pk_bf16(o[6], o[7]);
                *(u32x4*)(h + (size_t)(row0 + ai * HALF + m * 16) * FW + col0) = w; }
    }
};
struct EpiDownW {
    static constexpr bool PERM = true;
    bf16_t* y; const float* row_w;
    __device__ __forceinline__ void operator()(const f32x4 (&acc)[2][2][4][2], const Unit& u, int wr, int wc, int fr, int fq) const {
        const int row0 = u.pm * BM + wr * 64 + fr, col0 = u.pn * BM + wc * 32 + 8 * fq;
#pragma unroll
        for (int ai = 0; ai < 2; ++ai)
#pragma unroll
            for (int m = 0; m < 4; ++m) { const int row = row0 + ai * HALF + m * 16; const float s = row_w[row]; bf16_t* rowp = y + (size_t)row * D + col0;
#pragma unroll
                for (int bj = 0; bj < 2; ++bj) { const f32x4 v0 = acc[ai][bj][m][0] * s, v1 = acc[ai][bj][m][1] * s;
                    u32x4 w; w.x = cvt_pk_bf16(v0[0], v0[1]); w.y = cvt_pk_bf16(v0[2], v0[3]); w.z = cvt_pk_bf16(v1[0], v1[1]); w.w = cvt_pk_bf16(v1[2], v1[3]);
                    *(u32x4*)(rowp + bj * HALF) = w; } }
    }
};

template <class Epi, class Sched, bool GATHER>
__device__ __forceinline__ void gemm_phase(LAS unsigned char* lds, const int K, const Sched& S, const Epi& E) {
    const int tid = threadIdx.x, wid = __builtin_amdgcn_readfirstlane(tid >> 6), wr = wid >> 2, wc = wid & 3, lane = tid & 63, fr = lane & 15, fq = lane >> 4;
    const int nt = K / BK;
    unsigned voffA[2], voffB[2], voffG[2][2]; int gR[2], gC[2];
#pragma unroll
    for (int i = 0; i < 2; ++i) { int R, C; stage_rc(tid * 16 + i * 8192, R, C); const int Rb = Epi::PERM ? ((R & ~31) + perm32(R & 31)) : R;
        voffA[i] = (unsigned)(R * K + C) * 2u; voffB[i] = (unsigned)(Rb * K + C) * 2u; gR[i] = R; gC[i] = C; voffG[0][i] = 0u; voffG[1][i] = 0u; }
    const size_t kstep = (size_t)(BK * 2);
    const size_t hstep = (size_t)HALF * K * 2;
    const unsigned ldsw = (unsigned)wid * 1024u;
    const int aoff = lds_byte(wr * 64 + fr, fq * 8), boff = lds_byte(wc * 32 + fr, fq * 8);
    LAS u32x4* gtab = (LAS u32x4*)(lds + STAGE_BYTES) + tid;
#define PG8_SA(b, h) (((b) * 2 + (h)) * HTB)
#define PG8_SB(b, h) ((4 + (b) * 2 + (h)) * HTB)
#define PG8_STAGE(bufoff, gbase, voff) do { _Pragma("unroll") for (int _i = 0; _i < 2; ++_i) \
        __builtin_amdgcn_global_load_lds((const unsigned*)((const char*)(gbase) + (voff)[_i]), (LAS unsigned*)(lds + (bufoff) + ldsw + _i * 8192), 16, 0, 0); } while (0)
#define PG8_STAGE_A(bufoff, gbase, h) do { if constexpr (GATHER) PG8_STAGE(bufoff, gbase, voffG[h]); else PG8_STAGE(bufoff, (gbase) + (h) * hstep, voffA); } while (0)
#define PG8_LDA(dst, b, h) do { _Pragma("unroll") for (int m = 0; m < 4; ++m) _Pragma("unroll") for (int k = 0; k < 2; ++k) dst[m][k] = *(const LAS bf16x8*)(lds + PG8_SA(b, h) + aoff + m * 2048 + k * 1024); } while (0)
#define PG8_LDB(dst, b, h) do { _Pragma("unroll") for (int n = 0; n < 2; ++n) _Pragma("unroll") for (int k = 0; k < 2; ++k) dst[n][k] = *(const LAS bf16x8*)(lds + PG8_SB(b, h) + boff + n * 2048 + k * 1024); } while (0)
#define PG8_MMA(ai, bj, At, Bt) do { __builtin_amdgcn_s_setprio(1); _Pragma("unroll") for (int m = 0; m < 4; ++m) _Pragma("unroll") for (int n = 0; n < 2; ++n) _Pragma("unroll") for (int k = 0; k < 2; ++k) \
        acc[ai][bj][m][n] = __builtin_amdgcn_mfma_f32_16x16x32_bf16(Bt[n][k], At[m][k], acc[ai][bj][m][n], 0, 0, 0); __builtin_amdgcn_s_setprio(0); } while (0)
#define PG8_WAIT_V(n) asm volatile("s_waitcnt vmcnt(" #n ")" ::: "memory")
#define PG8_WAIT_L(n) asm volatile("s_waitcnt lgkmcnt(" #n ")" ::: "memory")
#define PG8_BAR __builtin_amdgcn_s_barrier()
#define PG8_SCHED __builtin_amdgcn_sched_barrier(0)
    auto gather_offs = [&](const Unit& u) -> u32x4 {
        const int* rm = S.rowmap(); u32x4 o;
        o.x = (unsigned)(rm[u.pm * 256 + gR[0]] * K + gC[0]) * 2u;       o.y = (unsigned)(rm[u.pm * 256 + gR[1]] * K + gC[1]) * 2u;
        o.z = (unsigned)(rm[u.pm * 256 + 128 + gR[0]] * K + gC[0]) * 2u; o.w = (unsigned)(rm[u.pm * 256 + 128 + gR[1]] * K + gC[1]) * 2u;
        return o; };
    Unit cur, nxt, nn; int ui = 0;
    if (!S.next(0, cur)) return;
    f32x4 acc[2][2][4][2];
#pragma unroll
    for (int a = 0; a < 2; ++a)
#pragma unroll
        for (int b = 0; b < 2; ++b)
#pragma unroll
            for (int m = 0; m < 4; ++m)
#pragma unroll
                for (int n = 0; n < 2; ++n) acc[a][b][m][n] = (f32x4){0.f, 0.f, 0.f, 0.f};
    bf16x8 At[4][2], B0[2][2], B1[2][2];
    const char* cA = S.a_base(cur); const char* cB = S.b_base(cur);
    if constexpr (GATHER) {
        const u32x4 o = gather_offs(cur); voffG[0][0] = o.x; voffG[0][1] = o.y; voffG[1][0] = o.z; voffG[1][1] = o.w;
        if (S.next(1, nn)) *gtab = gather_offs(nn);
        asm volatile("s_waitcnt vmcnt(0) lgkmcnt(0)" ::: "memory");
    }
    PG8_STAGE(PG8_SB(0, 0), cB, voffB); PG8_STAGE(PG8_SB(0, 1), cB + hstep, voffB); PG8_STAGE_A(PG8_SA(0, 0), cA, 0); PG8_STAGE_A(PG8_SA(0, 1), cA, 1);
    if (wr == 1) PG8_BAR;
    PG8_WAIT_V(2); PG8_BAR;
    PG8_STAGE(PG8_SB(1, 0), cB + kstep, voffB); PG8_STAGE_A(PG8_SA(1, 0), cA + kstep, 0); PG8_STAGE(PG8_SB(1, 1), cB + hstep + kstep, voffB);
    PG8_WAIT_V(6); PG8_BAR;
    for (;;) {
        const bool has_next = S.next(ui + 1, nxt);
        const char* nA = has_next ? S.a_base(nxt) : cA; const char* nB = has_next ? S.b_base(nxt) : cB;
        for (int t = 0; t < nt; t += 2) {
            const bool last = (t == nt - 2);
            const char* a1 = cA + (size_t)(t + 1) * kstep;
            const char* a2 = last ? nA : cA + (size_t)(t + 2) * kstep; const char* b2 = last ? nB : cB + (size_t)(t + 2) * kstep;
            const char* a3 = a2 + kstep; const char* b3 = b2 + kstep;
            PG8_LDB(B0, 0, 0); PG8_LDB(B1, 0, 1); PG8_SCHED; PG8_LDA(At, 0, 0); PG8_STAGE_A(PG8_SA(1, 1), a1, 1);
            if constexpr (GATHER) { if (last && has_next) { const u32x4 o = *gtab; voffG[0][0] = o.x; voffG[0][1] = o.y; voffG[1][0] = o.z; voffG[1][1] = o.w; } }
            PG8_WAIT_V(8); PG8_WAIT_L(0); PG8_BAR; PG8_MMA(0, 0, At, B0); PG8_MMA(0, 1, At, B1); PG8_BAR; PG8_SCHED;
            PG8_LDA(At, 0, 1); PG8_STAGE(PG8_SB(0, 0), b2, voffB); PG8_STAGE(PG8_SB(0, 1), b2 + hstep, voffB); PG8_STAGE_A(PG8_SA(0, 0), a2, 0);
            PG8_WAIT_V(8); PG8_WAIT_L(0); PG8_BAR; PG8_MMA(1, 0, At, B0); PG8_MMA(1, 1, At, B1); PG8_BAR; PG8_SCHED;
            PG8_LDB(B0, 1, 0); PG8_LDB(B1, 1, 1); PG8_SCHED; PG8_LDA(At, 1, 0); PG8_STAGE_A(PG8_SA(0, 1), a2, 1);
            PG8_WAIT_V(8); PG8_WAIT_L(0); PG8_BAR; PG8_MMA(0, 0, At, B0); PG8_MMA(0, 1, At, B1); PG8_BAR; PG8_SCHED;
            PG8_LDA(At, 1, 1); PG8_STAGE(PG8_SB(1, 0), b3, voffB); PG8_STAGE(PG8_SB(1, 1), b3 + hstep, voffB); PG8_STAGE_A(PG8_SA(1, 0), a3, 0);
            PG8_WAIT_V(8); PG8_WAIT_L(0); PG8_BAR; PG8_MMA(1, 0, At, B0); PG8_MMA(1, 1, At, B1); PG8_BAR; PG8_SCHED;
        }
        if (wr == 0) PG8_BAR;
        E(acc, cur, wr, wc, fr, fq);
        if constexpr (GATHER) { if (has_next && S.next(ui + 2, nn)) { *gtab = gather_offs(nn); } }
        if (!has_next) break;
#pragma unroll
        for (int a = 0; a < 2; ++a)
#pragma unroll
            for (int b = 0; b < 2; ++b)
#pragma unroll
                for (int m = 0; m < 4; ++m)
#pragma unroll
                    for (int n = 0; n < 2; ++n) acc[a][b][m][n] = (f32x4){0.f, 0.f, 0.f, 0.f};
        cur = nxt; cA = nA; cB = nB; ++ui;
        if (wr == 1) PG8_BAR;
    }
    PG8_WAIT_V(0);
    PG8_BAR;
#undef PG8_SA
#undef PG8_SB
#undef PG8_STAGE
#undef PG8_STAGE_A
#undef PG8_LDA
#undef PG8_LDB
#undef PG8_MMA
#undef PG8_WAIT_V
#undef PG8_WAIT_L
#undef PG8_BAR
#undef PG8_SCHED
}
}


struct PlainGemmArgs { const bf16_t* A; const bf16_t* Bt; int M, N, K, pad_; };
template <class Epi> __global__ __launch_bounds__(512, 2) void k_gplain(PlainGemmArgs a, Epi E) {
    extern __shared__ __attribute__((aligned(16))) unsigned char shm[];
    pg8::StaticOrder S; S.init(a.A, a.Bt, a.M, a.N, a.K, (int)gridDim.x, (int)blockIdx.x);
    pg8::gemm_phase<Epi, pg8::StaticOrder, false>((LAS unsigned char*)shm, a.K, S, E);
}
struct MoeGemmArgs { const bf16_t* A; const bf16_t* Bt; size_t estride; const int* panel_expert; const int* rowmap; const int* npanels; int NT, K; };
template <class Epi, bool GATHER> __global__ __launch_bounds__(512, 2) void k_gmoe(MoeGemmArgs a, Epi E) {
    extern __shared__ __attribute__((aligned(16))) unsigned char shm[];
    pg8::MoeOrder S; S.init(a.A, a.Bt, a.estride, a.panel_expert, GATHER ? a.rowmap : nullptr, *a.npanels, a.NT, a.K, (int)gridDim.x, (int)blockIdx.x);
    pg8::gemm_phase<Epi, pg8::MoeOrder, GATHER>((LAS unsigned char*)shm, a.K, S, E);
}

struct ConvArgs { const float *w_in, *we_gate, *we_up, *we_down, *ws_gate, *ws_up, *ws_down, *w_br, *w_out; bf16_t *WinT, *WguT, *WdT, *WbrT, *WoutT; int layer, pad_; };
constexpr int CV_SEG0 = 32 * 236, CV_SEG1 = 65 * 2 * 32 * 8, CV_SEG2 = 65 * 8 * 32, CV_SEG3 = 4 * 8 * 32, CV_SEG4 = 32 * 32;
constexpr int CV_TOTAL = CV_SEG0 + CV_SEG1 + CV_SEG2 + CV_SEG3 + CV_SEG4;
__device__ __forceinline__ void convert_tiles(const ConvArgs& a, int j0, int j1, int jstart, int jstride, float (*tile)[65]) {
    const int tid = threadIdx.x, L = a.layer;
    for (int j = j0 + jstart; j < j1; j += jstride) {
        const float* src; bf16_t* dst; int ld, ldd, valid = 64;
        if (j < CV_SEG0) { const int kb = j & 31, nb = j >> 5; ld = ZW; ldd = D;
            src = a.w_in + (size_t)L * D * ZW + (size_t)kb * 64 * ZW + nb * 64; valid = ZW - nb * 64; valid = valid < 0 ? 0 : (valid > 64 ? 64 : valid);
            dst = a.WinT + (size_t)nb * 64 * D + kb * 64; }
        else if (j < CV_SEG0 + CV_SEG1) { int q = j - CV_SEG0; const int cb = q & 7; q >>= 3; const int kb = q & 31; q >>= 5; const int bj = q & 1; const int e = q >> 1; ld = FW; ldd = D;
            const float* m = (e < NE) ? ((bj ? a.we_up : a.we_gate) + ((size_t)L * NE + e) * D * FW) : ((bj ? a.ws_up : a.ws_gate) + (size_t)L * D * FW);
            src = m + (size_t)kb * 64 * FW + cb * 64;
            dst = a.WguT + ((size_t)e * 1024 + (cb >> 1) * 256 + bj * 128 + (cb & 1) * 64) * D + kb * 64; }
        else if (j < CV_SEG0 + CV_SEG1 + CV_SEG2) { int q = j - CV_SEG0 - CV_SEG1; const int nb = q & 31; q >>= 5; const int kb = q & 7; const int e = q >> 3; ld = D; ldd = FW;
            const float* m = (e < NE) ? (a.we_down + ((size_t)L * NE + e) * FW * D) : (a.ws_down + (size_t)L * FW * D);
            src = m + (size_t)kb * 64 * D + nb * 64; dst = a.WdT + ((size_t)e * D + nb * 64) * FW + kb * 64; }
        else if (j < CV_SEG0 + CV_SEG1 + CV_SEG2 + CV_SEG3) { int q = j - CV_SEG0 - CV_SEG1 - CV_SEG2; const int nb = q & 31; q >>= 5; const int kb = q & 7; const int g = q >> 3; ld = D; ldd = FW;
            src = a.w_br + ((size_t)L * 4 + g) * FW * D + (size_t)kb * 64 * D + nb * 64; dst = a.WbrT + ((size_t)g * D + nb * 64) * FW + kb * 64; }
        else { const int q = j - CV_SEG0 - CV_SEG1 - CV_SEG2 - CV_SEG3; const int nb = q & 31, kb = q >> 5; ld = D; ldd = D;
            src = a.w_out + (size_t)L * D * D + (size_t)kb * 64 * D + nb * 64; dst = a.WoutT + (size_t)nb * 64 * D + kb * 64; }
        __syncthreads();
        { const int c4 = (tid & 15) * 4, k = tid >> 4;
#pragma unroll
          for (int h = 0; h < 2; ++h) { float4 v = make_float4(0.f, 0.f, 0.f, 0.f); if (c4 < valid) v = *(const float4*)(src + (size_t)(k + 32 * h) * ld + c4);
              tile[k + 32 * h][c4] = v.x; tile[k + 32 * h][c4 + 1] = v.y; tile[k + 32 * h][c4 + 2] = v.z; tile[k + 32 * h][c4 + 3] = v.w; } }
        __syncthreads();
        { const int n = tid >> 3, kc = (tid & 7) * 8; unsigned w[4];
#pragma unroll
          for (int q = 0; q < 4; ++q) w[q] = (unsigned)f2bf(tile[kc + 2 * q][n]) | ((unsigned)f2bf(tile[kc + 2 * q + 1][n]) << 16);
          *(uint4*)(dst + (size_t)n * ldd + kc) = make_uint4(w[0], w[1], w[2], w[3]); }
    }
}
__global__ __launch_bounds__(512) void k_convert(ConvArgs a) {
    __shared__ float tile[64][65];
    convert_tiles(a, 0, CV_TOTAL, blockIdx.x, gridDim.x, tile);
}

__global__ void k_cvt_bf16(const float* __restrict__ src, bf16_t* __restrict__ dst, size_t n) {
    for (size_t i = (size_t)blockIdx.x * blockDim.x + threadIdx.x; i < n; i += (size_t)gridDim.x * blockDim.x) dst[i] = f2bf(src[i]);
}

__global__ __launch_bounds__(256) void k_ln(const float* __restrict__ pre, const float* __restrict__ w, const float* __restrict__ b,
                                            float* __restrict__ outf, bf16_t* __restrict__ outb) {
    const int lane = threadIdx.x & 63;
    const int row = blockIdx.x * 4 + (threadIdx.x >> 6);
    const float* p = pre + (size_t)row * D;
    float v[32]; float s = 0.f;
#pragma unroll
    for (int i = 0; i < 8; ++i) { const float4 x = *(const float4*)(p + i * 256 + lane * 4); v[4 * i] = x.x; v[4 * i + 1] = x.y; v[4 * i + 2] = x.z; v[4 * i + 3] = x.w; s += (x.x + x.y) + (x.z + x.w); }
    const float mu = wave_sum(s) * (1.0f / D);
    float q = 0.f;
#pragma unroll
    for (int i = 0; i < 32; ++i) { const float d = v[i] - mu; q += d * d; }
    const float rstd = rsqrtf(wave_sum(q) * (1.0f / D) + 1e-5f);
#pragma unroll
    for (int i = 0; i < 8; ++i) {
        const int c = i * 256 + lane * 4;
        const float4 ww = *(const float4*)(w + c), bb = *(const float4*)(b + c);
        float4 o; o.x = (v[4 * i] - mu) * rstd * ww.x + bb.x; o.y = (v[4 * i + 1] - mu) * rstd * ww.y + bb.y; o.z = (v[4 * i + 2] - mu) * rstd * ww.z + bb.z; o.w = (v[4 * i + 3] - mu) * rstd * ww.w + bb.w;
        *(float4*)(outf + (size_t)row * D + c) = o;
        if (outb) { bf16_t* ob = outb + (size_t)row * D + c; ob[0] = f2bf(o.x); ob[1] = f2bf(o.y); ob[2] = f2bf(o.z); ob[3] = f2bf(o.w); }
    }
}

struct PrepArgs {
    const bf16_t* z;
    const float *hg_lb_logits, *rw_mu, *rw_w0, *rw_w2, *rw_a0, *rw_a2, *rw_g2, *rw_kk, *rw_ka, *rw_rk, *gla_g2, *gla_gb;
    float *rR, *rW, *rK, *rV, *rA, *rB, *rGate, *rBonus;
    float *hQ, *hW, *hK, *hV;
    float *gQ, *gW, *gK, *gV;
    int layer, pad_;
};
__global__ __launch_bounds__(512) void k_prep(PrepArgs p) {
    __shared__ float lr[160];
    __shared__ float glg[16];
    const int c = threadIdx.x, L = p.layer;
    const float mu_r = p.rw_mu[L * 1696 + c], mu_k = p.rw_mu[L * 1696 + 512 + c], mu_v = p.rw_mu[L * 1696 + 1024 + c];
    const float w0 = p.rw_w0[L * 512 + c], a0 = p.rw_a0[L * 512 + c], kkc = p.rw_kk[L * 512 + c], kac = p.rw_ka[L * 512 + c], rkc = p.rw_rk[L * 512 + c];
    float lb = 0.f;
    if (L == 1) { const float l0 = p.hg_lb_logits[c], l1 = p.hg_lb_logits[512 + c]; const float m = fmaxf(l0, l1); const float e0 = expf(l0 - m), e1 = expf(l1 - m); lb = e1 / (e0 + e1); }
    const float* w2 = p.rw_w2 + (size_t)L * 32 * 512; const float* a2 = p.rw_a2 + (size_t)L * 32 * 512; const float* g2 = p.rw_g2 + (size_t)L * 96 * 512;
    const float* gg2 = p.gla_g2 + (size_t)L * 16 * 256; const float gbc = (c < 256) ? p.gla_gb[L * 256 + c] : 0.f;
    for (int t = blockIdx.x; t < T; t += gridDim.x) {
        const bf16_t* zc = p.z + (size_t)t * ZLD;
        const bf16_t* zp = p.z + (size_t)(t > 0 ? t - 1 : 0) * ZLD;
        __syncthreads();
        if (c < 160) {
            const float cur = bf2f(zc[RW_LW + c]); const float prev = (t > 0) ? bf2f(zp[RW_LW + c]) : 0.f;
            const float zs = cur + (prev - cur) * p.rw_mu[L * 1696 + 1536 + c];
            lr[c] = (c < 32) ? tanhf(zs) : (c < 64 ? zs : sigmoidf_(zs));
        } else if (c >= 192 && c < 208) glg[c - 192] = bf2f(zc[GL_LG + (c - 192)]);
        __syncthreads();
        float r, k, v;
        { const float cr = bf2f(zc[RW_R + c]), ck = bf2f(zc[RW_K + c]), cv = bf2f(zc[RW_V + c]);
          const float pr = (t > 0) ? bf2f(zp[RW_R + c]) : 0.f, pk = (t > 0) ? bf2f(zp[RW_K + c]) : 0.f, pv = (t > 0) ? bf2f(zp[RW_V + c]) : 0.f;
          r = cr + (pr - cr) * mu_r; k = ck + (pk - ck) * mu_k; v = cv + (pv - cv) * mu_v; }
        float accW = w0, accA = a0, accG = 0.f;
#pragma unroll 8
        for (int j = 0; j < 32; ++j) { accW += lr[j] * w2[j * 512 + c]; accA += lr[32 + j] * a2[j * 512 + c]; }
#pragma unroll 8
        for (int j = 0; j < 96; ++j) accG += lr[64 + j] * g2[j * 512 + c];
        const float w_raw = -softplusf_(-accW) - 0.5f;
        const float decay = expf(-expf(w_raw));
        const float iclr = sigmoidf_(accA);
        const float kk = k * kkc;
        const float nrm = sqrtf(wave_sum(kk * kk));
        const float kkn = kk / fmaxf(nrm, 1e-12f);
        const float kmod = k * (1.0f + (iclr - 1.0f) * kac);
        const float bon = wave_sum(r * kmod * rkc) * v;
        const size_t o = (size_t)t * 512 + c;
        p.rR[o] = r; p.rW[o] = decay; p.rK[o] = kmod; p.rV[o] = v; p.rA[o] = -kkn; p.rB[o] = kkn * iclr; p.rGate[o] = accG; p.rBonus[o] = bon;
        { const float q = bf2f(zc[HG_Q + c]), f = bf2f(zc[HG_F + c]), i = bf2f(zc[HG_I + c]);
          const float omf = (1.0f - lb) * sigmoidf_(-f);
          p.hQ[o] = siluf_(q); p.hW[o] = 1.0f - omf; p.hK[o] = omf; p.hV[o] = i; }
        p.gV[o] = bf2f(zc[GL_V + c]);
        if (c < 256) {
            float acc = gbc;
#pragma unroll
            for (int j = 0; j < 16; ++j) acc += glg[j] * gg2[j * 256 + c];
            const float log_alpha = -softplusf_(-acc) * (1.0f / 16.0f);
            const size_t og = (size_t)t * 256 + c;
            p.gQ[og] = bf2f(zc[GL_Q + c]) * 0.125f; p.gW[og] = expf(log_alpha); p.gK[og] = bf2f(zc[GL_K + c]);
        }
    }
}

template <int KPL, bool HAS_SA>
__global__ __launch_bounds__(64) void k_rowrec(const float* __restrict__ Q, const float* __restrict__ Wd, const float* __restrict__ Kk, const float* __restrict__ V,
                                               const float* __restrict__ Aa, const float* __restrict__ Bb, float* __restrict__ O, int sq, int DV) {
    constexpr int DK = 64 * KPL;
    const int row = blockIdx.x, h = row / DV, lane = threadIdx.x;
    float S[KPL];
#pragma unroll
    for (int i = 0; i < KPL; ++i) S[i] = 0.f;
    const size_t qoff = (size_t)h * DK + lane;
    float obuf = 0.f;
    for (int t0 = 0; t0 < T; t0 += 8) {
        float q_[8][KPL], w_[8][KPL], k_[8][KPL], a_[8][KPL], b_[8][KPL], v_[8];
#pragma unroll
        for (int u = 0; u < 8; ++u) {
            const size_t base = (size_t)(t0 + u) * sq + qoff;
#pragma unroll
            for (int i = 0; i < KPL; ++i) {
                q_[u][i] = Q[base + 64 * i]; w_[u][i] = Wd[base + 64 * i]; k_[u][i] = Kk[base + 64 * i];
                if (HAS_SA) { a_[u][i] = Aa[base + 64 * i]; b_[u][i] = Bb[base + 64 * i]; } else { a_[u][i] = 0.f; b_[u][i] = 0.f; }
            }
            v_[u] = V[(size_t)(t0 + u) * 512 + row];
        }
#pragma unroll
        for (int u = 0; u < 8; ++u) {
            float sa = 0.f;
            if (HAS_SA) { float d = 0.f;
#pragma unroll
                for (int i = 0; i < KPL; ++i) d += S[i] * a_[u][i];
                sa = wave_sum(d); }
            float d2 = 0.f;
#pragma unroll
            for (int i = 0; i < KPL; ++i) { S[i] = S[i] * w_[u][i] + sa * b_[u][i] + v_[u] * k_[u][i]; d2 += S[i] * q_[u][i]; }
            const float o = wave_sum(d2);
            const int t = t0 + u;
            obuf = (lane == (t & 63)) ? o : obuf;
            if ((t & 63) == 63) O[(size_t)(t - 63 + lane) * 512 + row] = obuf;
        }
    }
}

__global__ __launch_bounds__(512) void k_finish_rms(const float* __restrict__ oraw, const float* __restrict__ gain, const bf16_t* __restrict__ z, bf16_t* __restrict__ bo, int gcol, int pad_) {
    __shared__ float part[8];
    const int c = threadIdx.x, wv = c >> 6;
    for (int t = blockIdx.x; t < T; t += gridDim.x) {
        const float o = oraw[(size_t)t * 512 + c];
        const float ss = wave_sum(o * o);
        __syncthreads();
        if ((c & 63) == 0) part[wv] = ss;
        __syncthreads();
        const float tot = part[(c >> 7) * 2] + part[(c >> 7) * 2 + 1];
        const float rs = rsqrtf(tot * (1.0f / 128.0f) + 1e-5f);
        const float g = bf2f(z[(size_t)t * ZLD + gcol + c]);
        bo[(size_t)t * 512 + c] = f2bf(o * rs * gain[c] * siluf_(g));
    }
}
__global__ __launch_bounds__(512) void k_finish_rw(const float* __restrict__ oraw, const float* __restrict__ lnw, const float* __restrict__ lnb,
                                                   const float* __restrict__ bonus, const float* __restrict__ gate, bf16_t* __restrict__ bo) {
    const int c = threadIdx.x;
    for (int t = blockIdx.x; t < T; t += gridDim.x) {
        const size_t o_ = (size_t)t * 512 + c;
        const float o = oraw[o_];
        const float mu = wave_sum(o) * (1.0f / 64.0f);
        const float d = o - mu;
        const float var = wave_sum(d * d) * (1.0f / 64.0f);
        const float y = d * rsqrtf(var + 64e-5f) * lnw[c] + lnb[c];
        bo[o_] = f2bf((y + bonus[o_]) * gate[o_]);
    }
}

__global__ __launch_bounds__(64) void k_sb_naive(const bf16_t* __restrict__ z, bf16_t* __restrict__ bo) {
    __shared__ float qs[128];
    const int h = blockIdx.x & 3, t = blockIdx.x >> 2, lane = threadIdx.x;
    const bf16_t* qp = z + (size_t)t * ZLD + SB_Q + h * 128;
    qs[lane] = bf2f(qp[lane]); qs[lane + 64] = bf2f(qp[lane + 64]);
    __syncthreads();
    float o0 = 0.f, o1 = 0.f, R = 0.f;
    const float scale = 0.08838834764831845f;
    for (int s_hi = t - 1; s_hi >= 0; s_hi -= 64) {
        const int s = s_hi - lane;
        const bool valid = s >= 0;
        float zz = 0.f;
        if (valid) {
            const bf16_t* kp = z + (size_t)s * ZLD + SB_K + h * 128;
            float acc = 0.f;
#pragma unroll 4
            for (int d8 = 0; d8 < 16; ++d8) {
                const uint4 kv = *(const uint4*)(kp + d8 * 8);
                const unsigned kw[4] = {kv.x, kv.y, kv.z, kv.w};
#pragma unroll
                for (int j = 0; j < 4; ++j) { acc += qs[d8 * 8 + 2 * j] * __uint_as_float(kw[j] << 16); acc += qs[d8 * 8 + 2 * j + 1] * __uint_as_float(kw[j] & 0xffff0000u); }
            }
            zz = acc * scale;
        }
        const float lk = valid ? -softplusf_(zz) : 0.f;
        float incl = lk;
#pragma unroll
        for (int off = 1; off < 64; off <<= 1) { const float y = __shfl_up(incl, off); if (lane >= off) incl += y; }
        const float logw = zz + lk + R + (incl - lk);
        const float w = valid ? expf(logw) : 0.f;
        const int nvalid = (s_hi + 1 < 64) ? s_hi + 1 : 64;
        for (int j = 0; j < nvalid; ++j) {
            const float wj = __shfl(w, j);
            const bf16_t* vp = z + (size_t)(s_hi - j) * ZLD + SB_V + h * 128;
            o0 += wj * bf2f(vp[lane]); o1 += wj * bf2f(vp[lane + 64]);
        }
        R += __shfl(incl, 63);
        if (R < -104.0f) break;
    }
    bo[(size_t)t * 512 + h * 128 + lane] = f2bf(o0); bo[(size_t)t * 512 + h * 128 + 64 + lane] = f2bf(o1);
}

__global__ __launch_bounds__(512) void k_router(const float* __restrict__ x1, const float* __restrict__ wr, const float* __restrict__ rbias,
                                                int* __restrict__ idx, float* __restrict__ wsel, int* __restrict__ hist) {
    __shared__ int hs[64];
    const int tid = threadIdx.x, lane = tid & 63, wv = __builtin_amdgcn_readfirstlane(tid >> 6);
    if (tid < 64) hs[tid] = 0;
    __syncthreads();
    const float bias = rbias[lane];
    for (int it = 0; it < 2; ++it) {
        const int tb = blockIdx.x * 64 + wv * 8 + it * 4;
        float acc[4] = {0.f, 0.f, 0.f, 0.f};
        const float* xp = x1 + (size_t)tb * D;
        for (int k0 = 0; k0 < D; k0 += 4) {
            float wv4[4];
#pragma unroll
            for (int j = 0; j < 4; ++j) wv4[j] = wr[(size_t)(k0 + j) * 64 + lane];
#pragma unroll
            for (int q = 0; q < 4; ++q) {
                const float4 xv = *(const float4*)(xp + (size_t)q * D + k0);
                acc[q] += xv.x * wv4[0]; acc[q] += xv.y * wv4[1]; acc[q] += xv.z * wv4[2]; acc[q] += xv.w * wv4[3];
            }
        }
#pragma unroll
        for (int q = 0; q < 4; ++q) {
            const int t = tb + q;
            const float score = sigmoidf_(acc[q]);
            const float biased = score + bias;
            float m1 = biased;
            m1 = fmaxf(m1, __shfl_xor(m1, 1)); m1 = fmaxf(m1, __shfl_xor(m1, 2)); m1 = fmaxf(m1, __shfl_xor(m1, 4));
            int am = (biased == m1) ? lane : 64;
            am = min(am, __shfl_xor(am, 1)); am = min(am, __shfl_xor(am, 2)); am = min(am, __shfl_xor(am, 4));
            float m2 = (lane == am) ? -INFINITY : biased;
            m2 = fmaxf(m2, __shfl_xor(m2, 1)); m2 = fmaxf(m2, __shfl_xor(m2, 2)); m2 = fmaxf(m2, __shfl_xor(m2, 4));
            const float gs = m1 + m2;
            const int g = lane >> 3;
            int grank = 0;
#pragma unroll
            for (int g2 = 0; g2 < 8; ++g2) { const float o = __shfl(gs, g2 * 8); grank += (o > gs || (o == gs && g2 < g)) ? 1 : 0; }
            const bool gok = grank < 4;
            const float masked = gok ? biased : -INFINITY;
            int rank = 0;
            for (int e2 = 0; e2 < 64; ++e2) { const float o = rdlane(masked, e2); rank += (o > masked || (o == masked && e2 < lane)) ? 1 : 0; }
            const bool sel = rank < 8;
            const float ssum = wave_sum(sel ? score : 0.f);
            if (sel) { idx[(size_t)t * 8 + rank] = lane; wsel[(size_t)t * 8 + rank] = 2.5f * score / ssum; atomicAdd(&hs[lane], 1); }
        }
    }
    __syncthreads();
    if (tid < 64) hist[blockIdx.x * 64 + tid] = hs[tid];
}

__global__ __launch_bounds__(512) void k_dispatch(const int* __restrict__ idx, const float* __restrict__ wsel, const int* __restrict__ hist,
                                                  int* __restrict__ row_tok, float* __restrict__ row_w, int* __restrict__ slotpos,
                                                  int* __restrict__ panel_expert, int* __restrict__ npanels) {
    __shared__ int tot[64], bef[64], pstart[64], es[512];
    __shared__ int np_s;
    const int tid = threadIdx.x, blk = blockIdx.x;
    if (tid < 64) { int b = 0, s = 0; for (int j = 0; j < 256; ++j) { const int c = hist[j * 64 + tid]; if (j < blk) b += c; s += c; } tot[tid] = s; bef[tid] = b; }
    __syncthreads();
    if (tid == 0) { int acc = 0; for (int e = 0; e < 64; ++e) { pstart[e] = acc; acc += (tot[e] + 255) / 256 * 256; } np_s = acc / 256; }
    const int t = blk * 64 + (tid >> 3), k = tid & 7;
    const int e = idx[(size_t)t * 8 + k];
    es[tid] = e;
    __syncthreads();
    int rank = 0;
    for (int j = 0; j < tid; ++j) rank += (es[j] == e) ? 1 : 0;
    const int pos = pstart[e] + bef[e] + rank;
    row_tok[pos] = t; row_w[pos] = wsel[(size_t)t * 8 + k]; slotpos[(size_t)t * 8 + k] = pos;
    const int NP = np_s;
    if (blk < 64) {
        const int ee = blk, st = pstart[ee], cnt = tot[ee], pad = (cnt + 255) / 256 * 256;
        for (int r = st + cnt + tid; r < st + pad; r += 512) { row_tok[r] = 0; row_w[r] = 0.f; }
        for (int pp = st / 256 + tid; pp < (st + pad) / 256; pp += 512) panel_expert[pp] = ee;
    }
    if (tid < 64) { const int tt = blk * 64 + tid; row_tok[NP * 256 + tt] = tt; row_w[NP * 256 + tt] = 1.0f; }
    if (blk == 0) { if (tid < 64) panel_expert[NP + tid] = 64; if (tid == 0) npanels[0] = NP + 64; }
}

__global__ __launch_bounds__(256) void k_combine_ln(const float* __restrict__ x1, const bf16_t* __restrict__ y, const int* __restrict__ slotpos, const int* __restrict__ npanels,
                                                    const float* __restrict__ w, const float* __restrict__ b, float* __restrict__ outf, bf16_t* __restrict__ outb) {
    const int lane = threadIdx.x & 63;
    const int t = blockIdx.x * 4 + (threadIdx.x >> 6);
    const int shared_row = (npanels[0] - 64) * 256 + t;
    int rows[9];
#pragma unroll
    for (int k = 0; k < 8; ++k) rows[k] = slotpos[(size_t)t * 8 + k];
    rows[8] = shared_row;
    float v[32]; float s = 0.f;
#pragma unroll
    for (int i = 0; i < 8; ++i) {
        const int c = i * 256 + lane * 4;
        const float4 x = *(const float4*)(x1 + (size_t)t * D + c);
        float a0 = 0.f, a1 = 0.f, a2 = 0.f, a3 = 0.f;
#pragma unroll
        for (int k = 0; k < 9; ++k) { const uint2 u = *(const uint2*)(y + (size_t)rows[k] * D + c);
            a0 += __uint_as_float(u.x << 16); a1 += __uint_as_float(u.x & 0xffff0000u); a2 += __uint_as_float(u.y << 16); a3 += __uint_as_float(u.y & 0xffff0000u); }
        v[4 * i] = ALPHA * x.x + a0; v[4 * i + 1] = ALPHA * x.y + a1; v[4 * i + 2] = ALPHA * x.z + a2; v[4 * i + 3] = ALPHA * x.w + a3;
        s += (v[4 * i] + v[4 * i + 1]) + (v[4 * i + 2] + v[4 * i + 3]);
    }
    const float mu = wave_sum(s) * (1.0f / D);
    float q = 0.f;
#pragma unroll
    for (int i = 0; i < 32; ++i) { const float d = v[i] - mu; q += d * d; }
    const float rstd = rsqrtf(wave_sum(q) * (1.0f / D) + 1e-5f);
#pragma unroll
    for (int i = 0; i < 8; ++i) {
        const int c = i * 256 + lane * 4;
        const float4 ww = *(const float4*)(w + c), bb = *(const float4*)(b + c);
        float4 o; o.x = (v[4 * i] - mu) * rstd * ww.x + bb.x; o.y = (v[4 * i + 1] - mu) * rstd * ww.y + bb.y; o.z = (v[4 * i + 2] - mu) * rstd * ww.z + bb.z; o.w = (v[4 * i + 3] - mu) * rstd * ww.w + bb.w;
        *(float4*)(outf + (size_t)t * D + c) = o;
        if (outb) { bf16_t* ob = outb + (size_t)t * D + c; ob[0] = f2bf(o.x); ob[1] = f2bf(o.y); ob[2] = f2bf(o.z); ob[3] = f2bf(o.w); }
    }
}


template <class Epi, bool DUAL>
static void launch_ngemm(hipStream_t stream, int mtiles, int ntiles, const bf16_t* A, int lda, const int* rowmap, const float* B0, const float* B1, int ldb,
                         const float* B0s, const float* B1s, size_t estride, const int* panel_expert, const int* npanels, int N, int K, const Epi& epi) {
    GemmArgs<Epi> ga; memset(&ga, 0, sizeof ga);
    ga.A = A; ga.rowmap = rowmap; ga.B0 = B0; ga.B1 = B1; ga.B0s = B0s; ga.B1s = B1s; ga.estride = estride; ga.panel_expert = panel_expert; ga.npanels = npanels;
    ga.lda = lda; ga.ldb = ldb; ga.N = N; ga.K = K; memcpy(&ga.epi, &epi, sizeof(Epi));
    k_ngemm<Epi, DUAL><<<dim3(mtiles, ntiles), 256, 0, stream>>>(ga);
}
template <class E> static E zeroed() { E e; memset(&e, 0, sizeof e); return e; }
extern "C" void kernel_launch(void* const* d_in, const int* in_sizes, int n_in, void* d_out, int out_size, void* d_ws, size_t ws_size, hipStream_t stream) {
    const float* x_in = (const float*)d_in[0];
    const float* w_in = (const float*)d_in[1];
    const float* hg_lb = (const float*)d_in[2];
    const float* hg_norm_w = (const float*)d_in[3];
    const float* rw_mu = (const float*)d_in[4];
    const float* rw_w0 = (const float*)d_in[5];
    const float* rw_w2 = (const float*)d_in[6];
    const float* rw_a0 = (const float*)d_in[7];
    const float* rw_a2 = (const float*)d_in[8];
    const float* rw_g2 = (const float*)d_in[9];
    const float* rw_kk = (const float*)d_in[10];
    const float* rw_ka = (const float*)d_in[11];
    const float* rw_rk = (const float*)d_in[12];
    const float* rw_ln_w = (const float*)d_in[13];
    const float* rw_ln_b = (const float*)d_in[14];
    const float* gla_g2 = (const float*)d_in[15];
    const float* gla_gb = (const float*)d_in[16];
    const float* gla_norm_w = (const float*)d_in[17];
    const float* w_br = (const float*)d_in[18];
    const float* w_out = (const float*)d_in[19];
    const float* ln1_w = (const float*)d_in[20];
    const float* ln1_b = (const float*)d_in[21];
    const float* w_router = (const float*)d_in[22];
    const float* router_bias = (const float*)d_in[23];
    const float* we_gate = (const float*)d_in[24];
    const float* we_up = (const float*)d_in[25];
    const float* we_down = (const float*)d_in[26];
    const float* ws_gate = (const float*)d_in[27];
    const float* ws_up = (const float*)d_in[28];
    const float* ws_down = (const float*)d_in[29];
    const float* ln2_w = (const float*)d_in[30];
    const float* ln2_b = (const float*)d_in[31];

    char* base = (char*)d_ws; size_t off = 0;
    auto take = [&](size_t bytes) { char* p = base + off; off += (bytes + 255) & ~(size_t)255; return p; };
    const size_t MiB = 1024 * 1024;
    const size_t TS = (size_t)T * 512 * 4;
    const size_t zbytes = (((size_t)T * ZLD * 2) + 255) & ~(size_t)255;
    char* regY = take(zbytes + 8 * TS);
    bf16_t* z = (bf16_t*)regY;
    float* rwa = (float*)(regY + zbytes);
    float *rR = rwa, *rW = rwa + (size_t)T * 512, *rK = rwa + 2 * (size_t)T * 512, *rV = rwa + 3 * (size_t)T * 512, *rA = rwa + 4 * (size_t)T * 512, *rB = rwa + 5 * (size_t)T * 512,
          *rGate = rwa + 6 * (size_t)T * 512, *rBonus = rwa + 7 * (size_t)T * 512;
    bf16_t* ybuf = (bf16_t*)regY;
    bf16_t* xb = (bf16_t*)take((size_t)T * D * 2);
    char* regM = take(4 * TS + 3 * (TS / 2) + TS + 3 * TS);
    float* hQ = (float*)regM; float* hW = hQ + (size_t)T * 512; float* hK = hW + (size_t)T * 512; float* hV = hK + (size_t)T * 512;
    float* gQ = hV + (size_t)T * 512; float* gW = gQ + (size_t)T * 256; float* gK = gW + (size_t)T * 256; float* gV = gK + (size_t)T * 256;
    float* oraw = gV + (size_t)T * 512;
    bf16_t* hbuf = (bf16_t*)regM;
    float* x1 = (float*)(regM + (size_t)MAXROWS * FW * 2);
    bf16_t* bo = (bf16_t*)take(4 * (size_t)T * 512 * 2);
    float* merged = (float*)take((size_t)T * D * 4);
    float* pre = merged;
    bf16_t* mergedb = (bf16_t*)take((size_t)T * D * 2);
    bf16_t* x1b = (bf16_t*)take((size_t)T * D * 2);
    float* x2 = (float*)d_out;
    bf16_t* WinT = (bf16_t*)take((size_t)ZLD * D * 2);
    bf16_t* WguT = (bf16_t*)take((size_t)65 * 1024 * D * 2);
    bf16_t* WdT = (bf16_t*)take((size_t)65 * D * FW * 2);
    bf16_t* WbrT = (bf16_t*)take((size_t)4 * D * FW * 2);
    bf16_t* WoutT = (bf16_t*)take((size_t)D * D * 2);
    int* idx = (int*)take((size_t)T * 8 * 4); float* wsel = (float*)take((size_t)T * 8 * 4); int* hist = (int*)take(256 * 64 * 4);
    int* row_tok = (int*)take((size_t)MAXROWS * 4); float* row_w = (float*)take((size_t)MAXROWS * 4); int* slotpos = (int*)take((size_t)T * 8 * 4);
    int* panel_expert = (int*)take(MAXPANELS * 4); int* npanels = (int*)take(256);
    if (off > ws_size) { fprintf(stderr, "workspace too small: need %zu MiB, have %zu MiB\n", off / MiB, ws_size / MiB); return; }
    const int GLDS = pg8::STAGE_BYTES + pg8::GTAB_BYTES;
    static bool attr_done = false;
    if (!attr_done) {
        hipFuncSetAttribute((const void*)k_gplain<pg8::EpiZ16>, hipFuncAttributeMaxDynamicSharedMemorySize, GLDS);
        hipFuncSetAttribute((const void*)k_gplain<pg8::EpiGateAcc>, hipFuncAttributeMaxDynamicSharedMemorySize, GLDS);
        hipFuncSetAttribute((const void*)k_gplain<pg8::EpiResid>, hipFuncAttributeMaxDynamicSharedMemorySize, GLDS);
        hipFuncSetAttribute((const void*)k_gmoe<pg8::EpiSwi, true>, hipFuncAttributeMaxDynamicSharedMemorySize, GLDS);
        hipFuncSetAttribute((const void*)k_gmoe<pg8::EpiDownW, false>, hipFuncAttributeMaxDynamicSharedMemorySize, GLDS);
        attr_done = true;
    }
    const int GRID = 256;

    for (int L = 0; L < 2; ++L) {
        const float* xin = (L == 0) ? x_in : x2;
        float* xout = (L == 0) ? x2 : (float*)d_out;
        if (L == 0) k_cvt_bf16<<<2048, 256, 0, stream>>>(x_in, xb, (size_t)T * D);
        { ConvArgs ca; memset(&ca, 0, sizeof ca); ca.w_in = w_in; ca.we_gate = we_gate; ca.we_up = we_up; ca.we_down = we_down; ca.ws_gate = ws_gate; ca.ws_up = ws_up; ca.ws_down = ws_down; ca.w_br = w_br; ca.w_out = w_out;
          ca.WinT = WinT; ca.WguT = WguT; ca.WdT = WdT; ca.WbrT = WbrT; ca.WoutT = WoutT; ca.layer = L;
          k_convert<<<2048, 512, 0, stream>>>(ca); }
        { PlainGemmArgs ga; memset(&ga, 0, sizeof ga); ga.A = xb; ga.Bt = WinT; ga.M = T; ga.N = ZLD; ga.K = D;
          pg8::EpiZ16 e; memset(&e, 0, sizeof e); e.O = z; e.ldc = ZLD;
          k_gplain<pg8::EpiZ16><<<GRID, 512, GLDS, stream>>>(ga, e); }
        PrepArgs pa; memset(&pa, 0, sizeof pa); pa.z = z; pa.layer = L; pa.hg_lb_logits = hg_lb; pa.rw_mu = rw_mu; pa.rw_w0 = rw_w0; pa.rw_w2 = rw_w2; pa.rw_a0 = rw_a0; pa.rw_a2 = rw_a2; pa.rw_g2 = rw_g2;
        pa.rw_kk = rw_kk; pa.rw_ka = rw_ka; pa.rw_rk = rw_rk; pa.gla_g2 = gla_g2; pa.gla_gb = gla_gb;
        pa.rR = rR; pa.rW = rW; pa.rK = rK; pa.rV = rV; pa.rA = rA; pa.rB = rB; pa.rGate = rGate; pa.rBonus = rBonus;
        pa.hQ = hQ; pa.hW = hW; pa.hK = hK; pa.hV = hV; pa.gQ = gQ; pa.gW = gW; pa.gK = gK; pa.gV = gV;
        k_prep<<<2048, 512, 0, stream>>>(pa);
        float* oH = oraw; float* oR = oraw + (size_t)T * 512; float* oG = oraw + 2 * (size_t)T * 512;
        k_rowrec<2, false><<<512, 64, 0, stream>>>(hQ, hW, hK, hV, nullptr, nullptr, oH, 512, 128);
        k_rowrec<1, true><<<512, 64, 0, stream>>>(rR, rW, rK, rV, rA, rB, oR, 512, 64);
        k_rowrec<1, false><<<512, 64, 0, stream>>>(gQ, gW, gK, gV, nullptr, nullptr, oG, 256, 128);
        k_sb_naive<<<4 * T, 64, 0, stream>>>(z, bo + 2 * (size_t)T * 512);
        k_finish_rms<<<2048, 512, 0, stream>>>(oH, hg_norm_w + L * 512, z, bo, HG_G, 0);
        k_finish_rw<<<2048, 512, 0, stream>>>(oR, rw_ln_w + L * 512, rw_ln_b + L * 512, rBonus, rGate, bo + (size_t)T * 512);
        k_finish_rms<<<2048, 512, 0, stream>>>(oG, gla_norm_w + L * 512, z, bo + 3 * (size_t)T * 512, GL_R, 0);
        for (int g = 0; g < 4; ++g) {
            PlainGemmArgs ga; memset(&ga, 0, sizeof ga); ga.A = bo + (size_t)g * T * 512; ga.Bt = WbrT + (size_t)g * D * FW; ga.M = T; ga.N = D; ga.K = FW;
            pg8::EpiGateAcc e; memset(&e, 0, sizeof e); e.zg = z + GATE0 + g * D; e.merged = merged; e.mergedb = mergedb; e.g = g;
            k_gplain<pg8::EpiGateAcc><<<GRID, 512, GLDS, stream>>>(ga, e); }
        { PlainGemmArgs ga; memset(&ga, 0, sizeof ga); ga.A = mergedb; ga.Bt = WoutT; ga.M = T; ga.N = D; ga.K = D;
          pg8::EpiResid e; memset(&e, 0, sizeof e); e.xin = xin; e.pre = pre;
          k_gplain<pg8::EpiResid><<<GRID, 512, GLDS, stream>>>(ga, e); }
        k_ln<<<T / 4, 256, 0, stream>>>(pre, ln1_w + L * D, ln1_b + L * D, x1, x1b);
        k_router<<<256, 512, 0, stream>>>(x1, w_router + (size_t)L * D * NE, router_bias + L * NE, idx, wsel, hist);
        k_dispatch<<<256, 512, 0, stream>>>(idx, wsel, hist, row_tok, row_w, slotpos, panel_expert, npanels);
        { MoeGemmArgs ga; memset(&ga, 0, sizeof ga); ga.A = x1b; ga.Bt = WguT; ga.estride = (size_t)1024 * D; ga.panel_expert = panel_expert; ga.rowmap = row_tok; ga.npanels = npanels; ga.NT = 4; ga.K = D;
          pg8::EpiSwi e; memset(&e, 0, sizeof e); e.h = hbuf;
          k_gmoe<pg8::EpiSwi, true><<<GRID, 512, GLDS, stream>>>(ga, e); }
        { MoeGemmArgs ga; memset(&ga, 0, sizeof ga); ga.A = hbuf; ga.Bt = WdT; ga.estride = (size_t)D * FW; ga.panel_expert = panel_expert; ga.rowmap = nullptr; ga.npanels = npanels; ga.NT = 8; ga.K = FW;
          pg8::EpiDownW e; memset(&e, 0, sizeof e); e.y = ybuf; e.row_w = row_w;
          k_gmoe<pg8::EpiDownW, false><<<GRID, 512, GLDS, stream>>>(ga, e); }
        k_combine_ln<<<T / 4, 256, 0, stream>>>(x1, ybuf, slotpos, npanels, ln2_w + L * D, ln2_b + L * D, xout, (L == 0) ? xb : nullptr);
    }
}
```

```cpp
#include <hip/hip_runtime.h>
#include <stdint.h>
#include <stdio.h>
#include <string.h>

typedef unsigned short bf16_t;

constexpr int T = 16384, D = 2048, ZW = 15024, ZLD = 15104, NE = 64, FW = 512;
constexpr int HG_Q = 0, HG_F = 512, HG_I = 1024, HG_G = 1536;
constexpr int RW_R = 2048, RW_K = 2560, RW_V = 3072, RW_LW = 3584;
constexpr int SB_Q = 3744, SB_K = 4256, SB_V = 4768;
constexpr int GL_Q = 5280, GL_K = 5536, GL_V = 5792, GL_LG = 6304, GL_R = 6320;
constexpr int GATE0 = 6832;
constexpr float ALPHA = 1.4142135623730951f;
constexpr int MAXPANELS = 640;
constexpr int MAXROWS = MAXPANELS * 256;

__device__ __forceinline__ float bf2f(bf16_t v) { return __uint_as_float(((unsigned)v) << 16); }
__device__ __forceinline__ bf16_t f2bf(float f) { unsigned u = __float_as_uint(f); u += 0x7FFFu + ((u >> 16) & 1u); return (bf16_t)(u >> 16); }
__device__ __forceinline__ float sigmoidf_(float x) { return 1.0f / (1.0f + expf(-x)); }
__device__ __forceinline__ float softplusf_(float x) { return fmaxf(x, 0.f) + log1pf(expf(-fabsf(x))); }
__device__ __forceinline__ float siluf_(float x) { return x / (1.0f + expf(-x)); }

template <int CTRL> __device__ __forceinline__ float dppmov(float x) {
    return __builtin_bit_cast(float, __builtin_amdgcn_update_dpp(0, __builtin_bit_cast(int, x), CTRL, 0xF, 0xF, true));
}
__device__ __forceinline__ float rdlane(float x, int l) { return __builtin_bit_cast(float, __builtin_amdgcn_readlane(__builtin_bit_cast(int, x), l)); }
__device__ __forceinline__ float wave_sum(float x) {
    x += dppmov<0xB1>(x);
    x += dppmov<0x4E>(x);
    x += dppmov<0x141>(x);
    x += dppmov<0x140>(x);
    return (rdlane(x, 0) + rdlane(x, 16)) + (rdlane(x, 32) + rdlane(x, 48));
}

struct EpiZ { bf16_t* z; __device__ void operator()(int m, int n, float a0, float) const { z[(size_t)m * ZLD + n] = f2bf(a0); } };
struct EpiGate { const bf16_t* z; float* merged; bf16_t* mergedb; int g; int pad_;
    __device__ void operator()(int m, int n, float a0, float) const {
        const float gl = bf2f(z[(size_t)m * ZLD + GATE0 + g * D + n]);
        float v = sigmoidf_(gl) * a0;
        const size_t o = (size_t)m * D + n;
        if (g > 0) v += merged[o];
        merged[o] = v;
        if (g == 3) mergedb[o] = f2bf(v);
    } };
struct EpiRes { const float* xin; float* pre; __device__ void operator()(int m, int n, float a0, float) const { const size_t o = (size_t)m * D + n; pre[o] = ALPHA * xin[o] + a0; } };
struct EpiSwiglu { bf16_t* h; __device__ void operator()(int m, int n, float a0, float a1) const { h[(size_t)m * FW + n] = f2bf(siluf_(a0) * a1); } };
struct EpiDown { bf16_t* y; const float* row_w; __device__ void operator()(int m, int n, float a0, float) const { y[(size_t)m * D + n] = f2bf(a0 * row_w[m]); } };

template <class Epi> struct GemmArgs { const bf16_t* A; const int* rowmap; const float *B0, *B1, *B0s, *B1s; size_t estride; const int* panel_expert; const int* npanels; int lda, ldb, N, K; Epi epi; };
template <class Epi, bool DUAL>
__global__ __launch_bounds__(256) void k_ngemm(const GemmArgs<Epi> ga) {
    const bf16_t* __restrict__ A = ga.A; const int* __restrict__ rowmap = ga.rowmap; const float* __restrict__ B0 = ga.B0; const float* __restrict__ B1 = ga.B1;
    const float* __restrict__ B0s = ga.B0s; const float* __restrict__ B1s = ga.B1s; const size_t estride = ga.estride;
    const int* __restrict__ panel_expert = ga.panel_expert; const int* __restrict__ npanels = ga.npanels; const int lda = ga.lda, ldb = ga.ldb, N = ga.N, K = ga.K; const Epi epi = ga.epi;
    __shared__ float As[16][132];
    __shared__ float Bs0[16][132];
    __shared__ float Bs1[DUAL ? 16 : 1][132];
    const int tid = threadIdx.x, tx = tid & 15, ty = tid >> 4;
    const int m0 = blockIdx.x * 128, n0 = blockIdx.y * 128;
    const float* Bp0 = B0; const float* Bp1 = B1;
    if (panel_expert) {
        const int p = m0 >> 8;
        if (p >= *npanels) return;
        const int e = panel_expert[p];
        if (e < NE) { Bp0 = B0 + (size_t)e * estride; if constexpr (DUAL) Bp1 = B1 + (size_t)e * estride; }
        else { Bp0 = B0s; if constexpr (DUAL) Bp1 = B1s; }
    }
    float acc0[8][8], acc1[DUAL ? 8 : 1][8];
#pragma unroll
    for (int i = 0; i < 8; ++i)
#pragma unroll
        for (int j = 0; j < 8; ++j) { acc0[i][j] = 0.f; if constexpr (DUAL) acc1[i][j] = 0.f; }
    const int arow = tid >> 1, akh = tid & 1;
    const int am = m0 + arow;
    const size_t asrc = (size_t)(rowmap ? rowmap[am] : am) * lda + akh * 8;
    const int bk = tid >> 4, bn = (tid & 15) * 8;
    for (int k0 = 0; k0 < K; k0 += 16) {
        const uint4 av = *(const uint4*)(A + asrc + k0);
        const unsigned aw[4] = {av.x, av.y, av.z, av.w};
#pragma unroll
        for (int j = 0; j < 4; ++j) { As[akh * 8 + 2 * j][arow] = __uint_as_float(aw[j] << 16); As[akh * 8 + 2 * j + 1][arow] = __uint_as_float(aw[j] & 0xffff0000u); }
#pragma unroll
        for (int q = 0; q < 2; ++q) {
            const int n = n0 + bn + q * 4;
            float4 v0 = make_float4(0.f, 0.f, 0.f, 0.f), v1 = v0;
            if (n < N) { v0 = *(const float4*)(Bp0 + (size_t)(k0 + bk) * ldb + n); if constexpr (DUAL) v1 = *(const float4*)(Bp1 + (size_t)(k0 + bk) * ldb + n); }
            *(float4*)&Bs0[bk][bn + q * 4] = v0;
            if constexpr (DUAL) *(float4*)&Bs1[bk][bn + q * 4] = v1;
        }
        __syncthreads();
#pragma unroll
        for (int k = 0; k < 16; ++k) {
            float a[8], b[8], c[8];
            *(float4*)&a[0] = *(const float4*)&As[k][ty * 8]; *(float4*)&a[4] = *(const float4*)&As[k][ty * 8 + 4];
            *(float4*)&b[0] = *(const float4*)&Bs0[k][tx * 8]; *(float4*)&b[4] = *(const float4*)&Bs0[k][tx * 8 + 4];
            if constexpr (DUAL) { *(float4*)&c[0] = *(const float4*)&Bs1[k][tx * 8]; *(float4*)&c[4] = *(const float4*)&Bs1[k][tx * 8 + 4]; }
#pragma unroll
            for (int i = 0; i < 8; ++i)
#pragma unroll
                for (int j = 0; j < 8; ++j) { acc0[i][j] += a[i] * b[j]; if constexpr (DUAL) acc1[i][j] += a[i] * c[j]; }
        }
        __syncthreads();
    }
#pragma unroll
    for (int i = 0; i < 8; ++i)
#pragma unroll
        for (int j = 0; j < 8; ++j) { const int m = m0 + ty * 8 + i, n = n0 + tx * 8 + j; if (n < N) { float a1 = 0.f; if constexpr (DUAL) a1 = acc1[i][j]; epi(m, n, acc0[i][j], a1); } }
}


#define LAS __attribute__((address_space(3)))
namespace pg8 {
typedef short bf16x8 __attribute__((ext_vector_type(8)));
typedef float f32x4 __attribute__((ext_vector_type(4)));
typedef unsigned u32x4 __attribute__((ext_vector_type(4)));
typedef unsigned u32x2 __attribute__((ext_vector_type(2)));
constexpr int BM = 256, BK = 64, HALF = 128, HTB = HALF * BK * 2, STAGE_BYTES = 8 * HTB, NXCD = 8, WGM = 8;
constexpr int GTAB_BYTES = 512 * 16;
__host__ __device__ __forceinline__ int lds_byte(int r, int c) { const int st = (r >> 4) * 2 + (c >> 5), rr = r & 15, cc = c & 31, ob = rr * 64 + cc * 2; return st * 1024 + (ob ^ (((ob >> 9) & 1) << 5)); }
__host__ __device__ __forceinline__ void stage_rc(int b, int& R, int& C) { const int st = b / 1024, sb = b % 1024, swz = sb ^ (((sb >> 9) & 1) << 5); R = (st >> 1) * 16 + swz / 64; C = (st & 1) * 32 + (swz % 64) / 2; }
__host__ __device__ __forceinline__ int perm32(int rho) { const int n = rho >> 4, i = rho & 15; return 8 * (i >> 2) + 4 * n + (i & 3); }
struct Unit { int pm, pn, e; };
__device__ __forceinline__ unsigned cvt_pk_bf16(float lo, float hi) { unsigned r; asm volatile("v_cvt_pk_bf16_f32 %0, %1, %2" : "=v"(r) : "v"(lo), "v"(hi)); return r; }

struct StaticOrder {
    const bf16_t* A; const bf16_t* Bt; int K; int nM, nN, nwg, G, c;
    __device__ void init(const bf16_t* A_, const bf16_t* Bt_, int M, int N, int K_, int G_, int c_) { A = A_; Bt = Bt_; K = K_; nM = M / BM; nN = N / BM; nwg = nM * nN; G = G_; c = c_; }
    __device__ bool next(int i, Unit& u) const {
        const int L = i * G + c; if (L >= nwg) return false;
        int wgid = L; { const int q = nwg / NXCD, r = nwg % NXCD, xcd = wgid % NXCD, off = wgid / NXCD; wgid = (xcd < r ? xcd * (q + 1) : r * (q + 1) + (xcd - r) * q) + off; }
        const int nig = WGM * nN, gid = wgid / nig, fm = gid * WGM, gsz = (nM - fm) < WGM ? (nM - fm) : WGM;
        u.pm = fm + ((wgid % nig) % gsz); u.pn = (wgid % nig) / gsz; u.e = 0; return true;
    }
    __device__ __forceinline__ const char* a_base(const Unit& u) const { return (const char*)A + (size_t)u.pm * 256 * K * 2; }
    __device__ __forceinline__ const char* b_base(const Unit& u) const { return (const char*)Bt + (size_t)u.pn * 256 * K * 2; }
    __device__ __forceinline__ const int* rowmap() const { return nullptr; }
};
struct MoeOrder {
    const bf16_t* A; const bf16_t* Bt; const int* panel_expert; const int* rmap; size_t estride; int K, NT, total, G, c;
    __device__ void init(const bf16_t* A_, const bf16_t* Bt_, size_t estride_, const int* pe, const int* rmap_, int npanels, int NT_, int K_, int G_, int c_) {
        A = A_; Bt = Bt_; estride = estride_; panel_expert = pe; rmap = rmap_; K = K_; NT = NT_; total = npanels * NT_; G = G_;
        c = (c_ & 7) * (G_ >> 3) + (c_ >> 3);
    }
    __device__ bool next(int i, Unit& u) const {
        const int L = i * G + c; if (L >= total) return false;
        u.pm = L / NT; u.pn = L % NT; u.e = panel_expert[u.pm]; return true;
    }
    __device__ __forceinline__ const char* a_base(const Unit& u) const { return rmap ? (const char*)A : (const char*)A + (size_t)u.pm * 256 * K * 2; }
    __device__ __forceinline__ const char* b_base(const Unit& u) const { return (const char*)(Bt + (size_t)u.e * estride) + (size_t)u.pn * 256 * K * 2; }
    __device__ __forceinline__ const int* rowmap() const { return rmap; }
};

struct EpiZ16 {
    static constexpr bool PERM = true;
    bf16_t* O; int ldc; int pad_;
    __device__ __forceinline__ void operator()(const f32x4 (&acc)[2][2][4][2], const Unit& u, int wr, int wc, int fr, int fq) const {
        const int row0 = u.pm * BM + wr * 64 + fr, col0 = u.pn * BM + wc * 32 + 8 * fq;
#pragma unroll
        for (int ai = 0; ai < 2; ++ai)
#pragma unroll
            for (int m = 0; m < 4; ++m) { bf16_t* rowp = O + (size_t)(row0 + ai * HALF + m * 16) * ldc + col0;
#pragma unroll
                for (int bj = 0; bj < 2; ++bj) { const f32x4 v0 = acc[ai][bj][m][0], v1 = acc[ai][bj][m][1];
                    u32x4 w; w.x = cvt_pk_bf16(v0[0], v0[1]); w.y = cvt_pk_bf16(v0[2], v0[3]); w.z = cvt_pk_bf16(v1[0], v1[1]); w.w = cvt_pk_bf16(v1[2], v1[3]);
                    *(u32x4*)(rowp + bj * HALF) = w; } }
    }
};
struct EpiGateAcc {
    static constexpr bool PERM = false;
    const bf16_t* zg; float* merged; bf16_t* mergedb; int g; int pad_;
    __device__ __forceinline__ void operator()(const f32x4 (&acc)[2][2][4][2], const Unit& u, int wr, int wc, int fr, int fq) const {
        const int row0 = u.pm * BM + wr * 64 + fr, col0 = u.pn * BM + wc * 32 + 4 * fq;
#pragma unroll
        for (int ai = 0; ai < 2; ++ai)
#pragma unroll
            for (int m = 0; m < 4; ++m) { const size_t row = (size_t)(row0 + ai * HALF + m * 16);
#pragma unroll
                for (int bj = 0; bj < 2; ++bj)
#pragma unroll
                    for (int n = 0; n < 2; ++n) { const int col = col0 + bj * HALF + n * 16;
                        const u32x2 gz = *(const u32x2*)(zg + row * ZLD + col);
                        f32x4 gl; gl[0] = __uint_as_float(gz.x << 16); gl[1] = __uint_as_float(gz.x & 0xffff0000u); gl[2] = __uint_as_float(gz.y << 16); gl[3] = __uint_as_float(gz.y & 0xffff0000u);
                        f32x4 v = acc[ai][bj][m][n];
#pragma unroll
                        for (int j = 0; j < 4; ++j) v[j] *= 1.0f / (1.0f + __expf(-gl[j]));
                        float* mp = merged + row * D + col;
                        if (g > 0) v += *(const f32x4*)mp;
                        if (g < 3) *(f32x4*)mp = v;
                        else { u32x2 w; w.x = cvt_pk_bf16(v[0], v[1]); w.y = cvt_pk_bf16(v[2], v[3]); *(u32x2*)(mergedb + row * D + col) = w; } } }
    }
};
struct EpiResid {
    static constexpr bool PERM = false;
    const float* xin; float* pre;
    __device__ __forceinline__ void operator()(const f32x4 (&acc)[2][2][4][2], const Unit& u, int wr, int wc, int fr, int fq) const {
        const int row0 = u.pm * BM + wr * 64 + fr, col0 = u.pn * BM + wc * 32 + 4 * fq;
#pragma unroll
        for (int ai = 0; ai < 2; ++ai)
#pragma unroll
            for (int m = 0; m < 4; ++m) { const size_t ro = (size_t)(row0 + ai * HALF + m * 16) * D + col0;
#pragma unroll
                for (int bj = 0; bj < 2; ++bj)
#pragma unroll
                    for (int n = 0; n < 2; ++n) { const f32x4 xv = *(const f32x4*)(xin + ro + bj * HALF + n * 16); *(f32x4*)(pre + ro + bj * HALF + n * 16) = xv * ALPHA + acc[ai][bj][m][n]; } }
    }
};
struct EpiSwi {
    static constexpr bool PERM = true;
    bf16_t* h;
    __device__ __forceinline__ void operator()(const f32x4 (&acc)[2][2][4][2], const Unit& u, int wr, int wc, int fr, int fq) const {
        const int row0 = u.pm * BM + wr * 64 + fr, col0 = u.pn * HALF + wc * 32 + 8 * fq;
#pragma unroll
        for (int ai = 0; ai < 2; ++ai)
#pragma unroll
            for (int m = 0; m < 4; ++m) { float o[8];
#pragma unroll
                for (int n = 0; n < 2; ++n)
#pragma unroll
                    for (int j = 0; j < 4; ++j) { const float gt = acc[ai][0][m][n][j], up = acc[ai][1][m][n][j]; o[4 * n + j] = gt / (1.0f + __expf(-gt)) * up; }
                u32x4 w; w.x = cvt_pk_bf16(o[0], o[1]); w.y = cvt_pk_bf16(o[2], o[3]); w.z = cvt_pk_bf16(o[4], o[5]); w.w = cvt_pk_bf16(o[6], o[7]);
                *(u32x4*)(h + (size_t)(row0 + ai * HALF + m * 16) * FW + col0) = w; }
    }
};
struct EpiDownW {
    static constexpr bool PERM = true;
    bf16_t* y; const float* row_w;
    __device__ __forceinline__ void operator()(const f32x4 (&acc)[2][2][4][2], const Unit& u, int wr, int wc, int fr, int fq) const {
        const int row0 = u.pm * BM + wr * 64 + fr, col0 = u.pn * BM + wc * 32 + 8 * fq;
#pragma unroll
        for (int ai = 0; ai < 2; ++ai)
#pragma unroll
            for (int m = 0; m < 4; ++m) { const int row = row0 + ai * HALF + m * 16; const float s = row_w[row]; bf16_t* rowp = y + (size_t)row * D + col0;
#pragma unroll
                for (int bj = 0; bj < 2; ++bj) { const f32x4 v0 = acc[ai][bj][m][0] * s, v1 = acc[ai][bj][m][1] * s;
                    u32x4 w; w.x = cvt_pk_bf16(v0[0], v0[1]); w.y = cvt_pk_bf16(v0[2], v0[3]); w.z = cvt_pk_bf16(v1[0], v1[1]); w.w = cvt_pk_bf16(v1[2], v1[3]);
                    *(u32x4*)(rowp + bj * HALF) = w; } }
    }
};

template <class Epi, class Sched, bool GATHER>
__device__ __forceinline__ void gemm_phase(LAS unsigned char* lds, const int K, const Sched& S, const Epi& E) {
    const int tid = threadIdx.x, wid = __builtin_amdgcn_readfirstlane(tid >> 6), wr = wid >> 2, wc = wid & 3, lane = tid & 63, fr = lane & 15, fq = lane >> 4;
    const int nt = K / BK;
    unsigned voffA[2], voffB[2], voffG[2][2]; int gR[2], gC[2];
#pragma unroll
    for (int i = 0; i < 2; ++i) { int R, C; stage_rc(tid * 16 + i * 8192, R, C); const int Rb = Epi::PERM ? ((R & ~31) + perm32(R & 31)) : R;
        voffA[i] = (unsigned)(R * K + C) * 2u; voffB[i] = (unsigned)(Rb * K + C) * 2u; gR[i] = R; gC[i] = C; voffG[0][i] = 0u; voffG[1][i] = 0u; }
    const size_t kstep = (size_t)(BK * 2);
    const size_t hstep = (size_t)HALF * K * 2;
    const unsigned ldsw = (unsigned)wid * 1024u;
    const int aoff = lds_byte(wr * 64 + fr, fq * 8), boff = lds_byte(wc * 32 + fr, fq * 8);
    LAS u32x4* gtab = (LAS u32x4*)(lds + STAGE_BYTES) + tid;
#define PG8_SA(b, h) (((b) * 2 + (h)) * HTB)
#define PG8_SB(b, h) ((4 + (b) * 2 + (h)) * HTB)
#define PG8_STAGE(bufoff, gbase, voff) do { _Pragma("unroll") for (int _i = 0; _i < 2; ++_i) \
        __builtin_amdgcn_global_load_lds((const unsigned*)((const char*)(gbase) + (voff)[_i]), (LAS unsigned*)(lds + (bufoff) + ldsw + _i * 8192), 16, 0, 0); } while (0)
#define PG8_STAGE_A(bufoff, gbase, h) do { if constexpr (GATHER) PG8_STAGE(bufoff, gbase, voffG[h]); else PG8_STAGE(bufoff, (gbase) + (h) * hstep, voffA); } while (0)
#define PG8_LDA(dst, b, h) do { _Pragma("unroll") for (int m = 0; m < 4; ++m) _Pragma("unroll") for (int k = 0; k < 2; ++k) dst[m][k] = *(const LAS bf16x8*)(lds + PG8_SA(b, h) + aoff + m * 2048 + k * 1024); } while (0)
#define PG8_LDB(dst, b, h) do { _Pragma("unroll") for (int n = 0; n < 2; ++n) _Pragma("unroll") for (int k = 0; k < 2; ++k) dst[n][k] = *(const LAS bf16x8*)(lds + PG8_SB(b, h) + boff + n * 2048 + k * 1024); } while (0)
#define PG8_MMA(ai, bj, At, Bt) do { __builtin_amdgcn_s_setprio(1); _Pragma("unroll") for (int m = 0; m < 4; ++m) _Pragma("unroll") for (int n = 0; n < 2; ++n) _Pragma("unroll") for (int k = 0; k < 2; ++k) \
        acc[ai][bj][m][n] = __builtin_amdgcn_mfma_f32_16x16x32_bf16(Bt[n][k], At[m][k], acc[ai][bj][m][n], 0, 0, 0); __builtin_amdgcn_s_setprio(0); } while (0)
#define PG8_WAIT_V(n) asm volatile("s_waitcnt vmcnt(" #n ")" ::: "memory")
#define PG8_WAIT_L(n) asm volatile("s_waitcnt lgkmcnt(" #n ")" ::: "memory")
#define PG8_BAR __builtin_amdgcn_s_barrier()
#define PG8_SCHED __builtin_amdgcn_sched_barrier(0)
    auto gather_offs = [&](const Unit& u) -> u32x4 {
        const int* rm = S.rowmap(); u32x4 o;
        o.x = (unsigned)(rm[u.pm * 256 + gR[0]] * K + gC[0]) * 2u;       o.y = (unsigned)(rm[u.pm * 256 + gR[1]] * K + gC[1]) * 2u;
        o.z = (unsigned)(rm[u.pm * 256 + 128 + gR[0]] * K + gC[0]) * 2u; o.w = (unsigned)(rm[u.pm * 256 + 128 + gR[1]] * K + gC[1]) * 2u;
        return o; };
    Unit cur, nxt, nn; int ui = 0;
    if (!S.next(0, cur)) return;
    f32x4 acc[2][2][4][2];
#pragma unroll
    for (int a = 0; a < 2; ++a)
#pragma unroll
        for (int b = 0; b < 2; ++b)
#pragma unroll
            for (int m = 0; m < 4; ++m)
#pragma unroll
                for (int n = 0; n < 2; ++n) acc[a][b][m][n] = (f32x4){0.f, 0.f, 0.f, 0.f};
    bf16x8 At[4][2], B0[2][2], B1[2][2];
    const char* cA = S.a_base(cur); const char* cB = S.b_base(cur);
    if constexpr (GATHER) {
        const u32x4 o = gather_offs(cur); voffG[0][0] = o.x; voffG[0][1] = o.y; voffG[1][0] = o.z; voffG[1][1] = o.w;
        if (S.next(1, nn)) *gtab = gather_offs(nn);
        asm volatile("s_waitcnt vmcnt(0) lgkmcnt(0)" ::: "memory");
    }
    PG8_STAGE(PG8_SB(0, 0), cB, voffB); PG8_STAGE(PG8_SB(0, 1), cB + hstep, voffB); PG8_STAGE_A(PG8_SA(0, 0), cA, 0); PG8_STAGE_A(PG8_SA(0, 1), cA, 1);
    if (wr == 1) PG8_BAR;
    PG8_WAIT_V(2); PG8_BAR;
    PG8_STAGE(PG8_SB(1, 0), cB + kstep, voffB); PG8_STAGE_A(PG8_SA(1, 0), cA + kstep, 0); PG8_STAGE(PG8_SB(1, 1), cB + hstep + kstep, voffB);
    PG8_WAIT_V(6); PG8_BAR;
    for (;;) {
        const bool has_next = S.next(ui + 1, nxt);
        const char* nA = has_next ? S.a_base(nxt) : cA; const char* nB = has_next ? S.b_base(nxt) : cB;
        for (int t = 0; t < nt; t += 2) {
            const bool last = (t == nt - 2);
            const char* a1 = cA + (size_t)(t + 1) * kstep;
            const char* a2 = last ? nA : cA + (size_t)(t + 2) * kstep; const char* b2 = last ? nB : cB + (size_t)(t + 2) * kstep;
            const char* a3 = a2 + kstep; const char* b3 = b2 + kstep;
            PG8_LDB(B0, 0, 0); PG8_LDB(B1, 0, 1); PG8_SCHED; PG8_LDA(At, 0, 0); PG8_STAGE_A(PG8_SA(1, 1), a1, 1);
            if constexpr (GATHER) { if (last && has_next) { const u32x4 o = *gtab; voffG[0][0] = o.x; voffG[0][1] = o.y; voffG[1][0] = o.z; voffG[1][1] = o.w; } }
            PG8_WAIT_V(8); PG8_WAIT_L(0); PG8_BAR; PG8_MMA(0, 0, At, B0); PG8_MMA(0, 1, At, B1); PG8_BAR; PG8_SCHED;
            PG8_LDA(At, 0, 1); PG8_STAGE(PG8_SB(0, 0), b2, voffB); PG8_STAGE(PG8_SB(0, 1), b2 + hstep, voffB); PG8_STAGE_A(PG8_SA(0, 0), a2, 0);
            PG8_WAIT_V(8); PG8_WAIT_L(0); PG8_BAR; PG8_MMA(1, 0, At, B0); PG8_MMA(1, 1, At, B1); PG8_BAR; PG8_SCHED;
            PG8_LDB(B0, 1, 0); PG8_LDB(B1, 1, 1); PG8_SCHED; PG8_LDA(At, 1, 0); PG8_STAGE_A(PG8_SA(0, 1), a2, 1);
            PG8_WAIT_V(8); PG8_WAIT_L(0); PG8_BAR; PG8_MMA(0, 0, At, B0); PG8_MMA(0, 1, At, B1); PG8_BAR; PG8_SCHED;
            PG8_LDA(At, 1, 1); PG8_STAGE(PG8_SB(1, 0), b3, voffB); PG8_STAGE(PG8_SB(1, 1), b3 + hstep, voffB); PG8_STAGE_A(PG8_SA(1, 0), a3, 0);
            PG8_WAIT_V(8); PG8_WAIT_L(0); PG8_BAR; PG8_MMA(1, 0, At, B0); PG8_MMA(1, 1, At, B1); PG8_BAR; PG8_SCHED;
        }
        if (wr == 0) PG8_BAR;
        E(acc, cur, wr, wc, fr, fq);
        if constexpr (GATHER) { if (has_next && S.next(ui + 2, nn)) { *gtab = gather_offs(nn); } }
        if (!has_next) break;
#pragma unroll
        for (int a = 0; a < 2; ++a)
#pragma unroll
            for (int b = 0; b < 2; ++b)
#pragma unroll
                for (int m = 0; m < 4; ++m)
#pragma unroll
                    for (int n = 0; n < 2; ++n) acc[a][b][m][n] = (f32x4){0.f, 0.f, 0.f, 0.f};
        cur = nxt; cA = nA; cB = nB; ++ui;
        if (wr == 1) PG8_BAR;
    }
    PG8_WAIT_V(0);
    PG8_BAR;
#undef PG8_SA
#undef PG8_SB
#undef PG8_STAGE
#undef PG8_STAGE_A
#undef PG8_LDA
#undef PG8_LDB
#undef PG8_MMA
#undef PG8_WAIT_V
#undef PG8_WAIT_L
#undef PG8_BAR
#undef PG8_SCHED
}
}


struct PlainGemmArgs { const bf16_t* A; const bf16_t* Bt; int M, N, K, pad_; };
template <class Epi> __global__ __launch_bounds__(512, 2) void k_gplain(PlainGemmArgs a, Epi E) {
    extern __shared__ __attribute__((aligned(16))) unsigned char shm[];
    pg8::StaticOrder S; S.init(a.A, a.Bt, a.M, a.N, a.K, (int)gridDim.x, (int)blockIdx.x);
    pg8::gemm_phase<Epi, pg8::StaticOrder, false>((LAS unsigned char*)shm, a.K, S, E);
}
struct MoeGemmArgs { const bf16_t* A; const bf16_t* Bt; size_t estride; const int* panel_expert; const int* rowmap; const int* npanels; int NT, K; };
template <class Epi, bool GATHER> __global__ __launch_bounds__(512, 2) void k_gmoe(MoeGemmArgs a, Epi E) {
    extern __shared__ __attribute__((aligned(16))) unsigned char shm[];
    pg8::MoeOrder S; S.init(a.A, a.Bt, a.estride, a.panel_expert, GATHER ? a.rowmap : nullptr, *a.npanels, a.NT, a.K, (int)gridDim.x, (int)blockIdx.x);
    pg8::gemm_phase<Epi, pg8::MoeOrder, GATHER>((LAS unsigned char*)shm, a.K, S, E);
}

struct ConvArgs { const float *w_in, *we_gate, *we_up, *we_down, *ws_gate, *ws_up, *ws_down, *w_br, *w_out; bf16_t *WinT, *WguT, *WdT, *WbrT, *WoutT; int layer, pad_; };
constexpr int CV_SEG0 = 32 * 236, CV_SEG1 = 65 * 2 * 32 * 8, CV_SEG2 = 65 * 8 * 32, CV_SEG3 = 4 * 8 * 32, CV_SEG4 = 32 * 32;
constexpr int CV_TOTAL = CV_SEG0 + CV_SEG1 + CV_SEG2 + CV_SEG3 + CV_SEG4;
__device__ __forceinline__ void convert_tiles(const ConvArgs& a, int j0, int j1, int jstart, int jstride, float (*tile)[65]) {
    const int tid = threadIdx.x, L = a.layer;
    for (int j = j0 + jstart; j < j1; j += jstride) {
        const float* src; bf16_t* dst; int ld, ldd, valid = 64;
        if (j < CV_SEG0) { const int kb = j & 31, nb = j >> 5; ld = ZW; ldd = D;
            src = a.w_in + (size_t)L * D * ZW + (size_t)kb * 64 * ZW + nb * 64; valid = ZW - nb * 64; valid = valid < 0 ? 0 : (valid > 64 ? 64 : valid);
            dst = a.WinT + (size_t)nb * 64 * D + kb * 64; }
        else if (j < CV_SEG0 + CV_SEG1) { int q = j - CV_SEG0; const int cb = q & 7; q >>= 3; const int kb = q & 31; q >>= 5; const int bj = q & 1; const int e = q >> 1; ld = FW; ldd = D;
            const float* m = (e < NE) ? ((bj ? a.we_up : a.we_gate) + ((size_t)L * NE + e) * D * FW) : ((bj ? a.ws_up : a.ws_gate) + (size_t)L * D * FW);
            src = m + (size_t)kb * 64 * FW + cb * 64;
            dst = a.WguT + ((size_t)e * 1024 + (cb >> 1) * 256 + bj * 128 + (cb & 1) * 64) * D + kb * 64; }
        else if (j < CV_SEG0 + CV_SEG1 + CV_SEG2) { int q = j - CV_SEG0 - CV_SEG1; const int nb = q & 31; q >>= 5; const int kb = q & 7; const int e = q >> 3; ld = D; ldd = FW;
            const float* m = (e < NE) ? (a.we_down + ((size_t)L * NE + e) * FW * D) : (a.ws_down + (size_t)L * FW * D);
            src = m + (size_t)kb * 64 * D + nb * 64; dst = a.WdT + ((size_t)e * D + nb * 64) * FW + kb * 64; }
        else if (j < CV_SEG0 + CV_SEG1 + CV_SEG2 + CV_SEG3) { int q = j - CV_SEG0 - CV_SEG1 - CV_SEG2; const int nb = q & 31; q >>= 5; const int kb = q & 7; const int g = q >> 3; ld = D; ldd = FW;
            src = a.w_br + ((size_t)L * 4 + g) * FW * D + (size_t)kb * 64 * D + nb * 64; dst = a.WbrT + ((size_t)g * D + nb * 64) * FW + kb * 64; }
        else { const int q = j - CV_SEG0 - CV_SEG1 - CV_SEG2 - CV_SEG3; const int nb = q & 31, kb = q >> 5; ld = D; ldd = D;
            src = a.w_out + (size_t)L * D * D + (size_t)kb * 64 * D + nb * 64; dst = a.WoutT + (size_t)nb * 64 * D + kb * 64; }
        __syncthreads();
        { const int c4 = (tid & 15) * 4, k = tid >> 4;
#pragma unroll
          for (int h = 0; h < 2; ++h) { float4 v = make_float4(0.f, 0.f, 0.f, 0.f); if (c4 < valid) v = *(const float4*)(src + (size_t)(k + 32 * h) * ld + c4);
              tile[k + 32 * h][c4] = v.x; tile[k + 32 * h][c4 + 1] = v.y; tile[k + 32 * h][c4 + 2] = v.z; tile[k + 32 * h][c4 + 3] = v.w; } }
        __syncthreads();
        { const int n = tid >> 3, kc = (tid & 7) * 8; unsigned w[4];
#pragma unroll
          for (int q = 0; q < 4; ++q) w[q] = (unsigned)f2bf(tile[kc + 2 * q][n]) | ((unsigned)f2bf(tile[kc + 2 * q + 1][n]) << 16);
          *(uint4*)(dst + (size_t)n * ldd + kc) = make_uint4(w[0], w[1], w[2], w[3]); }
    }
}
__global__ __launch_bounds__(512) void k_convert(ConvArgs a) {
    __shared__ float tile[64][65];
    convert_tiles(a, 0, CV_TOTAL, blockIdx.x, gridDim.x, tile);
}

__global__ void k_cvt_bf16(const float* __restrict__ src, bf16_t* __restrict__ dst, size_t n) {
    for (size_t i = (size_t)blockIdx.x * blockDim.x + threadIdx.x; i < n; i += (size_t)gridDim.x * blockDim.x) dst[i] = f2bf(src[i]);
}

__global__ __launch_bounds__(256) void k_ln(const float* __restrict__ pre, const float* __restrict__ w, const float* __restrict__ b,
                                            float* __restrict__ outf, bf16_t* __restrict__ outb) {
    const int lane = threadIdx.x & 63;
    const int row = blockIdx.x * 4 + (threadIdx.x >> 6);
    const float* p = pre + (size_t)row * D;
    float v[32]; float s = 0.f;
#pragma unroll
    for (int i = 0; i < 8; ++i) { const float4 x = *(const float4*)(p + i * 256 + lane * 4); v[4 * i] = x.x; v[4 * i + 1] = x.y; v[4 * i + 2] = x.z; v[4 * i + 3] = x.w; s += (x.x + x.y) + (x.z + x.w); }
    const float mu = wave_sum(s) * (1.0f / D);
    float q = 0.f;
#pragma unroll
    for (int i = 0; i < 32; ++i) { const float d = v[i] - mu; q += d * d; }
    const float rstd = rsqrtf(wave_sum(q) * (1.0f / D) + 1e-5f);
#pragma unroll
    for (int i = 0; i < 8; ++i) {
        const int c = i * 256 + lane * 4;
        const float4 ww = *(const float4*)(w + c), bb = *(const float4*)(b + c);
        float4 o; o.x = (v[4 * i] - mu) * rstd * ww.x + bb.x; o.y = (v[4 * i + 1] - mu) * rstd * ww.y + bb.y; o.z = (v[4 * i + 2] - mu) * rstd * ww.z + bb.z; o.w = (v[4 * i + 3] - mu) * rstd * ww.w + bb.w;
        *(float4*)(outf + (size_t)row * D + c) = o;
        if (outb) { bf16_t* ob = outb + (size_t)row * D + c; ob[0] = f2bf(o.x); ob[1] = f2bf(o.y); ob[2] = f2bf(o.z); ob[3] = f2bf(o.w); }
    }
}

struct PrepArgs {
    const bf16_t* z;
    const float *hg_lb_logits, *rw_mu, *rw_w0, *rw_w2, *rw_a0, *rw_a2, *rw_g2, *rw_kk, *rw_ka, *rw_rk, *gla_g2, *gla_gb;
    float *rR, *rW, *rK, *rV, *rA, *rB, *rGate, *rBonus;
    float *hQ, *hW, *hK, *hV;
    float *gQ, *gW, *gK, *gV;
    int layer, pad_;
};
__global__ __launch_bounds__(512) void k_prep(PrepArgs p) {
    __shared__ float lr[160];
    __shared__ float glg[16];
    const int c = threadIdx.x, L = p.layer;
    const float mu_r = p.rw_mu[L * 1696 + c], mu_k = p.rw_mu[L * 1696 + 512 + c], mu_v = p.rw_mu[L * 1696 + 1024 + c];
    const float w0 = p.rw_w0[L * 512 + c], a0 = p.rw_a0[L * 512 + c], kkc = p.rw_kk[L * 512 + c], kac = p.rw_ka[L * 512 + c], rkc = p.rw_rk[L * 512 + c];
    float lb = 0.f;
    if (L == 1) { const float l0 = p.hg_lb_logits[c], l1 = p.hg_lb_logits[512 + c]; const float m = fmaxf(l0, l1); const float e0 = expf(l0 - m), e1 = expf(l1 - m); lb = e1 / (e0 + e1); }
    const float* w2 = p.rw_w2 + (size_t)L * 32 * 512; const float* a2 = p.rw_a2 + (size_t)L * 32 * 512; const float* g2 = p.rw_g2 + (size_t)L * 96 * 512;
    const float* gg2 = p.gla_g2 + (size_t)L * 16 * 256; const float gbc = (c < 256) ? p.gla_gb[L * 256 + c] : 0.f;
    for (int t = blockIdx.x; t < T; t += gridDim.x) {
        const bf16_t* zc = p.z + (size_t)t * ZLD;
        const bf16_t* zp = p.z + (size_t)(t > 0 ? t - 1 : 0) * ZLD;
        __syncthreads();
        if (c < 160) {
            const float cur = bf2f(zc[RW_LW + c]); const float prev = (t > 0) ? bf2f(zp[RW_LW + c]) : 0.f;
            const float zs = cur + (prev - cur) * p.rw_mu[L * 1696 + 1536 + c];
            lr[c] = (c < 32) ? tanhf(zs) : (c < 64 ? zs : sigmoidf_(zs));
        } else if (c >= 192 && c < 208) glg[c - 192] = bf2f(zc[GL_LG + (c - 192)]);
        __syncthreads();
        float r, k, v;
        { const float cr = bf2f(zc[RW_R + c]), ck = bf2f(zc[RW_K + c]), cv = bf2f(zc[RW_V + c]);
          const float pr = (t > 0) ? bf2f(zp[RW_R + c]) : 0.f, pk = (t > 0) ? bf2f(zp[RW_K + c]) : 0.f, pv = (t > 0) ? bf2f(zp[RW_V + c]) : 0.f;
          r = cr + (pr - cr) * mu_r; k = ck + (pk - ck) * mu_k; v = cv + (pv - cv) * mu_v; }
        float accW = w0, accA = a0, accG = 0.f;
#pragma unroll 8
        for (int j = 0; j < 32; ++j) { accW += lr[j] * w2[j * 512 + c]; accA += lr[32 + j] * a2[j * 512 + c]; }
#pragma unroll 8
        for (int j = 0; j < 96; ++j) accG += lr[64 + j] * g2[j * 512 + c];
        const float w_raw = -softplusf_(-accW) - 0.5f;
        const float decay = expf(-expf(w_raw));
        const float iclr = sigmoidf_(accA);
        const float kk = k * kkc;
        const float nrm = sqrtf(wave_sum(kk * kk));
        const float kkn = kk / fmaxf(nrm, 1e-12f);
        const float kmod = k * (1.0f + (iclr - 1.0f) * kac);
        const float bon = wave_sum(r * kmod * rkc) * v;
        const size_t o = (size_t)t * 512 + c;
        p.rR[o] = r; p.rW[o] = decay; p.rK[o] = kmod; p.rV[o] = v; p.rA[o] = -kkn; p.rB[o] = kkn * iclr; p.rGate[o] = accG; p.rBonus[o] = bon;
        { const float q = bf2f(zc[HG_Q + c]), f = bf2f(zc[HG_F + c]), i = bf2f(zc[HG_I + c]);
          const float omf = (1.0f - lb) * sigmoidf_(-f);
          p.hQ[o] = siluf_(q); p.hW[o] = 1.0f - omf; p.hK[o] = omf; p.hV[o] = i; }
        p.gV[o] = bf2f(zc[GL_V + c]);
        if (c < 256) {
            float acc = gbc;
#pragma unroll
            for (int j = 0; j < 16; ++j) acc += glg[j] * gg2[j * 256 + c];
            const float log_alpha = -softplusf_(-acc) * (1.0f / 16.0f);
            const size_t og = (size_t)t * 256 + c;
            p.gQ[og] = bf2f(zc[GL_Q + c]) * 0.125f; p.gW[og] = expf(log_alpha); p.gK[og] = bf2f(zc[GL_K + c]);
        }
    }
}

template <int KPL, bool HAS_SA>
__global__ __launch_bounds__(64) void k_rowrec(const float* __restrict__ Q, const float* __restrict__ Wd, const float* __restrict__ Kk, const float* __restrict__ V,
                                               const float* __restrict__ Aa, const float* __restrict__ Bb, float* __restrict__ O, int sq, int DV) {
    constexpr int DK = 64 * KPL;
    const int row = blockIdx.x, h = row / DV, lane = threadIdx.x;
    float S[KPL];
#pragma unroll
    for (int i = 0; i < KPL; ++i) S[i] = 0.f;
    const size_t qoff = (size_t)h * DK + lane;
    float obuf = 0.f;
    for (int t0 = 0; t0 < T; t0 += 8) {
        float q_[8][KPL], w_[8][KPL], k_[8][KPL], a_[8][KPL], b_[8][KPL], v_[8];
#pragma unroll
        for (int u = 0; u < 8; ++u) {
            const size_t base = (size_t)(t0 + u) * sq + qoff;
#pragma unroll
            for (int i = 0; i < KPL; ++i) {
                q_[u][i] = Q[base + 64 * i]; w_[u][i] = Wd[base + 64 * i]; k_[u][i] = Kk[base + 64 * i];
                if (HAS_SA) { a_[u][i] = Aa[base + 64 * i]; b_[u][i] = Bb[base + 64 * i]; } else { a_[u][i] = 0.f; b_[u][i] = 0.f; }
            }
            v_[u] = V[(size_t)(t0 + u) * 512 + row];
        }
#pragma unroll
        for (int u = 0; u < 8; ++u) {
            float sa = 0.f;
            if (HAS_SA) { float d = 0.f;
#pragma unroll
                for (int i = 0; i < KPL; ++i) d += S[i] * a_[u][i];
                sa = wave_sum(d); }
            float d2 = 0.f;
#pragma unroll
            for (int i = 0; i < KPL; ++i) { S[i] = S[i] * w_[u][i] + sa * b_[u][i] + v_[u] * k_[u][i]; d2 += S[i] * q_[u][i]; }
            const float o = wave_sum(d2);
            const int t = t0 + u;
            obuf = (lane == (t & 63)) ? o : obuf;
            if ((t & 63) == 63) O[(size_t)(t - 63 + lane) * 512 + row] = obuf;
        }
    }
}

__global__ __launch_bounds__(512) void k_finish_rms(const float* __restrict__ oraw, const float* __restrict__ gain, const bf16_t* __restrict__ z, bf16_t* __restrict__ bo, int gcol, int pad_) {
    __shared__ float part[8];
    const int c = threadIdx.x, wv = c >> 6;
    for (int t = blockIdx.x; t < T; t += gridDim.x) {
        const float o = oraw[(size_t)t * 512 + c];
        const float ss = wave_sum(o * o);
        __syncthreads();
        if ((c & 63) == 0) part[wv] = ss;
        __syncthreads();
        const float tot = part[(c >> 7) * 2] + part[(c >> 7) * 2 + 1];
        const float rs = rsqrtf(tot * (1.0f / 128.0f) + 1e-5f);
        const float g = bf2f(z[(size_t)t * ZLD + gcol + c]);
        bo[(size_t)t * 512 + c] = f2bf(o * rs * gain[c] * siluf_(g));
    }
}
__global__ __launch_bounds__(512) void k_finish_rw(const float* __restrict__ oraw, const float* __restrict__ lnw, const float* __restrict__ lnb,
                                                   const float* __restrict__ bonus, const float* __restrict__ gate, bf16_t* __restrict__ bo) {
    const int c = threadIdx.x;
    for (int t = blockIdx.x; t < T; t += gridDim.x) {
        const size_t o_ = (size_t)t * 512 + c;
        const float o = oraw[o_];
        const float mu = wave_sum(o) * (1.0f / 64.0f);
        const float d = o - mu;
        const float var = wave_sum(d * d) * (1.0f / 64.0f);
        const float y = d * rsqrtf(var + 64e-5f) * lnw[c] + lnb[c];
        bo[o_] = f2bf((y + bonus[o_]) * gate[o_]);
    }
}

__global__ __launch_bounds__(64) void k_sb_naive(const bf16_t* __restrict__ z, bf16_t* __restrict__ bo) {
    __shared__ float qs[128];
    const int h = blockIdx.x & 3, t = blockIdx.x >> 2, lane = threadIdx.x;
    const bf16_t* qp = z + (size_t)t * ZLD + SB_Q + h * 128;
    qs[lane] = bf2f(qp[lane]); qs[lane + 64] = bf2f(qp[lane + 64]);
    __syncthreads();
    float o0 = 0.f, o1 = 0.f, R = 0.f;
    const float scale = 0.08838834764831845f;
    for (int s_hi = t - 1; s_hi >= 0; s_hi -= 64) {
        const int s = s_hi - lane;
        const bool valid = s >= 0;
        float zz = 0.f;
        if (valid) {
            const bf16_t* kp = z + (size_t)s * ZLD + SB_K + h * 128;
            float acc = 0.f;
#pragma unroll 4
            for (int d8 = 0; d8 < 16; ++d8) {
                const uint4 kv = *(const uint4*)(kp + d8 * 8);
                const unsigned kw[4] = {kv.x, kv.y, kv.z, kv.w};
#pragma unroll
                for (int j = 0; j < 4; ++j) { acc += qs[d8 * 8 + 2 * j] * __uint_as_float(kw[j] << 16); acc += qs[d8 * 8 + 2 * j + 1] * __uint_as_float(kw[j] & 0xffff0000u); }
            }
            zz = acc * scale;
        }
        const float lk = valid ? -softplusf_(zz) : 0.f;
        float incl = lk;
#pragma unroll
        for (int off = 1; off < 64; off <<= 1) { const float y = __shfl_up(incl, off); if (lane >= off) incl += y; }
        const float logw = zz + lk + R + (incl - lk);
        const float w = valid ? expf(logw) : 0.f;
        const int nvalid = (s_hi + 1 < 64) ? s_hi + 1 : 64;
        for (int j = 0; j < nvalid; ++j) {
            const float wj = __shfl(w, j);
            const bf16_t* vp = z + (size_t)(s_hi - j) * ZLD + SB_V + h * 128;
            o0 += wj * bf2f(vp[lane]); o1 += wj * bf2f(vp[lane + 64]);
        }
        R += __shfl(incl, 63);
        if (R < -104.0f) break;
    }
    bo[(size_t)t * 512 + h * 128 + lane] = f2bf(o0); bo[(size_t)t * 512 + h * 128 + 64 + lane] = f2bf(o1);
}

constexpr int NSEG = 8, LSEG = T / NSEG;
typedef float f32x2v __attribute__((ext_vector_type(2)));
typedef float f32x4v __attribute__((ext_vector_type(4)));
struct MixArgs {
    const bf16_t* z;
    const float *hg_lb_logits, *hg_norm_w, *rw_mu, *rw_w0, *rw_w2, *rw_a0, *rw_a2, *rw_g2, *rw_kk, *rw_ka, *rw_rk, *rw_ln_w, *rw_ln_b, *gla_g2, *gla_gb, *gla_norm_w;
    float *RS, *HS, *GS; bf16_t* Vt; float *rGate, *rBonus;
    float *oR, *oH, *oG; bf16_t *cR, *cH, *cG;
    float *SendR, *PendR, *SendH, *SendG, *GamH, *GamG;
    bf16_t *SstR, *SstH, *SstG;
    bf16_t* bo;
    int layer, pad_;
};
__device__ __forceinline__ float red8(float x) { x += dppmov<0xB1>(x); x += dppmov<0x4E>(x); x += dppmov<0x141>(x); return x; }
__device__ __forceinline__ float red16(float x) { x += dppmov<0xB1>(x); x += dppmov<0x4E>(x); x += dppmov<0x141>(x); x += dppmov<0x140>(x); return x; }

__device__ __forceinline__ void prep_phase(const MixArgs& p, LAS unsigned char* ldsraw) {
    LAS float (*lr)[160] = (LAS float (*)[160])ldsraw;
    LAS float (*glg)[16] = (LAS float (*)[16])(ldsraw + 8 * 160 * 4);
    LAS bf16_t (*vtile)[72] = (LAS bf16_t (*)[72])(ldsraw + 8192);
    const int c = threadIdx.x, L = p.layer;
    const float mu_r = p.rw_mu[L * 1696 + c], mu_k = p.rw_mu[L * 1696 + 512 + c], mu_v = p.rw_mu[L * 1696 + 1024 + c];
    const float w0 = p.rw_w0[L * 512 + c], a0 = p.rw_a0[L * 512 + c], kkc = p.rw_kk[L * 512 + c], kac = p.rw_ka[L * 512 + c], rkc = p.rw_rk[L * 512 + c];
    float lb = 0.f;
    if (L == 1) { const float l0 = p.hg_lb_logits[c], l1 = p.hg_lb_logits[512 + c]; const float m = fmaxf(l0, l1); const float e0 = expf(l0 - m), e1 = expf(l1 - m); lb = e1 / (e0 + e1); }
    const float* w2 = p.rw_w2 + (size_t)L * 32 * 512; const float* a2 = p.rw_a2 + (size_t)L * 32 * 512; const float* g2 = p.rw_g2 + (size_t)L * 96 * 512;
    const float* gg2 = p.gla_g2 + (size_t)L * 16 * 256; const float gbc = (c < 256) ? p.gla_gb[L * 256 + c] : 0.f;
    for (int tile = blockIdx.x; tile < T / 64; tile += gridDim.x) {
        const int t0 = tile * 64;
        for (int tb = 0; tb < 8; ++tb) {
            const int tt0 = t0 + tb * 8;
            __syncthreads();
            for (int i = c; i < 8 * 160; i += 512) {
                const int tok = i / 160, col = i - tok * 160, t = tt0 + tok;
                const float cur = bf2f(p.z[(size_t)t * ZLD + RW_LW + col]); const float prev = (t > 0) ? bf2f(p.z[(size_t)(t - 1) * ZLD + RW_LW + col]) : 0.f;
                const float zs = cur + (prev - cur) * p.rw_mu[L * 1696 + 1536 + col];
                lr[tok][col] = (col < 32) ? tanhf(zs) : (col < 64 ? zs : sigmoidf_(zs));
            }
            if (c < 128) glg[c >> 4][c & 15] = bf2f(p.z[(size_t)(tt0 + (c >> 4)) * ZLD + GL_LG + (c & 15)]);
            __syncthreads();
            float accW[8], accA[8], accG[8], accL[8];
#pragma unroll
            for (int k = 0; k < 8; ++k) { accW[k] = w0; accA[k] = a0; accG[k] = 0.f; accL[k] = gbc; }
            for (int j = 0; j < 32; ++j) { const float w2v = w2[j * 512 + c], a2v = a2[j * 512 + c];
#pragma unroll
                for (int k = 0; k < 8; ++k) { accW[k] += lr[k][j] * w2v; accA[k] += lr[k][32 + j] * a2v; } }
            for (int j = 0; j < 96; ++j) { const float g2v = g2[j * 512 + c];
#pragma unroll
                for (int k = 0; k < 8; ++k) accG[k] += lr[k][64 + j] * g2v; }
            if (c < 256) { for (int j = 0; j < 16; ++j) { const float gv = gg2[j * 256 + c];
#pragma unroll
                for (int k = 0; k < 8; ++k) accL[k] += glg[k][j] * gv; } }
#pragma unroll
            for (int k = 0; k < 8; ++k) {
                const int t = tt0 + k;
                const bf16_t* zc = p.z + (size_t)t * ZLD; const bf16_t* zp = p.z + (size_t)(t > 0 ? t - 1 : 0) * ZLD;
                const float cr = bf2f(zc[RW_R + c]), ck = bf2f(zc[RW_K + c]), cv = bf2f(zc[RW_V + c]);
                const float pr = (t > 0) ? bf2f(zp[RW_R + c]) : 0.f, pk = (t > 0) ? bf2f(zp[RW_K + c]) : 0.f, pv = (t > 0) ? bf2f(zp[RW_V + c]) : 0.f;
                const float r = cr + (pr - cr) * mu_r, kx = ck + (pk - ck) * mu_k, v = cv + (pv - cv) * mu_v;
                const float w_raw = -softplusf_(-accW[k]) - 0.5f;
                const float decay = expf(-expf(w_raw));
                const float iclr = sigmoidf_(accA[k]);
                const float kk = kx * kkc;
                const float nrm = sqrtf(wave_sum(kk * kk));
                const float kkn = kk / fmaxf(nrm, 1e-12f);
                const float kmod = kx * (1.0f + (iclr - 1.0f) * kac);
                const float bon = wave_sum(r * kmod * rkc) * v;
                { const int h = c >> 6, j = c & 63; float* rs = p.RS + ((size_t)h * T + t) * 384 + j;
                  rs[0] = -kkn; rs[64] = kkn * iclr; rs[128] = decay; rs[192] = kmod; rs[256] = r; rs[320] = v; }
                p.rGate[(size_t)t * 512 + c] = accG[k]; p.rBonus[(size_t)t * 512 + c] = bon;
                { const float q = bf2f(zc[HG_Q + c]), f = bf2f(zc[HG_F + c]), iv = bf2f(zc[HG_I + c]);
                  const float omf = (1.0f - lb) * sigmoidf_(-f);
                  const int h = c >> 7, j = c & 127; float* hs = p.HS + ((size_t)h * T + t) * 512 + j;
                  hs[0] = siluf_(q); hs[128] = 1.0f - omf; hs[256] = omf; hs[384] = iv; }
                { const int h = c >> 7, j = c & 127; p.GS[((size_t)h * T + t) * 320 + 192 + j] = bf2f(zc[GL_V + c]); }
                if (c < 256) { const int h = c >> 6, j = c & 63; float* gs = p.GS + ((size_t)h * T + t) * 320 + j;
                  const float log_alpha = -softplusf_(-accL[k]) * (1.0f / 16.0f);
                  gs[0] = bf2f(zc[GL_Q + c]) * 0.125f; gs[64] = expf(log_alpha); gs[128] = bf2f(zc[GL_K + c]); }
            }
        }
        __syncthreads();
        for (int i = 0; i < 64; ++i) vtile[c][i] = p.z[(size_t)(t0 + i) * ZLD + SB_V + c];
        __syncthreads();
#pragma unroll
        for (int it = 0; it < 8; ++it) { const int row = it * 64 + (c >> 3), sg = c & 7;
            *(pg8::u32x4*)(p.Vt + (size_t)row * T + t0 + sg * 8) = *(const LAS pg8::u32x4*)&vtile[row][sg * 8]; }
    }
}

template <int KIND>
__device__ __forceinline__ void chain_unit(const MixArgs& p, const int seg, const int h, const int half, LAS float* lds) {
    constexpr int SF = KIND == 2 ? 512 : (KIND == 3 ? 320 : 384);
    constexpr int EPL = KIND == 2 ? 16 : 8, E2 = EPL / 2, DK = EPL * 8;
    constexpr int CH = 16, NP = CH * SF * 4 / 1024;
    const float* stream = (KIND <= 1 ? p.RS : (KIND == 2 ? p.HS : p.GS)) + ((size_t)h * T + (size_t)seg * LSEG) * SF;
    const int tid = threadIdx.x, wv = __builtin_amdgcn_readfirstlane(tid >> 6), lane = tid & 63, rg = lane >> 3, lj = lane & 7, row = wv * 8 + rg;
    LAS float* ob = lds + 2 * CH * SF;
    f32x2v S[E2];
#pragma unroll
    for (int e = 0; e < E2; ++e) { S[e] = (f32x2v){0.f, 0.f}; if (KIND == 1) { if (lj * 8 + 2 * e == row) S[e].x = 1.f; if (lj * 8 + 2 * e + 1 == row) S[e].y = 1.f; } }
    auto stage = [&](int ci, LAS float* dst) {
        const char* g = (const char*)(stream + (size_t)ci * CH * SF) + lane * 16;
        for (int pc = wv; pc < NP; pc += 8) __builtin_amdgcn_global_load_lds((const unsigned*)(g + pc * 1024), (LAS unsigned*)((LAS char*)dst + pc * 1024), 16, 0, 0);
    };
    auto writeout = [&](int ci, const LAS float* o) {
#pragma unroll
        for (int q = 0; q < 2; ++q) { const int idx = tid + 512 * q, s = idx >> 6, r = idx & 63; const size_t t = (size_t)seg * LSEG + ci * CH + s; const float v = o[idx];
            if (KIND == 0) p.oR[t * 512 + h * 64 + r] = v;
            else if (KIND == 1) p.cR[t * 512 + h * 64 + r] = f2bf(v);
            else if (KIND == 2) p.oH[t * 512 + h * 128 + half * 64 + r] = v;
            else p.oG[t * 512 + h * 128 + half * 64 + r] = v; }
    };
    constexpr int NCH = LSEG / CH;
    stage(0, lds);
    for (int ci = 0; ci < NCH; ++ci) {
        asm volatile("s_waitcnt vmcnt(0)" ::: "memory"); __syncthreads();
        const LAS float* cur = lds + (ci & 1) * CH * SF;
        if (ci + 1 < NCH) stage(ci + 1, lds + ((ci + 1) & 1) * CH * SF);
        if (ci > 0) writeout(ci - 1, ob + ((ci - 1) & 1) * 1024);
        LAS float* oc = ob + (ci & 1) * 1024;
#pragma unroll 2
        for (int s = 0; s < CH; ++s) {
            const LAS float* sp = cur + s * SF;
            if constexpr (KIND <= 1) {
                f32x2v a[4], b[4], w[4], k[4], r[4];
                { const f32x4v x0 = *(const LAS f32x4v*)(sp + lj * 8), x1 = *(const LAS f32x4v*)(sp + lj * 8 + 4); a[0] = x0.xy; a[1] = x0.zw; a[2] = x1.xy; a[3] = x1.zw; }
                { const f32x4v x0 = *(const LAS f32x4v*)(sp + 64 + lj * 8), x1 = *(const LAS f32x4v*)(sp + 64 + lj * 8 + 4); b[0] = x0.xy; b[1] = x0.zw; b[2] = x1.xy; b[3] = x1.zw; }
                { const f32x4v x0 = *(const LAS f32x4v*)(sp + 128 + lj * 8), x1 = *(const LAS f32x4v*)(sp + 128 + lj * 8 + 4); w[0] = x0.xy; w[1] = x0.zw; w[2] = x1.xy; w[3] = x1.zw; }
                { const f32x4v x0 = *(const LAS f32x4v*)(sp + 256 + lj * 8), x1 = *(const LAS f32x4v*)(sp + 256 + lj * 8 + 4); r[0] = x0.xy; r[1] = x0.zw; r[2] = x1.xy; r[3] = x1.zw; }
                f32x2v pp = S[0] * a[0]; pp = S[1] * a[1] + pp; f32x2v pq = S[2] * a[2]; pq = S[3] * a[3] + pq; pp += pq;
                const float sa = red8(pp.x + pp.y);
                const f32x2v sav = (f32x2v){sa, sa};
                if constexpr (KIND == 0) {
                    { const f32x4v x0 = *(const LAS f32x4v*)(sp + 192 + lj * 8), x1 = *(const LAS f32x4v*)(sp + 192 + lj * 8 + 4); k[0] = x0.xy; k[1] = x0.zw; k[2] = x1.xy; k[3] = x1.zw; }
                    const float v = sp[320 + row]; const f32x2v vv = (f32x2v){v, v};
#pragma unroll
                    for (int e = 0; e < 4; ++e) S[e] = S[e] * w[e] + (sav * b[e] + vv * k[e]);
                } else {
#pragma unroll
                    for (int e = 0; e < 4; ++e) S[e] = S[e] * w[e] + sav * b[e];
                }
                f32x2v oo = S[0] * r[0]; oo = S[1] * r[1] + oo; f32x2v oq = S[2] * r[2]; oq = S[3] * r[3] + oq; oo += oq;
                const float o = red8(oo.x + oo.y);
                if (lj == 0) oc[s * 64 + row] = o;
            } else {
                const float v = sp[3 * DK + half * 64 + row]; const f32x2v vv = (f32x2v){v, v};
                f32x2v oo = (f32x2v){0.f, 0.f}, oq = (f32x2v){0.f, 0.f};
#pragma unroll
                for (int e4 = 0; e4 < EPL / 4; ++e4) {
                    const f32x4v q4 = *(const LAS f32x4v*)(sp + lj * EPL + e4 * 4), w4 = *(const LAS f32x4v*)(sp + DK + lj * EPL + e4 * 4), k4 = *(const LAS f32x4v*)(sp + 2 * DK + lj * EPL + e4 * 4);
                    S[2 * e4] = S[2 * e4] * w4.xy + vv * k4.xy; S[2 * e4 + 1] = S[2 * e4 + 1] * w4.zw + vv * k4.zw;
                    oo = S[2 * e4] * q4.xy + oo; oq = S[2 * e4 + 1] * q4.zw + oq;
                }
                oo += oq;
                const float o = red8(oo.x + oo.y);
                if (lj == 0) oc[s * 64 + row] = o;
            }
        }
    }
    __syncthreads();
    writeout(NCH - 1, ob + ((NCH - 1) & 1) * 1024);
    float* dst;
    if (KIND == 0) dst = p.SendR + (((size_t)seg * 8 + h) * 64 + row) * 64 + lj * 8;
    else if (KIND == 1) dst = p.PendR + (((size_t)seg * 8 + h) * 64 + row) * 64 + lj * 8;
    else if (KIND == 2) dst = p.SendH + (((size_t)seg * 4 + h) * 128 + half * 64 + row) * 128 + lj * 16;
    else dst = p.SendG + (((size_t)seg * 4 + h) * 128 + half * 64 + row) * 64 + lj * 8;
#pragma unroll
    for (int e = 0; e < E2; ++e) { dst[2 * e] = S[e].x; dst[2 * e + 1] = S[e].y; }
    __syncthreads();
}
template <int DK, int SF>
__device__ __forceinline__ void gamma_unit(const float* __restrict__ stream_h, bf16_t* __restrict__ cout, int cstride, int ccol0, float* __restrict__ gam_out  , int gstride) {
    constexpr int SLOTS = 512 / DK;
    const int tid = threadIdx.x, slot = tid / DK, k = tid % DK;
    for (int seg = 1 + slot; seg < NSEG; seg += SLOTS) {
        float gam = 1.f;
        const float* sp = stream_h + (size_t)seg * LSEG * SF + k;
        for (int t0 = 0; t0 < LSEG; t0 += 32) {
            float q_[32], w_[32];
#pragma unroll
            for (int u = 0; u < 32; ++u) { q_[u] = sp[(size_t)(t0 + u) * SF]; w_[u] = sp[(size_t)(t0 + u) * SF + DK]; }
#pragma unroll
            for (int u = 0; u < 32; ++u) { gam *= w_[u]; cout[(size_t)(seg * LSEG + t0 + u) * cstride + ccol0 + k] = f2bf(q_[u] * gam); }
        }
        gam_out[(size_t)seg * gstride + k] = gam;
    }
}
__device__ __forceinline__ void chains_phase(const MixArgs& p, LAS unsigned char* ldsraw) {
    LAS float* lds = (LAS float*)ldsraw;
    for (int u = blockIdx.x; u < 256; u += gridDim.x) {
        if (u < 64) chain_unit<0>(p, u >> 3, u & 7, 0, lds);
        else if (u < 120) { const int q = u - 64; chain_unit<1>(p, 1 + (q >> 3), q & 7, 0, lds); }
        else if (u < 184) { const int q = u - 120; chain_unit<2>(p, q >> 3, (q & 7) >> 1, q & 1, lds); }
        else if (u < 248) { const int q = u - 184; chain_unit<3>(p, q >> 3, (q & 7) >> 1, q & 1, lds); }
        else if (u < 252) { const int h = u - 248; gamma_unit<128, 512>(p.HS + (size_t)h * T * 512, p.cH, 512, h * 128, p.GamH + h * 128, 4 * 128); }
        else { const int h = u - 252; gamma_unit<64, 320>(p.GS + (size_t)h * T * 320, p.cG, 256, h * 64, p.GamG + h * 64, 4 * 64); }
    }
}

__device__ __forceinline__ void carry_phase(const MixArgs& p, LAS unsigned char* ldsraw) {
    const int tid = threadIdx.x;
    for (int u = blockIdx.x; u < 16; u += gridDim.x) {
        if (u < 8) {
            const int h = u;
            LAS float (*cur)[65] = (LAS float (*)[65])ldsraw; LAS float (*Pm)[65] = (LAS float (*)[65])(ldsraw + 64 * 65 * 4);
            const int v = tid >> 3, kb = (tid & 7) * 8;
            float nv[8];
#pragma unroll
            for (int e = 0; e < 8; ++e) nv[e] = p.SendR[(((size_t)0 * 8 + h) * 64 + v) * 64 + kb + e];
            for (int s = 1; s < NSEG; ++s) {
                __syncthreads();
#pragma unroll
                for (int e = 0; e < 8; ++e) { cur[v][kb + e] = nv[e]; p.SstR[(((size_t)s * 8 + h) * 64 + v) * 64 + kb + e] = f2bf(nv[e]); }
                if (s == NSEG - 1) break;
#pragma unroll
                for (int e = 0; e < 8; ++e) Pm[v][kb + e] = p.PendR[(((size_t)s * 8 + h) * 64 + v) * 64 + kb + e];
                __syncthreads();
#pragma unroll
                for (int e = 0; e < 8; ++e) nv[e] = p.SendR[(((size_t)s * 8 + h) * 64 + v) * 64 + kb + e];
                for (int i = 0; i < 64; ++i) { const float c = cur[v][i];
#pragma unroll
                    for (int e = 0; e < 8; ++e) nv[e] += c * Pm[i][kb + e]; }
            }
            __syncthreads();
        } else if (u < 12) {
            const int h = u - 8;
            for (int q = 0; q < 32; ++q) { const int idx = tid + 512 * q, k = idx & 127;
                float cv = p.SendH[((size_t)0 * 4 + h) * 16384 + idx];
                for (int s = 1; s < NSEG; ++s) { p.SstH[((size_t)s * 4 + h) * 16384 + idx] = f2bf(cv); if (s < NSEG - 1) cv = p.GamH[(size_t)s * 512 + h * 128 + k] * cv + p.SendH[((size_t)s * 4 + h) * 16384 + idx]; } }
        } else {
            const int h = u - 12;
            for (int q = 0; q < 16; ++q) { const int idx = tid + 512 * q, k = idx & 63;
                float cv = p.SendG[((size_t)0 * 4 + h) * 8192 + idx];
                for (int s = 1; s < NSEG; ++s) { p.SstG[((size_t)s * 4 + h) * 8192 + idx] = f2bf(cv); if (s < NSEG - 1) cv = p.GamG[(size_t)s * 256 + h * 64 + k] * cv + p.SendG[((size_t)s * 4 + h) * 8192 + idx]; } }
        }
    }
}

__device__ __forceinline__ void mixfin_phase(const MixArgs& p) {
    typedef short bf16x8v __attribute__((ext_vector_type(8)));
    const int tid = threadIdx.x, wv = tid >> 6, lane = tid & 63, r = lane & 15, q = lane >> 4, L = p.layer;
    const int W = gridDim.x * 8;
    for (int u = blockIdx.x * 8 + wv; u < 16384; u += W) {
        if (u < 8192) {
            const int tt = u >> 3, h = u & 7, t0 = tt * 16, seg = t0 / LSEG;
            f32x4v acc[4];
#pragma unroll
            for (int nb = 0; nb < 4; ++nb) acc[nb] = (f32x4v){0.f, 0.f, 0.f, 0.f};
            if (seg >= 1) {
#pragma unroll
                for (int ks = 0; ks < 2; ++ks) { const bf16x8v A = *(const bf16x8v*)(p.cR + (size_t)(t0 + r) * 512 + h * 64 + ks * 32 + q * 8);
#pragma unroll
                    for (int nb = 0; nb < 4; ++nb) { const bf16x8v B = *(const bf16x8v*)(p.SstR + (((size_t)seg * 8 + h) * 64 + nb * 16 + r) * 64 + ks * 32 + q * 8);
                        acc[nb] = __builtin_amdgcn_mfma_f32_16x16x32_bf16(A, B, acc[nb], 0, 0, 0); } }
            }
#pragma unroll
            for (int i = 0; i < 4; ++i) { const size_t t = (size_t)t0 + 4 * q + i; float o[4]; float s = 0.f;
#pragma unroll
                for (int nb = 0; nb < 4; ++nb) { o[nb] = acc[nb][i] + p.oR[t * 512 + h * 64 + nb * 16 + r]; s += o[nb]; }
                const float mu = red16(s) * (1.0f / 64.0f); float d2 = 0.f;
#pragma unroll
                for (int nb = 0; nb < 4; ++nb) { o[nb] -= mu; d2 += o[nb] * o[nb]; }
                const float rstd = rsqrtf(red16(d2) * (1.0f / 64.0f) + 64e-5f);
#pragma unroll
                for (int nb = 0; nb < 4; ++nb) { const int c = h * 64 + nb * 16 + r; const float y = o[nb] * rstd * p.rw_ln_w[L * 512 + c] + p.rw_ln_b[L * 512 + c];
                    p.bo[(size_t)T * 512 + t * 512 + c] = f2bf((y + p.rBonus[t * 512 + c]) * p.rGate[t * 512 + c]); } }
        } else {
            const bool isH = u < 12288; const int qq = isH ? u - 8192 : u - 12288;
            const int tt = qq >> 2, h = qq & 3, t0 = tt * 16, seg = t0 / LSEG;
            f32x4v acc[8];
#pragma unroll
            for (int nb = 0; nb < 8; ++nb) acc[nb] = (f32x4v){0.f, 0.f, 0.f, 0.f};
            if (seg >= 1) {
                if (isH) {
#pragma unroll
                    for (int ks = 0; ks < 4; ++ks) { const bf16x8v A = *(const bf16x8v*)(p.cH + (size_t)(t0 + r) * 512 + h * 128 + ks * 32 + q * 8);
#pragma unroll
                        for (int nb = 0; nb < 8; ++nb) { const bf16x8v B = *(const bf16x8v*)(p.SstH + (((size_t)seg * 4 + h) * 128 + nb * 16 + r) * 128 + ks * 32 + q * 8);
                            acc[nb] = __builtin_amdgcn_mfma_f32_16x16x32_bf16(A, B, acc[nb], 0, 0, 0); } }
                } else {
#pragma unroll
                    for (int ks = 0; ks < 2; ++ks) { const bf16x8v A = *(const bf16x8v*)(p.cG + (size_t)(t0 + r) * 256 + h * 64 + ks * 32 + q * 8);
#pragma unroll
                        for (int nb = 0; nb < 8; ++nb) { const bf16x8v B = *(const bf16x8v*)(p.SstG + (((size_t)seg * 4 + h) * 128 + nb * 16 + r) * 64 + ks * 32 + q * 8);
                            acc[nb] = __builtin_amdgcn_mfma_f32_16x16x32_bf16(A, B, acc[nb], 0, 0, 0); } }
                }
            }
            const float* ol = isH ? p.oH : p.oG; const float* gain = (isH ? p.hg_norm_w : p.gla_norm_w) + L * 512; const int gcol = isH ? HG_G : GL_R;
            bf16_t* bo = p.bo + (isH ? (size_t)0 : (size_t)3 * T * 512);
#pragma unroll
            for (int i = 0; i < 4; ++i) { const size_t t = (size_t)t0 + 4 * q + i; float o[8]; float ss = 0.f;
#pragma unroll
                for (int nb = 0; nb < 8; ++nb) { o[nb] = acc[nb][i] + ol[t * 512 + h * 128 + nb * 16 + r]; ss += o[nb] * o[nb]; }
                const float rs = rsqrtf(red16(ss) * (1.0f / 128.0f) + 1e-5f);
#pragma unroll
                for (int nb = 0; nb < 8; ++nb) { const int c = h * 128 + nb * 16 + r; const float g = bf2f(p.z[t * ZLD + gcol + c]);
                    bo[t * 512 + c] = f2bf(o[nb] * rs * gain[c] * siluf_(g)); } }
        }
    }
}
constexpr int MIX_LDS = 2 * 16 * 512 * 4 + 2 * 1024 * 4;
__global__ __launch_bounds__(512, 2) void k_prep2(MixArgs p) { extern __shared__ __attribute__((aligned(16))) unsigned char shm[]; prep_phase(p, (LAS unsigned char*)shm); }
__global__ __launch_bounds__(512, 2) void k_chains(MixArgs p) { extern __shared__ __attribute__((aligned(16))) unsigned char shm[]; chains_phase(p, (LAS unsigned char*)shm); }
__global__ __launch_bounds__(512, 2) void k_carry(MixArgs p) { extern __shared__ __attribute__((aligned(16))) unsigned char shm[]; carry_phase(p, (LAS unsigned char*)shm); }
__global__ __launch_bounds__(512, 2) void k_mixfin(MixArgs p) { mixfin_phase(p); }

__global__ __launch_bounds__(512) void k_router(const float* __restrict__ x1, const float* __restrict__ wr, const float* __restrict__ rbias,
                                                int* __restrict__ idx, float* __restrict__ wsel, int* __restrict__ hist) {
    __shared__ int hs[64];
    const int tid = threadIdx.x, lane = tid & 63, wv = __builtin_amdgcn_readfirstlane(tid >> 6);
    if (tid < 64) hs[tid] = 0;
    __syncthreads();
    const float bias = rbias[lane];
    for (int it = 0; it < 2; ++it) {
        const int tb = blockIdx.x * 64 + wv * 8 + it * 4;
        float acc[4] = {0.f, 0.f, 0.f, 0.f};
        const float* xp = x1 + (size_t)tb * D;
        for (int k0 = 0; k0 < D; k0 += 4) {
            float wv4[4];
#pragma unroll
            for (int j = 0; j < 4; ++j) wv4[j] = wr[(size_t)(k0 + j) * 64 + lane];
#pragma unroll
            for (int q = 0; q < 4; ++q) {
                const float4 xv = *(const float4*)(xp + (size_t)q * D + k0);
                acc[q] += xv.x * wv4[0]; acc[q] += xv.y * wv4[1]; acc[q] += xv.z * wv4[2]; acc[q] += xv.w * wv4[3];
            }
        }
#pragma unroll
        for (int q = 0; q < 4; ++q) {
            const int t = tb + q;
            const float score = sigmoidf_(acc[q]);
            const float biased = score + bias;
            float m1 = biased;
            m1 = fmaxf(m1, __shfl_xor(m1, 1)); m1 = fmaxf(m1, __shfl_xor(m1, 2)); m1 = fmaxf(m1, __shfl_xor(m1, 4));
            int am = (biased == m1) ? lane : 64;
            am = min(am, __shfl_xor(am, 1)); am = min(am, __shfl_xor(am, 2)); am = min(am, __shfl_xor(am, 4));
            float m2 = (lane == am) ? -INFINITY : biased;
            m2 = fmaxf(m2, __shfl_xor(m2, 1)); m2 = fmaxf(m2, __shfl_xor(m2, 2)); m2 = fmaxf(m2, __shfl_xor(m2, 4));
            const float gs = m1 + m2;
            const int g = lane >> 3;
            int grank = 0;
#pragma unroll
            for (int g2 = 0; g2 < 8; ++g2) { const float o = __shfl(gs, g2 * 8); grank += (o > gs || (o == gs && g2 < g)) ? 1 : 0; }
            const bool gok = grank < 4;
            const float masked = gok ? biased : -INFINITY;
            int rank = 0;
            for (int e2 = 0; e2 < 64; ++e2) { const float o = rdlane(masked, e2); rank += (o > masked || (o == masked && e2 < lane)) ? 1 : 0; }
            const bool sel = rank < 8;
            const float ssum = wave_sum(sel ? score : 0.f);
            if (sel) { idx[(size_t)t * 8 + rank] = lane; wsel[(size_t)t * 8 + rank] = 2.5f * score / ssum; atomicAdd(&hs[lane], 1); }
        }
    }
    __syncthreads();
    if (tid < 64) hist[blockIdx.x * 64 + tid] = hs[tid];
}

__global__ __launch_bounds__(512) void k_dispatch(const int* __restrict__ idx, const float* __restrict__ wsel, const int* __restrict__ hist,
                                                  int* __restrict__ row_tok, float* __restrict__ row_w, int* __restrict__ slotpos,
                                                  int* __restrict__ panel_expert, int* __restrict__ npanels) {
    __shared__ int tot[64], bef[64], pstart[64], es[512];
    __shared__ int np_s;
    const int tid = threadIdx.x, blk = blockIdx.x;
    if (tid < 64) { int b = 0, s = 0; for (int j = 0; j < 256; ++j) { const int c = hist[j * 64 + tid]; if (j < blk) b += c; s += c; } tot[tid] = s; bef[tid] = b; }
    __syncthreads();
    if (tid == 0) { int acc = 0; for (int e = 0; e < 64; ++e) { pstart[e] = acc; acc += (tot[e] + 255) / 256 * 256; } np_s = acc / 256; }
    const int t = blk * 64 + (tid >> 3), k = tid & 7;
    const int e = idx[(size_t)t * 8 + k];
    es[tid] = e;
    __syncthreads();
    int rank = 0;
    for (int j = 0; j < tid; ++j) rank += (es[j] == e) ? 1 : 0;
    const int pos = pstart[e] + bef[e] + rank;
    row_tok[pos] = t; row_w[pos] = wsel[(size_t)t * 8 + k]; slotpos[(size_t)t * 8 + k] = pos;
    const int NP = np_s;
    if (blk < 64) {
        const int ee = blk, st = pstart[ee], cnt = tot[ee], pad = (cnt + 255) / 256 * 256;
        for (int r = st + cnt + tid; r < st + pad; r += 512) { row_tok[r] = 0; row_w[r] = 0.f; }
        for (int pp = st / 256 + tid; pp < (st + pad) / 256; pp += 512) panel_expert[pp] = ee;
    }
    if (tid < 64) { const int tt = blk * 64 + tid; row_tok[NP * 256 + tt] = tt; row_w[NP * 256 + tt] = 1.0f; }
    if (blk == 0) { if (tid < 64) panel_expert[NP + tid] = 64; if (tid == 0) npanels[0] = NP + 64; }
}

__global__ __launch_bounds__(256) void k_combine_ln(const float* __restrict__ x1, const bf16_t* __restrict__ y, const int* __restrict__ slotpos, const int* __restrict__ npanels,
                                                    const float* __restrict__ w, const float* __restrict__ b, float* __restrict__ outf, bf16_t* __restrict__ outb) {
    const int lane = threadIdx.x & 63;
    const int t = blockIdx.x * 4 + (threadIdx.x >> 6);
    const int shared_row = (npanels[0] - 64) * 256 + t;
    int rows[9];
#pragma unroll
    for (int k = 0; k < 8; ++k) rows[k] = slotpos[(size_t)t * 8 + k];
    rows[8] = shared_row;
    float v[32]; float s = 0.f;
#pragma unroll
    for (int i = 0; i < 8; ++i) {
        const int c = i * 256 + lane * 4;
        const float4 x = *(const float4*)(x1 + (size_t)t * D + c);
        float a0 = 0.f, a1 = 0.f, a2 = 0.f, a3 = 0.f;
#pragma unroll
        for (int k = 0; k < 9; ++k) { const uint2 u = *(const uint2*)(y + (size_t)rows[k] * D + c);
            a0 += __uint_as_float(u.x << 16); a1 += __uint_as_float(u.x & 0xffff0000u); a2 += __uint_as_float(u.y << 16); a3 += __uint_as_float(u.y & 0xffff0000u); }
        v[4 * i] = ALPHA * x.x + a0; v[4 * i + 1] = ALPHA * x.y + a1; v[4 * i + 2] = ALPHA * x.z + a2; v[4 * i + 3] = ALPHA * x.w + a3;
        s += (v[4 * i] + v[4 * i + 1]) + (v[4 * i + 2] + v[4 * i + 3]);
    }
    const float mu = wave_sum(s) * (1.0f / D);
    float q = 0.f;
#pragma unroll
    for (int i = 0; i < 32; ++i) { const float d = v[i] - mu; q += d * d; }
    const float rstd = rsqrtf(wave_sum(q) * (1.0f / D) + 1e-5f);
#pragma unroll
    for (int i = 0; i < 8; ++i) {
        const int c = i * 256 + lane * 4;
        const float4 ww = *(const float4*)(w + c), bb = *(const float4*)(b + c);
        float4 o; o.x = (v[4 * i] - mu) * rstd * ww.x + bb.x; o.y = (v[4 * i + 1] - mu) * rstd * ww.y + bb.y; o.z = (v[4 * i + 2] - mu) * rstd * ww.z + bb.z; o.w = (v[4 * i + 3] - mu) * rstd * ww.w + bb.w;
        *(float4*)(outf + (size_t)t * D + c) = o;
        if (outb) { bf16_t* ob = outb + (size_t)t * D + c; ob[0] = f2bf(o.x); ob[1] = f2bf(o.y); ob[2] = f2bf(o.z); ob[3] = f2bf(o.w); }
    }
}


template <class Epi, bool DUAL>
static void launch_ngemm(hipStream_t stream, int mtiles, int ntiles, const bf16_t* A, int lda, const int* rowmap, const float* B0, const float* B1, int ldb,
                         const float* B0s, const float* B1s, size_t estride, const int* panel_expert, const int* npanels, int N, int K, const Epi& epi) {
    GemmArgs<Epi> ga; memset(&ga, 0, sizeof ga);
    ga.A = A; ga.rowmap = rowmap; ga.B0 = B0; ga.B1 = B1; ga.B0s = B0s; ga.B1s = B1s; ga.estride = estride; ga.panel_expert = panel_expert; ga.npanels = npanels;
    ga.lda = lda; ga.ldb = ldb; ga.N = N; ga.K = K; memcpy(&ga.epi, &epi, sizeof(Epi));
    k_ngemm<Epi, DUAL><<<dim3(mtiles, ntiles), 256, 0, stream>>>(ga);
}
template <class E> static E zeroed() { E e; memset(&e, 0, sizeof e); return e; }
extern "C" void kernel_launch(void* const* d_in, const int* in_sizes, int n_in, void* d_out, int out_size, void* d_ws, size_t ws_size, hipStream_t stream) {
    const float* x_in = (const float*)d_in[0];
    const float* w_in = (const float*)d_in[1];
    const float* hg_lb = (const float*)d_in[2];
    const float* hg_norm_w = (const float*)d_in[3];
    const float* rw_mu = (const float*)d_in[4];
    const float* rw_w0 = (const float*)d_in[5];
    const float* rw_w2 = (const float*)d_in[6];
    const float* rw_a0 = (const float*)d_in[7];
    const float* rw_a2 = (const float*)d_in[8];
    const float* rw_g2 = (const float*)d_in[9];
    const float* rw_kk = (const float*)d_in[10];
    const float* rw_ka = (const float*)d_in[11];
    const float* rw_rk = (const float*)d_in[12];
    const float* rw_ln_w = (const float*)d_in[13];
    const float* rw_ln_b = (const float*)d_in[14];
    const float* gla_g2 = (const float*)d_in[15];
    const float* gla_gb = (const float*)d_in[16];
    const float* gla_norm_w = (const float*)d_in[17];
    const float* w_br = (const float*)d_in[18];
    const float* w_out = (const float*)d_in[19];
    const float* ln1_w = (const float*)d_in[20];
    const float* ln1_b = (const float*)d_in[21];
    const float* w_router = (const float*)d_in[22];
    const float* router_bias = (const float*)d_in[23];
    const float* we_gate = (const float*)d_in[24];
    const float* we_up = (const float*)d_in[25];
    const float* we_down = (const float*)d_in[26];
    const float* ws_gate = (const float*)d_in[27];
    const float* ws_up = (const float*)d_in[28];
    const float* ws_down = (const float*)d_in[29];
    const float* ln2_w = (const float*)d_in[30];
    const float* ln2_b = (const float*)d_in[31];

    char* base = (char*)d_ws; size_t off = 0;
    auto take = [&](size_t bytes) { char* p = base + off; off += (bytes + 255) & ~(size_t)255; return p; };
    const size_t MiB = 1024 * 1024;
    const size_t TS = (size_t)T * 512 * 4;
    const size_t zbytes = (((size_t)T * ZLD * 2) + 255) & ~(size_t)255;
    char* regY = take(zbytes + (size_t)8 * T * 384 * 4);
    bf16_t* z = (bf16_t*)regY;
    float* RS = (float*)(regY + zbytes);
    bf16_t* ybuf = (bf16_t*)regY;
    bf16_t* xb = (bf16_t*)take((size_t)T * D * 2);
    char* regM = take((size_t)MAXROWS * FW * 2 + (size_t)T * D * 4);
    float* HS = (float*)regM; float* GS = HS + (size_t)4 * T * 512; bf16_t* Vt = (bf16_t*)(GS + (size_t)4 * T * 320);
    float* rGate = (float*)(Vt + (size_t)512 * T); float* rBonus = rGate + (size_t)T * 512;
    bf16_t* hbuf = (bf16_t*)regM;
    float* x1 = (float*)(regM + (size_t)MAXROWS * FW * 2);
    float* oR = (float*)take(TS); float* oH = (float*)take(TS); float* oG = (float*)take(TS);
    bf16_t* cR = (bf16_t*)take(TS / 2); bf16_t* cH = (bf16_t*)take(TS / 2); bf16_t* cG = (bf16_t*)take(TS / 4);
    float* SendR = (float*)take((size_t)NSEG * 8 * 64 * 64 * 4); float* PendR = (float*)take((size_t)NSEG * 8 * 64 * 64 * 4);
    float* SendH = (float*)take((size_t)NSEG * 4 * 128 * 128 * 4); float* SendG = (float*)take((size_t)NSEG * 4 * 128 * 64 * 4);
    float* GamH = (float*)take((size_t)NSEG * 4 * 128 * 4); float* GamG = (float*)take((size_t)NSEG * 4 * 64 * 4);
    bf16_t* SstR = (bf16_t*)take((size_t)NSEG * 8 * 64 * 64 * 2); bf16_t* SstH = (bf16_t*)take((size_t)NSEG * 4 * 128 * 128 * 2); bf16_t* SstG = (bf16_t*)take((size_t)NSEG * 4 * 128 * 64 * 2);
    bf16_t* bo = (bf16_t*)take(4 * (size_t)T * 512 * 2);
    float* merged = (float*)take((size_t)T * D * 4);
    float* pre = merged;
    bf16_t* mergedb = (bf16_t*)take((size_t)T * D * 2);
    bf16_t* x1b = (bf16_t*)take((size_t)T * D * 2);
    float* x2 = (float*)d_out;
    bf16_t* WinT = (bf16_t*)take((size_t)ZLD * D * 2);
    bf16_t* WguT = (bf16_t*)take((size_t)65 * 1024 * D * 2);
    bf16_t* WdT = (bf16_t*)take((size_t)65 * D * FW * 2);
    bf16_t* WbrT = (bf16_t*)take((size_t)4 * D * FW * 2);
    bf16_t* WoutT = (bf16_t*)take((size_t)D * D * 2);
    int* idx = (int*)take((size_t)T * 8 * 4); float* wsel = (float*)take((size_t)T * 8 * 4); int* hist = (int*)take(256 * 64 * 4);
    int* row_tok = (int*)take((size_t)MAXROWS * 4); float* row_w = (float*)take((size_t)MAXROWS * 4); int* slotpos = (int*)take((size_t)T * 8 * 4);
    int* panel_expert = (int*)take(MAXPANELS * 4); int* npanels = (int*)take(256);
    if (off > ws_size) { fprintf(stderr, "workspace too small: need %zu MiB, have %zu MiB\n", off / MiB, ws_size / MiB); return; }
    const int GLDS = pg8::STAGE_BYTES + pg8::GTAB_BYTES;
    static bool attr_done = false;
    if (!attr_done) {
        hipFuncSetAttribute((const void*)k_gplain<pg8::EpiZ16>, hipFuncAttributeMaxDynamicSharedMemorySize, GLDS);
        hipFuncSetAttribute((const void*)k_gplain<pg8::EpiGateAcc>, hipFuncAttributeMaxDynamicSharedMemorySize, GLDS);
        hipFuncSetAttribute((const void*)k_gplain<pg8::EpiResid>, hipFuncAttributeMaxDynamicSharedMemorySize, GLDS);
        hipFuncSetAttribute((const void*)k_gmoe<pg8::EpiSwi, true>, hipFuncAttributeMaxDynamicSharedMemorySize, GLDS);
        hipFuncSetAttribute((const void*)k_gmoe<pg8::EpiDownW, false>, hipFuncAttributeMaxDynamicSharedMemorySize, GLDS);
        hipFuncSetAttribute((const void*)k_prep2, hipFuncAttributeMaxDynamicSharedMemorySize, 81920);
        hipFuncSetAttribute((const void*)k_chains, hipFuncAttributeMaxDynamicSharedMemorySize, MIX_LDS);
        attr_done = true;
    }
    const int GRID = 256;

    for (int L = 0; L < 2; ++L) {
        const float* xin = (L == 0) ? x_in : x2;
        float* xout = (L == 0) ? x2 : (float*)d_out;
        if (L == 0) k_cvt_bf16<<<2048, 256, 0, stream>>>(x_in, xb, (size_t)T * D);
        { ConvArgs ca; memset(&ca, 0, sizeof ca); ca.w_in = w_in; ca.we_gate = we_gate; ca.we_up = we_up; ca.we_down = we_down; ca.ws_gate = ws_gate; ca.ws_up = ws_up; ca.ws_down = ws_down; ca.w_br = w_br; ca.w_out = w_out;
          ca.WinT = WinT; ca.WguT = WguT; ca.WdT = WdT; ca.WbrT = WbrT; ca.WoutT = WoutT; ca.layer = L;
          k_convert<<<2048, 512, 0, stream>>>(ca); }
        { PlainGemmArgs ga; memset(&ga, 0, sizeof ga); ga.A = xb; ga.Bt = WinT; ga.M = T; ga.N = ZLD; ga.K = D;
          pg8::EpiZ16 e; memset(&e, 0, sizeof e); e.O = z; e.ldc = ZLD;
          k_gplain<pg8::EpiZ16><<<GRID, 512, GLDS, stream>>>(ga, e); }
        { MixArgs ma; memset(&ma, 0, sizeof ma); ma.z = z; ma.hg_lb_logits = hg_lb; ma.hg_norm_w = hg_norm_w; ma.rw_mu = rw_mu; ma.rw_w0 = rw_w0; ma.rw_w2 = rw_w2; ma.rw_a0 = rw_a0; ma.rw_a2 = rw_a2; ma.rw_g2 = rw_g2;
          ma.rw_kk = rw_kk; ma.rw_ka = rw_ka; ma.rw_rk = rw_rk; ma.rw_ln_w = rw_ln_w; ma.rw_ln_b = rw_ln_b; ma.gla_g2 = gla_g2; ma.gla_gb = gla_gb; ma.gla_norm_w = gla_norm_w;
          ma.RS = RS; ma.HS = HS; ma.GS = GS; ma.Vt = Vt; ma.rGate = rGate; ma.rBonus = rBonus; ma.oR = oR; ma.oH = oH; ma.oG = oG; ma.cR = cR; ma.cH = cH; ma.cG = cG;
          ma.SendR = SendR; ma.PendR = PendR; ma.SendH = SendH; ma.SendG = SendG; ma.GamH = GamH; ma.GamG = GamG; ma.SstR = SstR; ma.SstH = SstH; ma.SstG = SstG; ma.bo = bo; ma.layer = L;
          k_prep2<<<GRID, 512, 81920, stream>>>(ma);
          k_chains<<<GRID, 512, MIX_LDS, stream>>>(ma);
          k_carry<<<16, 512, 2 * 64 * 65 * 4, stream>>>(ma);
          k_sb_naive<<<4 * T, 64, 0, stream>>>(z, bo + 2 * (size_t)T * 512);
          k_mixfin<<<GRID, 512, 0, stream>>>(ma); }
        for (int g = 0; g < 4; ++g) {
            PlainGemmArgs ga; memset(&ga, 0, sizeof ga); ga.A = bo + (size_t)g * T * 512; ga.Bt = WbrT + (size_t)g * D * FW; ga.M = T; ga.N = D; ga.K = FW;
            pg8::EpiGateAcc e; memset(&e, 0, sizeof e); e.zg = z + GATE0 + g * D; e.merged = merged; e.mergedb = mergedb; e.g = g;
            k_gplain<pg8::EpiGateAcc><<<GRID, 512, GLDS, stream>>>(ga, e); }
        { PlainGemmArgs ga; memset(&ga, 0, sizeof ga); ga.A = mergedb; ga.Bt = WoutT; ga.M = T; ga.N = D; ga.K = D;
          pg8::EpiResid e; memset(&e, 0, sizeof e); e.xin = xin; e.pre = pre;
          k_gplain<pg8::EpiResid><<<GRID, 512, GLDS, stream>>>(ga, e); }
        k_ln<<<T / 4, 256, 0, stream>>>(pre, ln1_w + L * D, ln1_b + L * D, x1, x1b);
        k_router<<<256, 512, 0, stream>>>(x1, w_router + (size_t)L * D * NE, router_bias + L * NE, idx, wsel, hist);
        k_dispatch<<<256, 512, 0, stream>>>(idx, wsel, hist, row_tok, row_w, slotpos, panel_expert, npanels);
        { MoeGemmArgs ga; memset(&ga, 0, sizeof ga); ga.A = x1b; ga.Bt = WguT; ga.estride = (size_t)1024 * D; ga.panel_expert = panel_expert; ga.rowmap = row_tok; ga.npanels = npanels; ga.NT = 4; ga.K = D;
          pg8::EpiSwi e; memset(&e, 0, sizeof e); e.h = hbuf;
          k_gmoe<pg8::EpiSwi, true><<<GRID, 512, GLDS, stream>>>(ga, e); }
        { MoeGemmArgs ga; memset(&ga, 0, sizeof ga); ga.A = hbuf; ga.Bt = WdT; ga.estride = (size_t)D * FW; ga.panel_expert = panel_expert; ga.rowmap = nullptr; ga.npanels = npanels; ga.NT = 8; ga.K = FW;
          pg8::EpiDownW e; memset(&e, 0, sizeof e); e.y = ybuf; e.row_w = row_w;
          k_gmoe<pg8::EpiDownW, false><<<GRID, 512, GLDS, stream>>>(ga, e); }
        k_combine_ln<<<T / 4, 256, 0, stream>>>(x1, ybuf, slotpos, npanels, ln2_w + L * D, ln2_b + L * D, xout, (L == 0) ? xb : nullptr);
    }
}
```

```cpp
#include <hip/hip_runtime.h>
#include <stdint.h>
#include <stdio.h>
#include <string.h>

typedef unsigned short bf16_t;

constexpr int T = 16384, D = 2048, ZW = 15024, ZLD = 15104, NE = 64, FW = 512;
constexpr int HG_Q = 0, HG_F = 512, HG_I = 1024, HG_G = 1536;
constexpr int RW_R = 2048, RW_K = 2560, RW_V = 3072, RW_LW = 3584;
constexpr int SB_Q = 3744, SB_K = 4256, SB_V = 4768;
constexpr int GL_Q = 5280, GL_K = 5536, GL_V = 5792, GL_LG = 6304, GL_R = 6320;
constexpr int GATE0 = 6832;
constexpr float ALPHA = 1.4142135623730951f;
constexpr int MAXPANELS = 640;
constexpr int MAXROWS = MAXPANELS * 256;

__device__ __forceinline__ float bf2f(bf16_t v) { return __uint_as_float(((unsigned)v) << 16); }
__device__ __forceinline__ bf16_t f2bf(float f) { unsigned u = __float_as_uint(f); u += 0x7FFFu + ((u >> 16) & 1u); return (bf16_t)(u >> 16); }
__device__ __forceinline__ float sigmoidf_(float x) { return 1.0f / (1.0f + expf(-x)); }
__device__ __forceinline__ float softplusf_(float x) { return fmaxf(x, 0.f) + log1pf(expf(-fabsf(x))); }
__device__ __forceinline__ float siluf_(float x) { return x / (1.0f + expf(-x)); }

template <int CTRL> __device__ __forceinline__ float dppmov(float x) {
    return __builtin_bit_cast(float, __builtin_amdgcn_update_dpp(0, __builtin_bit_cast(int, x), CTRL, 0xF, 0xF, true));
}
__device__ __forceinline__ float rdlane(float x, int l) { return __builtin_bit_cast(float, __builtin_amdgcn_readlane(__builtin_bit_cast(int, x), l)); }
__device__ __forceinline__ float wave_sum(float x) {
    x += dppmov<0xB1>(x);
    x += dppmov<0x4E>(x);
    x += dppmov<0x141>(x);
    x += dppmov<0x140>(x);
    return (rdlane(x, 0) + rdlane(x, 16)) + (rdlane(x, 32) + rdlane(x, 48));
}

struct EpiZ { bf16_t* z; __device__ void operator()(int m, int n, float a0, float) const { z[(size_t)m * ZLD + n] = f2bf(a0); } };
struct EpiGate { const bf16_t* z; float* merged; bf16_t* mergedb; int g; int pad_;
    __device__ void operator()(int m, int n, float a0, float) const {
        const float gl = bf2f(z[(size_t)m * ZLD + GATE0 + g * D + n]);
        float v = sigmoidf_(gl) * a0;
        const size_t o = (size_t)m * D + n;
        if (g > 0) v += merged[o];
        merged[o] = v;
        if (g == 3) mergedb[o] = f2bf(v);
    } };
struct EpiRes { const float* xin; float* pre; __device__ void operator()(int m, int n, float a0, float) const { const size_t o = (size_t)m * D + n; pre[o] = ALPHA * xin[o] + a0; } };
struct EpiSwiglu { bf16_t* h; __device__ void operator()(int m, int n, float a0, float a1) const { h[(size_t)m * FW + n] = f2bf(siluf_(a0) * a1); } };
struct EpiDown { bf16_t* y; const float* row_w; __device__ void operator()(int m, int n, float a0, float) const { y[(size_t)m * D + n] = f2bf(a0 * row_w[m]); } };

template <class Epi> struct GemmArgs { const bf16_t* A; const int* rowmap; const float *B0, *B1, *B0s, *B1s; size_t estride; const int* panel_expert; const int* npanels; int lda, ldb, N, K; Epi epi; };
template <class Epi, bool DUAL>
__global__ __launch_bounds__(256) void k_ngemm(const GemmArgs<Epi> ga) {
    const bf16_t* __restrict__ A = ga.A; const int* __restrict__ rowmap = ga.rowmap; const float* __restrict__ B0 = ga.B0; const float* __restrict__ B1 = ga.B1;
    const float* __restrict__ B0s = ga.B0s; const float* __restrict__ B1s = ga.B1s; const size_t estride = ga.estride;
    const int* __restrict__ panel_expert = ga.panel_expert; const int* __restrict__ npanels = ga.npanels; const int lda = ga.lda, ldb = ga.ldb, N = ga.N, K = ga.K; const Epi epi = ga.epi;
    __shared__ float As[16][132];
    __shared__ float Bs0[16][132];
    __shared__ float Bs1[DUAL ? 16 : 1][132];
    const int tid = threadIdx.x, tx = tid & 15, ty = tid >> 4;
    const int m0 = blockIdx.x * 128, n0 = blockIdx.y * 128;
    const float* Bp0 = B0; const float* Bp1 = B1;
    if (panel_expert) {
        const int p = m0 >> 8;
        if (p >= *npanels) return;
        const int e = panel_expert[p];
        if (e < NE) { Bp0 = B0 + (size_t)e * estride; if constexpr (DUAL) Bp1 = B1 + (size_t)e * estride; }
        else { Bp0 = B0s; if constexpr (DUAL) Bp1 = B1s; }
    }
    float acc0[8][8], acc1[DUAL ? 8 : 1][8];
#pragma unroll
    for (int i = 0; i < 8; ++i)
#pragma unroll
        for (int j = 0; j < 8; ++j) { acc0[i][j] = 0.f; if constexpr (DUAL) acc1[i][j] = 0.f; }
    const int arow = tid >> 1, akh = tid & 1;
    const int am = m0 + arow;
    const size_t asrc = (size_t)(rowmap ? rowmap[am] : am) * lda + akh * 8;
    const int bk = tid >> 4, bn = (tid & 15) * 8;
    for (int k0 = 0; k0 < K; k0 += 16) {
        const uint4 av = *(const uint4*)(A + asrc + k0);
        const unsigned aw[4] = {av.x, av.y, av.z, av.w};
#pragma unroll
        for (int j = 0; j < 4; ++j) { As[akh * 8 + 2 * j][arow] = __uint_as_float(aw[j] << 16); As[akh * 8 + 2 * j + 1][arow] = __uint_as_float(aw[j] & 0xffff0000u); }
#pragma unroll
        for (int q = 0; q < 2; ++q) {
            const int n = n0 + bn + q * 4;
            float4 v0 = make_float4(0.f, 0.f, 0.f, 0.f), v1 = v0;
            if (n < N) { v0 = *(const float4*)(Bp0 + (size_t)(k0 + bk) * ldb + n); if constexpr (DUAL) v1 = *(const float4*)(Bp1 + (size_t)(k0 + bk) * ldb + n); }
            *(float4*)&Bs0[bk][bn + q * 4] = v0;
            if constexpr (DUAL) *(float4*)&Bs1[bk][bn + q * 4] = v1;
        }
        __syncthreads();
#pragma unroll
        for (int k = 0; k < 16; ++k) {
            float a[8], b[8], c[8];
            *(float4*)&a[0] = *(const float4*)&As[k][ty * 8]; *(float4*)&a[4] = *(const float4*)&As[k][ty * 8 + 4];
            *(float4*)&b[0] = *(const float4*)&Bs0[k][tx * 8]; *(float4*)&b[4] = *(const float4*)&Bs0[k][tx * 8 + 4];
            if constexpr (DUAL) { *(float4*)&c[0] = *(const float4*)&Bs1[k][tx * 8]; *(float4*)&c[4] = *(const float4*)&Bs1[k][tx * 8 + 4]; }
#pragma unroll
            for (int i = 0; i < 8; ++i)
#pragma unroll
                for (int j = 0; j < 8; ++j) { acc0[i][j] += a[i] * b[j]; if constexpr (DUAL) acc1[i][j] += a[i] * c[j]; }
        }
        __syncthreads();
    }
#pragma unroll
    for (int i = 0; i < 8; ++i)
#pragma unroll
        for (int j = 0; j < 8; ++j) { const int m = m0 + ty * 8 + i, n = n0 + tx * 8 + j; if (n < N) { float a1 = 0.f; if constexpr (DUAL) a1 = acc1[i][j]; epi(m, n, acc0[i][j], a1); } }
}


#define LAS __attribute__((address_space(3)))
namespace pg8 {
typedef short bf16x8 __attribute__((ext_vector_type(8)));
typedef float f32x4 __attribute__((ext_vector_type(4)));
typedef unsigned u32x4 __attribute__((ext_vector_type(4)));
typedef unsigned u32x2 __attribute__((ext_vector_type(2)));
constexpr int BM = 256, BK = 64, HALF = 128, HTB = HALF * BK * 2, STAGE_BYTES = 8 * HTB, NXCD = 8, WGM = 8;
constexpr int GTAB_BYTES = 512 * 16;
__host__ __device__ __forceinline__ int lds_byte(int r, int c) { const int st = (r >> 4) * 2 + (c >> 5), rr = r & 15, cc = c & 31, ob = rr * 64 + cc * 2; return st * 1024 + (ob ^ (((ob >> 9) & 1) << 5)); }
__host__ __device__ __forceinline__ void stage_rc(int b, int& R, int& C) { const int st = b / 1024, sb = b % 1024, swz = sb ^ (((sb >> 9) & 1) << 5); R = (st >> 1) * 16 + swz / 64; C = (st & 1) * 32 + (swz % 64) / 2; }
__host__ __device__ __forceinline__ int perm32(int rho) { const int n = rho >> 4, i = rho & 15; return 8 * (i >> 2) + 4 * n + (i & 3); }
struct Unit { int pm, pn, e; };
__device__ __forceinline__ unsigned cvt_pk_bf16(float lo, float hi) { unsigned r; asm volatile("v_cvt_pk_bf16_f32 %0, %1, %2" : "=v"(r) : "v"(lo), "v"(hi)); return r; }

struct StaticOrder {
    const bf16_t* A; const bf16_t* Bt; int K; int nM, nN, nwg, G, c;
    __device__ void init(const bf16_t* A_, const bf16_t* Bt_, int M, int N, int K_, int G_, int c_) { A = A_; Bt = Bt_; K = K_; nM = M / BM; nN = N / BM; nwg = nM * nN; G = G_; c = c_; }
    __device__ bool next(int i, Unit& u) const {
        const int L = i * G + c; if (L >= nwg) return false;
        int wgid = L; { const int q = nwg / NXCD, r = nwg % NXCD, xcd = wgid % NXCD, off = wgid / NXCD; wgid = (xcd < r ? xcd * (q + 1) : r * (q + 1) + (xcd - r) * q) + off; }
        const int nig = WGM * nN, gid = wgid / nig, fm = gid * WGM, gsz = (nM - fm) < WGM ? (nM - fm) : WGM;
        u.pm = fm + ((wgid % nig) % gsz); u.pn = (wgid % nig) / gsz; u.e = 0; return true;
    }
    __device__ __forceinline__ const char* a_base(const Unit& u) const { return (const char*)A + (size_t)u.pm * 256 * K * 2; }
    __device__ __forceinline__ const char* b_base(const Unit& u) const { return (const char*)Bt + (size_t)u.pn * 256 * K * 2; }
    __device__ __forceinline__ const int* rowmap() const { return nullptr; }
};
struct MoeOrder {
    const bf16_t* A; const bf16_t* Bt; const int* panel_expert; const int* rmap; size_t estride; int K, NT, total, G, c;
    __device__ void init(const bf16_t* A_, const bf16_t* Bt_, size_t estride_, const int* pe, const int* rmap_, int npanels, int NT_, int K_, int G_, int c_) {
        A = A_; Bt = Bt_; estride = estride_; panel_expert = pe; rmap = rmap_; K = K_; NT = NT_; total = npanels * NT_; G = G_;
        c = (c_ & 7) * (G_ >> 3) + (c_ >> 3);
    }
    __device__ bool next(int i, Unit& u) const {
        const int L = i * G + c; if (L >= total) return false;
        u.pm = L / NT; u.pn = L % NT; u.e = panel_expert[u.pm]; return true;
    }
    __device__ __forceinline__ const char* a_base(const Unit& u) const { return rmap ? (const char*)A : (const char*)A + (size_t)u.pm * 256 * K * 2; }
    __device__ __forceinline__ const char* b_base(const Unit& u) const { return (const char*)(Bt + (size_t)u.e * estride) + (size_t)u.pn * 256 * K * 2; }
    __device__ __forceinline__ const int* rowmap() const { return rmap; }
};

struct EpiZ16 {
    static constexpr bool PERM = true;
    bf16_t* O; int ldc; int pad_;
    __device__ __forceinline__ void operator()(const f32x4 (&acc)[2][2][4][2], const Unit& u, int wr, int wc, int fr, int fq) const {
        const int row0 = u.pm * BM + wr * 64 + fr, col0 = u.pn * BM + wc * 32 + 8 * fq;
#pragma unroll
        for (int ai = 0; ai < 2; ++ai)
#pragma unroll
            for (int m = 0; m < 4; ++m) { bf16_t* rowp = O + (size_t)(row0 + ai * HALF + m * 16) * ldc + col0;
#pragma unroll
                for (int bj = 0; bj < 2; ++bj) { const f32x4 v0 = acc[ai][bj][m][0], v1 = acc[ai][bj][m][1];
                    u32x4 w; w.x = cvt_pk_bf16(v0[0], v0[1]); w.y = cvt_pk_bf16(v0[2], v0[3]); w.z = cvt_pk_bf16(v1[0], v1[1]); w.w = cvt_pk_bf16(v1[2], v1[3]);
                    *(u32x4*)(rowp + bj * HALF) = w; } }
    }
};
struct EpiGateAcc {
    static constexpr bool PERM = false;
    const bf16_t* zg; float* merged; bf16_t* mergedb; int g; int pad_;
    __device__ __forceinline__ void operator()(const f32x4 (&acc)[2][2][4][2], const Unit& u, int wr, int wc, int fr, int fq) const {
        const int row0 = u.pm * BM + wr * 64 + fr, col0 = u.pn * BM + wc * 32 + 4 * fq;
#pragma unroll
        for (int ai = 0; ai < 2; ++ai)
#pragma unroll
            for (int m = 0; m < 4; ++m) { const size_t row = (size_t)(row0 + ai * HALF + m * 16);
#pragma unroll
                for (int bj = 0; bj < 2; ++bj)
#pragma unroll
                    for (int n = 0; n < 2; ++n) { const int col = col0 + bj * HALF + n * 16;
                        const u32x2 gz = *(const u32x2*)(zg + row * ZLD + col);
                        f32x4 gl; gl[0] = __uint_as_float(gz.x << 16); gl[1] = __uint_as_float(gz.x & 0xffff0000u); gl[2] = __uint_as_float(gz.y << 16); gl[3] = __uint_as_float(gz.y & 0xffff0000u);
                        f32x4 v = acc[ai][bj][m][n];
#pragma unroll
                        for (int j = 0; j < 4; ++j) v[j] *= 1.0f / (1.0f + __expf(-gl[j]));
                        float* mp = merged + row * D + col;
                        if (g > 0) v += *(const f32x4*)mp;
                        if (g < 3) *(f32x4*)mp = v;
                        else { u32x2 w; w.x = cvt_pk_bf16(v[0], v[1]); w.y = cvt_pk_bf16(v[2], v[3]); *(u32x2*)(mergedb + row * D + col) = w; } } }
    }
};
struct EpiResid {
    static constexpr bool PERM = false;
    const float* xin; float* pre;
    __device__ __forceinline__ void operator()(const f32x4 (&acc)[2][2][4][2], const Unit& u, int wr, int wc, int fr, int fq) const {
        const int row0 = u.pm * BM + wr * 64 + fr, col0 = u.pn * BM + wc * 32 + 4 * fq;
#pragma unroll
        for (int ai = 0; ai < 2; ++ai)
#pragma unroll
            for (int m = 0; m < 4; ++m) { const size_t ro = (size_t)(row0 + ai * HALF + m * 16) * D + col0;
#pragma unroll
                for (int bj = 0; bj < 2; ++bj)
#pragma unroll
                    for (int n = 0; n < 2; ++n) { const f32x4 xv = *(const f32x4*)(xin + ro + bj * HALF + n * 16); *(f32x4*)(pre + ro + bj * HALF + n * 16) = xv * ALPHA + acc[ai][bj][m][n]; } }
    }
};
struct EpiSwi {
    static constexpr bool PERM = true;
    bf16_t* h;
    __device__ __forceinline__ void operator()(const f32x4 (&acc)[2][2][4][2], const Unit& u, int wr, int wc, int fr, int fq) const {
        const int row0 = u.pm * BM + wr * 64 + fr, col0 = u.pn * HALF + wc * 32 + 8 * fq;
#pragma unroll
        for (int ai = 0; ai < 2; ++ai)
#pragma unroll
            for (int m = 0; m < 4; ++m) { float o[8];
#pragma unroll
                for (int n = 0; n < 2; ++n)
#pragma unroll
                    for (int j = 0; j < 4; ++j) { const float gt = acc[ai][0][m][n][j], up = acc[ai][1][m][n][j]; o[4 * n + j] = gt / (1.0f + __expf(-gt)) * up; }
                u32x4 w; w.x = cvt_pk_bf16(o[0], o[1]); w.y = cvt_pk_bf16(o[2], o[3]); w.z = cvt_pk_bf16(o[4], o[5]); w.w = cvt_pk_bf16(o[6], o[7]);
                *(u32x4*)(h + (size_t)(row0 + ai * HALF + m * 16) * FW + col0) = w; }
    }
};
struct EpiDownW {
    static constexpr bool PERM = true;
    bf16_t* y; const float* row_w;
    __device__ __forceinline__ void operator()(const f32x4 (&acc)[2][2][4][2], const Unit& u, int wr, int wc, int fr, int fq) const {
        const int row0 = u.pm * BM + wr * 64 + fr, col0 = u.pn * BM + wc * 32 + 8 * fq;
#pragma unroll
        for (int ai = 0; ai < 2; ++ai)
#pragma unroll
            for (int m = 0; m < 4; ++m) { const int row = row0 + ai * HALF + m * 16; const float s = row_w[row]; bf16_t* rowp = y + (size_t)row * D + col0;
#pragma unroll
                for (int bj = 0; bj < 2; ++bj) { const f32x4 v0 = acc[ai][bj][m][0] * s, v1 = acc[ai][bj][m][1] * s;
                    u32x4 w; w.x = cvt_pk_bf16(v0[0], v0[1]); w.y = cvt_pk_bf16(v0[2], v0[3]); w.z = cvt_pk_bf16(v1[0], v1[1]); w.w = cvt_pk_bf16(v1[2], v1[3]);
                    *(u32x4*)(rowp + bj * HALF) = w; } }
    }
};

template <class Epi, class Sched, bool GATHER>
__device__ __forceinline__ void gemm_phase(LAS unsigned char* lds, const int K, const Sched& S, const Epi& E) {
    const int tid = threadIdx.x, wid = __builtin_amdgcn_readfirstlane(tid >> 6), wr = wid >> 2, wc = wid & 3, lane = tid & 63, fr = lane & 15, fq = lane >> 4;
    const int nt = K / BK;
    unsigned voffA[2], voffB[2], voffG[2][2]; int gR[2], gC[2];
#pragma unroll
    for (int i = 0; i < 2; ++i) { int R, C; stage_rc(tid * 16 + i * 8192, R, C); const int Rb = Epi::PERM ? ((R & ~31) + perm32(R & 31)) : R;
        voffA[i] = (unsigned)(R * K + C) * 2u; voffB[i] = (unsigned)(Rb * K + C) * 2u; gR[i] = R; gC[i] = C; voffG[0][i] = 0u; voffG[1][i] = 0u; }
    const size_t kstep = (size_t)(BK * 2);
    const size_t hstep = (size_t)HALF * K * 2;
    const unsigned ldsw = (unsigned)wid * 1024u;
    const int aoff = lds_byte(wr * 64 + fr, fq * 8), boff = lds_byte(wc * 32 + fr, fq * 8);
    LAS u32x4* gtab = (LAS u32x4*)(lds + STAGE_BYTES) + tid;
#define PG8_SA(b, h) (((b) * 2 + (h)) * HTB)
#define PG8_SB(b, h) ((4 + (b) * 2 + (h)) * HTB)
#define PG8_STAGE(bufoff, gbase, voff) do { _Pragma("unroll") for (int _i = 0; _i < 2; ++_i) \
        __builtin_amdgcn_global_load_lds((const unsigned*)((const char*)(gbase) + (voff)[_i]), (LAS unsigned*)(lds + (bufoff) + ldsw + _i * 8192), 16, 0, 0); } while (0)
#define PG8_STAGE_A(bufoff, gbase, h) do { if constexpr (GATHER) PG8_STAGE(bufoff, gbase, voffG[h]); else PG8_STAGE(bufoff, (gbase) + (h) * hstep, voffA); } while (0)
#define PG8_LDA(dst, b, h) do { _Pragma("unroll") for (int m = 0; m < 4; ++m) _Pragma("unroll") for (int k = 0; k < 2; ++k) dst[m][k] = *(const LAS bf16x8*)(lds + PG8_SA(b, h) + aoff + m * 2048 + k * 1024); } while (0)
#define PG8_LDB(dst, b, h) do { _Pragma("unroll") for (int n = 0; n < 2; ++n) _Pragma("unroll") for (int k = 0; k < 2; ++k) dst[n][k] = *(const LAS bf16x8*)(lds + PG8_SB(b, h) + boff + n * 2048 + k * 1024); } while (0)
#define PG8_MMA(ai, bj, At, Bt) do { __builtin_amdgcn_s_setprio(1); _Pragma("unroll") for (int m = 0; m < 4; ++m) _Pragma("unroll") for (int n = 0; n < 2; ++n) _Pragma("unroll") for (int k = 0; k < 2; ++k) \
        acc[ai][bj][m][n] = __builtin_amdgcn_mfma_f32_16x16x32_bf16(Bt[n][k], At[m][k], acc[ai][bj][m][n], 0, 0, 0); __builtin_amdgcn_s_setprio(0); } while (0)
#define PG8_WAIT_V(n) asm volatile("s_waitcnt vmcnt(" #n ")" ::: "memory")
#define PG8_WAIT_L(n) asm volatile("s_waitcnt lgkmcnt(" #n ")" ::: "memory")
#define PG8_BAR __builtin_amdgcn_s_barrier()
#define PG8_SCHED __builtin_amdgcn_sched_barrier(0)
    auto gather_offs = [&](const Unit& u) -> u32x4 {
        const int* rm = S.rowmap(); u32x4 o;
        o.x = (unsigned)(rm[u.pm * 256 + gR[0]] * K + gC[0]) * 2u;       o.y = (unsigned)(rm[u.pm * 256 + gR[1]] * K + gC[1]) * 2u;
        o.z = (unsigned)(rm[u.pm * 256 + 128 + gR[0]] * K + gC[0]) * 2u; o.w = (unsigned)(rm[u.pm * 256 + 128 + gR[1]] * K + gC[1]) * 2u;
        return o; };
    Unit cur, nxt, nn; int ui = 0;
    if (!S.next(0, cur)) return;
    f32x4 acc[2][2][4][2];
#pragma unroll
    for (int a = 0; a < 2; ++a)
#pragma unroll
        for (int b = 0; b < 2; ++b)
#pragma unroll
            for (int m = 0; m < 4; ++m)
#pragma unroll
                for (int n = 0; n < 2; ++n) acc[a][b][m][n] = (f32x4){0.f, 0.f, 0.f, 0.f};
    bf16x8 At[4][2], B0[2][2], B1[2][2];
    const char* cA = S.a_base(cur); const char* cB = S.b_base(cur);
    if constexpr (GATHER) {
        const u32x4 o = gather_offs(cur); voffG[0][0] = o.x; voffG[0][1] = o.y; voffG[1][0] = o.z; voffG[1][1] = o.w;
        if (S.next(1, nn)) *gtab = gather_offs(nn);
        asm volatile("s_waitcnt vmcnt(0) lgkmcnt(0)" ::: "memory");
    }
    PG8_STAGE(PG8_SB(0, 0), cB, voffB); PG8_STAGE(PG8_SB(0, 1), cB + hstep, voffB); PG8_STAGE_A(PG8_SA(0, 0), cA, 0); PG8_STAGE_A(PG8_SA(0, 1), cA, 1);
    if (wr == 1) PG8_BAR;
    PG8_WAIT_V(2); PG8_BAR;
    PG8_STAGE(PG8_SB(1, 0), cB + kstep, voffB); PG8_STAGE_A(PG8_SA(1, 0), cA + kstep, 0); PG8_STAGE(PG8_SB(1, 1), cB + hstep + kstep, voffB);
    PG8_WAIT_V(6); PG8_BAR;
    for (;;) {
        const bool has_next = S.next(ui + 1, nxt);
        const char* nA = has_next ? S.a_base(nxt) : cA; const char* nB = has_next ? S.b_base(nxt) : cB;
        for (int t = 0; t < nt; t += 2) {
            const bool last = (t == nt - 2);
            const char* a1 = cA + (size_t)(t + 1) * kstep;
            const char* a2 = last ? nA : cA + (size_t)(t + 2) * kstep; const char* b2 = last ? nB : cB + (size_t)(t + 2) * kstep;
            const char* a3 = a2 + kstep; const char* b3 = b2 + kstep;
            PG8_LDB(B0, 0, 0); PG8_LDB(B1, 0, 1); PG8_SCHED; PG8_LDA(At, 0, 0); PG8_STAGE_A(PG8_SA(1, 1), a1, 1);
            if constexpr (GATHER) { if (last && has_next) { const u32x4 o = *gtab; voffG[0][0] = o.x; voffG[0][1] = o.y; voffG[1][0] = o.z; voffG[1][1] = o.w; } }
            PG8_WAIT_V(8); PG8_WAIT_L(0); PG8_BAR; PG8_MMA(0, 0, At, B0); PG8_MMA(0, 1, At, B1); PG8_BAR; PG8_SCHED;
            PG8_LDA(At, 0, 1); PG8_STAGE(PG8_SB(0, 0), b2, voffB); PG8_STAGE(PG8_SB(0, 1), b2 + hstep, voffB); PG8_STAGE_A(PG8_SA(0, 0), a2, 0);
            PG8_WAIT_V(8); PG8_WAIT_L(0); PG8_BAR; PG8_MMA(1, 0, At, B0); PG8_MMA(1, 1, At, B1); PG8_BAR; PG8_SCHED;
            PG8_LDB(B0, 1, 0); PG8_LDB(B1, 1, 1); PG8_SCHED; PG8_LDA(At, 1, 0); PG8_STAGE_A(PG8_SA(0, 1), a2, 1);
            PG8_WAIT_V(8); PG8_WAIT_L(0); PG8_BAR; PG8_MMA(0, 0, At, B0); PG8_MMA(0, 1, At, B1); PG8_BAR; PG8_SCHED;
            PG8_LDA(At, 1, 1); PG8_STAGE(PG8_SB(1, 0), b3, voffB); PG8_STAGE(PG8_SB(1, 1), b3 + hstep, voffB); PG8_STAGE_A(PG8_SA(1, 0), a3, 0);
            PG8_WAIT_V(8); PG8_WAIT_L(0); PG8_BAR; PG8_MMA(1, 0, At, B0); PG8_MMA(1, 1, At, B1); PG8_BAR; PG8_SCHED;
        }
        if (wr == 0) PG8_BAR;
        E(acc, cur, wr, wc, fr, fq);
        if constexpr (GATHER) { if (has_next && S.next(ui + 2, nn)) { *gtab = gather_offs(nn); } }
        if (!has_next) break;
#pragma unroll
        for (int a = 0; a < 2; ++a)
#pragma unroll
            for (int b = 0; b < 2; ++b)
#pragma unroll
                for (int m = 0; m < 4; ++m)
#pragma unroll
                    for (int n = 0; n < 2; ++n) acc[a][b][m][n] = (f32x4){0.f, 0.f, 0.f, 0.f};
        cur = nxt; cA = nA; cB = nB; ++ui;
        if (wr == 1) PG8_BAR;
    }
    PG8_WAIT_V(0);
    PG8_BAR;
#undef PG8_SA
#undef PG8_SB
#undef PG8_STAGE
#undef PG8_STAGE_A
#undef PG8_LDA
#undef PG8_LDB
#undef PG8_MMA
#undef PG8_WAIT_V
#undef PG8_WAIT_L
#undef PG8_BAR
#undef PG8_SCHED
}
}


struct PlainGemmArgs { const bf16_t* A; const bf16_t* Bt; int M, N, K, pad_; };
template <class Epi> __global__ __launch_bounds__(512, 2) void k_gplain(PlainGemmArgs a, Epi E) {
    extern __shared__ __attribute__((aligned(16))) unsigned char shm[];
    pg8::StaticOrder S; S.init(a.A, a.Bt, a.M, a.N, a.K, (int)gridDim.x, (int)blockIdx.x);
    pg8::gemm_phase<Epi, pg8::StaticOrder, false>((LAS unsigned char*)shm, a.K, S, E);
}
struct MoeGemmArgs { const bf16_t* A; const bf16_t* Bt; size_t estride; const int* panel_expert; const int* rowmap; const int* npanels; int NT, K; };
template <class Epi, bool GATHER> __global__ __launch_bounds__(512, 2) void k_gmoe(MoeGemmArgs a, Epi E) {
    extern __shared__ __attribute__((aligned(16))) unsigned char shm[];
    pg8::MoeOrder S; S.init(a.A, a.Bt, a.estride, a.panel_expert, GATHER ? a.rowmap : nullptr, *a.npanels, a.NT, a.K, (int)gridDim.x, (int)blockIdx.x);
    pg8::gemm_phase<Epi, pg8::MoeOrder, GATHER>((LAS unsigned char*)shm, a.K, S, E);
}

struct ConvArgs { const float *w_in, *we_gate, *we_up, *we_down, *ws_gate, *ws_up, *ws_down, *w_br, *w_out; bf16_t *WinT, *WguT, *WdT, *WbrT, *WoutT; int layer, pad_; };
constexpr int CV_SEG0 = 32 * 236, CV_SEG1 = 65 * 2 * 32 * 8, CV_SEG2 = 65 * 8 * 32, CV_SEG3 = 4 * 8 * 32, CV_SEG4 = 32 * 32;
constexpr int CV_TOTAL = CV_SEG0 + CV_SEG1 + CV_SEG2 + CV_SEG3 + CV_SEG4;
__device__ __forceinline__ void convert_tiles(const ConvArgs& a, int j0, int j1, int jstart, int jstride, float (*tile)[65]) {
    const int tid = threadIdx.x, L = a.layer;
    for (int j = j0 + jstart; j < j1; j += jstride) {
        const float* src; bf16_t* dst; int ld, ldd, valid = 64;
        if (j < CV_SEG0) { const int kb = j & 31, nb = j >> 5; ld = ZW; ldd = D;
            src = a.w_in + (size_t)L * D * ZW + (size_t)kb * 64 * ZW + nb * 64; valid = ZW - nb * 64; valid = valid < 0 ? 0 : (valid > 64 ? 64 : valid);
            dst = a.WinT + (size_t)nb * 64 * D + kb * 64; }
        else if (j < CV_SEG0 + CV_SEG1) { int q = j - CV_SEG0; const int cb = q & 7; q >>= 3; const int kb = q & 31; q >>= 5; const int bj = q & 1; const int e = q >> 1; ld = FW; ldd = D;
            const float* m = (e < NE) ? ((bj ? a.we_up : a.we_gate) + ((size_t)L * NE + e) * D * FW) : ((bj ? a.ws_up : a.ws_gate) + (size_t)L * D * FW);
            src = m + (size_t)kb * 64 * FW + cb * 64;
            dst = a.WguT + ((size_t)e * 1024 + (cb >> 1) * 256 + bj * 128 + (cb & 1) * 64) * D + kb * 64; }
        else if (j < CV_SEG0 + CV_SEG1 + CV_SEG2) { int q = j - CV_SEG0 - CV_SEG1; const int nb = q & 31; q >>= 5; const int kb = q & 7; const int e = q >> 3; ld = D; ldd = FW;
            const float* m = (e < NE) ? (a.we_down + ((size_t)L * NE + e) * FW * D) : (a.ws_down + (size_t)L * FW * D);
            src = m + (size_t)kb * 64 * D + nb * 64; dst = a.WdT + ((size_t)e * D + nb * 64) * FW + kb * 64; }
        else if (j < CV_SEG0 + CV_SEG1 + CV_SEG2 + CV_SEG3) { int q = j - CV_SEG0 - CV_SEG1 - CV_SEG2; const int nb = q & 31; q >>= 5; const int kb = q & 7; const int g = q >> 3; ld = D; ldd = FW;
            src = a.w_br + ((size_t)L * 4 + g) * FW * D + (size_t)kb * 64 * D + nb * 64; dst = a.WbrT + ((size_t)g * D + nb * 64) * FW + kb * 64; }
        else { const int q = j - CV_SEG0 - CV_SEG1 - CV_SEG2 - CV_SEG3; const int nb = q & 31, kb = q >> 5; ld = D; ldd = D;
            src = a.w_out + (size_t)L * D * D + (size_t)kb * 64 * D + nb * 64; dst = a.WoutT + (size_t)nb * 64 * D + kb * 64; }
        __syncthreads();
        { const int c4 = (tid & 15) * 4, k = tid >> 4;
#pragma unroll
          for (int h = 0; h < 2; ++h) { float4 v = make_float4(0.f, 0.f, 0.f, 0.f); if (c4 < valid) v = *(const float4*)(src + (size_t)(k + 32 * h) * ld + c4);
              tile[k + 32 * h][c4] = v.x; tile[k + 32 * h][c4 + 1] = v.y; tile[k + 32 * h][c4 + 2] = v.z; tile[k + 32 * h][c4 + 3] = v.w; } }
        __syncthreads();
        { const int n = tid >> 3, kc = (tid & 7) * 8; unsigned w[4];
#pragma unroll
          for (int q = 0; q < 4; ++q) w[q] = (unsigned)f2bf(tile[kc + 2 * q][n]) | ((unsigned)f2bf(tile[kc + 2 * q + 1][n]) << 16);
          *(uint4*)(dst + (size_t)n * ldd + kc) = make_uint4(w[0], w[1], w[2], w[3]); }
    }
}
__global__ __launch_bounds__(512) void k_convert(ConvArgs a) {
    __shared__ float tile[64][65];
    convert_tiles(a, 0, CV_TOTAL, blockIdx.x, gridDim.x, tile);
}

__global__ void k_cvt_bf16(const float* __restrict__ src, bf16_t* __restrict__ dst, size_t n) {
    for (size_t i = (size_t)blockIdx.x * blockDim.x + threadIdx.x; i < n; i += (size_t)gridDim.x * blockDim.x) dst[i] = f2bf(src[i]);
}

__global__ __launch_bounds__(256) void k_ln(const float* __restrict__ pre, const float* __restrict__ w, const float* __restrict__ b,
                                            float* __restrict__ outf, bf16_t* __restrict__ outb) {
    const int lane = threadIdx.x & 63;
    const int row = blockIdx.x * 4 + (threadIdx.x >> 6);
    const float* p = pre + (size_t)row * D;
    float v[32]; float s = 0.f;
#pragma unroll
    for (int i = 0; i < 8; ++i) { const float4 x = *(const float4*)(p + i * 256 + lane * 4); v[4 * i] = x.x; v[4 * i + 1] = x.y; v[4 * i + 2] = x.z; v[4 * i + 3] = x.w; s += (x.x + x.y) + (x.z + x.w); }
    const float mu = wave_sum(s) * (1.0f / D);
    float q = 0.f;
#pragma unroll
    for (int i = 0; i < 32; ++i) { const float d = v[i] - mu; q += d * d; }
    const float rstd = rsqrtf(wave_sum(q) * (1.0f / D) + 1e-5f);
#pragma unroll
    for (int i = 0; i < 8; ++i) {
        const int c = i * 256 + lane * 4;
        const float4 ww = *(const float4*)(w + c), bb = *(const float4*)(b + c);
        float4 o; o.x = (v[4 * i] - mu) * rstd * ww.x + bb.x; o.y = (v[4 * i + 1] - mu) * rstd * ww.y + bb.y; o.z = (v[4 * i + 2] - mu) * rstd * ww.z + bb.z; o.w = (v[4 * i + 3] - mu) * rstd * ww.w + bb.w;
        *(float4*)(outf + (size_t)row * D + c) = o;
        if (outb) { bf16_t* ob = outb + (size_t)row * D + c; ob[0] = f2bf(o.x); ob[1] = f2bf(o.y); ob[2] = f2bf(o.z); ob[3] = f2bf(o.w); }
    }
}

struct PrepArgs {
    const bf16_t* z;
    const float *hg_lb_logits, *rw_mu, *rw_w0, *rw_w2, *rw_a0, *rw_a2, *rw_g2, *rw_kk, *rw_ka, *rw_rk, *gla_g2, *gla_gb;
    float *rR, *rW, *rK, *rV, *rA, *rB, *rGate, *rBonus;
    float *hQ, *hW, *hK, *hV;
    float *gQ, *gW, *gK, *gV;
    int layer, pad_;
};
__global__ __launch_bounds__(512) void k_prep(PrepArgs p) {
    __shared__ float lr[160];
    __shared__ float glg[16];
    const int c = threadIdx.x, L = p.layer;
    const float mu_r = p.rw_mu[L * 1696 + c], mu_k = p.rw_mu[L * 1696 + 512 + c], mu_v = p.rw_mu[L * 1696 + 1024 + c];
    const float w0 = p.rw_w0[L * 512 + c], a0 = p.rw_a0[L * 512 + c], kkc = p.rw_kk[L * 512 + c], kac = p.rw_ka[L * 512 + c], rkc = p.rw_rk[L * 512 + c];
    float lb = 0.f;
    if (L == 1) { const float l0 = p.hg_lb_logits[c], l1 = p.hg_lb_logits[512 + c]; const float m = fmaxf(l0, l1); const float e0 = expf(l0 - m), e1 = expf(l1 - m); lb = e1 / (e0 + e1); }
    const float* w2 = p.rw_w2 + (size_t)L * 32 * 512; const float* a2 = p.rw_a2 + (size_t)L * 32 * 512; const float* g2 = p.rw_g2 + (size_t)L * 96 * 512;
    const float* gg2 = p.gla_g2 + (size_t)L * 16 * 256; const float gbc = (c < 256) ? p.gla_gb[L * 256 + c] : 0.f;
    for (int t = blockIdx.x; t < T; t += gridDim.x) {
        const bf16_t* zc = p.z + (size_t)t * ZLD;
        const bf16_t* zp = p.z + (size_t)(t > 0 ? t - 1 : 0) * ZLD;
        __syncthreads();
        if (c < 160) {
            const float cur = bf2f(zc[RW_LW + c]); const float prev = (t > 0) ? bf2f(zp[RW_LW + c]) : 0.f;
            const float zs = cur + (prev - cur) * p.rw_mu[L * 1696 + 1536 + c];
            lr[c] = (c < 32) ? tanhf(zs) : (c < 64 ? zs : sigmoidf_(zs));
        } else if (c >= 192 && c < 208) glg[c - 192] = bf2f(zc[GL_LG + (c - 192)]);
        __syncthreads();
        float r, k, v;
        { const float cr = bf2f(zc[RW_R + c]), ck = bf2f(zc[RW_K + c]), cv = bf2f(zc[RW_V + c]);
          const float pr = (t > 0) ? bf2f(zp[RW_R + c]) : 0.f, pk = (t > 0) ? bf2f(zp[RW_K + c]) : 0.f, pv = (t > 0) ? bf2f(zp[RW_V + c]) : 0.f;
          r = cr + (pr - cr) * mu_r; k = ck + (pk - ck) * mu_k; v = cv + (pv - cv) * mu_v; }
        float accW = w0, accA = a0, accG = 0.f;
#pragma unroll 8
        for (int j = 0; j < 32; ++j) { accW += lr[j] * w2[j * 512 + c]; accA += lr[32 + j] * a2[j * 512 + c]; }
#pragma unroll 8
        for (int j = 0; j < 96; ++j) accG += lr[64 + j] * g2[j * 512 + c];
        const float w_raw = -softplusf_(-accW) - 0.5f;
        const float decay = expf(-expf(w_raw));
        const float iclr = sigmoidf_(accA);
        const float kk = k * kkc;
        const float nrm = sqrtf(wave_sum(kk * kk));
        const float kkn = kk / fmaxf(nrm, 1e-12f);
        const float kmod = k * (1.0f + (iclr - 1.0f) * kac);
        const float bon = wave_sum(r * kmod * rkc) * v;
        const size_t o = (size_t)t * 512 + c;
        p.rR[o] = r; p.rW[o] = decay; p.rK[o] = kmod; p.rV[o] = v; p.rA[o] = -kkn; p.rB[o] = kkn * iclr; p.rGate[o] = accG; p.rBonus[o] = bon;
        { const float q = bf2f(zc[HG_Q + c]), f = bf2f(zc[HG_F + c]), i = bf2f(zc[HG_I + c]);
          const float omf = (1.0f - lb) * sigmoidf_(-f);
          p.hQ[o] = siluf_(q); p.hW[o] = 1.0f - omf; p.hK[o] = omf; p.hV[o] = i; }
        p.gV[o] = bf2f(zc[GL_V + c]);
        if (c < 256) {
            float acc = gbc;
#pragma unroll
            for (int j = 0; j < 16; ++j) acc += glg[j] * gg2[j * 256 + c];
            const float log_alpha = -softplusf_(-acc) * (1.0f / 16.0f);
            const size_t og = (size_t)t * 256 + c;
            p.gQ[og] = bf2f(zc[GL_Q + c]) * 0.125f; p.gW[og] = expf(log_alpha); p.gK[og] = bf2f(zc[GL_K + c]);
        }
    }
}

template <int KPL, bool HAS_SA>
__global__ __launch_bounds__(64) void k_rowrec(const float* __restrict__ Q, const float* __restrict__ Wd, const float* __restrict__ Kk, const float* __restrict__ V,
                                               const float* __restrict__ Aa, const float* __restrict__ Bb, float* __restrict__ O, int sq, int DV) {
    constexpr int DK = 64 * KPL;
    const int row = blockIdx.x, h = row / DV, lane = threadIdx.x;
    float S[KPL];
#pragma unroll
    for (int i = 0; i < KPL; ++i) S[i] = 0.f;
    const size_t qoff = (size_t)h * DK + lane;
    float obuf = 0.f;
    for (int t0 = 0; t0 < T; t0 += 8) {
        float q_[8][KPL], w_[8][KPL], k_[8][KPL], a_[8][KPL], b_[8][KPL], v_[8];
#pragma unroll
        for (int u = 0; u < 8; ++u) {
            const size_t base = (size_t)(t0 + u) * sq + qoff;
#pragma unroll
            for (int i = 0; i < KPL; ++i) {
                q_[u][i] = Q[base + 64 * i]; w_[u][i] = Wd[base + 64 * i]; k_[u][i] = Kk[base + 64 * i];
                if (HAS_SA) { a_[u][i] = Aa[base + 64 * i]; b_[u][i] = Bb[base + 64 * i]; } else { a_[u][i] = 0.f; b_[u][i] = 0.f; }
            }
            v_[u] = V[(size_t)(t0 + u) * 512 + row];
        }
#pragma unroll
        for (int u = 0; u < 8; ++u) {
            float sa = 0.f;
            if (HAS_SA) { float d = 0.f;
#pragma unroll
                for (int i = 0; i < KPL; ++i) d += S[i] * a_[u][i];
                sa = wave_sum(d); }
            float d2 = 0.f;
#pragma unroll
            for (int i = 0; i < KPL; ++i) { S[i] = S[i] * w_[u][i] + sa * b_[u][i] + v_[u] * k_[u][i]; d2 += S[i] * q_[u][i]; }
            const float o = wave_sum(d2);
            const int t = t0 + u;
            obuf = (lane == (t & 63)) ? o : obuf;
            if ((t & 63) == 63) O[(size_t)(t - 63 + lane) * 512 + row] = obuf;
        }
    }
}

__global__ __launch_bounds__(512) void k_finish_rms(const float* __restrict__ oraw, const float* __restrict__ gain, const bf16_t* __restrict__ z, bf16_t* __restrict__ bo, int gcol, int pad_) {
    __shared__ float part[8];
    const int c = threadIdx.x, wv = c >> 6;
    for (int t = blockIdx.x; t < T; t += gridDim.x) {
        const float o = oraw[(size_t)t * 512 + c];
        const float ss = wave_sum(o * o);
        __syncthreads();
        if ((c & 63) == 0) part[wv] = ss;
        __syncthreads();
        const float tot = part[(c >> 7) * 2] + part[(c >> 7) * 2 + 1];
        const float rs = rsqrtf(tot * (1.0f / 128.0f) + 1e-5f);
        const float g = bf2f(z[(size_t)t * ZLD + gcol + c]);
        bo[(size_t)t * 512 + c] = f2bf(o * rs * gain[c] * siluf_(g));
    }
}
__global__ __launch_bounds__(512) void k_finish_rw(const float* __restrict__ oraw, const float* __restrict__ lnw, const float* __restrict__ lnb,
                                                   const float* __restrict__ bonus, const float* __restrict__ gate, bf16_t* __restrict__ bo) {
    const int c = threadIdx.x;
    for (int t = blockIdx.x; t < T; t += gridDim.x) {
        const size_t o_ = (size_t)t * 512 + c;
        const float o = oraw[o_];
        const float mu = wave_sum(o) * (1.0f / 64.0f);
        const float d = o - mu;
        const float var = wave_sum(d * d) * (1.0f / 64.0f);
        const float y = d * rsqrtf(var + 64e-5f) * lnw[c] + lnb[c];
        bo[o_] = f2bf((y + bonus[o_]) * gate[o_]);
    }
}

__global__ __launch_bounds__(64) void k_sb_naive(const bf16_t* __restrict__ z, bf16_t* __restrict__ bo) {
    __shared__ float qs[128];
    const int h = blockIdx.x & 3, t = blockIdx.x >> 2, lane = threadIdx.x;
    const bf16_t* qp = z + (size_t)t * ZLD + SB_Q + h * 128;
    qs[lane] = bf2f(qp[lane]); qs[lane + 64] = bf2f(qp[lane + 64]);
    __syncthreads();
    float o0 = 0.f, o1 = 0.f, R = 0.f;
    const float scale = 0.08838834764831845f;
    for (int s_hi = t - 1; s_hi >= 0; s_hi -= 64) {
        const int s = s_hi - lane;
        const bool valid = s >= 0;
        float zz = 0.f;
        if (valid) {
            const bf16_t* kp = z + (size_t)s * ZLD + SB_K + h * 128;
            float acc = 0.f;
#pragma unroll 4
            for (int d8 = 0; d8 < 16; ++d8) {
                const uint4 kv = *(const uint4*)(kp + d8 * 8);
                const unsigned kw[4] = {kv.x, kv.y, kv.z, kv.w};
#pragma unroll
                for (int j = 0; j < 4; ++j) { acc += qs[d8 * 8 + 2 * j] * __uint_as_float(kw[j] << 16); acc += qs[d8 * 8 + 2 * j + 1] * __uint_as_float(kw[j] & 0xffff0000u); }
            }
            zz = acc * scale;
        }
        const float lk = valid ? -softplusf_(zz) : 0.f;
        float incl = lk;
#pragma unroll
        for (int off = 1; off < 64; off <<= 1) { const float y = __shfl_up(incl, off); if (lane >= off) incl += y; }
        const float logw = zz + lk + R + (incl - lk);
        const float w = valid ? expf(logw) : 0.f;
        const int nvalid = (s_hi + 1 < 64) ? s_hi + 1 : 64;
        for (int j = 0; j < nvalid; ++j) {
            const float wj = __shfl(w, j);
            const bf16_t* vp = z + (size_t)(s_hi - j) * ZLD + SB_V + h * 128;
            o0 += wj * bf2f(vp[lane]); o1 += wj * bf2f(vp[lane + 64]);
        }
        R += __shfl(incl, 63);
        if (R < -104.0f) break;
    }
    bo[(size_t)t * 512 + h * 128 + lane] = f2bf(o0); bo[(size_t)t * 512 + h * 128 + 64 + lane] = f2bf(o1);
}

constexpr int NSEG = 8, LSEG = T / NSEG;
typedef float f32x2v __attribute__((ext_vector_type(2)));
typedef float f32x4v __attribute__((ext_vector_type(4)));
struct MixArgs {
    const bf16_t* z;
    const float *hg_lb_logits, *hg_norm_w, *rw_mu, *rw_w0, *rw_w2, *rw_a0, *rw_a2, *rw_g2, *rw_kk, *rw_ka, *rw_rk, *rw_ln_w, *rw_ln_b, *gla_g2, *gla_gb, *gla_norm_w;
    float *RS, *HS, *GS; bf16_t* Vt; float *rGate, *rBonus;
    float *oR, *oH, *oG; bf16_t *cR, *cH, *cG;
    float *SendR, *PendR, *SendH, *SendG, *GamH, *GamG;
    bf16_t *SstR, *SstH, *SstG;
    bf16_t* bo;
    int layer, pad_;
};
__device__ __forceinline__ float red8(float x) { x += dppmov<0xB1>(x); x += dppmov<0x4E>(x); x += dppmov<0x141>(x); return x; }
__device__ __forceinline__ float red16(float x) { x += dppmov<0xB1>(x); x += dppmov<0x4E>(x); x += dppmov<0x141>(x); x += dppmov<0x140>(x); return x; }

__device__ __forceinline__ void prep_phase(const MixArgs& p, LAS unsigned char* ldsraw) {
    LAS float (*lr)[160] = (LAS float (*)[160])ldsraw;
    LAS float (*glg)[16] = (LAS float (*)[16])(ldsraw + 8 * 160 * 4);
    LAS bf16_t (*vtile)[72] = (LAS bf16_t (*)[72])(ldsraw + 8192);
    const int c = threadIdx.x, L = p.layer;
    const float mu_r = p.rw_mu[L * 1696 + c], mu_k = p.rw_mu[L * 1696 + 512 + c], mu_v = p.rw_mu[L * 1696 + 1024 + c];
    const float w0 = p.rw_w0[L * 512 + c], a0 = p.rw_a0[L * 512 + c], kkc = p.rw_kk[L * 512 + c], kac = p.rw_ka[L * 512 + c], rkc = p.rw_rk[L * 512 + c];
    float lb = 0.f;
    if (L == 1) { const float l0 = p.hg_lb_logits[c], l1 = p.hg_lb_logits[512 + c]; const float m = fmaxf(l0, l1); const float e0 = expf(l0 - m), e1 = expf(l1 - m); lb = e1 / (e0 + e1); }
    const float* w2 = p.rw_w2 + (size_t)L * 32 * 512; const float* a2 = p.rw_a2 + (size_t)L * 32 * 512; const float* g2 = p.rw_g2 + (size_t)L * 96 * 512;
    const float* gg2 = p.gla_g2 + (size_t)L * 16 * 256; const float gbc = (c < 256) ? p.gla_gb[L * 256 + c] : 0.f;
    for (int tile = blockIdx.x; tile < T / 64; tile += gridDim.x) {
        const int t0 = tile * 64;
        for (int tb = 0; tb < 8; ++tb) {
            const int tt0 = t0 + tb * 8;
            __syncthreads();
            for (int i = c; i < 8 * 160; i += 512) {
                const int tok = i / 160, col = i - tok * 160, t = tt0 + tok;
                const float cur = bf2f(p.z[(size_t)t * ZLD + RW_LW + col]); const float prev = (t > 0) ? bf2f(p.z[(size_t)(t - 1) * ZLD + RW_LW + col]) : 0.f;
                const float zs = cur + (prev - cur) * p.rw_mu[L * 1696 + 1536 + col];
                lr[tok][col] = (col < 32) ? tanhf(zs) : (col < 64 ? zs : sigmoidf_(zs));
            }
            if (c < 128) glg[c >> 4][c & 15] = bf2f(p.z[(size_t)(tt0 + (c >> 4)) * ZLD + GL_LG + (c & 15)]);
            __syncthreads();
            float accW[8], accA[8], accG[8], accL[8];
#pragma unroll
            for (int k = 0; k < 8; ++k) { accW[k] = w0; accA[k] = a0; accG[k] = 0.f; accL[k] = gbc; }
            for (int j = 0; j < 32; ++j) { const float w2v = w2[j * 512 + c], a2v = a2[j * 512 + c];
#pragma unroll
                for (int k = 0; k < 8; ++k) { accW[k] += lr[k][j] * w2v; accA[k] += lr[k][32 + j] * a2v; } }
            for (int j = 0; j < 96; ++j) { const float g2v = g2[j * 512 + c];
#pragma unroll
                for (int k = 0; k < 8; ++k) accG[k] += lr[k][64 + j] * g2v; }
            if (c < 256) { for (int j = 0; j < 16; ++j) { const float gv = gg2[j * 256 + c];
#pragma unroll
                for (int k = 0; k < 8; ++k) accL[k] += glg[k][j] * gv; } }
#pragma unroll
            for (int k = 0; k < 8; ++k) {
                const int t = tt0 + k;
                const bf16_t* zc = p.z + (size_t)t * ZLD; const bf16_t* zp = p.z + (size_t)(t > 0 ? t - 1 : 0) * ZLD;
                const float cr = bf2f(zc[RW_R + c]), ck = bf2f(zc[RW_K + c]), cv = bf2f(zc[RW_V + c]);
                const float pr = (t > 0) ? bf2f(zp[RW_R + c]) : 0.f, pk = (t > 0) ? bf2f(zp[RW_K + c]) : 0.f, pv = (t > 0) ? bf2f(zp[RW_V + c]) : 0.f;
                const float r = cr + (pr - cr) * mu_r, kx = ck + (pk - ck) * mu_k, v = cv + (pv - cv) * mu_v;
                const float w_raw = -softplusf_(-accW[k]) - 0.5f;
                const float decay = expf(-expf(w_raw));
                const float iclr = sigmoidf_(accA[k]);
                const float kk = kx * kkc;
                const float nrm = sqrtf(wave_sum(kk * kk));
                const float kkn = kk / fmaxf(nrm, 1e-12f);
                const float kmod = kx * (1.0f + (iclr - 1.0f) * kac);
                const float bon = wave_sum(r * kmod * rkc) * v;
                { const int h = c >> 6, j = c & 63; float* rs = p.RS + ((size_t)h * T + t) * 384 + j;
                  rs[0] = -kkn; rs[64] = kkn * iclr; rs[128] = decay; rs[192] = kmod; rs[256] = r; rs[320] = v; }
                p.rGate[(size_t)t * 512 + c] = accG[k]; p.rBonus[(size_t)t * 512 + c] = bon;
                { const float q = bf2f(zc[HG_Q + c]), f = bf2f(zc[HG_F + c]), iv = bf2f(zc[HG_I + c]);
                  const float omf = (1.0f - lb) * sigmoidf_(-f);
                  const int h = c >> 7, j = c & 127; float* hs = p.HS + ((size_t)h * T + t) * 512 + j;
                  hs[0] = siluf_(q); hs[128] = 1.0f - omf; hs[256] = omf; hs[384] = iv; }
                { const int h = c >> 7, j = c & 127; p.GS[((size_t)h * T + t) * 320 + 192 + j] = bf2f(zc[GL_V + c]); }
                if (c < 256) { const int h = c >> 6, j = c & 63; float* gs = p.GS + ((size_t)h * T + t) * 320 + j;
                  const float log_alpha = -softplusf_(-accL[k]) * (1.0f / 16.0f);
                  gs[0] = bf2f(zc[GL_Q + c]) * 0.125f; gs[64] = expf(log_alpha); gs[128] = bf2f(zc[GL_K + c]); }
            }
        }
        __syncthreads();
        for (int i = 0; i < 64; ++i) vtile[c][i] = p.z[(size_t)(t0 + i) * ZLD + SB_V + c];
        __syncthreads();
#pragma unroll
        for (int it = 0; it < 8; ++it) { const int row = it * 64 + (c >> 3), sg = c & 7;
            *(pg8::u32x4*)(p.Vt + (size_t)row * T + t0 + sg * 8) = *(const LAS pg8::u32x4*)&vtile[row][sg * 8]; }
    }
}

template <int KIND>
__device__ __forceinline__ void chain_unit(const MixArgs& p, const int seg, const int h, const int half, LAS float* lds) {
    constexpr int SF = KIND == 2 ? 512 : (KIND == 3 ? 320 : 384);
    constexpr int EPL = KIND == 2 ? 16 : 8, E2 = EPL / 2, DK = EPL * 8;
    constexpr int CH = 16, NP = CH * SF * 4 / 1024;
    const float* stream = (KIND <= 1 ? p.RS : (KIND == 2 ? p.HS : p.GS)) + ((size_t)h * T + (size_t)seg * LSEG) * SF;
    const int tid = threadIdx.x, wv = __builtin_amdgcn_readfirstlane(tid >> 6), lane = tid & 63, rg = lane >> 3, lj = lane & 7, row = wv * 8 + rg;
    LAS float* ob = lds + 2 * CH * SF;
    f32x2v S[E2];
#pragma unroll
    for (int e = 0; e < E2; ++e) { S[e] = (f32x2v){0.f, 0.f}; if (KIND == 1) { if (lj * 8 + 2 * e == row) S[e].x = 1.f; if (lj * 8 + 2 * e + 1 == row) S[e].y = 1.f; } }
    auto stage = [&](int ci, LAS float* dst) {
        const char* g = (const char*)(stream + (size_t)ci * CH * SF) + lane * 16;
        for (int pc = wv; pc < NP; pc += 8) __builtin_amdgcn_global_load_lds((const unsigned*)(g + pc * 1024), (LAS unsigned*)((LAS char*)dst + pc * 1024), 16, 0, 0);
    };
    auto writeout = [&](int ci, const LAS float* o) {
#pragma unroll
        for (int q = 0; q < 2; ++q) { const int idx = tid + 512 * q, s = idx >> 6, r = idx & 63; const size_t t = (size_t)seg * LSEG + ci * CH + s; const float v = o[idx];
            if (KIND == 0) p.oR[t * 512 + h * 64 + r] = v;
            else if (KIND == 1) p.cR[t * 512 + h * 64 + r] = f2bf(v);
            else if (KIND == 2) p.oH[t * 512 + h * 128 + half * 64 + r] = v;
            else p.oG[t * 512 + h * 128 + half * 64 + r] = v; }
    };
    constexpr int NCH = LSEG / CH;
    stage(0, lds);
    for (int ci = 0; ci < NCH; ++ci) {
        asm volatile("s_waitcnt vmcnt(0)" ::: "memory"); __syncthreads();
        const LAS float* cur = lds + (ci & 1) * CH * SF;
        if (ci + 1 < NCH) stage(ci + 1, lds + ((ci + 1) & 1) * CH * SF);
        if (ci > 0) writeout(ci - 1, ob + ((ci - 1) & 1) * 1024);
        LAS float* oc = ob + (ci & 1) * 1024;
#pragma unroll 2
        for (int s = 0; s < CH; ++s) {
            const LAS float* sp = cur + s * SF;
            if constexpr (KIND <= 1) {
                f32x2v a[4], b[4], w[4], k[4], r[4];
                { const f32x4v x0 = *(const LAS f32x4v*)(sp + lj * 8), x1 = *(const LAS f32x4v*)(sp + lj * 8 + 4); a[0] = x0.xy; a[1] = x0.zw; a[2] = x1.xy; a[3] = x1.zw; }
                { const f32x4v x0 = *(const LAS f32x4v*)(sp + 64 + lj * 8), x1 = *(const LAS f32x4v*)(sp + 64 + lj * 8 + 4); b[0] = x0.xy; b[1] = x0.zw; b[2] = x1.xy; b[3] = x1.zw; }
                { const f32x4v x0 = *(const LAS f32x4v*)(sp + 128 + lj * 8), x1 = *(const LAS f32x4v*)(sp + 128 + lj * 8 + 4); w[0] = x0.xy; w[1] = x0.zw; w[2] = x1.xy; w[3] = x1.zw; }
                { const f32x4v x0 = *(const LAS f32x4v*)(sp + 256 + lj * 8), x1 = *(const LAS f32x4v*)(sp + 256 + lj * 8 + 4); r[0] = x0.xy; r[1] = x0.zw; r[2] = x1.xy; r[3] = x1.zw; }
                f32x2v pp = S[0] * a[0]; pp = S[1] * a[1] + pp; f32x2v pq = S[2] * a[2]; pq = S[3] * a[3] + pq; pp += pq;
                const float sa = red8(pp.x + pp.y);
                const f32x2v sav = (f32x2v){sa, sa};
                if constexpr (KIND == 0) {
                    { const f32x4v x0 = *(const LAS f32x4v*)(sp + 192 + lj * 8), x1 = *(const LAS f32x4v*)(sp + 192 + lj * 8 + 4); k[0] = x0.xy; k[1] = x0.zw; k[2] = x1.xy; k[3] = x1.zw; }
                    const float v = sp[320 + row]; const f32x2v vv = (f32x2v){v, v};
#pragma unroll
                    for (int e = 0; e < 4; ++e) S[e] = S[e] * w[e] + (sav * b[e] + vv * k[e]);
                } else {
#pragma unroll
                    for (int e = 0; e < 4; ++e) S[e] = S[e] * w[e] + sav * b[e];
                }
                f32x2v oo = S[0] * r[0]; oo = S[1] * r[1] + oo; f32x2v oq = S[2] * r[2]; oq = S[3] * r[3] + oq; oo += oq;
                const float o = red8(oo.x + oo.y);
                if (lj == 0) oc[s * 64 + row] = o;
            } else {
                const float v = sp[3 * DK + half * 64 + row]; const f32x2v vv = (f32x2v){v, v};
                f32x2v oo = (f32x2v){0.f, 0.f}, oq = (f32x2v){0.f, 0.f};
#pragma unroll
                for (int e4 = 0; e4 < EPL / 4; ++e4) {
                    const f32x4v q4 = *(const LAS f32x4v*)(sp + lj * EPL + e4 * 4), w4 = *(const LAS f32x4v*)(sp + DK + lj * EPL + e4 * 4), k4 = *(const LAS f32x4v*)(sp + 2 * DK + lj * EPL + e4 * 4);
                    S[2 * e4] = S[2 * e4] * w4.xy + vv * k4.xy; S[2 * e4 + 1] = S[2 * e4 + 1] * w4.zw + vv * k4.zw;
                    oo = S[2 * e4] * q4.xy + oo; oq = S[2 * e4 + 1] * q4.zw + oq;
                }
                oo += oq;
                const float o = red8(oo.x + oo.y);
                if (lj == 0) oc[s * 64 + row] = o;
            }
        }
    }
    __syncthreads();
    writeout(NCH - 1, ob + ((NCH - 1) & 1) * 1024);
    float* dst;
    if (KIND == 0) dst = p.SendR + (((size_t)seg * 8 + h) * 64 + row) * 64 + lj * 8;
    else if (KIND == 1) dst = p.PendR + (((size_t)seg * 8 + h) * 64 + row) * 64 + lj * 8;
    else if (KIND == 2) dst = p.SendH + (((size_t)seg * 4 + h) * 128 + half * 64 + row) * 128 + lj * 16;
    else dst = p.SendG + (((size_t)seg * 4 + h) * 128 + half * 64 + row) * 64 + lj * 8;
#pragma unroll
    for (int e = 0; e < E2; ++e) { dst[2 * e] = S[e].x; dst[2 * e + 1] = S[e].y; }
    __syncthreads();
}
template <int DK, int SF>
__device__ __forceinline__ void gamma_unit(const float* __restrict__ stream_h, bf16_t* __restrict__ cout, int cstride, int ccol0, float* __restrict__ gam_out  , int gstride) {
    constexpr int SLOTS = 512 / DK;
    const int tid = threadIdx.x, slot = tid / DK, k = tid % DK;
    for (int seg = 1 + slot; seg < NSEG; seg += SLOTS) {
        float gam = 1.f;
        const float* sp = stream_h + (size_t)seg * LSEG * SF + k;
        for (int t0 = 0; t0 < LSEG; t0 += 32) {
            float q_[32], w_[32];
#pragma unroll
            for (int u = 0; u < 32; ++u) { q_[u] = sp[(size_t)(t0 + u) * SF]; w_[u] = sp[(size_t)(t0 + u) * SF + DK]; }
#pragma unroll
            for (int u = 0; u < 32; ++u) { gam *= w_[u]; cout[(size_t)(seg * LSEG + t0 + u) * cstride + ccol0 + k] = f2bf(q_[u] * gam); }
        }
        gam_out[(size_t)seg * gstride + k] = gam;
    }
}
__device__ __forceinline__ void chains_phase(const MixArgs& p, LAS unsigned char* ldsraw) {
    LAS float* lds = (LAS float*)ldsraw;
    for (int u = blockIdx.x; u < 256; u += gridDim.x) {
        if (u < 64) chain_unit<0>(p, u >> 3, u & 7, 0, lds);
        else if (u < 120) { const int q = u - 64; chain_unit<1>(p, 1 + (q >> 3), q & 7, 0, lds); }
        else if (u < 184) { const int q = u - 120; chain_unit<2>(p, q >> 3, (q & 7) >> 1, q & 1, lds); }
        else if (u < 248) { const int q = u - 184; chain_unit<3>(p, q >> 3, (q & 7) >> 1, q & 1, lds); }
        else if (u < 252) { const int h = u - 248; gamma_unit<128, 512>(p.HS + (size_t)h * T * 512, p.cH, 512, h * 128, p.GamH + h * 128, 4 * 128); }
        else { const int h = u - 252; gamma_unit<64, 320>(p.GS + (size_t)h * T * 320, p.cG, 256, h * 64, p.GamG + h * 64, 4 * 64); }
    }
}

__device__ __forceinline__ void carry_phase(const MixArgs& p, LAS unsigned char* ldsraw) {
    const int tid = threadIdx.x;
    for (int u = blockIdx.x; u < 16; u += gridDim.x) {
        if (u < 8) {
            const int h = u;
            LAS float (*cur)[65] = (LAS float (*)[65])ldsraw; LAS float (*Pm)[65] = (LAS float (*)[65])(ldsraw + 64 * 65 * 4);
            const int v = tid >> 3, kb = (tid & 7) * 8;
            float nv[8];
#pragma unroll
            for (int e = 0; e < 8; ++e) nv[e] = p.SendR[(((size_t)0 * 8 + h) * 64 + v) * 64 + kb + e];
            for (int s = 1; s < NSEG; ++s) {
                __syncthreads();
#pragma unroll
                for (int e = 0; e < 8; ++e) { cur[v][kb + e] = nv[e]; p.SstR[(((size_t)s * 8 + h) * 64 + v) * 64 + kb + e] = f2bf(nv[e]); }
                if (s == NSEG - 1) break;
#pragma unroll
                for (int e = 0; e < 8; ++e) Pm[v][kb + e] = p.PendR[(((size_t)s * 8 + h) * 64 + v) * 64 + kb + e];
                __syncthreads();
#pragma unroll
                for (int e = 0; e < 8; ++e) nv[e] = p.SendR[(((size_t)s * 8 + h) * 64 + v) * 64 + kb + e];
                for (int i = 0; i < 64; ++i) { const float c = cur[v][i];
#pragma unroll
                    for (int e = 0; e < 8; ++e) nv[e] += c * Pm[i][kb + e]; }
            }
            __syncthreads();
        } else if (u < 12) {
            const int h = u - 8;
            for (int q = 0; q < 32; ++q) { const int idx = tid + 512 * q, k = idx & 127;
                float cv = p.SendH[((size_t)0 * 4 + h) * 16384 + idx];
                for (int s = 1; s < NSEG; ++s) { p.SstH[((size_t)s * 4 + h) * 16384 + idx] = f2bf(cv); if (s < NSEG - 1) cv = p.GamH[(size_t)s * 512 + h * 128 + k] * cv + p.SendH[((size_t)s * 4 + h) * 16384 + idx]; } }
        } else {
            const int h = u - 12;
            for (int q = 0; q < 16; ++q) { const int idx = tid + 512 * q, k = idx & 63;
                float cv = p.SendG[((size_t)0 * 4 + h) * 8192 + idx];
                for (int s = 1; s < NSEG; ++s) { p.SstG[((size_t)s * 4 + h) * 8192 + idx] = f2bf(cv); if (s < NSEG - 1) cv = p.GamG[(size_t)s * 256 + h * 64 + k] * cv + p.SendG[((size_t)s * 4 + h) * 8192 + idx]; } }
        }
    }
}

__device__ __forceinline__ void mixfin_phase(const MixArgs& p) {
    typedef short bf16x8v __attribute__((ext_vector_type(8)));
    const int tid = threadIdx.x, wv = tid >> 6, lane = tid & 63, r = lane & 15, q = lane >> 4, L = p.layer;
    const int W = gridDim.x * 8;
    for (int u = blockIdx.x * 8 + wv; u < 16384; u += W) {
        if (u < 8192) {
            const int tt = u >> 3, h = u & 7, t0 = tt * 16, seg = t0 / LSEG;
            f32x4v acc[4];
#pragma unroll
            for (int nb = 0; nb < 4; ++nb) acc[nb] = (f32x4v){0.f, 0.f, 0.f, 0.f};
            if (seg >= 1) {
#pragma unroll
                for (int ks = 0; ks < 2; ++ks) { const bf16x8v A = *(const bf16x8v*)(p.cR + (size_t)(t0 + r) * 512 + h * 64 + ks * 32 + q * 8);
#pragma unroll
                    for (int nb = 0; nb < 4; ++nb) { const bf16x8v B = *(const bf16x8v*)(p.SstR + (((size_t)seg * 8 + h) * 64 + nb * 16 + r) * 64 + ks * 32 + q * 8);
                        acc[nb] = __builtin_amdgcn_mfma_f32_16x16x32_bf16(A, B, acc[nb], 0, 0, 0); } }
            }
#pragma unroll
            for (int i = 0; i < 4; ++i) { const size_t t = (size_t)t0 + 4 * q + i; float o[4]; float s = 0.f;
#pragma unroll
                for (int nb = 0; nb < 4; ++nb) { o[nb] = acc[nb][i] + p.oR[t * 512 + h * 64 + nb * 16 + r]; s += o[nb]; }
                const float mu = red16(s) * (1.0f / 64.0f); float d2 = 0.f;
#pragma unroll
                for (int nb = 0; nb < 4; ++nb) { o[nb] -= mu; d2 += o[nb] * o[nb]; }
                const float rstd = rsqrtf(red16(d2) * (1.0f / 64.0f) + 64e-5f);
#pragma unroll
                for (int nb = 0; nb < 4; ++nb) { const int c = h * 64 + nb * 16 + r; const float y = o[nb] * rstd * p.rw_ln_w[L * 512 + c] + p.rw_ln_b[L * 512 + c];
                    p.bo[(size_t)T * 512 + t * 512 + c] = f2bf((y + p.rBonus[t * 512 + c]) * p.rGate[t * 512 + c]); } }
        } else {
            const bool isH = u < 12288; const int qq = isH ? u - 8192 : u - 12288;
            const int tt = qq >> 2, h = qq & 3, t0 = tt * 16, seg = t0 / LSEG;
            f32x4v acc[8];
#pragma unroll
            for (int nb = 0; nb < 8; ++nb) acc[nb] = (f32x4v){0.f, 0.f, 0.f, 0.f};
            if (seg >= 1) {
                if (isH) {
#pragma unroll
                    for (int ks = 0; ks < 4; ++ks) { const bf16x8v A = *(const bf16x8v*)(p.cH + (size_t)(t0 + r) * 512 + h * 128 + ks * 32 + q * 8);
#pragma unroll
                        for (int nb = 0; nb < 8; ++nb) { const bf16x8v B = *(const bf16x8v*)(p.SstH + (((size_t)seg * 4 + h) * 128 + nb * 16 + r) * 128 + ks * 32 + q * 8);
                            acc[nb] = __builtin_amdgcn_mfma_f32_16x16x32_bf16(A, B, acc[nb], 0, 0, 0); } }
                } else {
#pragma unroll
                    for (int ks = 0; ks < 2; ++ks) { const bf16x8v A = *(const bf16x8v*)(p.cG + (size_t)(t0 + r) * 256 + h * 64 + ks * 32 + q * 8);
#pragma unroll
                        for (int nb = 0; nb < 8; ++nb) { const bf16x8v B = *(const bf16x8v*)(p.SstG + (((size_t)seg * 4 + h) * 128 + nb * 16 + r) * 64 + ks * 32 + q * 8);
                            acc[nb] = __builtin_amdgcn_mfma_f32_16x16x32_bf16(A, B, acc[nb], 0, 0, 0); } }
                }
            }
            const float* ol = isH ? p.oH : p.oG; const float* gain = (isH ? p.hg_norm_w : p.gla_norm_w) + L * 512; const int gcol = isH ? HG_G : GL_R;
            bf16_t* bo = p.bo + (isH ? (size_t)0 : (size_t)3 * T * 512);
#pragma unroll
            for (int i = 0; i < 4; ++i) { const size_t t = (size_t)t0 + 4 * q + i; float o[8]; float ss = 0.f;
#pragma unroll
                for (int nb = 0; nb < 8; ++nb) { o[nb] = acc[nb][i] + ol[t * 512 + h * 128 + nb * 16 + r]; ss += o[nb] * o[nb]; }
                const float rs = rsqrtf(red16(ss) * (1.0f / 128.0f) + 1e-5f);
#pragma unroll
                for (int nb = 0; nb < 8; ++nb) { const int c = h * 128 + nb * 16 + r; const float g = bf2f(p.z[t * ZLD + gcol + c]);
                    bo[t * 512 + c] = f2bf(o[nb] * rs * gain[c] * siluf_(g)); } }
        }
    }
}
__device__ __forceinline__ void sb_phase(const MixArgs& p) {
    typedef short bf16x8v __attribute__((ext_vector_type(8)));
    typedef float f32x16v __attribute__((ext_vector_type(16)));
    typedef __bf16 bf16x2n __attribute__((ext_vector_type(2)));
    const int tid = threadIdx.x, wv = tid >> 6, lane = tid & 63, r = lane & 31, hh = lane >> 5;
    const int W = gridDim.x * 8;
    const float scale = 0.08838834764831845f;
    for (int u = blockIdx.x * 8 + wv; u < 2048; u += W) {
        const int h = u & 3, qb = u >> 2, q0 = qb * 32;
        bf16x8v Qf[8];
#pragma unroll
        for (int s = 0; s < 8; ++s) Qf[s] = *(const bf16x8v*)(p.z + (size_t)(q0 + r) * ZLD + SB_Q + h * 128 + s * 16 + hh * 8);
        f32x16v O[4];
#pragma unroll
        for (int db = 0; db < 4; ++db)
#pragma unroll
            for (int i = 0; i < 16; ++i) O[db][i] = 0.f;
        float R = 0.f;
        for (int kb = qb; kb >= 0; --kb) {
            const int k0 = kb * 32;
            f32x16v Sacc;
#pragma unroll
            for (int i = 0; i < 16; ++i) Sacc[i] = 0.f;
#pragma unroll
            for (int s = 0; s < 8; ++s) { const bf16x8v Kf = *(const bf16x8v*)(p.z + (size_t)(k0 + r) * ZLD + SB_K + h * 128 + s * 16 + hh * 8);
                Sacc = __builtin_amdgcn_mfma_f32_32x32x16_bf16(Kf, Qf[s], Sacc, 0, 0, 0); }
            float lk[16], zz[16]; bool valid[16];
            const bool diag = (kb == qb);
#pragma unroll
            for (int i = 0; i < 16; ++i) { const int kr = (i & 3) + 8 * (i >> 2) + 4 * hh;
                valid[i] = !diag || (kr < r);
                zz[i] = Sacc[i] * scale;
                const float sp = fmaxf(zz[i], 0.f) + __logf(1.0f + __expf(-fabsf(zz[i])));
                lk[i] = valid[i] ? -sp : 0.f; }
            float G[4], Gp[4];
#pragma unroll
            for (int g = 0; g < 4; ++g) { G[g] = (lk[4 * g] + lk[4 * g + 1]) + (lk[4 * g + 2] + lk[4 * g + 3]); Gp[g] = __shfl_xor(G[g], 32); }
            float Tq[4]; float run = 0.f;
#pragma unroll
            for (int g = 3; g >= 0; --g) { Tq[g] = run + (hh == 0 ? Gp[g] : 0.f); run += G[g] + Gp[g]; }
            float wgt[16];
#pragma unroll
            for (int g = 0; g < 4; ++g) { float ing = 0.f;
#pragma unroll
                for (int j = 3; j >= 0; --j) { const int i = 4 * g + j;
                    const float logw = zz[i] + lk[i] + (R + Tq[g] + ing);
                    wgt[i] = valid[i] ? __expf(logw) : 0.f;
                    ing += lk[i]; } }
            R += run;
            bf16x8v Pf[2];
#pragma unroll
            for (int s2 = 0; s2 < 2; ++s2) {
                union { bf16x2n h2[4]; bf16x8v v; } pk;
#pragma unroll
                for (int j = 0; j < 4; ++j) { f32x2v f; f.x = wgt[8 * s2 + 2 * j]; f.y = wgt[8 * s2 + 2 * j + 1]; pk.h2[j] = __builtin_convertvector(f, bf16x2n); }
                Pf[s2] = pk.v; }
#pragma unroll
            for (int db = 0; db < 4; ++db)
#pragma unroll
                for (int s2 = 0; s2 < 2; ++s2) { const bf16_t* vp = p.Vt + (size_t)(h * 128 + db * 32 + r) * T + k0 + 16 * s2 + 4 * hh;
                    union { pg8::u32x2 d[2]; bf16x8v v; } vf; vf.d[0] = *(const pg8::u32x2*)vp; vf.d[1] = *(const pg8::u32x2*)(vp + 8);
                    O[db] = __builtin_amdgcn_mfma_f32_32x32x16_bf16(vf.v, Pf[s2], O[db], 0, 0, 0); }
            if (__all(R < -104.0f)) break;
        }
        bf16_t* bo2 = p.bo + (size_t)2 * T * 512 + (size_t)(q0 + r) * 512 + h * 128;
#pragma unroll
        for (int db = 0; db < 4; ++db)
#pragma unroll
            for (int g = 0; g < 4; ++g) { pg8::u32x2 w; w.x = (unsigned)f2bf(O[db][4 * g]) | ((unsigned)f2bf(O[db][4 * g + 1]) << 16); w.y = (unsigned)f2bf(O[db][4 * g + 2]) | ((unsigned)f2bf(O[db][4 * g + 3]) << 16);
                *(pg8::u32x2*)(bo2 + db * 32 + 8 * g + 4 * hh) = w; }
    }
}
__global__ __launch_bounds__(512, 2) void k_sb(MixArgs p) { sb_phase(p); }
constexpr int MIX_LDS = 2 * 16 * 512 * 4 + 2 * 1024 * 4;
__global__ __launch_bounds__(512, 2) void k_prep2(MixArgs p) { extern __shared__ __attribute__((aligned(16))) unsigned char shm[]; prep_phase(p, (LAS unsigned char*)shm); }
__global__ __launch_bounds__(512, 2) void k_chains(MixArgs p) { extern __shared__ __attribute__((aligned(16))) unsigned char shm[]; chains_phase(p, (LAS unsigned char*)shm); }
__global__ __launch_bounds__(512, 2) void k_carry(MixArgs p) { extern __shared__ __attribute__((aligned(16))) unsigned char shm[]; carry_phase(p, (LAS unsigned char*)shm); }
__global__ __launch_bounds__(512, 2) void k_mixfin(MixArgs p) { mixfin_phase(p); }

__global__ __launch_bounds__(512) void k_router(const float* __restrict__ x1, const float* __restrict__ wr, const float* __restrict__ rbias,
                                                int* __restrict__ idx, float* __restrict__ wsel, int* __restrict__ hist) {
    __shared__ int hs[64];
    const int tid = threadIdx.x, lane = tid & 63, wv = __builtin_amdgcn_readfirstlane(tid >> 6);
    if (tid < 64) hs[tid] = 0;
    __syncthreads();
    const float bias = rbias[lane];
    for (int it = 0; it < 2; ++it) {
        const int tb = blockIdx.x * 64 + wv * 8 + it * 4;
        float acc[4] = {0.f, 0.f, 0.f, 0.f};
        const float* xp = x1 + (size_t)tb * D;
        for (int k0 = 0; k0 < D; k0 += 4) {
            float wv4[4];
#pragma unroll
            for (int j = 0; j < 4; ++j) wv4[j] = wr[(size_t)(k0 + j) * 64 + lane];
#pragma unroll
            for (int q = 0; q < 4; ++q) {
                const float4 xv = *(const float4*)(xp + (size_t)q * D + k0);
                acc[q] += xv.x * wv4[0]; acc[q] += xv.y * wv4[1]; acc[q] += xv.z * wv4[2]; acc[q] += xv.w * wv4[3];
            }
        }
#pragma unroll
        for (int q = 0; q < 4; ++q) {
            const int t = tb + q;
            const float score = sigmoidf_(acc[q]);
            const float biased = score + bias;
            float m1 = biased;
            m1 = fmaxf(m1, __shfl_xor(m1, 1)); m1 = fmaxf(m1, __shfl_xor(m1, 2)); m1 = fmaxf(m1, __shfl_xor(m1, 4));
            int am = (biased == m1) ? lane : 64;
            am = min(am, __shfl_xor(am, 1)); am = min(am, __shfl_xor(am, 2)); am = min(am, __shfl_xor(am, 4));
            float m2 = (lane == am) ? -INFINITY : biased;
            m2 = fmaxf(m2, __shfl_xor(m2, 1)); m2 = fmaxf(m2, __shfl_xor(m2, 2)); m2 = fmaxf(m2, __shfl_xor(m2, 4));
            const float gs = m1 + m2;
            const int g = lane >> 3;
            int grank = 0;
#pragma unroll
            for (int g2 = 0; g2 < 8; ++g2) { const float o = __shfl(gs, g2 * 8); grank += (o > gs || (o == gs && g2 < g)) ? 1 : 0; }
            const bool gok = grank < 4;
            const float masked = gok ? biased : -INFINITY;
            int rank = 0;
            for (int e2 = 0; e2 < 64; ++e2) { const float o = rdlane(masked, e2); rank += (o > masked || (o == masked && e2 < lane)) ? 1 : 0; }
            const bool sel = rank < 8;
            const float ssum = wave_sum(sel ? score : 0.f);
            if (sel) { idx[(size_t)t * 8 + rank] = lane; wsel[(size_t)t * 8 + rank] = 2.5f * score / ssum; atomicAdd(&hs[lane], 1); }
        }
    }
    __syncthreads();
    if (tid < 64) hist[blockIdx.x * 64 + tid] = hs[tid];
}

__global__ __launch_bounds__(512) void k_dispatch(const int* __restrict__ idx, const float* __restrict__ wsel, const int* __restrict__ hist,
                                                  int* __restrict__ row_tok, float* __restrict__ row_w, int* __restrict__ slotpos,
                                                  int* __restrict__ panel_expert, int* __restrict__ npanels) {
    __shared__ int tot[64], bef[64], pstart[64], es[512];
    __shared__ int np_s;
    const int tid = threadIdx.x, blk = blockIdx.x;
    if (tid < 64) { int b = 0, s = 0; for (int j = 0; j < 256; ++j) { const int c = hist[j * 64 + tid]; if (j < blk) b += c; s += c; } tot[tid] = s; bef[tid] = b; }
    __syncthreads();
    if (tid == 0) { int acc = 0; for (int e = 0; e < 64; ++e) { pstart[e] = acc; acc += (tot[e] + 255) / 256 * 256; } np_s = acc / 256; }
    const int t = blk * 64 + (tid >> 3), k = tid & 7;
    const int e = idx[(size_t)t * 8 + k];
    es[tid] = e;
    __syncthreads();
    int rank = 0;
    for (int j = 0; j < tid; ++j) rank += (es[j] == e) ? 1 : 0;
    const int pos = pstart[e] + bef[e] + rank;
    row_tok[pos] = t; row_w[pos] = wsel[(size_t)t * 8 + k]; slotpos[(size_t)t * 8 + k] = pos;
    const int NP = np_s;
    if (blk < 64) {
        const int ee = blk, st = pstart[ee], cnt = tot[ee], pad = (cnt + 255) / 256 * 256;
        for (int r = st + cnt + tid; r < st + pad; r += 512) { row_tok[r] = 0; row_w[r] = 0.f; }
        for (int pp = st / 256 + tid; pp < (st + pad) / 256; pp += 512) panel_expert[pp] = ee;
    }
    if (tid < 64) { const int tt = blk * 64 + tid; row_tok[NP * 256 + tt] = tt; row_w[NP * 256 + tt] = 1.0f; }
    if (blk == 0) { if (tid < 64) panel_expert[NP + tid] = 64; if (tid == 0) npanels[0] = NP + 64; }
}

__global__ __launch_bounds__(256) void k_combine_ln(const float* __restrict__ x1, const bf16_t* __restrict__ y, const int* __restrict__ slotpos, const int* __restrict__ npanels,
                                                    const float* __restrict__ w, const float* __restrict__ b, float* __restrict__ outf, bf16_t* __restrict__ outb) {
    const int lane = threadIdx.x & 63;
    const int t = blockIdx.x * 4 + (threadIdx.x >> 6);
    const int shared_row = (npanels[0] - 64) * 256 + t;
    int rows[9];
#pragma unroll
    for (int k = 0; k < 8; ++k) rows[k] = slotpos[(size_t)t * 8 + k];
    rows[8] = shared_row;
    float v[32]; float s = 0.f;
#pragma unroll
    for (int i = 0; i < 8; ++i) {
        const int c = i * 256 + lane * 4;
        const float4 x = *(const float4*)(x1 + (size_t)t * D + c);
        float a0 = 0.f, a1 = 0.f, a2 = 0.f, a3 = 0.f;
#pragma unroll
        for (int k = 0; k < 9; ++k) { const uint2 u = *(const uint2*)(y + (size_t)rows[k] * D + c);
            a0 += __uint_as_float(u.x << 16); a1 += __uint_as_float(u.x & 0xffff0000u); a2 += __uint_as_float(u.y << 16); a3 += __uint_as_float(u.y & 0xffff0000u); }
        v[4 * i] = ALPHA * x.x + a0; v[4 * i + 1] = ALPHA * x.y + a1; v[4 * i + 2] = ALPHA * x.z + a2; v[4 * i + 3] = ALPHA * x.w + a3;
        s += (v[4 * i] + v[4 * i + 1]) + (v[4 * i + 2] + v[4 * i + 3]);
    }
    const float mu = wave_sum(s) * (1.0f / D);
    float q = 0.f;
#pragma unroll
    for (int i = 0; i < 32; ++i) { const float d = v[i] - mu; q += d * d; }
    const float rstd = rsqrtf(wave_sum(q) * (1.0f / D) + 1e-5f);
#pragma unroll
    for (int i = 0; i < 8; ++i) {
        const int c = i * 256 + lane * 4;
        const float4 ww = *(const float4*)(w + c), bb = *(const float4*)(b + c);
        float4 o; o.x = (v[4 * i] - mu) * rstd * ww.x + bb.x; o.y = (v[4 * i + 1] - mu) * rstd * ww.y + bb.y; o.z = (v[4 * i + 2] - mu) * rstd * ww.z + bb.z; o.w = (v[4 * i + 3] - mu) * rstd * ww.w + bb.w;
        *(float4*)(outf + (size_t)t * D + c) = o;
        if (outb) { bf16_t* ob = outb + (size_t)t * D + c; ob[0] = f2bf(o.x); ob[1] = f2bf(o.y); ob[2] = f2bf(o.z); ob[3] = f2bf(o.w); }
    }
}


template <class Epi, bool DUAL>
static void launch_ngemm(hipStream_t stream, int mtiles, int ntiles, const bf16_t* A, int lda, const int* rowmap, const float* B0, const float* B1, int ldb,
                         const float* B0s, const float* B1s, size_t estride, const int* panel_expert, const int* npanels, int N, int K, const Epi& epi) {
    GemmArgs<Epi> ga; memset(&ga, 0, sizeof ga);
    ga.A = A; ga.rowmap = rowmap; ga.B0 = B0; ga.B1 = B1; ga.B0s = B0s; ga.B1s = B1s; ga.estride = estride; ga.panel_expert = panel_expert; ga.npanels = npanels;
    ga.lda = lda; ga.ldb = ldb; ga.N = N; ga.K = K; memcpy(&ga.epi, &epi, sizeof(Epi));
    k_ngemm<Epi, DUAL><<<dim3(mtiles, ntiles), 256, 0, stream>>>(ga);
}
template <class E> static E zeroed() { E e; memset(&e, 0, sizeof e); return e; }
extern "C" void kernel_launch(void* const* d_in, const int* in_sizes, int n_in, void* d_out, int out_size, void* d_ws, size_t ws_size, hipStream_t stream) {
    const float* x_in = (const float*)d_in[0];
    const float* w_in = (const float*)d_in[1];
    const float* hg_lb = (const float*)d_in[2];
    const float* hg_norm_w = (const float*)d_in[3];
    const float* rw_mu = (const float*)d_in[4];
    const float* rw_w0 = (const float*)d_in[5];
    const float* rw_w2 = (const float*)d_in[6];
    const float* rw_a0 = (const float*)d_in[7];
    const float* rw_a2 = (const float*)d_in[8];
    const float* rw_g2 = (const float*)d_in[9];
    const float* rw_kk = (const float*)d_in[10];
    const float* rw_ka = (const float*)d_in[11];
    const float* rw_rk = (const float*)d_in[12];
    const float* rw_ln_w = (const float*)d_in[13];
    const float* rw_ln_b = (const float*)d_in[14];
    const float* gla_g2 = (const float*)d_in[15];
    const float* gla_gb = (const float*)d_in[16];
    const float* gla_norm_w = (const float*)d_in[17];
    const float* w_br = (const float*)d_in[18];
    const float* w_out = (const float*)d_in[19];
    const float* ln1_w = (const float*)d_in[20];
    const float* ln1_b = (const float*)d_in[21];
    const float* w_router = (const float*)d_in[22];
    const float* router_bias = (const float*)d_in[23];
    const float* we_gate = (const float*)d_in[24];
    const float* we_up = (const float*)d_in[25];
    const float* we_down = (const float*)d_in[26];
    const float* ws_gate = (const float*)d_in[27];
    const float* ws_up = (const float*)d_in[28];
    const float* ws_down = (const float*)d_in[29];
    const float* ln2_w = (const float*)d_in[30];
    const float* ln2_b = (const float*)d_in[31];

    char* base = (char*)d_ws; size_t off = 0;
    auto take = [&](size_t bytes) { char* p = base + off; off += (bytes + 255) & ~(size_t)255; return p; };
    const size_t MiB = 1024 * 1024;
    const size_t TS = (size_t)T * 512 * 4;
    const size_t zbytes = (((size_t)T * ZLD * 2) + 255) & ~(size_t)255;
    char* regY = take(zbytes + (size_t)8 * T * 384 * 4);
    bf16_t* z = (bf16_t*)regY;
    float* RS = (float*)(regY + zbytes);
    bf16_t* ybuf = (bf16_t*)regY;
    bf16_t* xb = (bf16_t*)take((size_t)T * D * 2);
    char* regM = take((size_t)MAXROWS * FW * 2 + (size_t)T * D * 4);
    float* HS = (float*)regM; float* GS = HS + (size_t)4 * T * 512; bf16_t* Vt = (bf16_t*)(GS + (size_t)4 * T * 320);
    float* rGate = (float*)(Vt + (size_t)512 * T); float* rBonus = rGate + (size_t)T * 512;
    bf16_t* hbuf = (bf16_t*)regM;
    float* x1 = (float*)(regM + (size_t)MAXROWS * FW * 2);
    float* oR = (float*)take(TS); float* oH = (float*)take(TS); float* oG = (float*)take(TS);
    bf16_t* cR = (bf16_t*)take(TS / 2); bf16_t* cH = (bf16_t*)take(TS / 2); bf16_t* cG = (bf16_t*)take(TS / 4);
    float* SendR = (float*)take((size_t)NSEG * 8 * 64 * 64 * 4); float* PendR = (float*)take((size_t)NSEG * 8 * 64 * 64 * 4);
    float* SendH = (float*)take((size_t)NSEG * 4 * 128 * 128 * 4); float* SendG = (float*)take((size_t)NSEG * 4 * 128 * 64 * 4);
    float* GamH = (float*)take((size_t)NSEG * 4 * 128 * 4); float* GamG = (float*)take((size_t)NSEG * 4 * 64 * 4);
    bf16_t* SstR = (bf16_t*)take((size_t)NSEG * 8 * 64 * 64 * 2); bf16_t* SstH = (bf16_t*)take((size_t)NSEG * 4 * 128 * 128 * 2); bf16_t* SstG = (bf16_t*)take((size_t)NSEG * 4 * 128 * 64 * 2);
    bf16_t* bo = (bf16_t*)take(4 * (size_t)T * 512 * 2);
    float* merged = (float*)take((size_t)T * D * 4);
    float* pre = merged;
    bf16_t* mergedb = (bf16_t*)take((size_t)T * D * 2);
    bf16_t* x1b = (bf16_t*)take((size_t)T * D * 2);
    float* x2 = (float*)d_out;
    bf16_t* WinT = (bf16_t*)take((size_t)ZLD * D * 2);
    bf16_t* WguT = (bf16_t*)take((size_t)65 * 1024 * D * 2);
    bf16_t* WdT = (bf16_t*)take((size_t)65 * D * FW * 2);
    bf16_t* WbrT = (bf16_t*)take((size_t)4 * D * FW * 2);
    bf16_t* WoutT = (bf16_t*)take((size_t)D * D * 2);
    int* idx = (int*)take((size_t)T * 8 * 4); float* wsel = (float*)take((size_t)T * 8 * 4); int* hist = (int*)take(256 * 64 * 4);
    int* row_tok = (int*)take((size_t)MAXROWS * 4); float* row_w = (float*)take((size_t)MAXROWS * 4); int* slotpos = (int*)take((size_t)T * 8 * 4);
    int* panel_expert = (int*)take(MAXPANELS * 4); int* npanels = (int*)take(256);
    if (off > ws_size) { fprintf(stderr, "workspace too small: need %zu MiB, have %zu MiB\n", off / MiB, ws_size / MiB); return; }
    const int GLDS = pg8::STAGE_BYTES + pg8::GTAB_BYTES;
    static bool attr_done = false;
    if (!attr_done) {
        hipFuncSetAttribute((const void*)k_gplain<pg8::EpiZ16>, hipFuncAttributeMaxDynamicSharedMemorySize, GLDS);
        hipFuncSetAttribute((const void*)k_gplain<pg8::EpiGateAcc>, hipFuncAttributeMaxDynamicSharedMemorySize, GLDS);
        hipFuncSetAttribute((const void*)k_gplain<pg8::EpiResid>, hipFuncAttributeMaxDynamicSharedMemorySize, GLDS);
        hipFuncSetAttribute((const void*)k_gmoe<pg8::EpiSwi, true>, hipFuncAttributeMaxDynamicSharedMemorySize, GLDS);
        hipFuncSetAttribute((const void*)k_gmoe<pg8::EpiDownW, false>, hipFuncAttributeMaxDynamicSharedMemorySize, GLDS);
        hipFuncSetAttribute((const void*)k_prep2, hipFuncAttributeMaxDynamicSharedMemorySize, 81920);
        hipFuncSetAttribute((const void*)k_chains, hipFuncAttributeMaxDynamicSharedMemorySize, MIX_LDS);
        attr_done = true;
    }
    const int GRID = 256;

    for (int L = 0; L < 2; ++L) {
        const float* xin = (L == 0) ? x_in : x2;
        float* xout = (L == 0) ? x2 : (float*)d_out;
        if (L == 0) k_cvt_bf16<<<2048, 256, 0, stream>>>(x_in, xb, (size_t)T * D);
        { ConvArgs ca; memset(&ca, 0, sizeof ca); ca.w_in = w_in; ca.we_gate = we_gate; ca.we_up = we_up; ca.we_down = we_down; ca.ws_gate = ws_gate; ca.ws_up = ws_up; ca.ws_down = ws_down; ca.w_br = w_br; ca.w_out = w_out;
          ca.WinT = WinT; ca.WguT = WguT; ca.WdT = WdT; ca.WbrT = WbrT; ca.WoutT = WoutT; ca.layer = L;
          k_convert<<<2048, 512, 0, stream>>>(ca); }
        { PlainGemmArgs ga; memset(&ga, 0, sizeof ga); ga.A = xb; ga.Bt = WinT; ga.M = T; ga.N = ZLD; ga.K = D;
          pg8::EpiZ16 e; memset(&e, 0, sizeof e); e.O = z; e.ldc = ZLD;
          k_gplain<pg8::EpiZ16><<<GRID, 512, GLDS, stream>>>(ga, e); }
        { MixArgs ma; memset(&ma, 0, sizeof ma); ma.z = z; ma.hg_lb_logits = hg_lb; ma.hg_norm_w = hg_norm_w; ma.rw_mu = rw_mu; ma.rw_w0 = rw_w0; ma.rw_w2 = rw_w2; ma.rw_a0 = rw_a0; ma.rw_a2 = rw_a2; ma.rw_g2 = rw_g2;
          ma.rw_kk = rw_kk; ma.rw_ka = rw_ka; ma.rw_rk = rw_rk; ma.rw_ln_w = rw_ln_w; ma.rw_ln_b = rw_ln_b; ma.gla_g2 = gla_g2; ma.gla_gb = gla_gb; ma.gla_norm_w = gla_norm_w;
          ma.RS = RS; ma.HS = HS; ma.GS = GS; ma.Vt = Vt; ma.rGate = rGate; ma.rBonus = rBonus; ma.oR = oR; ma.oH = oH; ma.oG = oG; ma.cR = cR; ma.cH = cH; ma.cG = cG;
          ma.SendR = SendR; ma.PendR = PendR; ma.SendH = SendH; ma.SendG = SendG; ma.GamH = GamH; ma.GamG = GamG; ma.SstR = SstR; ma.SstH = SstH; ma.SstG = SstG; ma.bo = bo; ma.layer = L;
          k_prep2<<<GRID, 512, 81920, stream>>>(ma);
          k_chains<<<GRID, 512, MIX_LDS, stream>>>(ma);
          k_carry<<<16, 512, 2 * 64 * 65 * 4, stream>>>(ma);
          k_sb<<<GRID, 512, 0, stream>>>(ma);
          k_mixfin<<<GRID, 512, 0, stream>>>(ma); }
        for (int g = 0; g < 4; ++g) {
            PlainGemmArgs ga; memset(&ga, 0, sizeof ga); ga.A = bo + (size_t)g * T * 512; ga.Bt = WbrT + (size_t)g * D * FW; ga.M = T; ga.N = D; ga.K = FW;
            pg8::EpiGateAcc e; memset(&e, 0, sizeof e); e.zg = z + GATE0 + g * D; e.merged = merged; e.mergedb = mergedb; e.g = g;
            k_gplain<pg8::EpiGateAcc><<<GRID, 512, GLDS, stream>>>(ga, e); }
        { PlainGemmArgs ga; memset(&ga, 0, sizeof ga); ga.A = mergedb; ga.Bt = WoutT; ga.M = T; ga.N = D; ga.K = D;
          pg8::EpiResid e; memset(&e, 0, sizeof e); e.xin = xin; e.pre = pre;
          k_gplain<pg8::EpiResid><<<GRID, 512, GLDS, stream>>>(ga, e); }
        k_ln<<<T / 4, 256, 0, stream>>>(pre, ln1_w + L * D, ln1_b + L * D, x1, x1b);
        k_router<<<256, 512, 0, stream>>>(x1, w_router + (size_t)L * D * NE, router_bias + L * NE, idx, wsel, hist);
        k_dispatch<<<256, 512, 0, stream>>>(idx, wsel, hist, row_tok, row_w, slotpos, panel_expert, npanels);
        { MoeGemmArgs ga; memset(&ga, 0, sizeof ga); ga.A = x1b; ga.Bt = WguT; ga.estride = (size_t)1024 * D; ga.panel_expert = panel_expert; ga.rowmap = row_tok; ga.npanels = npanels; ga.NT = 4; ga.K = D;
          pg8::EpiSwi e; memset(&e, 0, sizeof e); e.h = hbuf;
          k_gmoe<pg8::EpiSwi, true><<<GRID, 512, GLDS, stream>>>(ga, e); }
        { MoeGemmArgs ga; memset(&ga, 0, sizeof ga); ga.A = hbuf; ga.Bt = WdT; ga.estride = (size_t)D * FW; ga.panel_expert = panel_expert; ga.rowmap = nullptr; ga.npanels = npanels; ga.NT = 8; ga.K = FW;
          pg8::EpiDownW e; memset(&e, 0, sizeof e); e.y = ybuf; e.row_w = row_w;
          k_gmoe<pg8::EpiDownW, false><<<GRID, 512, GLDS, stream>>>(ga, e); }
        k_combine_ln<<<T / 4, 256, 0, stream>>>(x1, ybuf, slotpos, npanels, ln2_w + L * D, ln2_b + L * D, xout, (L == 0) ? xb : nullptr);
    }
}
```

```cpp
#include <hip/hip_runtime.h>
#include <stdint.h>
#include <stdio.h>
#include <string.h>

typedef unsigned short bf16_t;

constexpr int T = 16384, D = 2048, ZW = 15024, ZLD = 15104, NE = 64, FW = 512;
constexpr int HG_Q = 0, HG_F = 512, HG_I = 1024, HG_G = 1536;
constexpr int RW_R = 2048, RW_K = 2560, RW_V = 3072, RW_LW = 3584;
constexpr int SB_Q = 3744, SB_K = 4256, SB_V = 4768;
constexpr int GL_Q = 5280, GL_K = 5536, GL_V = 5792, GL_LG = 6304, GL_R = 6320;
constexpr int GATE0 = 6832;
constexpr float ALPHA = 1.4142135623730951f;
constexpr int MAXPANELS = 640;
constexpr int MAXROWS = MAXPANELS * 256;
constexpr int NSEG = 32, LSEG = T / NSEG;
constexpr int NCHK = T / 64;

__device__ __forceinline__ float bf2f(bf16_t v) { return __uint_as_float(((unsigned)v) << 16); }
__device__ __forceinline__ bf16_t f2bf(float f) { unsigned u = __float_as_uint(f); u += 0x7FFFu + ((u >> 16) & 1u); return (bf16_t)(u >> 16); }
__device__ __forceinline__ float sigmoidf_(float x) { return 1.0f / (1.0f + expf(-x)); }
__device__ __forceinline__ float softplusf_(float x) { return fmaxf(x, 0.f) + log1pf(expf(-fabsf(x))); }
__device__ __forceinline__ float siluf_(float x) { return x / (1.0f + expf(-x)); }
__device__ __forceinline__ float fsig(float x) { return __builtin_amdgcn_rcpf(1.0f + __expf(-x)); }
__device__ __forceinline__ float fsoftplus(float x) { return fmaxf(x, 0.f) + __logf(1.0f + __expf(-fabsf(x))); }

template <int CTRL> __device__ __forceinline__ float dppmov(float x) {
    return __builtin_bit_cast(float, __builtin_amdgcn_update_dpp(0, __builtin_bit_cast(int, x), CTRL, 0xF, 0xF, true));
}
__device__ __forceinline__ float rdlane(float x, int l) { return __builtin_bit_cast(float, __builtin_amdgcn_readlane(__builtin_bit_cast(int, x), l)); }
__device__ __forceinline__ int phase_tid() { int t = (int)threadIdx.x; asm volatile("" : "+v"(t)); return t & 511; }
__device__ __forceinline__ float wave_sum(float x) {
    x += dppmov<0xB1>(x);
    x += dppmov<0x4E>(x);
    x += dppmov<0x141>(x);
    x += dppmov<0x140>(x);
    return (rdlane(x, 0) + rdlane(x, 16)) + (rdlane(x, 32) + rdlane(x, 48));
}
#define LAS __attribute__((address_space(3)))
namespace pg8 {
typedef short bf16x8 __attribute__((ext_vector_type(8)));
typedef float f32x4 __attribute__((ext_vector_type(4)));
typedef unsigned u32x4 __attribute__((ext_vector_type(4)));
typedef unsigned u32x2 __attribute__((ext_vector_type(2)));
constexpr int BM = 256, BK = 64, HALF = 128, HTB = HALF * BK * 2, STAGE_BYTES = 8 * HTB, NXCD = 8, WGM = 8;
constexpr int GTAB_BYTES = 512 * 16;
__host__ __device__ __forceinline__ int lds_byte(int r, int c) { const int st = (r >> 4) * 2 + (c >> 5), rr = r & 15, cc = c & 31, ob = rr * 64 + cc * 2; return st * 1024 + (ob ^ (((ob >> 9) & 1) << 5)); }
__host__ __device__ __forceinline__ void stage_rc(int b, int& R, int& C) { const int st = b / 1024, sb = b % 1024, swz = sb ^ (((sb >> 9) & 1) << 5); R = (st >> 1) * 16 + swz / 64; C = (st & 1) * 32 + (swz % 64) / 2; }
__host__ __device__ __forceinline__ int perm32(int rho) { const int n = rho >> 4, i = rho & 15; return 8 * (i >> 2) + 4 * n + (i & 3); }
struct Unit { int pm, pn, e; };
__device__ __forceinline__ unsigned cvt_pk_bf16(float lo, float hi) { unsigned r; asm volatile("v_cvt_pk_bf16_f32 %0, %1, %2" : "=v"(r) : "v"(lo), "v"(hi)); return r; }

struct StaticOrder {
    const bf16_t* A; const bf16_t* Bt; int K; int nM, nN, nwg, G, c;
    __device__ void init(const bf16_t* A_, const bf16_t* Bt_, int M, int N, int K_, int G_, int c_) { A = A_; Bt = Bt_; K = K_; nM = M / BM; nN = N / BM; nwg = nM * nN; G = G_; c = c_; }
    __device__ bool next(int i, Unit& u) const {
        const int L = i * G + c; if (L >= nwg) return false;
        int wgid = L; { const int q = nwg / NXCD, r = nwg % NXCD, xcd = wgid % NXCD, off = wgid / NXCD; wgid = (xcd < r ? xcd * (q + 1) : r * (q + 1) + (xcd - r) * q) + off; }
        const int nig = WGM * nN, gid = wgid / nig, fm = gid * WGM, gsz = (nM - fm) < WGM ? (nM - fm) : WGM;
        u.pm = fm + ((wgid % nig) % gsz); u.pn = (wgid % nig) / gsz; u.e = 0; return true;
    }
    __device__ __forceinline__ const char* a_base(const Unit& u) const { return (const char*)A + (size_t)u.pm * 256 * K * 2; }
    __device__ __forceinline__ const char* b_base(const Unit& u) const { return (const char*)Bt + (size_t)u.pn * 256 * K * 2; }
    __device__ __forceinline__ const int* rowmap() const { return nullptr; }
};
struct GateOrder {
    StaticOrder so; const bf16_t* A; const bf16_t* Bt; int per;
    __device__ void init(const bf16_t* bo, const bf16_t* WbrT, int G_, int c_) { so.init(bo, WbrT, T, D, FW, G_, c_); A = bo; Bt = WbrT; Unit t; per = 0; while (so.next(per, t)) ++per; }
    __device__ bool next(int i, Unit& u) const { if (per == 0 || i >= 4 * per) return false; const int g = i / per; const bool ok = so.next(i - g * per, u); u.e = g; return ok; }
    __device__ __forceinline__ const char* a_base(const Unit& u) const { return (const char*)(A + (size_t)u.e * T * 512) + (size_t)u.pm * 256 * FW * 2; }
    __device__ __forceinline__ const char* b_base(const Unit& u) const { return (const char*)(Bt + (size_t)u.e * D * FW) + (size_t)u.pn * 256 * FW * 2; }
    __device__ __forceinline__ const int* rowmap() const { return nullptr; }
};
struct MoeOrder {
    const bf16_t* A; const bf16_t* Bt; const int* rmap; const LAS int* petab; size_t estride; int K, NT, total, G, c;
    __device__ void init(const bf16_t* A_, const bf16_t* Bt_, size_t estride_, const LAS int* petab_, const int* rmap_, int npanels, int NT_, int K_, int G_, int c_) {
        A = A_; Bt = Bt_; estride = estride_; petab = petab_; rmap = rmap_; K = K_; NT = NT_; total = npanels * NT_; G = G_;
        c = remap(c_, G_);
    }
    static __device__ __forceinline__ int remap(int c_, int G_) { return (c_ & 7) * (G_ >> 3) + (c_ >> 3); }
    static __device__ __forceinline__ void fill_table(LAS int* tab, const int* panel_expert, int npanels, int NT_, int G_, int c_, int tid) {
        const int cc = remap(c_, G_), tot = npanels * NT_;
        if (tid < 64) { const int Lu = tid * G_ + cc; tab[tid] = (Lu < tot) ? panel_expert[Lu / NT_] : 0; }
        __syncthreads();
    }
    __device__ bool next(int i, Unit& u) const {
        const int L = i * G + c; if (L >= total) return false;
        u.pm = L / NT; u.pn = L % NT; u.e = petab[i]; return true;
    }
    __device__ __forceinline__ const char* a_base(const Unit& u) const { return rmap ? (const char*)A : (const char*)A + (size_t)u.pm * 256 * K * 2; }
    __device__ __forceinline__ const char* b_base(const Unit& u) const { return (const char*)(Bt + (size_t)u.e * estride) + (size_t)u.pn * 256 * K * 2; }
    __device__ __forceinline__ const int* rowmap() const { return rmap; }
};

struct EpiZ16 {
    static constexpr bool PERM = true;
    bf16_t* O; int ldc; int pad_;
    __device__ __forceinline__ void operator()(const f32x4 (&acc)[2][2][4][2], const Unit& u, int wr, int wc, int fr, int fq) const {
        const int row0 = u.pm * BM + wr * 64 + fr, col0 = u.pn * BM + wc * 32 + 8 * fq;
#pragma unroll
        for (int ai = 0; ai < 2; ++ai)
#pragma unroll
            for (int m = 0; m < 4; ++m) { bf16_t* rowp = O + (size_t)(row0 + ai * HALF + m * 16) * ldc + col0;
#pragma unroll
                for (int bj = 0; bj < 2; ++bj) { const f32x4 v0 = acc[ai][bj][m][0], v1 = acc[ai][bj][m][1];
                    u32x4 w; w.x = cvt_pk_bf16(v0[0], v0[1]); w.y = cvt_pk_bf16(v0[2], v0[3]); w.z = cvt_pk_bf16(v1[0], v1[1]); w.w = cvt_pk_bf16(v1[2], v1[3]);
                    *(u32x4*)(rowp + bj * HALF) = w; } }
    }
};
struct EpiGateAcc {
    static constexpr bool PERM = true;
    const bf16_t* zg0; bf16_t* mergedb;
    __device__ __forceinline__ void operator()(const f32x4 (&acc)[2][2][4][2], const Unit& u, int wr, int wc, int fr, int fq) const {
        const int g = u.e; const bf16_t* zg = zg0 + g * D;
        const int row0 = u.pm * BM + wr * 64 + fr, col0 = u.pn * BM + wc * 32 + 8 * fq;
#pragma unroll
        for (int ai = 0; ai < 2; ++ai)
#pragma unroll
            for (int m = 0; m < 4; ++m) { const size_t row = (size_t)(row0 + ai * HALF + m * 16);
#pragma unroll
                for (int bj = 0; bj < 2; ++bj) { const int col = col0 + bj * HALF;
                    const u32x4 gz = *(const u32x4*)(zg + row * ZLD + col);
                    f32x4 g0, g1; g0[0] = __uint_as_float(gz.x << 16); g0[1] = __uint_as_float(gz.x & 0xffff0000u); g0[2] = __uint_as_float(gz.y << 16); g0[3] = __uint_as_float(gz.y & 0xffff0000u);
                    g1[0] = __uint_as_float(gz.z << 16); g1[1] = __uint_as_float(gz.z & 0xffff0000u); g1[2] = __uint_as_float(gz.w << 16); g1[3] = __uint_as_float(gz.w & 0xffff0000u);
                    f32x4 v0 = acc[ai][bj][m][0], v1 = acc[ai][bj][m][1];
#pragma unroll
                    for (int j = 0; j < 4; ++j) { v0[j] *= __builtin_amdgcn_rcpf(1.0f + __expf(-g0[j])); v1[j] *= __builtin_amdgcn_rcpf(1.0f + __expf(-g1[j])); }
                    bf16_t* mp = mergedb + row * D + col;
                    if (g > 0) { const u32x4 pv = *(const u32x4*)mp;
                        v0[0] += __uint_as_float(pv.x << 16); v0[1] += __uint_as_float(pv.x & 0xffff0000u); v0[2] += __uint_as_float(pv.y << 16); v0[3] += __uint_as_float(pv.y & 0xffff0000u);
                        v1[0] += __uint_as_float(pv.z << 16); v1[1] += __uint_as_float(pv.z & 0xffff0000u); v1[2] += __uint_as_float(pv.w << 16); v1[3] += __uint_as_float(pv.w & 0xffff0000u); }
                    u32x4 w; w.x = cvt_pk_bf16(v0[0], v0[1]); w.y = cvt_pk_bf16(v0[2], v0[3]); w.z = cvt_pk_bf16(v1[0], v1[1]); w.w = cvt_pk_bf16(v1[2], v1[3]);
                    *(u32x4*)mp = w; } }
    }
};
struct EpiResid {
    static constexpr bool PERM = true;
    const float* xin; float* pre;
    __device__ __forceinline__ void operator()(const f32x4 (&acc)[2][2][4][2], const Unit& u, int wr, int wc, int fr, int fq) const {
        const int row0 = u.pm * BM + wr * 64 + fr, col0 = u.pn * BM + wc * 32 + 8 * fq;
#pragma unroll
        for (int ai = 0; ai < 2; ++ai)
#pragma unroll
            for (int m = 0; m < 4; ++m) { const size_t ro = (size_t)(row0 + ai * HALF + m * 16) * D + col0;
#pragma unroll
                for (int bj = 0; bj < 2; ++bj)
#pragma unroll
                    for (int n = 0; n < 2; ++n) { const f32x4 xv = *(const f32x4*)(xin + ro + bj * HALF + n * 4); *(f32x4*)(pre + ro + bj * HALF + n * 4) = xv * ALPHA + acc[ai][bj][m][n]; } }
    }
};
struct EpiSwi {
    static constexpr bool PERM = true;
    bf16_t* h;
    __device__ __forceinline__ void operator()(const f32x4 (&acc)[2][2][4][2], const Unit& u, int wr, int wc, int fr, int fq) const {
        const int row0 = u.pm * BM + wr * 64 + fr, col0 = u.pn * HALF + wc * 32 + 8 * fq;
#pragma unroll
        for (int ai = 0; ai < 2; ++ai)
#pragma unroll
            for (int m = 0; m < 4; ++m) { float o[8];
#pragma unroll
                for (int n = 0; n < 2; ++n)
#pragma unroll
                    for (int j = 0; j < 4; ++j) { const float gt = acc[ai][0][m][n][j], up = acc[ai][1][m][n][j]; o[4 * n + j] = gt / (1.0f + __expf(-gt)) * up; }
                u32x4 w; w.x = cvt_pk_bf16(o[0], o[1]); w.y = cvt_pk_bf16(o[2], o[3]); w.z = cvt_pk_bf16(o[4], o[5]); w.w = cvt_pk_bf16(o[6], o[7]);
                *(u32x4*)(h + (size_t)(row0 + ai * HALF + m * 16) * FW + col0) = w; }
    }
};
struct EpiDownW {
    static constexpr bool PERM = true;
    bf16_t* y;
    __device__ __forceinline__ void operator()(const f32x4 (&acc)[2][2][4][2], const Unit& u, int wr, int wc, int fr, int fq) const {
        const int row0 = u.pm * BM + wr * 64 + fr, col0 = u.pn * BM + wc * 32 + 8 * fq;
#pragma unroll
        for (int ai = 0; ai < 2; ++ai)
#pragma unroll
            for (int m = 0; m < 4; ++m) { const int row = row0 + ai * HALF + m * 16; bf16_t* rowp = y + (size_t)row * D + col0;
#pragma unroll
                for (int bj = 0; bj < 2; ++bj) { const f32x4 v0 = acc[ai][bj][m][0], v1 = acc[ai][bj][m][1];
                    u32x4 w; w.x = cvt_pk_bf16(v0[0], v0[1]); w.y = cvt_pk_bf16(v0[2], v0[3]); w.z = cvt_pk_bf16(v1[0], v1[1]); w.w = cvt_pk_bf16(v1[2], v1[3]);
                    *(u32x4*)(rowp + bj * HALF) = w; } }
    }
};

template <class Epi, class Sched, bool GATHER>
__device__ __forceinline__ void gemm_phase(LAS unsigned char* lds, const int K, const Sched& S, const Epi& E) {
    const int tid = phase_tid(), wid = __builtin_amdgcn_readfirstlane(tid >> 6), wr = wid >> 2, wc = wid & 3, lane = tid & 63, fr = lane & 15, fq = lane >> 4;
    const int nt = K / BK;
    unsigned voffA[2], voffB[2], voffG[2][2]; int gR[2], gC[2];
#pragma unroll
    for (int i = 0; i < 2; ++i) { int R, C; stage_rc(tid * 16 + i * 8192, R, C); const int Rb = Epi::PERM ? ((R & ~31) + perm32(R & 31)) : R;
        voffA[i] = (unsigned)(R * K + C) * 2u; voffB[i] = (unsigned)(Rb * K + C) * 2u; gR[i] = R; gC[i] = C; voffG[0][i] = 0u; voffG[1][i] = 0u; }
    const size_t kstep = (size_t)(BK * 2);
    const size_t hstep = (size_t)HALF * K * 2;
    const unsigned ldsw = (unsigned)wid * 1024u;
    const int aoff = lds_byte(wr * 64 + fr, fq * 8), boff = lds_byte(wc * 32 + fr, fq * 8);
    LAS u32x4* gtab = (LAS u32x4*)(lds + STAGE_BYTES) + tid;
#define PG8_SA(b, h) (((b) * 2 + (h)) * HTB)
#define PG8_SB(b, h) ((4 + (b) * 2 + (h)) * HTB)
#define PG8_STAGE(bufoff, gbase, voff) do { _Pragma("unroll") for (int _i = 0; _i < 2; ++_i) \
        __builtin_amdgcn_global_load_lds((const unsigned*)((const char*)(gbase) + (voff)[_i]), (LAS unsigned*)(lds + (bufoff) + ldsw + _i * 8192), 16, 0, 0); } while (0)
#define PG8_STAGE_A(bufoff, gbase, h) do { if constexpr (GATHER) PG8_STAGE(bufoff, gbase, voffG[h]); else PG8_STAGE(bufoff, (gbase) + (h) * hstep, voffA); } while (0)
#define PG8_LDA(dst, b, h) do { _Pragma("unroll") for (int m = 0; m < 4; ++m) _Pragma("unroll") for (int k = 0; k < 2; ++k) dst[m][k] = *(const LAS bf16x8*)(lds + PG8_SA(b, h) + aoff + m * 2048 + k * 1024); } while (0)
#define PG8_LDB(dst, b, h) do { _Pragma("unroll") for (int n = 0; n < 2; ++n) _Pragma("unroll") for (int k = 0; k < 2; ++k) dst[n][k] = *(const LAS bf16x8*)(lds + PG8_SB(b, h) + boff + n * 2048 + k * 1024); } while (0)
#define PG8_MMA(ai, bj, At, Bt) do { __builtin_amdgcn_s_setprio(1); _Pragma("unroll") for (int m = 0; m < 4; ++m) _Pragma("unroll") for (int n = 0; n < 2; ++n) _Pragma("unroll") for (int k = 0; k < 2; ++k) \
        acc[ai][bj][m][n] = __builtin_amdgcn_mfma_f32_16x16x32_bf16(Bt[n][k], At[m][k], acc[ai][bj][m][n], 0, 0, 0); __builtin_amdgcn_s_setprio(0); } while (0)
#define PG8_WAIT_V(n) asm volatile("s_waitcnt vmcnt(" #n ")" ::: "memory")
#define PG8_WAIT_L(n) asm volatile("s_waitcnt lgkmcnt(" #n ")" ::: "memory")
#define PG8_BAR __builtin_amdgcn_s_barrier()
#define PG8_SCHED __builtin_amdgcn_sched_barrier(0)
    auto gather_offs = [&](const Unit& u) -> u32x4 {
        const int* rm = S.rowmap(); u32x4 o;
        o.x = (unsigned)(rm[u.pm * 256 + gR[0]] * K + gC[0]) * 2u;       o.y = (unsigned)(rm[u.pm * 256 + gR[1]] * K + gC[1]) * 2u;
        o.z = (unsigned)(rm[u.pm * 256 + 128 + gR[0]] * K + gC[0]) * 2u; o.w = (unsigned)(rm[u.pm * 256 + 128 + gR[1]] * K + gC[1]) * 2u;
        return o; };
    Unit cur, nxt, nn; int ui = 0;
    if (!S.next(0, cur)) return;
    f32x4 acc[2][2][4][2];
#pragma unroll
    for (int a = 0; a < 2; ++a)
#pragma unroll
        for (int b = 0; b < 2; ++b)
#pragma unroll
            for (int m = 0; m < 4; ++m)
#pragma unroll
                for (int n = 0; n < 2; ++n) acc[a][b][m][n] = (f32x4){0.f, 0.f, 0.f, 0.f};
    bf16x8 At[4][2], B0[2][2], B1[2][2];
    const char* cA = S.a_base(cur); const char* cB = S.b_base(cur);
    if constexpr (GATHER) {
        const u32x4 o = gather_offs(cur); voffG[0][0] = o.x; voffG[0][1] = o.y; voffG[1][0] = o.z; voffG[1][1] = o.w;
        if (S.next(1, nn)) *gtab = gather_offs(nn);
        asm volatile("s_waitcnt vmcnt(0) lgkmcnt(0)" ::: "memory");
    }
    PG8_STAGE(PG8_SB(0, 0), cB, voffB); PG8_STAGE(PG8_SB(0, 1), cB + hstep, voffB); PG8_STAGE_A(PG8_SA(0, 0), cA, 0); PG8_STAGE_A(PG8_SA(0, 1), cA, 1);
    if (wr == 1) PG8_BAR;
    PG8_WAIT_V(2); PG8_BAR;
    PG8_STAGE(PG8_SB(1, 0), cB + kstep, voffB); PG8_STAGE_A(PG8_SA(1, 0), cA + kstep, 0); PG8_STAGE(PG8_SB(1, 1), cB + hstep + kstep, voffB);
    PG8_WAIT_V(6); PG8_BAR;
    for (;;) {
        const bool has_next = S.next(ui + 1, nxt);
        const char* nA = has_next ? S.a_base(nxt) : cA; const char* nB = has_next ? S.b_base(nxt) : cB;
        for (int t = 0; t < nt; t += 2) {
            const bool last = (t == nt - 2);
            const char* a1 = cA + (size_t)(t + 1) * kstep;
            const char* a2 = last ? nA : cA + (size_t)(t + 2) * kstep; const char* b2 = last ? nB : cB + (size_t)(t + 2) * kstep;
            const char* a3 = a2 + kstep; const char* b3 = b2 + kstep;
            PG8_LDB(B0, 0, 0); PG8_LDB(B1, 0, 1); PG8_SCHED; PG8_LDA(At, 0, 0); PG8_STAGE_A(PG8_SA(1, 1), a1, 1);
            if constexpr (GATHER) { if (last && has_next) { const u32x4 o = *gtab; voffG[0][0] = o.x; voffG[0][1] = o.y; voffG[1][0] = o.z; voffG[1][1] = o.w; } }
            PG8_WAIT_V(8); PG8_WAIT_L(0); PG8_BAR; PG8_MMA(0, 0, At, B0); PG8_MMA(0, 1, At, B1); PG8_BAR; PG8_SCHED;
            PG8_LDA(At, 0, 1); PG8_STAGE(PG8_SB(0, 0), b2, voffB); PG8_STAGE(PG8_SB(0, 1), b2 + hstep, voffB); PG8_STAGE_A(PG8_SA(0, 0), a2, 0);
            PG8_WAIT_V(8); PG8_WAIT_L(0); PG8_BAR; PG8_MMA(1, 0, At, B0); PG8_MMA(1, 1, At, B1); PG8_BAR; PG8_SCHED;
            PG8_LDB(B0, 1, 0); PG8_LDB(B1, 1, 1); PG8_SCHED; PG8_LDA(At, 1, 0); PG8_STAGE_A(PG8_SA(0, 1), a2, 1);
            PG8_WAIT_V(8); PG8_WAIT_L(0); PG8_BAR; PG8_MMA(0, 0, At, B0); PG8_MMA(0, 1, At, B1); PG8_BAR; PG8_SCHED;
            PG8_LDA(At, 1, 1); PG8_STAGE(PG8_SB(1, 0), b3, voffB); PG8_STAGE(PG8_SB(1, 1), b3 + hstep, voffB); PG8_STAGE_A(PG8_SA(1, 0), a3, 0);
            PG8_WAIT_V(8); PG8_WAIT_L(0); PG8_BAR; PG8_MMA(1, 0, At, B0); PG8_MMA(1, 1, At, B1); PG8_BAR; PG8_SCHED;
        }
        if (wr == 0) PG8_BAR;
        E(acc, cur, wr, wc, fr, fq);
        if constexpr (GATHER) { if (has_next && S.next(ui + 2, nn)) { *gtab = gather_offs(nn); } }
        if (!has_next) break;
#pragma unroll
        for (int a = 0; a < 2; ++a)
#pragma unroll
            for (int b = 0; b < 2; ++b)
#pragma unroll
                for (int m = 0; m < 4; ++m)
#pragma unroll
                    for (int n = 0; n < 2; ++n) acc[a][b][m][n] = (f32x4){0.f, 0.f, 0.f, 0.f};
        cur = nxt; cA = nA; cB = nB; ++ui;
        if (wr == 1) PG8_BAR;
    }
    PG8_WAIT_V(0);
    PG8_BAR;
#undef PG8_SA
#undef PG8_SB
#undef PG8_STAGE
#undef PG8_STAGE_A
#undef PG8_LDA
#undef PG8_LDB
#undef PG8_MMA
#undef PG8_WAIT_V
#undef PG8_WAIT_L
#undef PG8_BAR
#undef PG8_SCHED
}
}


struct ConvArgs { const float *w_in, *we_gate, *we_up, *we_down, *ws_gate, *ws_up, *ws_down, *w_br, *w_out; bf16_t *WinT, *WguT, *WdT, *WbrT, *WoutT; int layer, pad_; };
constexpr int CV_SEG0 = 32 * 236, CV_SEG1 = 65 * 2 * 32 * 8, CV_SEG2 = 65 * 8 * 32, CV_SEG3 = 4 * 8 * 32, CV_SEG4 = 32 * 32;
constexpr int CV_TOTAL = CV_SEG0 + CV_SEG1 + CV_SEG2 + CV_SEG3 + CV_SEG4;
struct CvJob { const float* src; bf16_t* dst; int ld, ldd, valid; };
__device__ __forceinline__ CvJob cv_decode(const ConvArgs& a, const int j, const int L) {
    CvJob o; o.valid = 64;
    if (j < CV_SEG0) { const int kb = j & 31, nb = j >> 5; o.ld = ZW; o.ldd = D;
        o.src = a.w_in + (size_t)L * D * ZW + (size_t)kb * 64 * ZW + nb * 64; int v = ZW - nb * 64; o.valid = v < 0 ? 0 : (v > 64 ? 64 : v);
        o.dst = a.WinT + (size_t)nb * 64 * D + kb * 64; }
    else if (j < CV_SEG0 + CV_SEG1) { int q = j - CV_SEG0; const int cb = q & 7; q >>= 3; const int kb = q & 31; q >>= 5; const int bj = q & 1; const int e = q >> 1; o.ld = FW; o.ldd = D;
        const float* m = (e < NE) ? ((bj ? a.we_up : a.we_gate) + ((size_t)L * NE + e) * D * FW) : ((bj ? a.ws_up : a.ws_gate) + (size_t)L * D * FW);
        o.src = m + (size_t)kb * 64 * FW + cb * 64;
        o.dst = a.WguT + ((size_t)e * 1024 + (cb >> 1) * 256 + bj * 128 + (cb & 1) * 64) * D + kb * 64; }
    else if (j < CV_SEG0 + CV_SEG1 + CV_SEG2) { int q = j - CV_SEG0 - CV_SEG1; const int nb = q & 31; q >>= 5; const int kb = q & 7; const int e = q >> 3; o.ld = D; o.ldd = FW;
        const float* m = (e < NE) ? (a.we_down + ((size_t)L * NE + e) * FW * D) : (a.ws_down + (size_t)L * FW * D);
        o.src = m + (size_t)kb * 64 * D + nb * 64; o.dst = a.WdT + ((size_t)e * D + nb * 64) * FW + kb * 64; }
    else if (j < CV_SEG0 + CV_SEG1 + CV_SEG2 + CV_SEG3) { int q = j - CV_SEG0 - CV_SEG1 - CV_SEG2; const int nb = q & 31; q >>= 5; const int kb = q & 7; const int g = q >> 3; o.ld = D; o.ldd = FW;
        o.src = a.w_br + ((size_t)L * 4 + g) * FW * D + (size_t)kb * 64 * D + nb * 64; o.dst = a.WbrT + ((size_t)g * D + nb * 64) * FW + kb * 64; }
    else { const int q = j - CV_SEG0 - CV_SEG1 - CV_SEG2 - CV_SEG3; const int nb = q & 31, kb = q >> 5; o.ld = D; o.ldd = D;
        o.src = a.w_out + (size_t)L * D * D + (size_t)kb * 64 * D + nb * 64; o.dst = a.WoutT + (size_t)nb * 64 * D + kb * 64; }
    return o;
}
__device__ __forceinline__ void convert_tiles(const ConvArgs& a, int j0, int j1, int jstart, int jstride, LAS float (*tile)[65]) {
    const int tid = phase_tid(), L = a.layer;
    for (int j = j0 + jstart; j < j1; j += jstride) {
        const CvJob jb = cv_decode(a, j, L);
        const float* src = jb.src; bf16_t* dst = jb.dst; const int ld = jb.ld, ldd = jb.ldd, valid = jb.valid;
        __syncthreads();
        { const int c4 = (tid & 15) * 4, k = tid >> 4;
#pragma unroll
          for (int h = 0; h < 2; ++h) { float4 v = make_float4(0.f, 0.f, 0.f, 0.f); if (c4 < valid) v = *(const float4*)(src + (size_t)(k + 32 * h) * ld + c4);
              tile[k + 32 * h][c4] = v.x; tile[k + 32 * h][c4 + 1] = v.y; tile[k + 32 * h][c4 + 2] = v.z; tile[k + 32 * h][c4 + 3] = v.w; } }
        __syncthreads();
        { const int n = tid >> 3, kc = (tid & 7) * 8; unsigned w[4];
#pragma unroll
          for (int q = 0; q < 4; ++q) w[q] = (unsigned)f2bf(tile[kc + 2 * q][n]) | ((unsigned)f2bf(tile[kc + 2 * q + 1][n]) << 16);
          *(uint4*)(dst + (size_t)n * ldd + kc) = make_uint4(w[0], w[1], w[2], w[3]); }
    }
}
constexpr int CVX_OWN = CV_TOTAL - CV_SEG0, CVX_TOTAL = CVX_OWN + CV_SEG0;
__device__ __forceinline__ bool cvx_job(const ConvArgs& a, const int n, const int L, CvJob& jb) {
    if (n < CVX_OWN) { jb = cv_decode(a, CV_SEG0 + n, L); return true; }
    if (n < CVX_TOTAL && L + 1 < 2) { jb = cv_decode(a, n - CVX_OWN, L + 1); return true; }
    return false;
}
typedef float f32x2v __attribute__((ext_vector_type(2)));
typedef float f32x4v __attribute__((ext_vector_type(4)));
struct MixArgs {
    const bf16_t* z;
    const float *hg_lb_logits, *hg_norm_w, *rw_mu, *rw_w0, *rw_w2, *rw_a0, *rw_a2, *rw_g2, *rw_kk, *rw_ka, *rw_rk, *rw_ln_w, *rw_ln_b, *gla_g2, *gla_gb, *gla_norm_w;
    float* RS; bf16_t *Vt, *KH, *KG, *VtH, *VtG; float *rGate, *rBonus;
    float *oR, *oH, *oG; bf16_t *cR, *cH, *cG;
    float *SendR, *PendR, *SendH, *SendG, *GamH, *GamG;
    bf16_t *SstR, *SstH, *SstG;
    bf16_t* bo;
    int layer, pad_;
};
__device__ __forceinline__ float red8(float x) { x += dppmov<0xB1>(x); x += dppmov<0x4E>(x); x += dppmov<0x141>(x); return x; }
__device__ __forceinline__ float red16(float x) { x += dppmov<0xB1>(x); x += dppmov<0x4E>(x); x += dppmov<0x141>(x); x += dppmov<0x140>(x); return x; }

__device__ __forceinline__ void prep_phase(const MixArgs& p, LAS unsigned char* ldsraw) {
    LAS float (*lr)[160] = (LAS float (*)[160])ldsraw;
    LAS float (*glg)[16] = (LAS float (*)[16])(ldsraw + 8 * 160 * 4);
    LAS bf16_t (*vtile)[72] = (LAS bf16_t (*)[72])(ldsraw + 8192);
    const int c = phase_tid(), L = p.layer;
    const float mu_r = p.rw_mu[L * 1696 + c], mu_k = p.rw_mu[L * 1696 + 512 + c], mu_v = p.rw_mu[L * 1696 + 1024 + c];
    const float w0 = p.rw_w0[L * 512 + c], a0 = p.rw_a0[L * 512 + c], kkc = p.rw_kk[L * 512 + c], kac = p.rw_ka[L * 512 + c], rkc = p.rw_rk[L * 512 + c];
    float lb = 0.f;
    if (L == 1) { const float l0 = p.hg_lb_logits[c], l1 = p.hg_lb_logits[512 + c]; const float m = fmaxf(l0, l1); const float e0 = expf(l0 - m), e1 = expf(l1 - m); lb = e1 / (e0 + e1); }
    const float* w2 = p.rw_w2 + (size_t)L * 32 * 512; const float* a2 = p.rw_a2 + (size_t)L * 32 * 512; const float* g2 = p.rw_g2 + (size_t)L * 96 * 512;
    const float* gg2 = p.gla_g2 + (size_t)L * 16 * 256; const float gbc = (c < 256) ? p.gla_gb[L * 256 + c] : 0.f;
    for (int tile = blockIdx.x; tile < T / 64; tile += gridDim.x) {
        const int t0 = tile * 64;
        float bH = 0.f, bG = 0.f;
        for (int tb = 0; tb < 8; ++tb) {
            const int tt0 = t0 + tb * 8;
            __syncthreads();
            for (int i = c; i < 8 * 160; i += 512) {
                const int tok = i / 160, col = i - tok * 160, t = tt0 + tok;
                const float cur = bf2f(p.z[(size_t)t * ZLD + RW_LW + col]); const float prev = (t > 0) ? bf2f(p.z[(size_t)(t - 1) * ZLD + RW_LW + col]) : 0.f;
                const float zs = cur + (prev - cur) * p.rw_mu[L * 1696 + 1536 + col];
                lr[tok][col] = (col < 32) ? (1.0f - 2.0f / (1.0f + __expf(2.0f * zs))) : (col < 64 ? zs : fsig(zs));
            }
            if (c < 128) glg[c >> 4][c & 15] = bf2f(p.z[(size_t)(tt0 + (c >> 4)) * ZLD + GL_LG + (c & 15)]);
            __syncthreads();
            float accW[8], accA[8], accG[8], accL[8];
#pragma unroll
            for (int k = 0; k < 8; ++k) { accW[k] = w0; accA[k] = a0; accG[k] = 0.f; accL[k] = gbc; }
#pragma unroll 1
            for (int j0 = 0; j0 < 32; j0 += 16) { float wv[16], av[16];
#pragma unroll
                for (int u = 0; u < 16; ++u) { wv[u] = w2[(j0 + u) * 512 + c]; av[u] = a2[(j0 + u) * 512 + c]; }
#pragma unroll
                for (int u = 0; u < 16; ++u)
#pragma unroll
                    for (int k = 0; k < 8; ++k) { accW[k] += lr[k][j0 + u] * wv[u]; accA[k] += lr[k][32 + j0 + u] * av[u]; } }
#pragma unroll 1
            for (int j0 = 0; j0 < 96; j0 += 16) { float gv[16];
#pragma unroll
                for (int u = 0; u < 16; ++u) gv[u] = g2[(j0 + u) * 512 + c];
#pragma unroll
                for (int u = 0; u < 16; ++u)
#pragma unroll
                    for (int k = 0; k < 8; ++k) accG[k] += lr[k][64 + j0 + u] * gv[u]; }
            if (c < 256) { float gv[16];
#pragma unroll
                for (int u = 0; u < 16; ++u) gv[u] = gg2[u * 256 + c];
#pragma unroll
                for (int u = 0; u < 16; ++u)
#pragma unroll
                    for (int k = 0; k < 8; ++k) accL[k] += glg[k][u] * gv[u]; }
#pragma unroll
            for (int k = 0; k < 8; ++k) {
                const int t = tt0 + k;
                const bf16_t* zc = p.z + (size_t)t * ZLD; const bf16_t* zp = p.z + (size_t)(t > 0 ? t - 1 : 0) * ZLD;
                const float cr = bf2f(zc[RW_R + c]), ck = bf2f(zc[RW_K + c]), cv = bf2f(zc[RW_V + c]);
                const float pr = (t > 0) ? bf2f(zp[RW_R + c]) : 0.f, pk = (t > 0) ? bf2f(zp[RW_K + c]) : 0.f, pv = (t > 0) ? bf2f(zp[RW_V + c]) : 0.f;
                const float r = cr + (pr - cr) * mu_r, kx = ck + (pk - ck) * mu_k, v = cv + (pv - cv) * mu_v;
                const float w_raw = -fsoftplus(-accW[k]) - 0.5f;
                const float decay = __expf(-__expf(w_raw));
                const float iclr = fsig(accA[k]);
                const float kk = kx * kkc;
                const float nrm = sqrtf(wave_sum(kk * kk));
                const float kkn = kk / fmaxf(nrm, 1e-12f);
                const float kmod = kx * (1.0f + (iclr - 1.0f) * kac);
                const float bon = wave_sum(r * kmod * rkc) * v;
                { const int h = c >> 6, j = c & 63; float* rs = p.RS + ((size_t)h * T + t) * 384 + j;
                  rs[0] = -kkn; rs[64] = kkn * iclr; rs[128] = decay; rs[192] = kmod; rs[256] = r; rs[320] = v; }
                p.rGate[(size_t)t * 512 + c] = accG[k]; p.rBonus[(size_t)t * 512 + c] = bon;
                { const float q = bf2f(zc[HG_Q + c]), f = bf2f(zc[HG_F + c]);
                  const float omf = (1.0f - lb) * fsig(-f);
                  bH = fmaxf(bH + __logf(fmaxf(1.0f - omf, 1e-37f)), -85.0f);
                  p.cH[(size_t)t * 512 + c] = f2bf(q * fsig(q) * __expf(bH)); p.KH[(size_t)t * 512 + c] = f2bf(omf * __expf(-bH)); }
                if (c < 256) {
                  bG = fmaxf(bG - fsoftplus(-accL[k]) * (1.0f / 16.0f), -85.0f);
                  p.cG[(size_t)t * 256 + c] = f2bf(bf2f(zc[GL_Q + c]) * 0.125f * __expf(bG)); p.KG[(size_t)t * 256 + c] = f2bf(bf2f(zc[GL_K + c]) * __expf(-bG)); }
            }
        }
        { const int h = c >> 7, j = c & 127; p.GamH[((size_t)tile * 4 + h) * 128 + j] = __expf(bH); }
        if (c < 256) { const int h = c >> 6, j = c & 63; p.GamG[((size_t)tile * 4 + h) * 64 + j] = __expf(bG); }
#pragma unroll 1
        for (int pass = 0; pass < 3; ++pass) {
            const int col0 = pass == 0 ? HG_I : (pass == 1 ? GL_V : SB_V); bf16_t* dstT = p.VtH + (size_t)pass * 512 * T;
            __syncthreads();
            for (int i = 0; i < 64; ++i) vtile[c][i] = p.z[(size_t)(t0 + i) * ZLD + col0 + c];
            __syncthreads();
#pragma unroll
            for (int it = 0; it < 8; ++it) { const int row = it * 64 + (c >> 3), sg = c & 7;
                *(pg8::u32x4*)(dstT + (size_t)row * T + t0 + sg * 8) = *(const LAS pg8::u32x4*)&vtile[row][sg * 8]; }
        }
    }
}

template <int KIND>
__device__ __forceinline__ void chain_unit(const MixArgs& p, const ConvArgs& cva, const int unit, const int seg, const int h, LAS float* lds) {
    constexpr int SF = KIND == 2 ? 512 : (KIND == 3 ? 320 : 384);
    constexpr int EPL = KIND == 2 ? 16 : 8, E2 = EPL / 2, DK = EPL * 8;
    constexpr int CH = 16, NP = CH * SF * 4 / 1024;
    static_assert(KIND == 0, "only the RWKV-7 chain is left (HGRN2 / GLA: intra_unit + chunk scan)");
    const float* stream = p.RS + ((size_t)h * T + (size_t)seg * LSEG) * SF;
    const int tid = phase_tid(), wv = __builtin_amdgcn_readfirstlane(tid >> 6), lane = tid & 63, rg = lane >> 3, lj = lane & 7;
    const bool isP = (KIND == 0) && (wv >= 4);
    const bool active = !(isP && seg == 0);
    const bool wantc = (KIND != 0) && (seg >= 1);
    const int rowA = ((KIND == 0) ? (wv & 3) : wv) * 16 + rg, rowB = rowA + 8;
    const int orow = (isP ? 64 : 0) + rowA;
    LAS float* ob = lds + 2 * CH * SF;
    LAS float* cb = ob;
    constexpr int NT = 8;
    const int jb0 = unit * (LSEG / 16) * NT;
    LAS bf16_t (*cvt)[64][66] = (LAS bf16_t (*)[64][66])(ob + 2 * 16 * 128);
    const int L = p.layer;
    f32x2v SA[E2], SB[E2];
#pragma unroll
    for (int e = 0; e < E2; ++e) { SA[e] = (f32x2v){0.f, 0.f}; SB[e] = (f32x2v){0.f, 0.f};
        if (isP) { if (lj * 8 + 2 * e == rowA) SA[e].x = 1.f; if (lj * 8 + 2 * e + 1 == rowA) SA[e].y = 1.f; if (lj * 8 + 2 * e == rowB) SB[e].x = 1.f; if (lj * 8 + 2 * e + 1 == rowB) SB[e].y = 1.f; } }
    f32x2v gam = (f32x2v){1.f, 1.f};
    auto stage = [&](int ci, LAS float* dst) {
        const char* g = (const char*)(stream + (size_t)ci * CH * SF) + lane * 16;
        for (int pc = wv; pc < NP; pc += 8) __builtin_amdgcn_global_load_lds((const unsigned*)(g + pc * 1024), (LAS unsigned*)((LAS char*)dst + pc * 1024), 16, 0, 0);
    };
    auto writeout = [&](int ci, const LAS float* o, const LAS float* cc) {
#pragma unroll
        for (int q = 0; q < 4; ++q) { const int idx = tid + 512 * q, s = idx >> 7, r = idx & 127; const size_t t = (size_t)seg * LSEG + ci * CH + s; const float v = o[idx];
            if (KIND == 0) { if (r < 64) p.oR[t * 512 + h * 64 + r] = v; else if (seg >= 1) p.cR[t * 512 + h * 64 + (r - 64)] = f2bf(v); }
            else if (KIND == 2) p.oH[t * 512 + h * 128 + r] = v;
            else p.oG[t * 512 + h * 128 + r] = v; }
        if (wantc) {
#pragma unroll
            for (int q = 0; q < (DK * 16) / 512; ++q) { const int idx = tid + 512 * q, s = idx / DK, k = idx % DK; const size_t t = (size_t)seg * LSEG + ci * CH + s;
                if (KIND == 2) p.cH[t * 512 + h * 128 + k] = f2bf(cc[s * 128 + k]); else p.cG[t * 256 + h * 64 + k] = f2bf(cc[s * 128 + k]); }
        }
    };
    constexpr int NCH = LSEG / CH;
    struct OpsR { f32x4v a0, a1, b0, b1, w0, w1, r0, r1, k0, k1; float vA, vB; };
    struct OpsG { f32x4v q[EPL / 4], w[EPL / 4], k[EPL / 4]; float vA, vB; f32x2v gw, gq; };
    const float vscale = isP ? 0.f : 1.f;
    const int goff = (EPL == 8) ? (lj * 8 + wv) : (lj * 16 + 2 * wv);
    stage(0, lds);
    for (int ci = 0; ci < NCH; ++ci) {
        asm volatile("s_waitcnt vmcnt(0)" ::: "memory"); __syncthreads();
        const LAS float* cur = lds + (ci & 1) * CH * SF;
        if (ci + 1 < NCH) stage(ci + 1, lds + ((ci + 1) & 1) * CH * SF);
        if (ci > 0) writeout(ci - 1, ob + ((ci - 1) & 1) * 2048, cb + ((ci - 1) & 1) * 2048);
        LAS float* oc = ob + (ci & 1) * 2048; LAS float* ccur = cb + (ci & 1) * 2048;
        if (ci > 0) {
#pragma unroll
            for (int k4 = 0; k4 < NT; ++k4) { CvJob jb; if (cvx_job(cva, jb0 + (ci - 1) * NT + k4, L, jb)) { const int n = tid >> 3, kc = (tid & 7) * 8;
                const LAS unsigned* tp = (const LAS unsigned*)&cvt[k4][n][kc]; pg8::u32x4 w; w.x = tp[0]; w.y = tp[1]; w.z = tp[2]; w.w = tp[3];
                *(pg8::u32x4*)(jb.dst + (size_t)n * jb.ldd + kc) = w; } }
        }
        float4 cvr[NT][2]; bool cvok[NT];
#pragma unroll
        for (int k4 = 0; k4 < NT; ++k4) { CvJob jb; cvok[k4] = cvx_job(cva, jb0 + ci * NT + k4, L, jb);
            cvr[k4][0] = make_float4(0.f, 0.f, 0.f, 0.f); cvr[k4][1] = cvr[k4][0];
            if (cvok[k4]) { const int c4 = (tid & 15) * 4, kr = tid >> 4;
                if (c4 < jb.valid) { cvr[k4][0] = *(const float4*)(jb.src + (size_t)(2 * kr) * jb.ld + c4); cvr[k4][1] = *(const float4*)(jb.src + (size_t)(2 * kr + 1) * jb.ld + c4); } } }
        if (active) {
            if constexpr (KIND == 0) {
                auto ld = [&](int s) { const LAS float* sp = cur + s * SF + lj * 8; OpsR o;
                    o.a0 = *(const LAS f32x4v*)(sp); o.a1 = *(const LAS f32x4v*)(sp + 4); o.b0 = *(const LAS f32x4v*)(sp + 64); o.b1 = *(const LAS f32x4v*)(sp + 68);
                    o.w0 = *(const LAS f32x4v*)(sp + 128); o.w1 = *(const LAS f32x4v*)(sp + 132); o.k0 = *(const LAS f32x4v*)(sp + 192); o.k1 = *(const LAS f32x4v*)(sp + 196);
                    o.r0 = *(const LAS f32x4v*)(sp + 256); o.r1 = *(const LAS f32x4v*)(sp + 260);
                    o.vA = cur[s * SF + 320 + rowA]; o.vB = cur[s * SF + 320 + rowB]; return o; };
                OpsR nx = ld(0);
#pragma unroll
                for (int s = 0; s < CH; ++s) {
                    const OpsR o = nx;
                    if (s + 1 < CH) nx = ld(s + 1);
                    f32x2v pa = SA[0] * o.a0.xy, pb = SB[0] * o.a0.xy; pa = SA[1] * o.a0.zw + pa; pb = SB[1] * o.a0.zw + pb;
                    f32x2v qa = SA[2] * o.a1.xy, qb = SB[2] * o.a1.xy; qa = SA[3] * o.a1.zw + qa; qb = SB[3] * o.a1.zw + qb; pa += qa; pb += qb;
                    float sA = pa.x + pa.y, sB = pb.x + pb.y;
                    sA += dppmov<0xB1>(sA); sB += dppmov<0xB1>(sB); sA += dppmov<0x4E>(sA); sB += dppmov<0x4E>(sB); sA += dppmov<0x141>(sA); sB += dppmov<0x141>(sB);
                    const f32x2v savA = (f32x2v){sA, sA}, savB = (f32x2v){sB, sB};
                    const float vA = o.vA * vscale, vB = o.vB * vscale; const f32x2v vvA = (f32x2v){vA, vA}, vvB = (f32x2v){vB, vB};
                    SA[0] = SA[0] * o.w0.xy + (savA * o.b0.xy + vvA * o.k0.xy); SB[0] = SB[0] * o.w0.xy + (savB * o.b0.xy + vvB * o.k0.xy);
                    SA[1] = SA[1] * o.w0.zw + (savA * o.b0.zw + vvA * o.k0.zw); SB[1] = SB[1] * o.w0.zw + (savB * o.b0.zw + vvB * o.k0.zw);
                    SA[2] = SA[2] * o.w1.xy + (savA * o.b1.xy + vvA * o.k1.xy); SB[2] = SB[2] * o.w1.xy + (savB * o.b1.xy + vvB * o.k1.xy);
                    SA[3] = SA[3] * o.w1.zw + (savA * o.b1.zw + vvA * o.k1.zw); SB[3] = SB[3] * o.w1.zw + (savB * o.b1.zw + vvB * o.k1.zw);
                    f32x2v oa = SA[0] * o.r0.xy, obb = SB[0] * o.r0.xy; oa = SA[1] * o.r0.zw + oa; obb = SB[1] * o.r0.zw + obb;
                    f32x2v oa2 = SA[2] * o.r1.xy, ob2 = SB[2] * o.r1.xy; oa2 = SA[3] * o.r1.zw + oa2; ob2 = SB[3] * o.r1.zw + ob2; oa += oa2; obb += ob2;
                    float oA = oa.x + oa.y, oB = obb.x + obb.y;
                    oA += dppmov<0xB1>(oA); oB += dppmov<0xB1>(oB); oA += dppmov<0x4E>(oA); oB += dppmov<0x4E>(oB); oA += dppmov<0x141>(oA); oB += dppmov<0x141>(oB);
                    if (lj == 0) { oc[s * 128 + orow] = oA; oc[s * 128 + orow + 8] = oB; }
                }
            } else {
                auto ld = [&](int s) { const LAS float* sp = cur + s * SF + lj * EPL; OpsG o;
#pragma unroll
                    for (int e4 = 0; e4 < EPL / 4; ++e4) { o.q[e4] = *(const LAS f32x4v*)(sp + e4 * 4); o.w[e4] = *(const LAS f32x4v*)(sp + DK + e4 * 4); o.k[e4] = *(const LAS f32x4v*)(sp + 2 * DK + e4 * 4); }
                    o.vA = cur[s * SF + 3 * DK + rowA]; o.vB = cur[s * SF + 3 * DK + rowB];
                    if constexpr (EPL == 8) { o.gw = (f32x2v){cur[s * SF + DK + goff], 1.f}; o.gq = (f32x2v){cur[s * SF + goff], 0.f}; }
                    else { o.gw = *(const LAS f32x2v*)(cur + s * SF + DK + goff); o.gq = *(const LAS f32x2v*)(cur + s * SF + goff); }
                    return o; };
                OpsG nx = ld(0);
#pragma unroll
                for (int s = 0; s < CH; ++s) {
                    const OpsG o = nx;
                    if (s + 1 < CH) nx = ld(s + 1);
                    const f32x2v vvA = (f32x2v){o.vA, o.vA}, vvB = (f32x2v){o.vB, o.vB};
                    f32x2v oa = (f32x2v){0.f, 0.f}, oa2 = oa, obb = oa, ob2 = oa;
#pragma unroll
                    for (int e4 = 0; e4 < EPL / 4; ++e4) {
                        SA[2 * e4] = SA[2 * e4] * o.w[e4].xy + vvA * o.k[e4].xy; SA[2 * e4 + 1] = SA[2 * e4 + 1] * o.w[e4].zw + vvA * o.k[e4].zw;
                        SB[2 * e4] = SB[2 * e4] * o.w[e4].xy + vvB * o.k[e4].xy; SB[2 * e4 + 1] = SB[2 * e4 + 1] * o.w[e4].zw + vvB * o.k[e4].zw;
                        oa = SA[2 * e4] * o.q[e4].xy + oa; oa2 = SA[2 * e4 + 1] * o.q[e4].zw + oa2; obb = SB[2 * e4] * o.q[e4].xy + obb; ob2 = SB[2 * e4 + 1] * o.q[e4].zw + ob2;
                    }
                    oa += oa2; obb += ob2;
                    float oA = oa.x + oa.y, oB = obb.x + obb.y;
                    oA += dppmov<0xB1>(oA); oB += dppmov<0xB1>(oB); oA += dppmov<0x4E>(oA); oB += dppmov<0x4E>(oB); oA += dppmov<0x141>(oA); oB += dppmov<0x141>(oB);
                    if (lj == 0) { oc[s * 128 + rowA] = oA; oc[s * 128 + rowB] = oB; }
                    gam *= o.gw; const f32x2v cq = o.gq * gam;
                    if (wantc && rg == 0) { if constexpr (EPL == 8) ccur[s * 128 + goff] = cq.x; else *(LAS f32x2v*)(ccur + s * 128 + goff) = cq; }
                }
            }
        }
        __syncthreads();
#pragma unroll
        for (int k4 = 0; k4 < NT; ++k4) if (cvok[k4]) { const int c4 = (tid & 15) * 4, kr = tid >> 4; const float4 v0 = cvr[k4][0], v1 = cvr[k4][1];
            *(LAS unsigned*)&cvt[k4][c4][2 * kr] = pg8::cvt_pk_bf16(v0.x, v1.x); *(LAS unsigned*)&cvt[k4][c4 + 1][2 * kr] = pg8::cvt_pk_bf16(v0.y, v1.y);
            *(LAS unsigned*)&cvt[k4][c4 + 2][2 * kr] = pg8::cvt_pk_bf16(v0.z, v1.z); *(LAS unsigned*)&cvt[k4][c4 + 3][2 * kr] = pg8::cvt_pk_bf16(v0.w, v1.w); }
    }
    __syncthreads();
#pragma unroll
    for (int k4 = 0; k4 < NT; ++k4) { CvJob jb; if (cvx_job(cva, jb0 + (NCH - 1) * NT + k4, L, jb)) { const int n = tid >> 3, kc = (tid & 7) * 8;
        const LAS unsigned* tp = (const LAS unsigned*)&cvt[k4][n][kc]; pg8::u32x4 w; w.x = tp[0]; w.y = tp[1]; w.z = tp[2]; w.w = tp[3];
        *(pg8::u32x4*)(jb.dst + (size_t)n * jb.ldd + kc) = w; } }
    writeout(NCH - 1, ob + ((NCH - 1) & 1) * 2048, cb + ((NCH - 1) & 1) * 2048);
    if (active) {
        float* dA;
        if (KIND == 0) dA = (isP ? p.PendR : p.SendR) + (((size_t)seg * 8 + h) * 64 + rowA) * 64 + lj * 8;
        else if (KIND == 2) dA = p.SendH + (((size_t)seg * 4 + h) * 128 + rowA) * 128 + lj * 16;
        else dA = p.SendG + (((size_t)seg * 4 + h) * 128 + rowA) * 64 + lj * 8;
        float* dB = dA + 8 * DK;
#pragma unroll
        for (int e = 0; e < E2; ++e) { dA[2 * e] = SA[e].x; dA[2 * e + 1] = SA[e].y; dB[2 * e] = SB[e].x; dB[2 * e + 1] = SB[e].y; }
    }
    if (wantc && rg == 0) {
        if constexpr (EPL == 8) p.GamG[(size_t)seg * 256 + h * 64 + lj * 8 + wv] = gam.x;
        else { p.GamH[(size_t)seg * 512 + h * 128 + lj * 16 + 2 * wv] = gam.x; p.GamH[(size_t)seg * 512 + h * 128 + lj * 16 + 2 * wv + 1] = gam.y; }
    }
    __syncthreads();
}
__device__ __forceinline__ void sb_phase(const MixArgs& p, const int wave0, const int W, const int uend);
template <int DK>
__device__ __forceinline__ void intra_unit(const MixArgs& p, const int h, const int chunk, LAS bf16_t* ktT, const int lane) {
    typedef short bf16x8v __attribute__((ext_vector_type(8)));
    typedef float f32x16v __attribute__((ext_vector_type(16)));
    typedef __bf16 bf16x2n __attribute__((ext_vector_type(2)));
    constexpr int QP = DK * 4, NKS = DK / 16, NKB = DK / 32;
    const bf16_t* Qb = (DK == 128 ? p.cH : p.cG) + h * DK; const bf16_t* Kb = (DK == 128 ? p.KH : p.KG) + h * DK;
    const bf16_t* Vt = (DK == 128 ? p.VtH : p.VtG) + (size_t)h * 128 * T;
    float* ol = (DK == 128 ? p.oH : p.oG) + h * 128; float* Send = (DK == 128 ? p.SendH : p.SendG) + ((size_t)chunk * 4 + h) * 128 * DK;
    const int r = lane & 31, hh = lane >> 5, t0 = chunk * 64;
#pragma unroll 1
    for (int tb = 0; tb < 2; ++tb) {
        bf16x8v Qf[NKS];
#pragma unroll
        for (int ks = 0; ks < NKS; ++ks) Qf[ks] = *(const bf16x8v*)(Qb + (unsigned)((t0 + 32 * tb + r) * QP + 16 * ks + 8 * hh));
#pragma unroll 1
        for (int vh = 0; vh < 2; ++vh) {
            f32x16v O[2];
#pragma unroll
            for (int vb = 0; vb < 2; ++vb)
#pragma unroll
                for (int i = 0; i < 16; ++i) O[vb][i] = 0.f;
            for (int sb = 0; sb <= tb; ++sb) {
                f32x16v P;
#pragma unroll
                for (int i = 0; i < 16; ++i) P[i] = 0.f;
#pragma unroll
                for (int ks = 0; ks < NKS; ++ks) { const bf16x8v Kf = *(const bf16x8v*)(Kb + (unsigned)((t0 + 32 * sb + r) * QP + 16 * ks + 8 * hh));
                    P = __builtin_amdgcn_mfma_f32_32x32x16_bf16(Kf, Qf[ks], P, 0, 0, 0); }
                const bool diag = (sb == tb);
                bf16x8v Pf[2];
#pragma unroll
                for (int s2 = 0; s2 < 2; ++s2) {
                    union { bf16x2n h2[4]; bf16x8v v; } pk;
#pragma unroll
                    for (int j = 0; j < 4; ++j) { f32x2v f;
                        { const int i = 8 * s2 + 2 * j, kr = (i & 3) + 8 * (i >> 2) + 4 * hh; f.x = (!diag || kr <= r) ? P[i] : 0.f; }
                        { const int i = 8 * s2 + 2 * j + 1, kr = (i & 3) + 8 * (i >> 2) + 4 * hh; f.y = (!diag || kr <= r) ? P[i] : 0.f; }
                        pk.h2[j] = __builtin_convertvector(f, bf16x2n); }
                    Pf[s2] = pk.v; }
#pragma unroll
                for (int vb = 0; vb < 2; ++vb)
#pragma unroll
                    for (int s2 = 0; s2 < 2; ++s2) { const bf16_t* vp = Vt + (unsigned)((32 * (2 * vh + vb) + r) * T + t0 + 32 * sb + 16 * s2 + 4 * hh);
                        union { pg8::u32x2 d[2]; bf16x8v v; } vf; vf.d[0] = *(const pg8::u32x2*)vp; vf.d[1] = *(const pg8::u32x2*)(vp + 8);
                        O[vb] = __builtin_amdgcn_mfma_f32_32x32x16_bf16(vf.v, Pf[s2], O[vb], 0, 0, 0); }
            }
#pragma unroll
            for (int vb = 0; vb < 2; ++vb)
#pragma unroll
                for (int g = 0; g < 4; ++g) { f32x4v w; w.x = O[vb][4 * g]; w.y = O[vb][4 * g + 1]; w.z = O[vb][4 * g + 2]; w.w = O[vb][4 * g + 3];
                    *(f32x4v*)(ol + (unsigned)((t0 + 32 * tb + r) * 512 + 32 * (2 * vh + vb) + 8 * g + 4 * hh)) = w; }
        }
    }
#pragma unroll 4
    for (int it = 0; it < DK / 8; ++it) { const int pidx = it * 64 + lane, srow = pidx / (DK / 8), cb8 = pidx % (DK / 8);
        const pg8::u32x4 w = *(const pg8::u32x4*)(Kb + (unsigned)((t0 + srow) * QP + cb8 * 8));
        const unsigned ww[4] = {w.x, w.y, w.z, w.w};
#pragma unroll
        for (int j = 0; j < 4; ++j) { ktT[(cb8 * 8 + 2 * j) * 66 + srow] = (bf16_t)(ww[j] & 0xffffu); ktT[(cb8 * 8 + 2 * j + 1) * 66 + srow] = (bf16_t)(ww[j] >> 16); } }
#pragma unroll 1
    for (int vb = 0; vb < 4; ++vb) {
        bf16x8v Af[4];
#pragma unroll
        for (int ks = 0; ks < 4; ++ks) Af[ks] = *(const bf16x8v*)(Vt + (unsigned)((32 * vb + r) * T + t0 + 16 * ks + 8 * hh));
#pragma unroll 1
        for (int kb = 0; kb < NKB; ++kb) {
            f32x16v U;
#pragma unroll
            for (int i = 0; i < 16; ++i) U[i] = 0.f;
#pragma unroll
            for (int ks = 0; ks < 4; ++ks) { const LAS unsigned* tp = (const LAS unsigned*)(ktT + (32 * kb + r) * 66 + 16 * ks + 8 * hh);
                union { unsigned d[4]; bf16x8v v; } bf; bf.d[0] = tp[0]; bf.d[1] = tp[1]; bf.d[2] = tp[2]; bf.d[3] = tp[3];
                U = __builtin_amdgcn_mfma_f32_32x32x16_bf16(Af[ks], bf.v, U, 0, 0, 0); }
            float* sp = Send + (unsigned)((32 * vb + 4 * hh) * DK + 32 * kb + r);
#pragma unroll
            for (int i = 0; i < 16; ++i) sp[((i & 3) + 8 * (i >> 2)) * DK] = U[i];
        }
    }
}
__device__ __forceinline__ void chains_phase(const MixArgs& p, const ConvArgs& cva, unsigned* sbq, LAS unsigned char* ldsraw) {
    LAS float* lds = (LAS float*)ldsraw;
    for (int u = blockIdx.x; u < 8 * NSEG; u += gridDim.x) chain_unit<0>(p, cva, u, u >> 3, u & 7, lds);
    LAS int* slot = (LAS int*)(ldsraw + 8 * 128 * 66 * 2);
    const int ptid = phase_tid(), wv = ptid >> 6, lane = ptid & 63;
    LAS bf16_t* ktT = (LAS bf16_t*)ldsraw + (size_t)wv * 128 * 66;
    for (;;) {
        __syncthreads();
        if (ptid == 0) slot[0] = (int)__hip_atomic_fetch_add(sbq, 8u, __ATOMIC_RELAXED, __HIP_MEMORY_SCOPE_AGENT);
        __syncthreads();
        const int base = slot[0];
        if (base >= 2048) break;
        const int u = base + wv; if (u < 1024) intra_unit<128>(p, u & 3, u >> 2, ktT, lane); else intra_unit<64>(p, (u - 1024) & 3, (u - 1024) >> 2, ktT, lane);
    }
}
__device__ __forceinline__ void sb_queue(const MixArgs& p, unsigned* sbq2, LAS unsigned char* ldsraw) {
    LAS int* slot = (LAS int*)(ldsraw + 8 * 128 * 66 * 2);
    const int ptid = phase_tid();
    for (;;) {
        __syncthreads();
        if (ptid == 0) slot[0] = (int)__hip_atomic_fetch_add(sbq2, 8u, __ATOMIC_RELAXED, __HIP_MEMORY_SCOPE_AGENT);
        __syncthreads();
        const int base = slot[0];
        if (base >= 2048) break;
        sb_phase(p, base, 1 << 30, 2048);
    }
}

__device__ __forceinline__ void carry_phase(const MixArgs& p, LAS unsigned char* ldsraw, const int part) {
    const int tid = phase_tid();
    if (part != 2) for (int u = blockIdx.x; u < 16; u += gridDim.x) {
        if (u < 8) {
            const int h = u;
            LAS float (*cur)[68] = (LAS float (*)[68])ldsraw; LAS float (*Pm)[68] = (LAS float (*)[68])(ldsraw + 64 * 68 * 4);
            const int v = tid >> 3, kb = (tid & 7) * 8;
            const size_t eo = (size_t)v * 64 + kb;
            float nv[8], nP[8], nS[8];
            { const f32x4v a0 = *(const f32x4v*)(p.SendR + ((size_t)0 * 8 + h) * 4096 + eo), a1 = *(const f32x4v*)(p.SendR + ((size_t)0 * 8 + h) * 4096 + eo + 4);
              nv[0] = a0.x; nv[1] = a0.y; nv[2] = a0.z; nv[3] = a0.w; nv[4] = a1.x; nv[5] = a1.y; nv[6] = a1.z; nv[7] = a1.w; }
            { const f32x4v a0 = *(const f32x4v*)(p.PendR + ((size_t)1 * 8 + h) * 4096 + eo), a1 = *(const f32x4v*)(p.PendR + ((size_t)1 * 8 + h) * 4096 + eo + 4);
              nP[0] = a0.x; nP[1] = a0.y; nP[2] = a0.z; nP[3] = a0.w; nP[4] = a1.x; nP[5] = a1.y; nP[6] = a1.z; nP[7] = a1.w;
              const f32x4v b0 = *(const f32x4v*)(p.SendR + ((size_t)1 * 8 + h) * 4096 + eo), b1 = *(const f32x4v*)(p.SendR + ((size_t)1 * 8 + h) * 4096 + eo + 4);
              nS[0] = b0.x; nS[1] = b0.y; nS[2] = b0.z; nS[3] = b0.w; nS[4] = b1.x; nS[5] = b1.y; nS[6] = b1.z; nS[7] = b1.w; }
            for (int s = 1; s < NSEG; ++s) {
                __syncthreads();
                { pg8::u32x4 w; w.x = pg8::cvt_pk_bf16(nv[0], nv[1]); w.y = pg8::cvt_pk_bf16(nv[2], nv[3]); w.z = pg8::cvt_pk_bf16(nv[4], nv[5]); w.w = pg8::cvt_pk_bf16(nv[6], nv[7]);
                  *(pg8::u32x4*)(p.SstR + ((size_t)s * 8 + h) * 4096 + eo) = w; }
                if (s == NSEG - 1) break;
#pragma unroll
                for (int e = 0; e < 8; ++e) { cur[v][kb + e] = nv[e]; Pm[v][kb + e] = nP[e]; nv[e] = nS[e]; }
                __syncthreads();
                if (s + 1 < NSEG - 1) {
                    const f32x4v a0 = *(const f32x4v*)(p.PendR + ((size_t)(s + 1) * 8 + h) * 4096 + eo), a1 = *(const f32x4v*)(p.PendR + ((size_t)(s + 1) * 8 + h) * 4096 + eo + 4);
                    nP[0] = a0.x; nP[1] = a0.y; nP[2] = a0.z; nP[3] = a0.w; nP[4] = a1.x; nP[5] = a1.y; nP[6] = a1.z; nP[7] = a1.w;
                    const f32x4v b0 = *(const f32x4v*)(p.SendR + ((size_t)(s + 1) * 8 + h) * 4096 + eo), b1 = *(const f32x4v*)(p.SendR + ((size_t)(s + 1) * 8 + h) * 4096 + eo + 4);
                    nS[0] = b0.x; nS[1] = b0.y; nS[2] = b0.z; nS[3] = b0.w; nS[4] = b1.x; nS[5] = b1.y; nS[6] = b1.z; nS[7] = b1.w;
                }
#pragma unroll 4
                for (int i4 = 0; i4 < 64; i4 += 4) { const f32x4v c4 = *(const LAS f32x4v*)&cur[v][i4];
#pragma unroll
                    for (int ii = 0; ii < 4; ++ii) { const f32x4v p0 = *(const LAS f32x4v*)&Pm[i4 + ii][kb], p1 = *(const LAS f32x4v*)&Pm[i4 + ii][kb + 4]; const float c = c4[ii];
                        nv[0] += c * p0.x; nv[1] += c * p0.y; nv[2] += c * p0.z; nv[3] += c * p0.w; nv[4] += c * p1.x; nv[5] += c * p1.y; nv[6] += c * p1.z; nv[7] += c * p1.w; } }
            }
            __syncthreads();
        }
    }
    if (part != 1) for (int u = blockIdx.x; u < 8 + 192; u += gridDim.x) {
        if (u < 8) continue;
        const bool isH = u < 8 + 128; const int idx = (isH ? (u - 8) : (u - 136)) * 512 + tid;
        const float* Ub = (isH ? p.SendH : p.SendG) + idx; bf16_t* Sb = (isH ? p.SstH : p.SstG) + idx; const size_t cstr = isH ? 65536 : 32768;
        const float* Gb = isH ? p.GamH + (idx >> 14) * 128 + (idx & 127) : p.GamG + (idx >> 13) * 64 + (idx & 63); const int gstr = isH ? 512 : 256;
        float S = 0.f;
        float uu[16], gg[16], un[16], gn[16];
#pragma unroll
        for (int j = 0; j < 16; ++j) { un[j] = Ub[(size_t)j * cstr]; gn[j] = Gb[(size_t)j * gstr]; }
        for (int c0 = 0; c0 < NCHK; c0 += 16) {
#pragma unroll
            for (int j = 0; j < 16; ++j) { uu[j] = un[j]; gg[j] = gn[j]; }
            if (c0 + 16 < NCHK) {
#pragma unroll
                for (int j = 0; j < 16; ++j) { un[j] = Ub[(size_t)(c0 + 16 + j) * cstr]; gn[j] = Gb[(size_t)(c0 + 16 + j) * gstr]; } }
#pragma unroll
            for (int j = 0; j < 16; ++j) { Sb[(size_t)(c0 + j) * cstr] = f2bf(S); S = gg[j] * (S + uu[j]); }
        }
    }
}

__device__ __forceinline__ void mixfin_phase(const MixArgs& p) {
    typedef short bf16x8v __attribute__((ext_vector_type(8)));
    const int tid = phase_tid(), wv = tid >> 6, lane = tid & 63, r = lane & 15, q = lane >> 4, L = p.layer;
    const int W = gridDim.x * 8;
    for (int u = blockIdx.x * 8 + wv; u < 16384; u += W) {
        if (u < 8192) {
            const int tt = u >> 3, h = u & 7, t0 = tt * 16, seg = t0 / LSEG;
            f32x4v acc[4];
#pragma unroll
            for (int nb = 0; nb < 4; ++nb) acc[nb] = (f32x4v){0.f, 0.f, 0.f, 0.f};
            if (seg >= 1) {
#pragma unroll
                for (int ks = 0; ks < 2; ++ks) { const bf16x8v A = *(const bf16x8v*)(p.cR + (size_t)(t0 + r) * 512 + h * 64 + ks * 32 + q * 8);
#pragma unroll
                    for (int nb = 0; nb < 4; ++nb) { const bf16x8v B = *(const bf16x8v*)(p.SstR + (((size_t)seg * 8 + h) * 64 + nb * 16 + r) * 64 + ks * 32 + q * 8);
                        acc[nb] = __builtin_amdgcn_mfma_f32_16x16x32_bf16(A, B, acc[nb], 0, 0, 0); } }
            }
#pragma unroll
            for (int i = 0; i < 4; ++i) { const size_t t = (size_t)t0 + 4 * q + i; float o[4]; float s = 0.f;
#pragma unroll
                for (int nb = 0; nb < 4; ++nb) { o[nb] = acc[nb][i] + p.oR[t * 512 + h * 64 + nb * 16 + r]; s += o[nb]; }
                const float mu = red16(s) * (1.0f / 64.0f); float d2 = 0.f;
#pragma unroll
                for (int nb = 0; nb < 4; ++nb) { o[nb] -= mu; d2 += o[nb] * o[nb]; }
                const float rstd = rsqrtf(red16(d2) * (1.0f / 64.0f) + 64e-5f);
#pragma unroll
                for (int nb = 0; nb < 4; ++nb) { const int c = h * 64 + nb * 16 + r; const float y = o[nb] * rstd * p.rw_ln_w[L * 512 + c] + p.rw_ln_b[L * 512 + c];
                    p.bo[(size_t)T * 512 + t * 512 + c] = f2bf((y + p.rBonus[t * 512 + c]) * p.rGate[t * 512 + c]); } }
        } else {
            const bool isH = u < 12288; const int qq = isH ? u - 8192 : u - 12288;
            const int tt = qq >> 2, h = qq & 3, t0 = tt * 16, seg = t0 >> 6;
            f32x4v acc[8];
#pragma unroll
            for (int nb = 0; nb < 8; ++nb) acc[nb] = (f32x4v){0.f, 0.f, 0.f, 0.f};
            if (seg >= 1) {
                if (isH) {
#pragma unroll
                    for (int ks = 0; ks < 4; ++ks) { const bf16x8v A = *(const bf16x8v*)(p.cH + (size_t)(t0 + r) * 512 + h * 128 + ks * 32 + q * 8);
#pragma unroll
                        for (int nb = 0; nb < 8; ++nb) { const bf16x8v B = *(const bf16x8v*)(p.SstH + (((size_t)seg * 4 + h) * 128 + nb * 16 + r) * 128 + ks * 32 + q * 8);
                            acc[nb] = __builtin_amdgcn_mfma_f32_16x16x32_bf16(A, B, acc[nb], 0, 0, 0); } }
                } else {
#pragma unroll
                    for (int ks = 0; ks < 2; ++ks) { const bf16x8v A = *(const bf16x8v*)(p.cG + (size_t)(t0 + r) * 256 + h * 64 + ks * 32 + q * 8);
#pragma unroll
                        for (int nb = 0; nb < 8; ++nb) { const bf16x8v B = *(const bf16x8v*)(p.SstG + (((size_t)seg * 4 + h) * 128 + nb * 16 + r) * 64 + ks * 32 + q * 8);
                            acc[nb] = __builtin_amdgcn_mfma_f32_16x16x32_bf16(A, B, acc[nb], 0, 0, 0); } }
                }
            }
            const float* ol = isH ? p.oH : p.oG; const float* gain = (isH ? p.hg_norm_w : p.gla_norm_w) + L * 512; const int gcol = isH ? HG_G : GL_R;
            bf16_t* bo = p.bo + (isH ? (size_t)0 : (size_t)3 * T * 512);
#pragma unroll
            for (int i = 0; i < 4; ++i) { const size_t t = (size_t)t0 + 4 * q + i; float o[8]; float ss = 0.f;
#pragma unroll
                for (int nb = 0; nb < 8; ++nb) { o[nb] = acc[nb][i] + ol[t * 512 + h * 128 + nb * 16 + r]; ss += o[nb] * o[nb]; }
                const float rs = rsqrtf(red16(ss) * (1.0f / 128.0f) + 1e-5f);
#pragma unroll
                for (int nb = 0; nb < 8; ++nb) { const int c = h * 128 + nb * 16 + r; const float g = bf2f(p.z[t * ZLD + gcol + c]);
                    bo[t * 512 + c] = f2bf(o[nb] * rs * gain[c] * siluf_(g)); } }
        }
    }
}
__device__ __forceinline__ void sb_phase(const MixArgs& p, const int wave0, const int W, const int uend) {
    typedef short bf16x8v __attribute__((ext_vector_type(8)));
    typedef float f32x16v __attribute__((ext_vector_type(16)));
    typedef __bf16 bf16x2n __attribute__((ext_vector_type(2)));
    const int tid = phase_tid(), wv = tid >> 6, lane = tid & 63, r = lane & 31, hh = lane >> 5;
    const float scale = 0.08838834764831845f;
    for (int u = wave0 + wv; u < uend; u += W) {
        const int h = u & 3, qb = u >> 2, q0 = qb * 32;
        bf16x8v Qf[8];
#pragma unroll
        for (int s = 0; s < 8; ++s) Qf[s] = *(const bf16x8v*)(p.z + (size_t)(q0 + r) * ZLD + SB_Q + h * 128 + s * 16 + hh * 8);
        f32x16v O[4];
#pragma unroll
        for (int db = 0; db < 4; ++db)
#pragma unroll
            for (int i = 0; i < 16; ++i) O[db][i] = 0.f;
        float R = 0.f;
        for (int kb = qb; kb >= 0; --kb) {
            const int k0 = kb * 32;
            f32x16v Sacc;
#pragma unroll
            for (int i = 0; i < 16; ++i) Sacc[i] = 0.f;
#pragma unroll
            for (int s = 0; s < 8; ++s) { const bf16x8v Kf = *(const bf16x8v*)(p.z + (size_t)(k0 + r) * ZLD + SB_K + h * 128 + s * 16 + hh * 8);
                Sacc = __builtin_amdgcn_mfma_f32_32x32x16_bf16(Kf, Qf[s], Sacc, 0, 0, 0); }
            float lk[16], zz[16]; bool valid[16];
            const bool diag = (kb == qb);
#pragma unroll
            for (int i = 0; i < 16; ++i) { const int kr = (i & 3) + 8 * (i >> 2) + 4 * hh;
                valid[i] = !diag || (kr < r);
                zz[i] = Sacc[i] * scale;
                const float sp = fmaxf(zz[i], 0.f) + __logf(1.0f + __expf(-fabsf(zz[i])));
                lk[i] = valid[i] ? -sp : 0.f; }
            float G[4], Gp[4];
#pragma unroll
            for (int g = 0; g < 4; ++g) { G[g] = (lk[4 * g] + lk[4 * g + 1]) + (lk[4 * g + 2] + lk[4 * g + 3]); Gp[g] = __shfl_xor(G[g], 32); }
            float Tq[4]; float run = 0.f;
#pragma unroll
            for (int g = 3; g >= 0; --g) { Tq[g] = run + (hh == 0 ? Gp[g] : 0.f); run += G[g] + Gp[g]; }
            float wgt[16];
#pragma unroll
            for (int g = 0; g < 4; ++g) { float ing = 0.f;
#pragma unroll
                for (int j = 3; j >= 0; --j) { const int i = 4 * g + j;
                    const float logw = zz[i] + lk[i] + (R + Tq[g] + ing);
                    wgt[i] = valid[i] ? __expf(logw) : 0.f;
                    ing += lk[i]; } }
            R += run;
            bf16x8v Pf[2];
#pragma unroll
            for (int s2 = 0; s2 < 2; ++s2) {
                union { bf16x2n h2[4]; bf16x8v v; } pk;
#pragma unroll
                for (int j = 0; j < 4; ++j) { f32x2v f; f.x = wgt[8 * s2 + 2 * j]; f.y = wgt[8 * s2 + 2 * j + 1]; pk.h2[j] = __builtin_convertvector(f, bf16x2n); }
                Pf[s2] = pk.v; }
#pragma unroll
            for (int db = 0; db < 4; ++db)
#pragma unroll
                for (int s2 = 0; s2 < 2; ++s2) { const bf16_t* vp = p.Vt + (size_t)(h * 128 + db * 32 + r) * T + k0 + 16 * s2 + 4 * hh;
                    union { pg8::u32x2 d[2]; bf16x8v v; } vf; vf.d[0] = *(const pg8::u32x2*)vp; vf.d[1] = *(const pg8::u32x2*)(vp + 8);
                    O[db] = __builtin_amdgcn_mfma_f32_32x32x16_bf16(vf.v, Pf[s2], O[db], 0, 0, 0); }
            if (__all(R < -104.0f)) break;
        }
        bf16_t* bo2 = p.bo + (size_t)2 * T * 512 + (size_t)(q0 + r) * 512 + h * 128;
#pragma unroll
        for (int db = 0; db < 4; ++db)
#pragma unroll
            for (int g = 0; g < 4; ++g) { pg8::u32x2 w; w.x = (unsigned)f2bf(O[db][4 * g]) | ((unsigned)f2bf(O[db][4 * g + 1]) << 16); w.y = (unsigned)f2bf(O[db][4 * g + 2]) | ((unsigned)f2bf(O[db][4 * g + 3]) << 16);
                *(pg8::u32x2*)(bo2 + db * 32 + 8 * g + 4 * hh) = w; }
    }
}

#define XB_TMO      128
#define XB_XCNT(j)  (256  + 64 * (j))
#define XB_XSUB(j)  (1280 + 64 * (j))
#define XB_XGEN(j)  (2304 + 64 * (j))
#define XB_TOP      3328
#define XB_TOPGEN   3392
#define XCD_BAR_WORDS 3456
#define XB_SPIN_CAP (1u << 18)
__device__ __forceinline__ unsigned xb_ld(unsigned* p)              { return __hip_atomic_load(p, __ATOMIC_RELAXED, __HIP_MEMORY_SCOPE_AGENT); }
__device__ __forceinline__ unsigned xb_add(unsigned* p, unsigned v) { return __hip_atomic_fetch_add(p, v, __ATOMIC_RELAXED, __HIP_MEMORY_SCOPE_AGENT); }
__device__ __forceinline__ unsigned xb_xcc_id() { return (unsigned)__builtin_amdgcn_s_getreg((3 << 11) | 20) & 0xFu; }
#define XB_SPIN(cond, bar) do { unsigned _sp = 0; while (cond) { __builtin_amdgcn_s_sleep(1); \
    if ((++_sp & 255u) == 0u) { if (xb_ld(&(bar)[XB_TMO])) break; if (_sp > XB_SPIN_CAP) { atomicAdd(&(bar)[XB_TMO], 1u); break; } } } } while (0)
struct XcdBarrier { unsigned* bar; unsigned x; volatile LAS unsigned* st; };
__device__ __forceinline__ XcdBarrier xcd_barrier_post(unsigned* bar, volatile LAS unsigned* st) {
    XcdBarrier b; b.bar = bar; b.x = xb_xcc_id(); b.st = st;
    if (threadIdx.x == 0) (void)xb_add(&bar[XB_XCNT(b.x)], 1u);
    return b;
}
__device__ __forceinline__ void xcd_barrier_complete(unsigned* bar, unsigned x, unsigned& nloc, unsigned& nx) {
    const unsigned G = gridDim.x * gridDim.y * gridDim.z;
    unsigned sum, cnt, mine, sp = 0u;
    for (;;) {
        sum = 0u; cnt = 0u; mine = 0u;
#pragma unroll
        for (unsigned j = 0; j < 16; ++j) { const unsigned c = xb_ld(&bar[XB_XCNT(j)]); sum += c; cnt += (c > 0u) ? 1u : 0u; mine = (j == x) ? c : mine; }
        if (sum == G) break;
        __builtin_amdgcn_s_sleep(1);
        if ((++sp & 255u) == 0u) { if (xb_ld(&bar[XB_TMO])) break; if (sp > XB_SPIN_CAP) { atomicAdd(&bar[XB_TMO], 1u); break; } }
    }
    nloc = mine > 0u ? mine : 1u; nx = cnt > 0u ? cnt : 1u;
}
__device__ __forceinline__ void xcd_barrier(const XcdBarrier& b) {
    asm volatile("s_waitcnt vmcnt(0)" ::: "memory");
    __syncthreads();
    if (threadIdx.x == 0) {
        unsigned* bar = b.bar;
        __builtin_amdgcn_s_waitcnt(0);
        unsigned nloc = b.st[0], nx = b.st[1];
        if (nloc == 0u) { xcd_barrier_complete(bar, b.x, nloc, nx); b.st[0] = nloc; b.st[1] = nx; }
        const unsigned old = xb_add(&bar[XB_XSUB(b.x)], 1u);
        const unsigned gen = old / nloc;
        if (old + 1u == (gen + 1u) * nloc) {
            __builtin_amdgcn_fence(__ATOMIC_RELEASE, "agent");
            asm volatile("s_waitcnt vmcnt(0)" ::: "memory");
            const unsigned og = xb_add(&bar[XB_TOP], 1u);
            const unsigned tg = og / nx;
            if (og + 1u == (tg + 1u) * nx) xb_add(&bar[XB_TOPGEN], 1u);
            else XB_SPIN(xb_ld(&bar[XB_TOPGEN]) == tg, bar);
            __builtin_amdgcn_fence(__ATOMIC_ACQUIRE, "agent");
            xb_add(&bar[XB_XGEN(b.x)], 1u);
            asm volatile("s_waitcnt vmcnt(0)" ::: "memory");
        } else {
            XB_SPIN(xb_ld(&bar[XB_XGEN(b.x)]) == gen, bar);
            __builtin_amdgcn_fence(__ATOMIC_ACQUIRE, "agent");
            asm volatile("s_waitcnt vmcnt(0)" ::: "memory");
        }
    }
    __syncthreads();
}


constexpr size_t al256(size_t x) { return (x + 255) & ~(size_t)255; }
constexpr size_t TS_ = (size_t)T * 512 * 4;
constexpr size_t OFF_BAR = 0;
constexpr size_t OFF_Z = al256(OFF_BAR + 3456 * 4);
constexpr size_t OFF_RS = OFF_Z + al256((size_t)T * ZLD * 2);
constexpr size_t OFF_XB = al256(OFF_RS + (size_t)8 * T * 384 * 4);
constexpr size_t OFF_REGM = al256(OFF_XB + (size_t)T * D * 2);
constexpr size_t OFF_KH = OFF_REGM, OFF_KG = OFF_KH + (size_t)T * 512 * 2, OFF_VTH = OFF_KG + (size_t)T * 256 * 2, OFF_VTG = OFF_VTH + (size_t)512 * T * 2, OFF_VT = OFF_VTG + (size_t)512 * T * 2;
constexpr size_t OFF_RGATE = OFF_VT + (size_t)512 * T * 2, OFF_RBONUS = OFF_RGATE + TS_;
constexpr size_t OFF_SENDH = OFF_RBONUS + TS_, OFF_SENDG = OFF_SENDH + (size_t)NCHK * 4 * 128 * 128 * 4, OFF_SSTH = OFF_SENDG + (size_t)NCHK * 4 * 128 * 64 * 4, OFF_SSTG = OFF_SSTH + (size_t)NCHK * 4 * 128 * 128 * 2;
constexpr size_t OFF_GAMH = OFF_SSTG + (size_t)NCHK * 4 * 128 * 64 * 2, OFF_GAMG = OFF_GAMH + (size_t)NCHK * 4 * 128 * 4, OFF_REGM_END = OFF_GAMG + (size_t)NCHK * 4 * 64 * 4;
constexpr size_t OFF_HBUF = OFF_REGM, OFF_X1 = OFF_REGM + (size_t)MAXROWS * FW * 2;
constexpr size_t OFF_OR = al256(OFF_REGM + (size_t)MAXROWS * FW * 2 + (size_t)T * D * 4);
constexpr size_t OFF_OH = OFF_OR + TS_, OFF_OG = OFF_OH + TS_, OFF_CR = OFF_OG + TS_, OFF_CH = OFF_CR + TS_ / 2, OFF_CG = OFF_CH + TS_ / 2;
constexpr size_t OFF_SENDR = OFF_CG + TS_ / 4, OFF_PENDR = OFF_SENDR + (size_t)NSEG * 8 * 64 * 64 * 4, OFF_SSTR = OFF_PENDR + (size_t)NSEG * 8 * 64 * 64 * 4;
constexpr size_t OFF_BO = al256(OFF_SSTR + (size_t)NSEG * 8 * 64 * 64 * 2);
constexpr size_t OFF_MERGED = OFF_BO + 4 * (size_t)T * 512 * 2, OFF_MERGEDB = OFF_MERGED + (size_t)T * D * 4, OFF_X1B = OFF_MERGEDB + (size_t)T * D * 2;
constexpr size_t OFF_WINT = OFF_X1B + (size_t)T * D * 2, OFF_WGUT = OFF_WINT + (size_t)ZLD * D * 2, OFF_WDT = OFF_WGUT + (size_t)65 * 1024 * D * 2, OFF_WBRT = OFF_WDT + (size_t)65 * D * FW * 2, OFF_WOUTT = OFF_WBRT + (size_t)4 * D * FW * 2;
constexpr size_t OFF_IDX = OFF_WOUTT + (size_t)D * D * 2, OFF_WSEL = OFF_IDX + (size_t)T * 8 * 4, OFF_HIST = OFF_WSEL + (size_t)T * 8 * 4, OFF_ROWTOK = OFF_HIST + 256 * 64 * 4;
constexpr size_t OFF_ROWW = OFF_ROWTOK + (size_t)MAXROWS * 4, OFF_SLOTPOS = OFF_ROWW + (size_t)MAXROWS * 4, OFF_PANEXP = OFF_SLOTPOS + (size_t)T * 8 * 4, OFF_NPAN = al256(OFF_PANEXP + MAXPANELS * 4);
constexpr size_t OFF_WRH = OFF_NPAN + 256, OFF_WRL = OFF_WRH + (size_t)2 * NE * D * 2;
constexpr size_t WS_NEEDED = OFF_WRL + (size_t)2 * NE * D * 2;
static_assert(OFF_RS + (size_t)8 * T * 384 * 4 - OFF_Z >= (size_t)MAXROWS * D * 2, "ybuf must fit in region Y");
static_assert(OFF_REGM_END <= OFF_OR, "region M");
static_assert(OFF_VTG == OFF_VTH + (size_t)512 * T * 2 && OFF_VT == OFF_VTG + (size_t)512 * T * 2, "prep writes VtH, VtG, Vt as one array of three");
__device__ __forceinline__ void ln_row(const float (&v)[32], float s, const float* __restrict__ w, const float* __restrict__ b, float* __restrict__ outf, bf16_t* __restrict__ outb, int lane) {
    const float mu = wave_sum(s) * (1.0f / D);
    float q = 0.f;
#pragma unroll
    for (int i = 0; i < 32; ++i) { const float d = v[i] - mu; q += d * d; }
    const float rstd = rsqrtf(wave_sum(q) * (1.0f / D) + 1e-5f);
#pragma unroll
    for (int i = 0; i < 8; ++i) {
        const unsigned c = (unsigned)(i * 256 + lane * 4);
        const float4 ww = *(const float4*)(w + c), bb = *(const float4*)(b + c);
        float4 o; o.x = (v[4 * i] - mu) * rstd * ww.x + bb.x; o.y = (v[4 * i + 1] - mu) * rstd * ww.y + bb.y; o.z = (v[4 * i + 2] - mu) * rstd * ww.z + bb.z; o.w = (v[4 * i + 3] - mu) * rstd * ww.w + bb.w;
        *(float4*)(outf + c) = o;
        if (outb) { pg8::u32x2 pk; pk.x = pg8::cvt_pk_bf16(o.x, o.y); pk.y = pg8::cvt_pk_bf16(o.z, o.w); *(pg8::u32x2*)(outb + c) = pk; }
    }
}
struct KArgs {
    const float* in[32]; char* ws; float* out;
};
struct MegaArgs {
    MixArgs mix;
    const float *x_in, *w_in, *w_br, *w_out, *ln1_w, *ln1_b, *w_router, *router_bias, *we_gate, *we_up, *we_down, *ws_gate, *ws_up, *ws_down, *ln2_w, *ln2_b;
    bf16_t *xb, *WinT, *WguT, *WdT, *WbrT, *WoutT, *mergedb, *x1b, *hbuf, *ybuf, *WrH, *WrL;
    float *merged, *x1, *out;
    int* idx; float* wsel; int *hist, *row_tok; float* row_w; int *slotpos, *panel_expert, *npanels;
    unsigned* bar;
};
__host__ __device__ __forceinline__ MegaArgs make_args(const KArgs& k) {
    MegaArgs a; char* ws = k.ws;
    a.x_in = k.in[0]; a.w_in = k.in[1];
    a.mix.hg_lb_logits = k.in[2]; a.mix.hg_norm_w = k.in[3]; a.mix.rw_mu = k.in[4]; a.mix.rw_w0 = k.in[5]; a.mix.rw_w2 = k.in[6]; a.mix.rw_a0 = k.in[7]; a.mix.rw_a2 = k.in[8]; a.mix.rw_g2 = k.in[9];
    a.mix.rw_kk = k.in[10]; a.mix.rw_ka = k.in[11]; a.mix.rw_rk = k.in[12]; a.mix.rw_ln_w = k.in[13]; a.mix.rw_ln_b = k.in[14]; a.mix.gla_g2 = k.in[15]; a.mix.gla_gb = k.in[16]; a.mix.gla_norm_w = k.in[17];
    a.w_br = k.in[18]; a.w_out = k.in[19]; a.ln1_w = k.in[20]; a.ln1_b = k.in[21]; a.w_router = k.in[22]; a.router_bias = k.in[23]; a.we_gate = k.in[24]; a.we_up = k.in[25]; a.we_down = k.in[26];
    a.ws_gate = k.in[27]; a.ws_up = k.in[28]; a.ws_down = k.in[29]; a.ln2_w = k.in[30]; a.ln2_b = k.in[31];
    a.bar = (unsigned*)(ws + OFF_BAR);
    a.mix.z = (const bf16_t*)(ws + OFF_Z); a.mix.RS = (float*)(ws + OFF_RS); a.ybuf = (bf16_t*)(ws + OFF_Z); a.xb = (bf16_t*)(ws + OFF_XB);
    a.mix.KH = (bf16_t*)(ws + OFF_KH); a.mix.KG = (bf16_t*)(ws + OFF_KG); a.mix.VtH = (bf16_t*)(ws + OFF_VTH); a.mix.VtG = (bf16_t*)(ws + OFF_VTG); a.mix.Vt = (bf16_t*)(ws + OFF_VT); a.mix.rGate = (float*)(ws + OFF_RGATE); a.mix.rBonus = (float*)(ws + OFF_RBONUS);
    a.hbuf = (bf16_t*)(ws + OFF_HBUF); a.x1 = (float*)(ws + OFF_X1);
    a.mix.oR = (float*)(ws + OFF_OR); a.mix.oH = (float*)(ws + OFF_OH); a.mix.oG = (float*)(ws + OFF_OG); a.mix.cR = (bf16_t*)(ws + OFF_CR); a.mix.cH = (bf16_t*)(ws + OFF_CH); a.mix.cG = (bf16_t*)(ws + OFF_CG);
    a.mix.SendR = (float*)(ws + OFF_SENDR); a.mix.PendR = (float*)(ws + OFF_PENDR); a.mix.SendH = (float*)(ws + OFF_SENDH); a.mix.SendG = (float*)(ws + OFF_SENDG); a.mix.GamH = (float*)(ws + OFF_GAMH); a.mix.GamG = (float*)(ws + OFF_GAMG);
    a.mix.SstR = (bf16_t*)(ws + OFF_SSTR); a.mix.SstH = (bf16_t*)(ws + OFF_SSTH); a.mix.SstG = (bf16_t*)(ws + OFF_SSTG);
    a.mix.bo = (bf16_t*)(ws + OFF_BO); a.merged = (float*)(ws + OFF_MERGED); a.mergedb = (bf16_t*)(ws + OFF_MERGEDB); a.x1b = (bf16_t*)(ws + OFF_X1B); a.out = k.out;
    a.WinT = (bf16_t*)(ws + OFF_WINT); a.WguT = (bf16_t*)(ws + OFF_WGUT); a.WdT = (bf16_t*)(ws + OFF_WDT); a.WbrT = (bf16_t*)(ws + OFF_WBRT); a.WoutT = (bf16_t*)(ws + OFF_WOUTT);
    a.idx = (int*)(ws + OFF_IDX); a.wsel = (float*)(ws + OFF_WSEL); a.hist = (int*)(ws + OFF_HIST); a.row_tok = (int*)(ws + OFF_ROWTOK); a.row_w = (float*)(ws + OFF_ROWW);
    a.slotpos = (int*)(ws + OFF_SLOTPOS); a.panel_expert = (int*)(ws + OFF_PANEXP); a.npanels = (int*)(ws + OFF_NPAN);
    a.WrH = (bf16_t*)(ws + OFF_WRH); a.WrL = (bf16_t*)(ws + OFF_WRL);
    a.mix.layer = 0; a.mix.pad_ = 0;
    return a;
}
__device__ __forceinline__ void ln_router_phase(const MegaArgs& a, int L, LAS unsigned char* ldsraw) {
    LAS int* hs = (LAS int*)ldsraw;
    const int tid = phase_tid(), lane = tid & 63, wv = __builtin_amdgcn_readfirstlane(tid >> 6);
    const float* pre = a.merged; const float* wr = a.w_router + (size_t)L * D * NE;
    const float bias = a.router_bias[L * NE + lane];
    for (int vb = blockIdx.x; vb < 256; vb += gridDim.x) {
        __syncthreads();
        if (tid < 64) hs[tid] = 0;
        for (int i = 0; i < 8; ++i) {
            const size_t row = (size_t)vb * 64 + wv * 8 + i;
            const float* p = pre + row * D; float v[32]; float s = 0.f;
#pragma unroll
            for (int j = 0; j < 8; ++j) { const float4 x = *(const float4*)(p + j * 256 + lane * 4); v[4 * j] = x.x; v[4 * j + 1] = x.y; v[4 * j + 2] = x.z; v[4 * j + 3] = x.w; s += (x.x + x.y) + (x.z + x.w); }
            ln_row(v, s, a.ln1_w + L * D, a.ln1_b + L * D, a.x1 + row * D, a.x1b + row * D, lane);
        }
        asm volatile("s_waitcnt vmcnt(0)" ::: "memory");
        __syncthreads();
        {
            typedef short bf16x8v __attribute__((ext_vector_type(8)));
            typedef __bf16 bf16x2n __attribute__((ext_vector_type(2)));
            const int tile = wv >> 1, khalf = wv & 1, r = lane & 15, q = lane >> 4;
            const float* xrow = a.x1 + (size_t)(vb * 64 + tile * 16 + r) * D + khalf * 1024 + q * 8;
            const bf16_t* bh = a.WrH + (size_t)L * NE * D + (size_t)r * D + khalf * 1024 + q * 8; const bf16_t* bl = a.WrL + (size_t)L * NE * D + (size_t)r * D + khalf * 1024 + q * 8;
            f32x4v acc[4];
#pragma unroll
            for (int nb = 0; nb < 4; ++nb) acc[nb] = (f32x4v){0.f, 0.f, 0.f, 0.f};
#pragma unroll 2
            for (int ks = 0; ks < 32; ++ks) {
                const float4 x0 = *(const float4*)(xrow + ks * 32), x1v = *(const float4*)(xrow + ks * 32 + 4);
                const float xs[8] = {x0.x, x0.y, x0.z, x0.w, x1v.x, x1v.y, x1v.z, x1v.w};
                union { bf16x2n h2[4]; bf16x8v v; } ah, al;
#pragma unroll
                for (int j = 0; j < 4; ++j) { f32x2v f; f.x = xs[2 * j]; f.y = xs[2 * j + 1]; const bf16x2n hh = __builtin_convertvector(f, bf16x2n); ah.h2[j] = hh;
                    const f32x2v back = __builtin_convertvector(hh, f32x2v); al.h2[j] = __builtin_convertvector(f - back, bf16x2n); }
#pragma unroll
                for (int nb = 0; nb < 4; ++nb) { const bf16x8v Bh = *(const bf16x8v*)(bh + (size_t)nb * 16 * D + ks * 32), Bl = *(const bf16x8v*)(bl + (size_t)nb * 16 * D + ks * 32);
                    acc[nb] = __builtin_amdgcn_mfma_f32_16x16x32_bf16(ah.v, Bh, acc[nb], 0, 0, 0);
                    acc[nb] = __builtin_amdgcn_mfma_f32_16x16x32_bf16(al.v, Bh, acc[nb], 0, 0, 0);
                    acc[nb] = __builtin_amdgcn_mfma_f32_16x16x32_bf16(ah.v, Bl, acc[nb], 0, 0, 0); }
            }
            LAS float* lg = (LAS float*)(ldsraw + 1024) + (size_t)((tile * 2 + khalf) * 16) * 64;
#pragma unroll
            for (int nb = 0; nb < 4; ++nb)
#pragma unroll
                for (int i = 0; i < 4; ++i) lg[(4 * q + i) * 64 + nb * 16 + r] = acc[nb][i];
        }
        __syncthreads();
        for (int it = 0; it < 8; ++it) {
            {
                const int tk = wv * 8 + it, t = vb * 64 + tk;
                const LAS float* lg = (const LAS float*)(ldsraw + 1024) + (size_t)(((tk >> 4) * 2) * 16 + (tk & 15)) * 64;
                const float logit = lg[lane] + lg[16 * 64 + lane];
                const float score = sigmoidf_(logit);
                const float biased = score + bias;
                float m1 = biased;
                m1 = fmaxf(m1, __shfl_xor(m1, 1)); m1 = fmaxf(m1, __shfl_xor(m1, 2)); m1 = fmaxf(m1, __shfl_xor(m1, 4));
                int am = (biased == m1) ? lane : 64;
                am = min(am, __shfl_xor(am, 1)); am = min(am, __shfl_xor(am, 2)); am = min(am, __shfl_xor(am, 4));
                float m2 = (lane == am) ? -INFINITY : biased;
                m2 = fmaxf(m2, __shfl_xor(m2, 1)); m2 = fmaxf(m2, __shfl_xor(m2, 2)); m2 = fmaxf(m2, __shfl_xor(m2, 4));
                const float gs = m1 + m2;
                const int g = lane >> 3;
                int grank = 0;
#pragma unroll
                for (int g2 = 0; g2 < 8; ++g2) { const float o = __shfl(gs, g2 * 8); grank += (o > gs || (o == gs && g2 < g)) ? 1 : 0; }
                const float masked = (grank < 4) ? biased : -INFINITY;
                int rank = 0;
                for (int e2 = 0; e2 < 64; ++e2) { const float o = rdlane(masked, e2); rank += (o > masked || (o == masked && e2 < lane)) ? 1 : 0; }
                const bool sel = rank < 8;
                const float ssum = wave_sum(sel ? score : 0.f);
                if (sel) { a.idx[(size_t)t * 8 + rank] = lane; a.wsel[(size_t)t * 8 + rank] = 2.5f * score / ssum; atomicAdd((int*)&hs[lane], 1); }
            }
        }
        __syncthreads();
        if (tid < 64) a.hist[vb * 64 + tid] = hs[tid];
    }
}
__device__ __forceinline__ void dispatch_phase(const MegaArgs& a, LAS unsigned char* ldsraw) {
    LAS int* tot = (LAS int*)ldsraw; LAS int* bef = tot + 64; LAS int* pstart = tot + 128; LAS int* es = tot + 192; LAS int* np_s = tot + 704; LAS int* ptot = tot + 768; LAS int* pbef = tot + 1280;
    const int tid = phase_tid();
    for (int blk = blockIdx.x; blk < 256; blk += gridDim.x) {
        __syncthreads();
        { const int part = tid >> 6, e = tid & 63; int b = 0, sm = 0;
#pragma unroll 8
          for (int j = part * 32; j < part * 32 + 32; ++j) { const int cc = a.hist[j * 64 + e]; if (j < blk) b += cc; sm += cc; }
          ptot[tid] = sm; pbef[tid] = b; }
        __syncthreads();
        if (tid < 64) { int sm = 0, b = 0;
#pragma unroll
            for (int pp = 0; pp < 8; ++pp) { sm += ptot[pp * 64 + tid]; b += pbef[pp * 64 + tid]; }
            tot[tid] = sm; bef[tid] = b; }
        __syncthreads();
        if (tid == 0) { int acc = 0; for (int e = 0; e < 64; ++e) { pstart[e] = acc; acc += (tot[e] + 255) / 256 * 256; } np_s[0] = acc / 256; }
        const int t = blk * 64 + (tid >> 3), k = tid & 7;
        const int e = a.idx[(size_t)t * 8 + k];
        es[tid] = e;
        __syncthreads();
        int rank = 0;
        for (int j = 0; j < tid; ++j) rank += (es[j] == e) ? 1 : 0;
        const int pos = pstart[e] + bef[e] + rank;
        a.row_tok[pos] = t; a.row_w[pos] = a.wsel[(size_t)t * 8 + k]; a.slotpos[(size_t)t * 8 + k] = pos;
        const int NP = np_s[0];
        if (blk < 64) {
            const int ee = blk, st = pstart[ee], cnt = tot[ee], pad = (cnt + 255) / 256 * 256;
            for (int r = st + cnt + tid; r < st + pad; r += 512) { a.row_tok[r] = 0; a.row_w[r] = 0.f; }
            for (int pp = st / 256 + tid; pp < (st + pad) / 256; pp += 512) a.panel_expert[pp] = ee;
        }
        if (tid < 64) { const int tt = blk * 64 + tid; a.row_tok[NP * 256 + tt] = tt; a.row_w[NP * 256 + tt] = 1.0f; }
        if (blk == 0) { if (tid < 64) a.panel_expert[NP + tid] = 64; if (tid == 0) a.npanels[0] = NP + 64; }
    }
}
__device__ __forceinline__ void combine_phase(const MegaArgs& a, int L, LAS unsigned char* ldsraw) {
    const int ptid = phase_tid(); const int lane = ptid & 63, wv = ptid >> 6, pair = wv >> 1, half = wv & 1;
    LAS float* part = (LAS float*)ldsraw;
    const unsigned shared_base = (unsigned)(a.npanels[0] - 64) * 256u;
    const float* lw = a.ln2_w + L * D; const float* lbp = a.ln2_b + L * D;
    int it = 0;
    for (int t0 = blockIdx.x * 4; t0 < T; t0 += gridDim.x * 4, ++it) {
        const unsigned t = (unsigned)(t0 + pair);
        unsigned rows[9];
#pragma unroll
        for (int k = 0; k < 8; ++k) rows[k] = (unsigned)a.slotpos[t * 8 + k] * (unsigned)D;
        rows[8] = (shared_base + t) * (unsigned)D;
        float wk[9];
#pragma unroll
        for (int k = 0; k < 8; ++k) wk[k] = a.wsel[t * 8 + k];
        wk[8] = 1.0f;
        float v[16]; float s1 = 0.f, s2 = 0.f;
#pragma unroll
        for (int i = 0; i < 4; ++i) {
            const unsigned c = (unsigned)(half * 1024 + i * 256 + lane * 4);
            const float4 x = *(const float4*)(a.x1 + t * (unsigned)D + c);
            float a0 = 0.f, a1 = 0.f, a2 = 0.f, a3 = 0.f;
#pragma unroll
            for (int k = 0; k < 9; ++k) { const uint2 u = *(const uint2*)(a.ybuf + (rows[k] + c));
                a0 += wk[k] * __uint_as_float(u.x << 16); a1 += wk[k] * __uint_as_float(u.x & 0xffff0000u); a2 += wk[k] * __uint_as_float(u.y << 16); a3 += wk[k] * __uint_as_float(u.y & 0xffff0000u); }
            v[4 * i] = ALPHA * x.x + a0; v[4 * i + 1] = ALPHA * x.y + a1; v[4 * i + 2] = ALPHA * x.z + a2; v[4 * i + 3] = ALPHA * x.w + a3;
#pragma unroll
            for (int j = 0; j < 4; ++j) { s1 += v[4 * i + j]; s2 += v[4 * i + j] * v[4 * i + j]; }
            if (i & 1) asm volatile("" ::: "memory");
        }
        s1 = wave_sum(s1); s2 = wave_sum(s2);
        LAS float* slot = part + (((it & 1) * 4 + pair) * 2) * 2;
        if (lane == 0) { slot[half * 2] = s1; slot[half * 2 + 1] = s2; }
        __syncthreads();
        const float S1 = slot[0] + slot[2], S2 = slot[1] + slot[3];
        const float mu = S1 * (1.0f / D);
        const float rstd = rsqrtf(fmaxf(S2 * (1.0f / D) - mu * mu, 0.f) + 1e-5f);
        float* outf = a.out + t * (unsigned)D; bf16_t* outb = a.xb + t * (unsigned)D;
#pragma unroll
        for (int i = 0; i < 4; ++i) {
            const unsigned c = (unsigned)(half * 1024 + i * 256 + lane * 4);
            const float4 ww = *(const float4*)(lw + c), bb = *(const float4*)(lbp + c);
            float4 o; o.x = (v[4 * i] - mu) * rstd * ww.x + bb.x; o.y = (v[4 * i + 1] - mu) * rstd * ww.y + bb.y; o.z = (v[4 * i + 2] - mu) * rstd * ww.z + bb.z; o.w = (v[4 * i + 3] - mu) * rstd * ww.w + bb.w;
            *(float4*)(outf + c) = o;
            if (L == 0) { pg8::u32x2 pk; pk.x = pg8::cvt_pk_bf16(o.x, o.y); pk.y = pg8::cvt_pk_bf16(o.z, o.w); *(pg8::u32x2*)(outb + c) = pk; }
        }
    }
}

constexpr int NPHASE = 13;
constexpr int LDS_GEMM = pg8::STAGE_BYTES + pg8::GTAB_BYTES;
constexpr int LDS_BARW = LDS_GEMM;
constexpr int LDS_PETAB = LDS_GEMM + 64;
constexpr int LDS_ARGS = LDS_GEMM + 16;
constexpr int LDS_BYTES = LDS_GEMM + 512;
__device__ __forceinline__ void args_to_lds(const KArgs& ka, LAS unsigned char* lds) {
    const int t = (int)threadIdx.x;
    if (t < 34) { const unsigned long long v = (t < 32) ? (unsigned long long)ka.in[t] : (t == 32 ? (unsigned long long)ka.ws : (unsigned long long)ka.out);
        *(LAS unsigned long long*)(lds + LDS_ARGS + t * 8) = v; }
}
__device__ __forceinline__ unsigned long long lds_ptr_load(LAS unsigned char* lds, int i) {
    const LAS unsigned* p = (const LAS unsigned*)(lds + LDS_ARGS + i * 8);
    const unsigned lo = (unsigned)__builtin_amdgcn_readfirstlane((int)p[0]), hi = (unsigned)__builtin_amdgcn_readfirstlane((int)p[1]);
    return ((unsigned long long)hi << 32) | lo;
}
template <int PH> __device__ __forceinline__ void run_phase(const KArgs& kin, const int Lp, LAS unsigned char* lds_in) {
    const int L = Lp & 15, part = Lp >> 4;
    LAS unsigned char* lds = lds_in; asm volatile("" : "+s"(lds));
    size_t z0 = 0; asm volatile("" : "+s"(z0));
    KArgs ka;
#pragma unroll
    for (int i = 0; i < 32; ++i) ka.in[i] = (const float*)((const char*)kin.in[i] + z0);
    ka.ws = kin.ws + z0; ka.out = (float*)((char*)kin.out + z0);
    const MegaArgs a = make_args(ka);
    int G = (int)gridDim.x, c = (int)blockIdx.x; asm volatile("" : "+s"(G), "+s"(c));
    if constexpr (PH == 0) {
        if (L == 0) { const size_t n4 = (size_t)T * D / 4; const int ptid = phase_tid(); for (size_t i = (size_t)c * 512 + ptid; i < n4; i += (size_t)G * 512) { const float4 v = *(const float4*)(a.x_in + 4 * i);
            pg8::u32x2 pk; pk.x = pg8::cvt_pk_bf16(v.x, v.y); pk.y = pg8::cvt_pk_bf16(v.z, v.w); *(pg8::u32x2*)(a.xb + 4 * i) = pk; } }
        ConvArgs ca; ca.w_in = a.w_in; ca.we_gate = a.we_gate; ca.we_up = a.we_up; ca.we_down = a.we_down; ca.ws_gate = a.ws_gate; ca.ws_up = a.ws_up; ca.ws_down = a.ws_down; ca.w_br = a.w_br; ca.w_out = a.w_out;
        ca.WinT = a.WinT; ca.WguT = a.WguT; ca.WdT = a.WdT; ca.WbrT = a.WbrT; ca.WoutT = a.WoutT; ca.layer = L; ca.pad_ = 0;
        if (L == 0) convert_tiles(ca, 0, CV_SEG0, c, G, (LAS float (*)[65])lds);
        if (L == 0) { const int ptid2 = phase_tid();
          for (int i = c * 512 + ptid2; i < 2 * NE * D; i += G * 512) { const int l2 = i >> 17, n = (i >> 11) & 63, k = i & 2047; const float v = a.w_router[(size_t)l2 * D * NE + (size_t)k * NE + n];
              const bf16_t hi = f2bf(v); a.WrH[i] = hi; a.WrL[i] = f2bf(v - bf2f(hi)); } }
    } else if constexpr (PH == 1) {
        pg8::StaticOrder S; S.init(a.xb, a.WinT, T, ZLD, D, G, c);
        pg8::EpiZ16 E; E.O = (bf16_t*)a.mix.z; E.ldc = ZLD; E.pad_ = 0;
        pg8::gemm_phase<pg8::EpiZ16, pg8::StaticOrder, false>(lds, D, S, E);
    } else if constexpr (PH == 2) { MixArgs m = a.mix; m.layer = L; prep_phase(m, lds);
    } else if constexpr (PH == 3) { MixArgs m = a.mix; m.layer = L;
        ConvArgs ca; ca.w_in = a.w_in; ca.we_gate = a.we_gate; ca.we_up = a.we_up; ca.we_down = a.we_down; ca.ws_gate = a.ws_gate; ca.ws_up = a.ws_up; ca.ws_down = a.ws_down; ca.w_br = a.w_br; ca.w_out = a.w_out;
        ca.WinT = a.WinT; ca.WguT = a.WguT; ca.WdT = a.WdT; ca.WbrT = a.WbrT; ca.WoutT = a.WoutT; ca.layer = L; ca.pad_ = 0;
        chains_phase(m, ca, a.bar + 8 + L, lds);
    } else if constexpr (PH == 4) { MixArgs m = a.mix; m.layer = L;
        carry_phase(m, lds, part);
        if (part == 0 && (c >= 8 || G <= 8)) sb_queue(m, a.bar + 12 + L, lds);
    } else if constexpr (PH == 5) { MixArgs m = a.mix; m.layer = L; mixfin_phase(m);
    } else if constexpr (PH == 6) {
        pg8::GateOrder S; S.init(a.mix.bo, a.WbrT, G, c);
        pg8::EpiGateAcc E; E.zg0 = a.mix.z + GATE0; E.mergedb = a.mergedb;
        pg8::gemm_phase<pg8::EpiGateAcc, pg8::GateOrder, false>(lds, FW, S, E);
    } else if constexpr (PH == 7) {
        pg8::StaticOrder S; S.init(a.mergedb, a.WoutT, T, D, D, G, c);
        pg8::EpiResid E; E.xin = (L == 0) ? a.x_in : a.out; E.pre = a.merged;
        pg8::gemm_phase<pg8::EpiResid, pg8::StaticOrder, false>(lds, D, S, E);
    } else if constexpr (PH == 8) { ln_router_phase(a, L, lds);
    } else if constexpr (PH == 9) { dispatch_phase(a, lds);
    } else if constexpr (PH == 10) {
        LAS int* petab = (LAS int*)(lds + LDS_PETAB); const int npan = a.npanels[0];
        pg8::MoeOrder::fill_table(petab, a.panel_expert, npan, 4, G, c, phase_tid());
        pg8::MoeOrder S; S.init(a.x1b, a.WguT, (size_t)1024 * D, petab, a.row_tok, npan, 4, D, G, c);
        pg8::EpiSwi E; E.h = a.hbuf;
        pg8::gemm_phase<pg8::EpiSwi, pg8::MoeOrder, true>(lds, D, S, E);
    } else if constexpr (PH == 11) {
        LAS int* petab = (LAS int*)(lds + LDS_PETAB); const int npan = a.npanels[0];
        pg8::MoeOrder::fill_table(petab, a.panel_expert, npan, 8, G, c, phase_tid());
        pg8::MoeOrder S; S.init(a.hbuf, a.WdT, (size_t)D * FW, petab, nullptr, npan, 8, FW, G, c);
        pg8::EpiDownW E; E.y = a.ybuf;
        pg8::gemm_phase<pg8::EpiDownW, pg8::MoeOrder, false>(lds, FW, S, E);
    } else { combine_phase(a, L, lds); }
}
#ifndef MK_MULTI
#define MK_MULTI 0
#endif
#ifndef MK_PART
#define MK_PART 0
#endif
#ifndef MK_DBL
#define MK_DBL 0
#endif
#if MK_MULTI
template <int PH> __global__ __launch_bounds__(512, 2) void k_one(KArgs a, int L, int pad_) {
    extern __shared__ __attribute__((aligned(16))) unsigned char shm[];
    run_phase<PH>(a, L, (LAS unsigned char*)shm);
}
#else
__device__ __forceinline__ void run_layer(const KArgs& a, const int L, LAS unsigned char* lds, const XcdBarrier& bar) {
#define MK_RUN(PH) do { run_phase<PH>(a, L, lds); xcd_barrier(bar); if ((MK_DBL >> PH) & 1) { run_phase<PH>(a, L | (MK_PART << 4), lds); xcd_barrier(bar); } } while (0)
    if (L == 0) { MK_RUN(0); }
    MK_RUN(1); MK_RUN(2); MK_RUN(3); MK_RUN(4); MK_RUN(5); MK_RUN(6); MK_RUN(7); MK_RUN(8); MK_RUN(9); MK_RUN(10); MK_RUN(11); MK_RUN(12);
#undef MK_RUN
}
__global__ __launch_bounds__(512, 2) void k_mega(KArgs a) {
    extern __shared__ __attribute__((aligned(16))) unsigned char shm[];
    LAS unsigned char* lds = (LAS unsigned char*)shm;
    if (threadIdx.x < 4) ((LAS unsigned*)(lds + LDS_BARW))[threadIdx.x] = 0u;
    __syncthreads();
    const XcdBarrier bar = xcd_barrier_post((unsigned*)(a.ws + OFF_BAR), (volatile LAS unsigned*)(lds + LDS_BARW));
    run_layer(a, 0, lds, bar);
    run_layer(a, 1, lds, bar);
}
#endif

#if MK_MULTI
template <int PH> static void launch_one(const KArgs& a, int L, int grid, hipStream_t stream) {
    static bool attr = false; if (!attr) { (void)hipFuncSetAttribute((const void*)k_one<PH>, hipFuncAttributeMaxDynamicSharedMemorySize, LDS_BYTES); attr = true; }
    k_one<PH><<<grid, 512, LDS_BYTES, stream>>>(a, L, 0);
}
#endif
extern "C" void kernel_launch(void* const* d_in, const int* in_sizes, int n_in, void* d_out, int out_size, void* d_ws, size_t ws_size, hipStream_t stream) {
    KArgs a; memset(&a, 0, sizeof a);
    for (int i = 0; i < 32; ++i) a.in[i] = (const float*)d_in[i];
    a.ws = (char*)d_ws; a.out = (float*)d_out;
    if (WS_NEEDED > ws_size || n_in < 32) { fprintf(stderr, "workspace too small: need %zu MiB, have %zu MiB (n_in %d)\n", WS_NEEDED >> 20, ws_size >> 20, n_in); return; }

    static int grid = 0;
    if (!grid) { int dev = 0, cus = 0; (void)hipGetDevice(&dev); (void)hipDeviceGetAttribute(&cus, hipDeviceAttributeMultiprocessorCount, dev); grid = cus > 0 ? cus : 256; if (grid > 256) grid = 256; }
#if MK_MULTI
    for (int L = 0; L < 2; ++L) {
        launch_one<0>(a, L, grid, stream); launch_one<1>(a, L, grid, stream); launch_one<2>(a, L, grid, stream); launch_one<3>(a, L, grid, stream); launch_one<4>(a, L, grid, stream);
        launch_one<5>(a, L, grid, stream); launch_one<6>(a, L, grid, stream); launch_one<7>(a, L, grid, stream); launch_one<8>(a, L, grid, stream); launch_one<9>(a, L, grid, stream);
        launch_one<10>(a, L, grid, stream); launch_one<11>(a, L, grid, stream); launch_one<12>(a, L, grid, stream);
    }
#else
    static bool attr = false;
    if (!attr) {
        if (hipFuncSetAttribute((const void*)k_mega, hipFuncAttributeMaxDynamicSharedMemorySize, LDS_BYTES) != hipSuccess) { fprintf(stderr, "hipFuncSetAttribute failed\n"); return; }
        int per_cu = 0; (void)hipOccupancyMaxActiveBlocksPerMultiprocessor(&per_cu, (const void*)k_mega, 512, LDS_BYTES);
        if (per_cu < 1) fprintf(stderr, "occupancy query reports %d workgroups per CU\n", per_cu);
        attr = true;
    }
    (void)hipMemsetAsync(a.ws + OFF_BAR, 0, XCD_BAR_WORDS * sizeof(unsigned), stream);
    k_mega<<<grid, 512, LDS_BYTES, stream>>>(a);
#endif
}
```

```cpp
#include <hip/hip_runtime.h>
#include <stdint.h>
#include <stdio.h>
#include <string.h>

typedef unsigned short bf16_t;

constexpr int T = 16384, D = 2048, ZW = 15024, ZLD = 15104, NE = 64, FW = 512;
constexpr int HG_Q = 0, HG_F = 512, HG_I = 1024, HG_G = 1536;
constexpr int RW_R = 2048, RW_K = 2560, RW_V = 3072, RW_LW = 3584;
constexpr int SB_Q = 3744, SB_K = 4256, SB_V = 4768;
constexpr int GL_Q = 5280, GL_K = 5536, GL_V = 5792, GL_LG = 6304, GL_R = 6320;
constexpr int GATE0 = 6832;
constexpr float ALPHA = 1.4142135623730951f;
constexpr int MAXPANELS = 640;
constexpr int MAXROWS = MAXPANELS * 256;
constexpr int NSEG = 32, LSEG = T / NSEG;
constexpr int NCHK = T / 64;

__device__ __forceinline__ float bf2f(bf16_t v) { return __uint_as_float(((unsigned)v) << 16); }
__device__ __forceinline__ bf16_t f2bf(float f) { unsigned u = __float_as_uint(f); u += 0x7FFFu + ((u >> 16) & 1u); return (bf16_t)(u >> 16); }
__device__ __forceinline__ float sigmoidf_(float x) { return 1.0f / (1.0f + expf(-x)); }
__device__ __forceinline__ float softplusf_(float x) { return fmaxf(x, 0.f) + log1pf(expf(-fabsf(x))); }
__device__ __forceinline__ float siluf_(float x) { return x / (1.0f + expf(-x)); }
__device__ __forceinline__ float fsig(float x) { return __builtin_amdgcn_rcpf(1.0f + __expf(-x)); }
__device__ __forceinline__ float fsoftplus(float x) { return fmaxf(x, 0.f) + __logf(1.0f + __expf(-fabsf(x))); }

template <int CTRL> __device__ __forceinline__ float dppmov(float x) {
    return __builtin_bit_cast(float, __builtin_amdgcn_update_dpp(0, __builtin_bit_cast(int, x), CTRL, 0xF, 0xF, true));
}
__device__ __forceinline__ float rdlane(float x, int l) { return __builtin_bit_cast(float, __builtin_amdgcn_readlane(__builtin_bit_cast(int, x), l)); }
__device__ __forceinline__ int phase_tid() { int t = (int)threadIdx.x; asm volatile("" : "+v"(t)); return t & 511; }
__device__ __forceinline__ float wave_sum(float x) {
    x += dppmov<0xB1>(x);
    x += dppmov<0x4E>(x);
    x += dppmov<0x141>(x);
    x += dppmov<0x140>(x);
    return (rdlane(x, 0) + rdlane(x, 16)) + (rdlane(x, 32) + rdlane(x, 48));
}
#define LAS __attribute__((address_space(3)))
namespace pg8 {
typedef short bf16x8 __attribute__((ext_vector_type(8)));
typedef float f32x4 __attribute__((ext_vector_type(4)));
typedef unsigned u32x4 __attribute__((ext_vector_type(4)));
typedef unsigned u32x2 __attribute__((ext_vector_type(2)));
constexpr int BM = 256, BK = 64, HALF = 128, HTB = HALF * BK * 2, STAGE_BYTES = 8 * HTB, NXCD = 8, WGM = 8;
constexpr int GTAB_BYTES = 512 * 16;
__host__ __device__ __forceinline__ int lds_byte(int r, int c) { const int st = (r >> 4) * 2 + (c >> 5), rr = r & 15, cc = c & 31, ob = rr * 64 + cc * 2; return st * 1024 + (ob ^ (((ob >> 9) & 1) << 5)); }
__host__ __device__ __forceinline__ void stage_rc(int b, int& R, int& C) { const int st = b / 1024, sb = b % 1024, swz = sb ^ (((sb >> 9) & 1) << 5); R = (st >> 1) * 16 + swz / 64; C = (st & 1) * 32 + (swz % 64) / 2; }
__host__ __device__ __forceinline__ int perm32(int rho) { const int n = rho >> 4, i = rho & 15; return 8 * (i >> 2) + 4 * n + (i & 3); }
struct Unit { int pm, pn, e; };
__device__ __forceinline__ unsigned cvt_pk_bf16(float lo, float hi) { unsigned r; asm volatile("v_cvt_pk_bf16_f32 %0, %1, %2" : "=v"(r) : "v"(lo), "v"(hi)); return r; }

struct StaticOrder {
    const bf16_t* A; const bf16_t* Bt; int K; int nM, nN, nwg, G, c;
    __device__ void init(const bf16_t* A_, const bf16_t* Bt_, int M, int N, int K_, int G_, int c_) { A = A_; Bt = Bt_; K = K_; nM = M / BM; nN = N / BM; nwg = nM * nN; G = G_; c = c_; }
    __device__ bool next(int i, Unit& u) const {
        const int L = i * G + c; if (L >= nwg) return false;
        int wgid = L; { const int q = nwg / NXCD, r = nwg % NXCD, xcd = wgid % NXCD, off = wgid / NXCD; wgid = (xcd < r ? xcd * (q + 1) : r * (q + 1) + (xcd - r) * q) + off; }
        const int nig = WGM * nN, gid = wgid / nig, fm = gid * WGM, gsz = (nM - fm) < WGM ? (nM - fm) : WGM;
        u.pm = fm + ((wgid % nig) % gsz); u.pn = (wgid % nig) / gsz; u.e = 0; return true;
    }
    __device__ __forceinline__ const char* a_base(const Unit& u) const { return (const char*)A + (size_t)u.pm * 256 * K * 2; }
    __device__ __forceinline__ const char* b_base(const Unit& u) const { return (const char*)Bt + (size_t)u.pn * 256 * K * 2; }
    __device__ __forceinline__ const int* rowmap() const { return nullptr; }
};
struct GateOrder {
    StaticOrder so; const bf16_t* A; const bf16_t* Bt; int per;
    __device__ void init(const bf16_t* bo, const bf16_t* WbrT, int G_, int c_) { so.init(bo, WbrT, T, D, FW, G_, c_); A = bo; Bt = WbrT; Unit t; per = 0; while (so.next(per, t)) ++per; }
    __device__ bool next(int i, Unit& u) const { if (per == 0 || i >= 4 * per) return false; const int g = i / per; const bool ok = so.next(i - g * per, u); u.e = g; return ok; }
    __device__ __forceinline__ const char* a_base(const Unit& u) const { return (const char*)(A + (size_t)u.e * T * 512) + (size_t)u.pm * 256 * FW * 2; }
    __device__ __forceinline__ const char* b_base(const Unit& u) const { return (const char*)(Bt + (size_t)u.e * D * FW) + (size_t)u.pn * 256 * FW * 2; }
    __device__ __forceinline__ const int* rowmap() const { return nullptr; }
};
struct MoeOrder {
    const bf16_t* A; const bf16_t* Bt; const int* rmap; const LAS int* petab; size_t estride; int K, NT, total, G, c;
    __device__ void init(const bf16_t* A_, const bf16_t* Bt_, size_t estride_, const LAS int* petab_, const int* rmap_, int npanels, int NT_, int K_, int G_, int c_) {
        A = A_; Bt = Bt_; estride = estride_; petab = petab_; rmap = rmap_; K = K_; NT = NT_; total = npanels * NT_; G = G_;
        c = remap(c_, G_);
    }
    static __device__ __forceinline__ int remap(int c_, int G_) { return (c_ & 7) * (G_ >> 3) + (c_ >> 3); }
    static __device__ __forceinline__ void fill_table(LAS int* tab, const int* panel_expert, int npanels, int NT_, int G_, int c_, int tid) {
        const int cc = remap(c_, G_), tot = npanels * NT_;
        if (tid < 64) { const int Lu = tid * G_ + cc; tab[tid] = (Lu < tot) ? panel_expert[Lu / NT_] : 0; }
        __syncthreads();
    }
    __device__ bool next(int i, Unit& u) const {
        const int L = i * G + c; if (L >= total) return false;
        u.pm = L / NT; u.pn = L % NT; u.e = petab[i]; return true;
    }
    __device__ __forceinline__ const char* a_base(const Unit& u) const { return rmap ? (const char*)A : (const char*)A + (size_t)u.pm * 256 * K * 2; }
    __device__ __forceinline__ const char* b_base(const Unit& u) const { return (const char*)(Bt + (size_t)u.e * estride) + (size_t)u.pn * 256 * K * 2; }
    __device__ __forceinline__ const int* rowmap() const { return rmap; }
};

struct EpiZ16 {
    static constexpr bool PERM = true;
    bf16_t* O; int ldc; int pad_;
    __device__ __forceinline__ void operator()(const f32x4 (&acc)[2][2][4][2], const Unit& u, int wr, int wc, int fr, int fq) const {
        const int row0 = u.pm * BM + wr * 64 + fr, col0 = u.pn * BM + wc * 32 + 8 * fq;
#pragma unroll
        for (int ai = 0; ai < 2; ++ai)
#pragma unroll
            for (int m = 0; m < 4; ++m) { bf16_t* rowp = O + (size_t)(row0 + ai * HALF + m * 16) * ldc + col0;
#pragma unroll
                for (int bj = 0; bj < 2; ++bj) { const f32x4 v0 = acc[ai][bj][m][0], v1 = acc[ai][bj][m][1];
                    u32x4 w; w.x = cvt_pk_bf16(v0[0], v0[1]); w.y = cvt_pk_bf16(v0[2], v0[3]); w.z = cvt_pk_bf16(v1[0], v1[1]); w.w = cvt_pk_bf16(v1[2], v1[3]);
                    *(u32x4*)(rowp + bj * HALF) = w; } }
    }
};
struct EpiGateAcc {
    static constexpr bool PERM = true;
    const bf16_t* zg0; bf16_t* mergedb;
    __device__ __forceinline__ void operator()(const f32x4 (&acc)[2][2][4][2], const Unit& u, int wr, int wc, int fr, int fq) const {
        const int g = u.e; const bf16_t* zg = zg0 + g * D;
        const int row0 = u.pm * BM + wr * 64 + fr, col0 = u.pn * BM + wc * 32 + 8 * fq;
#pragma unroll
        for (int ai = 0; ai < 2; ++ai)
#pragma unroll
            for (int m = 0; m < 4; ++m) { const size_t row = (size_t)(row0 + ai * HALF + m * 16);
#pragma unroll
                for (int bj = 0; bj < 2; ++bj) { const int col = col0 + bj * HALF;
                    const u32x4 gz = *(const u32x4*)(zg + row * ZLD + col);
                    f32x4 g0, g1; g0[0] = __uint_as_float(gz.x << 16); g0[1] = __uint_as_float(gz.x & 0xffff0000u); g0[2] = __uint_as_float(gz.y << 16); g0[3] = __uint_as_float(gz.y & 0xffff0000u);
                    g1[0] = __uint_as_float(gz.z << 16); g1[1] = __uint_as_float(gz.z & 0xffff0000u); g1[2] = __uint_as_float(gz.w << 16); g1[3] = __uint_as_float(gz.w & 0xffff0000u);
                    f32x4 v0 = acc[ai][bj][m][0], v1 = acc[ai][bj][m][1];
#pragma unroll
                    for (int j = 0; j < 4; ++j) { v0[j] *= __builtin_amdgcn_rcpf(1.0f + __expf(-g0[j])); v1[j] *= __builtin_amdgcn_rcpf(1.0f + __expf(-g1[j])); }
                    bf16_t* mp = mergedb + row * D + col;
                    if (g > 0) { const u32x4 pv = *(const u32x4*)mp;
                        v0[0] += __uint_as_float(pv.x << 16); v0[1] += __uint_as_float(pv.x & 0xffff0000u); v0[2] += __uint_as_float(pv.y << 16); v0[3] += __uint_as_float(pv.y & 0xffff0000u);
                        v1[0] += __uint_as_float(pv.z << 16); v1[1] += __uint_as_float(pv.z & 0xffff0000u); v1[2] += __uint_as_float(pv.w << 16); v1[3] += __uint_as_float(pv.w & 0xffff0000u); }
                    u32x4 w; w.x = cvt_pk_bf16(v0[0], v0[1]); w.y = cvt_pk_bf16(v0[2], v0[3]); w.z = cvt_pk_bf16(v1[0], v1[1]); w.w = cvt_pk_bf16(v1[2], v1[3]);
                    *(u32x4*)mp = w; } }
    }
};
struct EpiResid {
    static constexpr bool PERM = true;
    const float* xin; float* pre;
    __device__ __forceinline__ void operator()(const f32x4 (&acc)[2][2][4][2], const Unit& u, int wr, int wc, int fr, int fq) const {
        const int row0 = u.pm * BM + wr * 64 + fr, col0 = u.pn * BM + wc * 32 + 8 * fq;
#pragma unroll
        for (int ai = 0; ai < 2; ++ai)
#pragma unroll
            for (int m = 0; m < 4; ++m) { const size_t ro = (size_t)(row0 + ai * HALF + m * 16) * D + col0;
#pragma unroll
                for (int bj = 0; bj < 2; ++bj)
#pragma unroll
                    for (int n = 0; n < 2; ++n) { const f32x4 xv = *(const f32x4*)(xin + ro + bj * HALF + n * 4); *(f32x4*)(pre + ro + bj * HALF + n * 4) = xv * ALPHA + acc[ai][bj][m][n]; } }
    }
};
struct EpiSwi {
    static constexpr bool PERM = true;
    bf16_t* h;
    __device__ __forceinline__ void operator()(const f32x4 (&acc)[2][2][4][2], const Unit& u, int wr, int wc, int fr, int fq) const {
        const int row0 = u.pm * BM + wr * 64 + fr, col0 = u.pn * HALF + wc * 32 + 8 * fq;
#pragma unroll
        for (int ai = 0; ai < 2; ++ai)
#pragma unroll
            for (int m = 0; m < 4; ++m) { float o[8];
#pragma unroll
                for (int n = 0; n < 2; ++n)
#pragma unroll
                    for (int j = 0; j < 4; ++j) { const float gt = acc[ai][0][m][n][j], up = acc[ai][1][m][n][j]; o[4 * n + j] = gt / (1.0f + __expf(-gt)) * up; }
                u32x4 w; w.x = cvt_pk_bf16(o[0], o[1]); w.y = cvt_pk_bf16(o[2], o[3]); w.z = cvt_pk_bf16(o[4], o[5]); w.w = cvt_pk_bf16(o[6], o[7]);
                *(u32x4*)(h + (size_t)(row0 + ai * HALF + m * 16) * FW + col0) = w; }
    }
};
struct EpiDownW {
    static constexpr bool PERM = true;
    bf16_t* y;
    __device__ __forceinline__ void operator()(const f32x4 (&acc)[2][2][4][2], const Unit& u, int wr, int wc, int fr, int fq) const {
        const int row0 = u.pm * BM + wr * 64 + fr, col0 = u.pn * BM + wc * 32 + 8 * fq;
#pragma unroll
        for (int ai = 0; ai < 2; ++ai)
#pragma unroll
            for (int m = 0; m < 4; ++m) { const int row = row0 + ai * HALF + m * 16; bf16_t* rowp = y + (size_t)row * D + col0;
#pragma unroll
                for (int bj = 0; bj < 2; ++bj) { const f32x4 v0 = acc[ai][bj][m][0], v1 = acc[ai][bj][m][1];
                    u32x4 w; w.x = cvt_pk_bf16(v0[0], v0[1]); w.y = cvt_pk_bf16(v0[2], v0[3]); w.z = cvt_pk_bf16(v1[0], v1[1]); w.w = cvt_pk_bf16(v1[2], v1[3]);
                    *(u32x4*)(rowp + bj * HALF) = w; } }
    }
};

template <class Epi, class Sched, bool GATHER>
__device__ __forceinline__ void gemm_phase(LAS unsigned char* lds, const int K, const Sched& S, const Epi& E) {
    const int tid = phase_tid(), wid = __builtin_amdgcn_readfirstlane(tid >> 6), wr = wid >> 2, wc = wid & 3, lane = tid & 63, fr = lane & 15, fq = lane >> 4;
    const int nt = K / BK;
    unsigned voffA[2], voffB[2], voffG[2][2]; int gR[2], gC[2];
#pragma unroll
    for (int i = 0; i < 2; ++i) { int R, C; stage_rc(tid * 16 + i * 8192, R, C); const int Rb = Epi::PERM ? ((R & ~31) + perm32(R & 31)) : R;
        voffA[i] = (unsigned)(R * K + C) * 2u; voffB[i] = (unsigned)(Rb * K + C) * 2u; gR[i] = R; gC[i] = C; voffG[0][i] = 0u; voffG[1][i] = 0u; }
    const size_t kstep = (size_t)(BK * 2);
    const size_t hstep = (size_t)HALF * K * 2;
    const unsigned ldsw = (unsigned)wid * 1024u;
    const int aoff = lds_byte(wr * 64 + fr, fq * 8), boff = lds_byte(wc * 32 + fr, fq * 8);
    LAS u32x4* gtab = (LAS u32x4*)(lds + STAGE_BYTES) + tid;
#define PG8_SA(b, h) (((b) * 2 + (h)) * HTB)
#define PG8_SB(b, h) ((4 + (b) * 2 + (h)) * HTB)
#define PG8_STAGE(bufoff, gbase, voff) do { _Pragma("unroll") for (int _i = 0; _i < 2; ++_i) \
        __builtin_amdgcn_global_load_lds((const unsigned*)((const char*)(gbase) + (voff)[_i]), (LAS unsigned*)(lds + (bufoff) + ldsw + _i * 8192), 16, 0, 0); } while (0)
#define PG8_STAGE_A(bufoff, gbase, h) do { if constexpr (GATHER) PG8_STAGE(bufoff, gbase, voffG[h]); else PG8_STAGE(bufoff, (gbase) + (h) * hstep, voffA); } while (0)
#define PG8_LDA(dst, b, h) do { _Pragma("unroll") for (int m = 0; m < 4; ++m) _Pragma("unroll") for (int k = 0; k < 2; ++k) dst[m][k] = *(const LAS bf16x8*)(lds + PG8_SA(b, h) + aoff + m * 2048 + k * 1024); } while (0)
#define PG8_LDB(dst, b, h) do { _Pragma("unroll") for (int n = 0; n < 2; ++n) _Pragma("unroll") for (int k = 0; k < 2; ++k) dst[n][k] = *(const LAS bf16x8*)(lds + PG8_SB(b, h) + boff + n * 2048 + k * 1024); } while (0)
#define PG8_MMA(ai, bj, At, Bt) do { __builtin_amdgcn_s_setprio(1); _Pragma("unroll") for (int m = 0; m < 4; ++m) _Pragma("unroll") for (int n = 0; n < 2; ++n) _Pragma("unroll") for (int k = 0; k < 2; ++k) \
        acc[ai][bj][m][n] = __builtin_amdgcn_mfma_f32_16x16x32_bf16(Bt[n][k], At[m][k], acc[ai][bj][m][n], 0, 0, 0); __builtin_amdgcn_s_setprio(0); } while (0)
#define PG8_WAIT_V(n) asm volatile("s_waitcnt vmcnt(" #n ")" ::: "memory")
#define PG8_WAIT_L(n) asm volatile("s_waitcnt lgkmcnt(" #n ")" ::: "memory")
#define PG8_BAR __builtin_amdgcn_s_barrier()
#define PG8_SCHED __builtin_amdgcn_sched_barrier(0)
    auto gather_offs = [&](const Unit& u) -> u32x4 {
        const int* rm = S.rowmap(); u32x4 o;
        o.x = (unsigned)(rm[u.pm * 256 + gR[0]] * K + gC[0]) * 2u;       o.y = (unsigned)(rm[u.pm * 256 + gR[1]] * K + gC[1]) * 2u;
        o.z = (unsigned)(rm[u.pm * 256 + 128 + gR[0]] * K + gC[0]) * 2u; o.w = (unsigned)(rm[u.pm * 256 + 128 + gR[1]] * K + gC[1]) * 2u;
        return o; };
    Unit cur, nxt, nn; int ui = 0;
    if (!S.next(0, cur)) return;
    f32x4 acc[2][2][4][2];
#pragma unroll
    for (int a = 0; a < 2; ++a)
#pragma unroll
        for (int b = 0; b < 2; ++b)
#pragma unroll
            for (int m = 0; m < 4; ++m)
#pragma unroll
                for (int n = 0; n < 2; ++n) acc[a][b][m][n] = (f32x4){0.f, 0.f, 0.f, 0.f};
    bf16x8 At[4][2], B0[2][2], B1[2][2];
    const char* cA = S.a_base(cur); const char* cB = S.b_base(cur);
    if constexpr (GATHER) {
        const u32x4 o = gather_offs(cur); voffG[0][0] = o.x; voffG[0][1] = o.y; voffG[1][0] = o.z; voffG[1][1] = o.w;
        if (S.next(1, nn)) *gtab = gather_offs(nn);
        asm volatile("s_waitcnt vmcnt(0) lgkmcnt(0)" ::: "memory");
    }
    PG8_STAGE(PG8_SB(0, 0), cB, voffB); PG8_STAGE(PG8_SB(0, 1), cB + hstep, voffB); PG8_STAGE_A(PG8_SA(0, 0), cA, 0); PG8_STAGE_A(PG8_SA(0, 1), cA, 1);
    if (wr == 1) PG8_BAR;
    PG8_WAIT_V(2); PG8_BAR;
    PG8_STAGE(PG8_SB(1, 0), cB + kstep, voffB); PG8_STAGE_A(PG8_SA(1, 0), cA + kstep, 0); PG8_STAGE(PG8_SB(1, 1), cB + hstep + kstep, voffB);
    PG8_WAIT_V(6); PG8_BAR;
    for (;;) {
        const bool has_next = S.next(ui + 1, nxt);
        const char* nA = has_next ? S.a_base(nxt) : cA; const char* nB = has_next ? S.b_base(nxt) : cB;
        for (int t = 0; t < nt; t += 2) {
            const bool last = (t == nt - 2);
            const char* a1 = cA + (size_t)(t + 1) * kstep;
            const char* a2 = last ? nA : cA + (size_t)(t + 2) * kstep; const char* b2 = last ? nB : cB + (size_t)(t + 2) * kstep;
            const char* a3 = a2 + kstep; const char* b3 = b2 + kstep;
            PG8_LDB(B0, 0, 0); PG8_LDB(B1, 0, 1); PG8_SCHED; PG8_LDA(At, 0, 0); PG8_STAGE_A(PG8_SA(1, 1), a1, 1);
            if constexpr (GATHER) { if (last && has_next) { const u32x4 o = *gtab; voffG[0][0] = o.x; voffG[0][1] = o.y; voffG[1][0] = o.z; voffG[1][1] = o.w; } }
            PG8_WAIT_V(8); PG8_WAIT_L(0); PG8_BAR; PG8_MMA(0, 0, At, B0); PG8_MMA(0, 1, At, B1); PG8_BAR; PG8_SCHED;
            PG8_LDA(At, 0, 1); PG8_STAGE(PG8_SB(0, 0), b2, voffB); PG8_STAGE(PG8_SB(0, 1), b2 + hstep, voffB); PG8_STAGE_A(PG8_SA(0, 0), a2, 0);
            PG8_WAIT_V(8); PG8_WAIT_L(0); PG8_BAR; PG8_MMA(1, 0, At, B0); PG8_MMA(1, 1, At, B1); PG8_BAR; PG8_SCHED;
            PG8_LDB(B0, 1, 0); PG8_LDB(B1, 1, 1); PG8_SCHED; PG8_LDA(At, 1, 0); PG8_STAGE_A(PG8_SA(0, 1), a2, 1);
            PG8_WAIT_V(8); PG8_WAIT_L(0); PG8_BAR; PG8_MMA(0, 0, At, B0); PG8_MMA(0, 1, At, B1); PG8_BAR; PG8_SCHED;
            PG8_LDA(At, 1, 1); PG8_STAGE(PG8_SB(1, 0), b3, voffB); PG8_STAGE(PG8_SB(1, 1), b3 + hstep, voffB); PG8_STAGE_A(PG8_SA(1, 0), a3, 0);
            PG8_WAIT_V(8); PG8_WAIT_L(0); PG8_BAR; PG8_MMA(1, 0, At, B0); PG8_MMA(1, 1, At, B1); PG8_BAR; PG8_SCHED;
        }
        if (wr == 0) PG8_BAR;
        E(acc, cur, wr, wc, fr, fq);
        if constexpr (GATHER) { if (has_next && S.next(ui + 2, nn)) { *gtab = gather_offs(nn); } }
        if (!has_next) break;
#pragma unroll
        for (int a = 0; a < 2; ++a)
#pragma unroll
            for (int b = 0; b < 2; ++b)
#pragma unroll
                for (int m = 0; m < 4; ++m)
#pragma unroll
                    for (int n = 0; n < 2; ++n) acc[a][b][m][n] = (f32x4){0.f, 0.f, 0.f, 0.f};
        cur = nxt; cA = nA; cB = nB; ++ui;
        if (wr == 1) PG8_BAR;
    }
    PG8_WAIT_V(0);
    PG8_BAR;
#undef PG8_SA
#undef PG8_SB
#undef PG8_STAGE
#undef PG8_STAGE_A
#undef PG8_LDA
#undef PG8_LDB
#undef PG8_MMA
#undef PG8_WAIT_V
#undef PG8_WAIT_L
#undef PG8_BAR
#undef PG8_SCHED
}
}


struct ConvArgs { const float *w_in, *we_gate, *we_up, *we_down, *ws_gate, *ws_up, *ws_down, *w_br, *w_out; bf16_t *WinT, *WguT, *WdT, *WbrT, *WoutT; int layer, pad_; };
constexpr int CV_SEG0 = 32 * 236, CV_SEG1 = 65 * 2 * 32 * 8, CV_SEG2 = 65 * 8 * 32, CV_SEG3 = 4 * 8 * 32, CV_SEG4 = 32 * 32;
constexpr int CV_TOTAL = CV_SEG0 + CV_SEG1 + CV_SEG2 + CV_SEG3 + CV_SEG4;
struct CvJob { const float* src; bf16_t* dst; int ld, ldd, valid; };
__device__ __forceinline__ CvJob cv_decode(const ConvArgs& a, const int j, const int L) {
    CvJob o; o.valid = 64;
    if (j < CV_SEG0) { const int kb = j & 31, nb = j >> 5; o.ld = ZW; o.ldd = D;
        o.src = a.w_in + (size_t)L * D * ZW + (size_t)kb * 64 * ZW + nb * 64; int v = ZW - nb * 64; o.valid = v < 0 ? 0 : (v > 64 ? 64 : v);
        o.dst = a.WinT + (size_t)nb * 64 * D + kb * 64; }
    else if (j < CV_SEG0 + CV_SEG1) { int q = j - CV_SEG0; const int cb = q & 7; q >>= 3; const int kb = q & 31; q >>= 5; const int bj = q & 1; const int e = q >> 1; o.ld = FW; o.ldd = D;
        const float* m = (e < NE) ? ((bj ? a.we_up : a.we_gate) + ((size_t)L * NE + e) * D * FW) : ((bj ? a.ws_up : a.ws_gate) + (size_t)L * D * FW);
        o.src = m + (size_t)kb * 64 * FW + cb * 64;
        o.dst = a.WguT + ((size_t)e * 1024 + (cb >> 1) * 256 + bj * 128 + (cb & 1) * 64) * D + kb * 64; }
    else if (j < CV_SEG0 + CV_SEG1 + CV_SEG2) { int q = j - CV_SEG0 - CV_SEG1; const int nb = q & 31; q >>= 5; const int kb = q & 7; const int e = q >> 3; o.ld = D; o.ldd = FW;
        const float* m = (e < NE) ? (a.we_down + ((size_t)L * NE + e) * FW * D) : (a.ws_down + (size_t)L * FW * D);
        o.src = m + (size_t)kb * 64 * D + nb * 64; o.dst = a.WdT + ((size_t)e * D + nb * 64) * FW + kb * 64; }
    else if (j < CV_SEG0 + CV_SEG1 + CV_SEG2 + CV_SEG3) { int q = j - CV_SEG0 - CV_SEG1 - CV_SEG2; const int nb = q & 31; q >>= 5; const int kb = q & 7; const int g = q >> 3; o.ld = D; o.ldd = FW;
        o.src = a.w_br + ((size_t)L * 4 + g) * FW * D + (size_t)kb * 64 * D + nb * 64; o.dst = a.WbrT + ((size_t)g * D + nb * 64) * FW + kb * 64; }
    else { const int q = j - CV_SEG0 - CV_SEG1 - CV_SEG2 - CV_SEG3; const int nb = q & 31, kb = q >> 5; o.ld = D; o.ldd = D;
        o.src = a.w_out + (size_t)L * D * D + (size_t)kb * 64 * D + nb * 64; o.dst = a.WoutT + (size_t)nb * 64 * D + kb * 64; }
    return o;
}
__device__ __forceinline__ void convert_tiles(const ConvArgs& a, int j0, int j1, int jstart, int jstride, LAS float (*tile)[65]) {
    const int tid = phase_tid(), L = a.layer;
    for (int j = j0 + jstart; j < j1; j += jstride) {
        const CvJob jb = cv_decode(a, j, L);
        const float* src = jb.src; bf16_t* dst = jb.dst; const int ld = jb.ld, ldd = jb.ldd, valid = jb.valid;
        __syncthreads();
        { const int c4 = (tid & 15) * 4, k = tid >> 4;
#pragma unroll
          for (int h = 0; h < 2; ++h) { float4 v = make_float4(0.f, 0.f, 0.f, 0.f); if (c4 < valid) v = *(const float4*)(src + (size_t)(k + 32 * h) * ld + c4);
              tile[k + 32 * h][c4] = v.x; tile[k + 32 * h][c4 + 1] = v.y; tile[k + 32 * h][c4 + 2] = v.z; tile[k + 32 * h][c4 + 3] = v.w; } }
        __syncthreads();
        { const int n = tid >> 3, kc = (tid & 7) * 8; unsigned w[4];
#pragma unroll
          for (int q = 0; q < 4; ++q) w[q] = (unsigned)f2bf(tile[kc + 2 * q][n]) | ((unsigned)f2bf(tile[kc + 2 * q + 1][n]) << 16);
          *(uint4*)(dst + (size_t)n * ldd + kc) = make_uint4(w[0], w[1], w[2], w[3]); }
    }
}
constexpr int CVX_OWN = CV_TOTAL - CV_SEG0, CVX_TOTAL = CVX_OWN + CV_SEG0;
__device__ __forceinline__ bool cvx_job(const ConvArgs& a, const int n, const int L, CvJob& jb) {
    if (n < CVX_OWN) { jb = cv_decode(a, CV_SEG0 + n, L); return true; }
    if (n < CVX_TOTAL && L + 1 < 2) { jb = cv_decode(a, n - CVX_OWN, L + 1); return true; }
    return false;
}
typedef float f32x2v __attribute__((ext_vector_type(2)));
typedef float f32x4v __attribute__((ext_vector_type(4)));
struct MixArgs {
    const bf16_t* z;
    const float *hg_lb_logits, *hg_norm_w, *rw_mu, *rw_w0, *rw_w2, *rw_a0, *rw_a2, *rw_g2, *rw_kk, *rw_ka, *rw_rk, *rw_ln_w, *rw_ln_b, *gla_g2, *gla_gb, *gla_norm_w;
    float* RS; bf16_t *Vt, *KH, *KG, *VtH, *VtG; float *rGate, *rBonus;
    float *oR, *oH, *oG; bf16_t *cR, *cH, *cG;
    float *SendR, *PendR, *SendH, *SendG, *GamH, *GamG;
    bf16_t *SstR, *SstH, *SstG;
    bf16_t* bo;
    const bf16_t *W2T, *A2T, *G2T, *GGT;
    float *LW, *LA, *LG, *LL;
    int layer, pad_;
};
__device__ __forceinline__ float red8(float x) { x += dppmov<0xB1>(x); x += dppmov<0x4E>(x); x += dppmov<0x141>(x); return x; }
__device__ __forceinline__ float red16(float x) { x += dppmov<0xB1>(x); x += dppmov<0x4E>(x); x += dppmov<0x141>(x); x += dppmov<0x140>(x); return x; }

__device__ __forceinline__ void prep_phase(const MixArgs& p, LAS unsigned char* ldsraw) {
    LAS bf16_t (*vtile)[72] = (LAS bf16_t (*)[72])(ldsraw + 8192);
    const int c = phase_tid(), L = p.layer;
    const float mu_r = p.rw_mu[L * 1696 + c], mu_k = p.rw_mu[L * 1696 + 512 + c], mu_v = p.rw_mu[L * 1696 + 1024 + c];
    const float w0 = p.rw_w0[L * 512 + c], a0 = p.rw_a0[L * 512 + c], kkc = p.rw_kk[L * 512 + c], kac = p.rw_ka[L * 512 + c], rkc = p.rw_rk[L * 512 + c];
    float lb = 0.f;
    if (L == 1) { const float l0 = p.hg_lb_logits[c], l1 = p.hg_lb_logits[512 + c]; const float m = fmaxf(l0, l1); const float e0 = expf(l0 - m), e1 = expf(l1 - m); lb = e1 / (e0 + e1); }
    const float gbc = (c < 256) ? p.gla_gb[L * 256 + c] : 0.f;
    for (int tile = blockIdx.x; tile < T / 64; tile += gridDim.x) {
        const int t0 = tile * 64;
        {
            typedef short bf16x8v __attribute__((ext_vector_type(8)));
            typedef __bf16 bf16x2n __attribute__((ext_vector_type(2)));
            const int wvu = __builtin_amdgcn_readfirstlane(c >> 6), lane = c & 63, r = lane & 15, q = lane >> 4, mp = wvu >> 2, nq = wvu & 3;
            bf16x8v Af[2][6];
#pragma unroll
            for (int m = 0; m < 2; ++m) { const int t = t0 + 32 * mp + 16 * m + r;
#pragma unroll
                for (int ks = 0; ks < 5; ++ks) {
                    const pg8::u32x4 cu = *(const pg8::u32x4*)(p.z + (size_t)t * ZLD + RW_LW + 32 * ks + 8 * q);
                    pg8::u32x4 pv = (pg8::u32x4){0u, 0u, 0u, 0u}; if (t > 0) pv = *(const pg8::u32x4*)(p.z + (size_t)(t - 1) * ZLD + RW_LW + 32 * ks + 8 * q);
                    const float4 m0 = *(const float4*)(p.rw_mu + L * 1696 + 1536 + 32 * ks + 8 * q), m1 = *(const float4*)(p.rw_mu + L * 1696 + 1536 + 32 * ks + 8 * q + 4);
                    const float mu8[8] = {m0.x, m0.y, m0.z, m0.w, m1.x, m1.y, m1.z, m1.w};
                    const unsigned cw[4] = {cu.x, cu.y, cu.z, cu.w}, pw[4] = {pv.x, pv.y, pv.z, pv.w};
                    union { bf16x2n h2[4]; bf16x8v v; } pk;
#pragma unroll
                    for (int j = 0; j < 4; ++j) { f32x2v f;
                        { const float cur = __uint_as_float(cw[j] << 16), prv = __uint_as_float(pw[j] << 16); const float zs = cur + (prv - cur) * mu8[2 * j];
                          f.x = (ks == 0) ? (1.0f - 2.0f / (1.0f + __expf(2.0f * zs))) : (ks == 1 ? zs : fsig(zs)); }
                        { const float cur = __uint_as_float(cw[j] & 0xffff0000u), prv = __uint_as_float(pw[j] & 0xffff0000u); const float zs = cur + (prv - cur) * mu8[2 * j + 1];
                          f.y = (ks == 0) ? (1.0f - 2.0f / (1.0f + __expf(2.0f * zs))) : (ks == 1 ? zs : fsig(zs)); }
                        pk.h2[j] = __builtin_convertvector(f, bf16x2n); }
                    Af[m][ks] = pk.v; }
                { pg8::u32x4 gl = (pg8::u32x4){0u, 0u, 0u, 0u}; if (q < 2) gl = *(const pg8::u32x4*)(p.z + (size_t)t * ZLD + GL_LG + 8 * q);
                  union { pg8::u32x4 u; bf16x8v v; } cvu; cvu.u = gl; Af[m][5] = cvu.v; } }
            const bf16_t* w2t = p.W2T + (size_t)L * 512 * 32; const bf16_t* a2t = p.A2T + (size_t)L * 512 * 32; const bf16_t* g2t = p.G2T + (size_t)L * 512 * 96; const bf16_t* ggt = p.GGT + (size_t)L * 256 * 32;
#pragma unroll 2
            for (int nt = 0; nt < 8; ++nt) { const int ch = 128 * nq + 16 * nt + r;
                const bf16x8v Bw = *(const bf16x8v*)(w2t + ch * 32 + 8 * q), Ba = *(const bf16x8v*)(a2t + ch * 32 + 8 * q);
                const bf16x8v Bg0 = *(const bf16x8v*)(g2t + ch * 96 + 8 * q), Bg1 = *(const bf16x8v*)(g2t + ch * 96 + 32 + 8 * q), Bg2 = *(const bf16x8v*)(g2t + ch * 96 + 64 + 8 * q);
#pragma unroll
                for (int m = 0; m < 2; ++m) { const f32x4v zero = (f32x4v){0.f, 0.f, 0.f, 0.f};
                    const f32x4v aw = __builtin_amdgcn_mfma_f32_16x16x32_bf16(Af[m][0], Bw, zero, 0, 0, 0), aa = __builtin_amdgcn_mfma_f32_16x16x32_bf16(Af[m][1], Ba, zero, 0, 0, 0);
                    f32x4v ag = __builtin_amdgcn_mfma_f32_16x16x32_bf16(Af[m][2], Bg0, zero, 0, 0, 0); ag = __builtin_amdgcn_mfma_f32_16x16x32_bf16(Af[m][3], Bg1, ag, 0, 0, 0); ag = __builtin_amdgcn_mfma_f32_16x16x32_bf16(Af[m][4], Bg2, ag, 0, 0, 0);
#pragma unroll
                    for (int i = 0; i < 4; ++i) { const size_t o = (size_t)(t0 + 32 * mp + 16 * m + 4 * q + i) * 512 + ch; p.LW[o] = aw[i]; p.LA[o] = aa[i]; p.LG[o] = ag[i]; } } }
#pragma unroll 2
            for (int nt = 0; nt < 4; ++nt) { const int ch = 64 * nq + 16 * nt + r;
                const bf16x8v Bl = *(const bf16x8v*)(ggt + ch * 32 + 8 * q);
#pragma unroll
                for (int m = 0; m < 2; ++m) { const f32x4v al = __builtin_amdgcn_mfma_f32_16x16x32_bf16(Af[m][5], Bl, (f32x4v){0.f, 0.f, 0.f, 0.f}, 0, 0, 0);
#pragma unroll
                    for (int i = 0; i < 4; ++i) p.LL[(size_t)(t0 + 32 * mp + 16 * m + 4 * q + i) * 256 + ch] = al[i]; } }
        }
        asm volatile("s_waitcnt vmcnt(0)" ::: "memory");
        __syncthreads();
        float bH = 0.f, bG = 0.f;
        for (int tb = 0; tb < 8; ++tb) {
            const int tt0 = t0 + tb * 8;
            float accW[8], accA[8], accG[8], accL[8];
#pragma unroll
            for (int k = 0; k < 8; ++k) { const size_t o = (size_t)(tt0 + k) * 512 + c; accW[k] = w0 + p.LW[o]; accA[k] = a0 + p.LA[o]; accG[k] = p.LG[o]; accL[k] = (c < 256) ? gbc + p.LL[(size_t)(tt0 + k) * 256 + c] : 0.f; }
#pragma unroll
            for (int k = 0; k < 8; ++k) {
                const int t = tt0 + k;
                const bf16_t* zc = p.z + (size_t)t * ZLD; const bf16_t* zp = p.z + (size_t)(t > 0 ? t - 1 : 0) * ZLD;
                const float cr = bf2f(zc[RW_R + c]), ck = bf2f(zc[RW_K + c]), cv = bf2f(zc[RW_V + c]);
                const float pr = (t > 0) ? bf2f(zp[RW_R + c]) : 0.f, pk = (t > 0) ? bf2f(zp[RW_K + c]) : 0.f, pv = (t > 0) ? bf2f(zp[RW_V + c]) : 0.f;
                const float r = cr + (pr - cr) * mu_r, kx = ck + (pk - ck) * mu_k, v = cv + (pv - cv) * mu_v;
                const float w_raw = -fsoftplus(-accW[k]) - 0.5f;
                const float decay = __expf(-__expf(w_raw));
                const float iclr = fsig(accA[k]);
                const float kk = kx * kkc;
                const float nrm = sqrtf(wave_sum(kk * kk));
                const float kkn = kk / fmaxf(nrm, 1e-12f);
                const float kmod = kx * (1.0f + (iclr - 1.0f) * kac);
                const float bon = wave_sum(r * kmod * rkc) * v;
                { const int h = c >> 6, j = c & 63; float* rs = p.RS + ((size_t)h * T + t) * 384 + j;
                  rs[0] = -kkn; rs[64] = kkn * iclr; rs[128] = decay; rs[192] = kmod; rs[256] = r; rs[320] = v; }
                p.rGate[(size_t)t * 512 + c] = accG[k]; p.rBonus[(size_t)t * 512 + c] = bon;
                { const float q = bf2f(zc[HG_Q + c]), f = bf2f(zc[HG_F + c]);
                  const float omf = (1.0f - lb) * fsig(-f);
                  bH = fmaxf(bH + __logf(fmaxf(1.0f - omf, 1e-37f)), -85.0f);
                  p.cH[(size_t)t * 512 + c] = f2bf(q * fsig(q) * __expf(bH)); p.KH[(size_t)t * 512 + c] = f2bf(omf * __expf(-bH)); }
                if (c < 256) {
                  bG = fmaxf(bG - fsoftplus(-accL[k]) * (1.0f / 16.0f), -85.0f);
                  p.cG[(size_t)t * 256 + c] = f2bf(bf2f(zc[GL_Q + c]) * 0.125f * __expf(bG)); p.KG[(size_t)t * 256 + c] = f2bf(bf2f(zc[GL_K + c]) * __expf(-bG)); }
            }
        }
        { const int h = c >> 7, j = c & 127; p.GamH[((size_t)tile * 4 + h) * 128 + j] = __expf(bH); }
        if (c < 256) { const int h = c >> 6, j = c & 63; p.GamG[((size_t)tile * 4 + h) * 64 + j] = __expf(bG); }
#pragma unroll 1
        for (int pass = 0; pass < 3; ++pass) {
            const int col0 = pass == 0 ? HG_I : (pass == 1 ? GL_V : SB_V); bf16_t* dstT = p.VtH + (size_t)pass * 512 * T;
            __syncthreads();
            for (int i = 0; i < 64; ++i) vtile[c][i] = p.z[(size_t)(t0 + i) * ZLD + col0 + c];
            __syncthreads();
#pragma unroll
            for (int it = 0; it < 8; ++it) { const int row = it * 64 + (c >> 3), sg = c & 7;
                *(pg8::u32x4*)(dstT + (size_t)row * T + t0 + sg * 8) = *(const LAS pg8::u32x4*)&vtile[row][sg * 8]; }
        }
    }
}

template <int KIND>
__device__ __forceinline__ void chain_unit(const MixArgs& p, const ConvArgs& cva, const int unit, const int seg, const int h, LAS float* lds) {
    constexpr int SF = KIND == 2 ? 512 : (KIND == 3 ? 320 : 384);
    constexpr int EPL = KIND == 2 ? 16 : 8, E2 = EPL / 2, DK = EPL * 8;
    constexpr int CH = 16, NP = CH * SF * 4 / 1024;
    static_assert(KIND == 0, "only the RWKV-7 chain is left (HGRN2 / GLA: intra_unit + chunk scan)");
    const float* stream = p.RS + ((size_t)h * T + (size_t)seg * LSEG) * SF;
    const int tid = phase_tid(), wv = __builtin_amdgcn_readfirstlane(tid >> 6), lane = tid & 63, rg = lane >> 3, lj = lane & 7;
    const bool isP = (KIND == 0) && (wv >= 4);
    const bool active = !(isP && seg == 0);
    const bool wantc = (KIND != 0) && (seg >= 1);
    const int rowA = ((KIND == 0) ? (wv & 3) : wv) * 16 + rg, rowB = rowA + 8;
    const int orow = (isP ? 64 : 0) + rowA;
    LAS float* ob = lds + 2 * CH * SF;
    LAS float* cb = ob;
    constexpr int NT = 8;
    const int jb0 = unit * (LSEG / 16) * NT;
    LAS bf16_t (*cvt)[64][66] = (LAS bf16_t (*)[64][66])(ob + 2 * 16 * 128);
    const int L = p.layer;
    f32x2v SA[E2], SB[E2];
#pragma unroll
    for (int e = 0; e < E2; ++e) { SA[e] = (f32x2v){0.f, 0.f}; SB[e] = (f32x2v){0.f, 0.f};
        if (isP) { if (lj * 8 + 2 * e == rowA) SA[e].x = 1.f; if (lj * 8 + 2 * e + 1 == rowA) SA[e].y = 1.f; if (lj * 8 + 2 * e == rowB) SB[e].x = 1.f; if (lj * 8 + 2 * e + 1 == rowB) SB[e].y = 1.f; } }
    f32x2v gam = (f32x2v){1.f, 1.f};
    auto stage = [&](int ci, LAS float* dst) {
        const char* g = (const char*)(stream + (size_t)ci * CH * SF) + lane * 16;
        for (int pc = wv; pc < NP; pc += 8) __builtin_amdgcn_global_load_lds((const unsigned*)(g + pc * 1024), (LAS unsigned*)((LAS char*)dst + pc * 1024), 16, 0, 0);
    };
    auto writeout = [&](int ci, const LAS float* o, const LAS float* cc) {
#pragma unroll
        for (int q = 0; q < 4; ++q) { const int idx = tid + 512 * q, s = idx >> 7, r = idx & 127; const size_t t = (size_t)seg * LSEG + ci * CH + s; const float v = o[idx];
            if (KIND == 0) { if (r < 64) p.oR[t * 512 + h * 64 + r] = v; else if (seg >= 1) p.cR[t * 512 + h * 64 + (r - 64)] = f2bf(v); }
            else if (KIND == 2) p.oH[t * 512 + h * 128 + r] = v;
            else p.oG[t * 512 + h * 128 + r] = v; }
        if (wantc) {
#pragma unroll
            for (int q = 0; q < (DK * 16) / 512; ++q) { const int idx = tid + 512 * q, s = idx / DK, k = idx % DK; const size_t t = (size_t)seg * LSEG + ci * CH + s;
                if (KIND == 2) p.cH[t * 512 + h * 128 + k] = f2bf(cc[s * 128 + k]); else p.cG[t * 256 + h * 64 + k] = f2bf(cc[s * 128 + k]); }
        }
    };
    constexpr int NCH = LSEG / CH;
    struct OpsR { f32x4v a0, a1, b0, b1, w0, w1, r0, r1, k0, k1; float vA, vB; };
    struct OpsG { f32x4v q[EPL / 4], w[EPL / 4], k[EPL / 4]; float vA, vB; f32x2v gw, gq; };
    const float vscale = isP ? 0.f : 1.f;
    const int goff = (EPL == 8) ? (lj * 8 + wv) : (lj * 16 + 2 * wv);
    stage(0, lds);
    for (int ci = 0; ci < NCH; ++ci) {
        asm volatile("s_waitcnt vmcnt(0)" ::: "memory"); __syncthreads();
        const LAS float* cur = lds + (ci & 1) * CH * SF;
        if (ci + 1 < NCH) stage(ci + 1, lds + ((ci + 1) & 1) * CH * SF);
        if (ci > 0) writeout(ci - 1, ob + ((ci - 1) & 1) * 2048, cb + ((ci - 1) & 1) * 2048);
        LAS float* oc = ob + (ci & 1) * 2048; LAS float* ccur = cb + (ci & 1) * 2048;
        if (ci > 0) {
#pragma unroll
            for (int k4 = 0; k4 < NT; ++k4) { CvJob jb; if (cvx_job(cva, jb0 + (ci - 1) * NT + k4, L, jb)) { const int n = tid >> 3, kc = (tid & 7) * 8;
                const LAS unsigned* tp = (const LAS unsigned*)&cvt[k4][n][kc]; pg8::u32x4 w; w.x = tp[0]; w.y = tp[1]; w.z = tp[2]; w.w = tp[3];
                *(pg8::u32x4*)(jb.dst + (size_t)n * jb.ldd + kc) = w; } }
        }
        float4 cvr[NT][2]; bool cvok[NT];
#pragma unroll
        for (int k4 = 0; k4 < NT; ++k4) { CvJob jb; cvok[k4] = cvx_job(cva, jb0 + ci * NT + k4, L, jb);
            cvr[k4][0] = make_float4(0.f, 0.f, 0.f, 0.f); cvr[k4][1] = cvr[k4][0];
            if (cvok[k4]) { const int c4 = (tid & 15) * 4, kr = tid >> 4;
                if (c4 < jb.valid) { cvr[k4][0] = *(const float4*)(jb.src + (size_t)(2 * kr) * jb.ld + c4); cvr[k4][1] = *(const float4*)(jb.src + (size_t)(2 * kr + 1) * jb.ld + c4); } } }
        if (active) {
            if constexpr (KIND == 0) {
                auto ld = [&](int s) { const LAS float* sp = cur + s * SF + lj * 8; OpsR o;
                    o.a0 = *(const LAS f32x4v*)(sp); o.a1 = *(const LAS f32x4v*)(sp + 4); o.b0 = *(const LAS f32x4v*)(sp + 64); o.b1 = *(const LAS f32x4v*)(sp + 68);
                    o.w0 = *(const LAS f32x4v*)(sp + 128); o.w1 = *(const LAS f32x4v*)(sp + 132); o.k0 = *(const LAS f32x4v*)(sp + 192); o.k1 = *(const LAS f32x4v*)(sp + 196);
                    o.r0 = *(const LAS f32x4v*)(sp + 256); o.r1 = *(const LAS f32x4v*)(sp + 260);
                    o.vA = cur[s * SF + 320 + rowA]; o.vB = cur[s * SF + 320 + rowB]; return o; };
                OpsR nx = ld(0);
#pragma unroll
                for (int s = 0; s < CH; ++s) {
                    const OpsR o = nx;
                    if (s + 1 < CH) nx = ld(s + 1);
                    f32x2v pa = SA[0] * o.a0.xy, pb = SB[0] * o.a0.xy; pa = SA[1] * o.a0.zw + pa; pb = SB[1] * o.a0.zw + pb;
                    f32x2v qa = SA[2] * o.a1.xy, qb = SB[2] * o.a1.xy; qa = SA[3] * o.a1.zw + qa; qb = SB[3] * o.a1.zw + qb; pa += qa; pb += qb;
                    float sA = pa.x + pa.y, sB = pb.x + pb.y;
                    sA += dppmov<0xB1>(sA); sB += dppmov<0xB1>(sB); sA += dppmov<0x4E>(sA); sB += dppmov<0x4E>(sB); sA += dppmov<0x141>(sA); sB += dppmov<0x141>(sB);
                    const f32x2v savA = (f32x2v){sA, sA}, savB = (f32x2v){sB, sB};
                    const float vA = o.vA * vscale, vB = o.vB * vscale; const f32x2v vvA = (f32x2v){vA, vA}, vvB = (f32x2v){vB, vB};
                    SA[0] = SA[0] * o.w0.xy + (savA * o.b0.xy + vvA * o.k0.xy); SB[0] = SB[0] * o.w0.xy + (savB * o.b0.xy + vvB * o.k0.xy);
                    SA[1] = SA[1] * o.w0.zw + (savA * o.b0.zw + vvA * o.k0.zw); SB[1] = SB[1] * o.w0.zw + (savB * o.b0.zw + vvB * o.k0.zw);
                    SA[2] = SA[2] * o.w1.xy + (savA * o.b1.xy + vvA * o.k1.xy); SB[2] = SB[2] * o.w1.xy + (savB * o.b1.xy + vvB * o.k1.xy);
                    SA[3] = SA[3] * o.w1.zw + (savA * o.b1.zw + vvA * o.k1.zw); SB[3] = SB[3] * o.w1.zw + (savB * o.b1.zw + vvB * o.k1.zw);
                    f32x2v oa = SA[0] * o.r0.xy, obb = SB[0] * o.r0.xy; oa = SA[1] * o.r0.zw + oa; obb = SB[1] * o.r0.zw + obb;
                    f32x2v oa2 = SA[2] * o.r1.xy, ob2 = SB[2] * o.r1.xy; oa2 = SA[3] * o.r1.zw + oa2; ob2 = SB[3] * o.r1.zw + ob2; oa += oa2; obb += ob2;
                    float oA = oa.x + oa.y, oB = obb.x + obb.y;
                    oA += dppmov<0xB1>(oA); oB += dppmov<0xB1>(oB); oA += dppmov<0x4E>(oA); oB += dppmov<0x4E>(oB); oA += dppmov<0x141>(oA); oB += dppmov<0x141>(oB);
                    if (lj == 0) { oc[s * 128 + orow] = oA; oc[s * 128 + orow + 8] = oB; }
                }
            } else {
                auto ld = [&](int s) { const LAS float* sp = cur + s * SF + lj * EPL; OpsG o;
#pragma unroll
                    for (int e4 = 0; e4 < EPL / 4; ++e4) { o.q[e4] = *(const LAS f32x4v*)(sp + e4 * 4); o.w[e4] = *(const LAS f32x4v*)(sp + DK + e4 * 4); o.k[e4] = *(const LAS f32x4v*)(sp + 2 * DK + e4 * 4); }
                    o.vA = cur[s * SF + 3 * DK + rowA]; o.vB = cur[s * SF + 3 * DK + rowB];
                    if constexpr (EPL == 8) { o.gw = (f32x2v){cur[s * SF + DK + goff], 1.f}; o.gq = (f32x2v){cur[s * SF + goff], 0.f}; }
                    else { o.gw = *(const LAS f32x2v*)(cur + s * SF + DK + goff); o.gq = *(const LAS f32x2v*)(cur + s * SF + goff); }
                    return o; };
                OpsG nx = ld(0);
#pragma unroll
                for (int s = 0; s < CH; ++s) {
                    const OpsG o = nx;
                    if (s + 1 < CH) nx = ld(s + 1);
                    const f32x2v vvA = (f32x2v){o.vA, o.vA}, vvB = (f32x2v){o.vB, o.vB};
                    f32x2v oa = (f32x2v){0.f, 0.f}, oa2 = oa, obb = oa, ob2 = oa;
#pragma unroll
                    for (int e4 = 0; e4 < EPL / 4; ++e4) {
                        SA[2 * e4] = SA[2 * e4] * o.w[e4].xy + vvA * o.k[e4].xy; SA[2 * e4 + 1] = SA[2 * e4 + 1] * o.w[e4].zw + vvA * o.k[e4].zw;
                        SB[2 * e4] = SB[2 * e4] * o.w[e4].xy + vvB * o.k[e4].xy; SB[2 * e4 + 1] = SB[2 * e4 + 1] * o.w[e4].zw + vvB * o.k[e4].zw;
                        oa = SA[2 * e4] * o.q[e4].xy + oa; oa2 = SA[2 * e4 + 1] * o.q[e4].zw + oa2; obb = SB[2 * e4] * o.q[e4].xy + obb; ob2 = SB[2 * e4 + 1] * o.q[e4].zw + ob2;
                    }
                    oa += oa2; obb += ob2;
                    float oA = oa.x + oa.y, oB = obb.x + obb.y;
                    oA += dppmov<0xB1>(oA); oB += dppmov<0xB1>(oB); oA += dppmov<0x4E>(oA); oB += dppmov<0x4E>(oB); oA += dppmov<0x141>(oA); oB += dppmov<0x141>(oB);
                    if (lj == 0) { oc[s * 128 + rowA] = oA; oc[s * 128 + rowB] = oB; }
                    gam *= o.gw; const f32x2v cq = o.gq * gam;
                    if (wantc && rg == 0) { if constexpr (EPL == 8) ccur[s * 128 + goff] = cq.x; else *(LAS f32x2v*)(ccur + s * 128 + goff) = cq; }
                }
            }
        }
        __syncthreads();
#pragma unroll
        for (int k4 = 0; k4 < NT; ++k4) if (cvok[k4]) { const int c4 = (tid & 15) * 4, kr = tid >> 4; const float4 v0 = cvr[k4][0], v1 = cvr[k4][1];
            *(LAS unsigned*)&cvt[k4][c4][2 * kr] = pg8::cvt_pk_bf16(v0.x, v1.x); *(LAS unsigned*)&cvt[k4][c4 + 1][2 * kr] = pg8::cvt_pk_bf16(v0.y, v1.y);
            *(LAS unsigned*)&cvt[k4][c4 + 2][2 * kr] = pg8::cvt_pk_bf16(v0.z, v1.z); *(LAS unsigned*)&cvt[k4][c4 + 3][2 * kr] = pg8::cvt_pk_bf16(v0.w, v1.w); }
    }
    __syncthreads();
#pragma unroll
    for (int k4 = 0; k4 < NT; ++k4) { CvJob jb; if (cvx_job(cva, jb0 + (NCH - 1) * NT + k4, L, jb)) { const int n = tid >> 3, kc = (tid & 7) * 8;
        const LAS unsigned* tp = (const LAS unsigned*)&cvt[k4][n][kc]; pg8::u32x4 w; w.x = tp[0]; w.y = tp[1]; w.z = tp[2]; w.w = tp[3];
        *(pg8::u32x4*)(jb.dst + (size_t)n * jb.ldd + kc) = w; } }
    writeout(NCH - 1, ob + ((NCH - 1) & 1) * 2048, cb + ((NCH - 1) & 1) * 2048);
    if (active) {
        float* dA;
        if (KIND == 0) dA = (isP ? p.PendR : p.SendR) + (((size_t)seg * 8 + h) * 64 + rowA) * 64 + lj * 8;
        else if (KIND == 2) dA = p.SendH + (((size_t)seg * 4 + h) * 128 + rowA) * 128 + lj * 16;
        else dA = p.SendG + (((size_t)seg * 4 + h) * 128 + rowA) * 64 + lj * 8;
        float* dB = dA + 8 * DK;
#pragma unroll
        for (int e = 0; e < E2; ++e) { dA[2 * e] = SA[e].x; dA[2 * e + 1] = SA[e].y; dB[2 * e] = SB[e].x; dB[2 * e + 1] = SB[e].y; }
    }
    if (wantc && rg == 0) {
        if constexpr (EPL == 8) p.GamG[(size_t)seg * 256 + h * 64 + lj * 8 + wv] = gam.x;
        else { p.GamH[(size_t)seg * 512 + h * 128 + lj * 16 + 2 * wv] = gam.x; p.GamH[(size_t)seg * 512 + h * 128 + lj * 16 + 2 * wv + 1] = gam.y; }
    }
    __syncthreads();
}
__device__ __forceinline__ void sb_phase(const MixArgs& p, const int wave0, const int W, const int uend);
template <int DK>
__device__ __forceinline__ void intra_unit(const MixArgs& p, const int h, const int chunk, LAS bf16_t* ktT, const int lane) {
    typedef short bf16x8v __attribute__((ext_vector_type(8)));
    typedef float f32x16v __attribute__((ext_vector_type(16)));
    typedef __bf16 bf16x2n __attribute__((ext_vector_type(2)));
    constexpr int QP = DK * 4, NKS = DK / 16, NKB = DK / 32;
    const bf16_t* Qb = (DK == 128 ? p.cH : p.cG) + h * DK; const bf16_t* Kb = (DK == 128 ? p.KH : p.KG) + h * DK;
    const bf16_t* Vt = (DK == 128 ? p.VtH : p.VtG) + (size_t)h * 128 * T;
    float* ol = (DK == 128 ? p.oH : p.oG) + h * 128; float* Send = (DK == 128 ? p.SendH : p.SendG) + ((size_t)chunk * 4 + h) * 128 * DK;
    const int r = lane & 31, hh = lane >> 5, t0 = chunk * 64;
#pragma unroll 1
    for (int tb = 0; tb < 2; ++tb) {
        bf16x8v Qf[NKS];
#pragma unroll
        for (int ks = 0; ks < NKS; ++ks) Qf[ks] = *(const bf16x8v*)(Qb + (unsigned)((t0 + 32 * tb + r) * QP + 16 * ks + 8 * hh));
#pragma unroll 1
        for (int vh = 0; vh < 2; ++vh) {
            f32x16v O[2];
#pragma unroll
            for (int vb = 0; vb < 2; ++vb)
#pragma unroll
                for (int i = 0; i < 16; ++i) O[vb][i] = 0.f;
            for (int sb = 0; sb <= tb; ++sb) {
                f32x16v P;
#pragma unroll
                for (int i = 0; i < 16; ++i) P[i] = 0.f;
#pragma unroll
                for (int ks = 0; ks < NKS; ++ks) { const bf16x8v Kf = *(const bf16x8v*)(Kb + (unsigned)((t0 + 32 * sb + r) * QP + 16 * ks + 8 * hh));
                    P = __builtin_amdgcn_mfma_f32_32x32x16_bf16(Kf, Qf[ks], P, 0, 0, 0); }
                const bool diag = (sb == tb);
                bf16x8v Pf[2];
#pragma unroll
                for (int s2 = 0; s2 < 2; ++s2) {
                    union { bf16x2n h2[4]; bf16x8v v; } pk;
#pragma unroll
                    for (int j = 0; j < 4; ++j) { f32x2v f;
                        { const int i = 8 * s2 + 2 * j, kr = (i & 3) + 8 * (i >> 2) + 4 * hh; f.x = (!diag || kr <= r) ? P[i] : 0.f; }
                        { const int i = 8 * s2 + 2 * j + 1, kr = (i & 3) + 8 * (i >> 2) + 4 * hh; f.y = (!diag || kr <= r) ? P[i] : 0.f; }
                        pk.h2[j] = __builtin_convertvector(f, bf16x2n); }
                    Pf[s2] = pk.v; }
#pragma unroll
                for (int vb = 0; vb < 2; ++vb)
#pragma unroll
                    for (int s2 = 0; s2 < 2; ++s2) { const bf16_t* vp = Vt + (unsigned)((32 * (2 * vh + vb) + r) * T + t0 + 32 * sb + 16 * s2 + 4 * hh);
                        union { pg8::u32x2 d[2]; bf16x8v v; } vf; vf.d[0] = *(const pg8::u32x2*)vp; vf.d[1] = *(const pg8::u32x2*)(vp + 8);
                        O[vb] = __builtin_amdgcn_mfma_f32_32x32x16_bf16(vf.v, Pf[s2], O[vb], 0, 0, 0); }
            }
#pragma unroll
            for (int vb = 0; vb < 2; ++vb)
#pragma unroll
                for (int g = 0; g < 4; ++g) { f32x4v w; w.x = O[vb][4 * g]; w.y = O[vb][4 * g + 1]; w.z = O[vb][4 * g + 2]; w.w = O[vb][4 * g + 3];
                    *(f32x4v*)(ol + (unsigned)((t0 + 32 * tb + r) * 512 + 32 * (2 * vh + vb) + 8 * g + 4 * hh)) = w; }
        }
    }
#pragma unroll 4
    for (int it = 0; it < DK / 8; ++it) { const int pidx = it * 64 + lane, srow = pidx / (DK / 8), cb8 = pidx % (DK / 8);
        const pg8::u32x4 w = *(const pg8::u32x4*)(Kb + (unsigned)((t0 + srow) * QP + cb8 * 8));
        const unsigned ww[4] = {w.x, w.y, w.z, w.w};
#pragma unroll
        for (int j = 0; j < 4; ++j) { ktT[(cb8 * 8 + 2 * j) * 66 + srow] = (bf16_t)(ww[j] & 0xffffu); ktT[(cb8 * 8 + 2 * j + 1) * 66 + srow] = (bf16_t)(ww[j] >> 16); } }
#pragma unroll 1
    for (int vb = 0; vb < 4; ++vb) {
        bf16x8v Af[4];
#pragma unroll
        for (int ks = 0; ks < 4; ++ks) Af[ks] = *(const bf16x8v*)(Vt + (unsigned)((32 * vb + r) * T + t0 + 16 * ks + 8 * hh));
#pragma unroll 1
        for (int kb = 0; kb < NKB; ++kb) {
            f32x16v U;
#pragma unroll
            for (int i = 0; i < 16; ++i) U[i] = 0.f;
#pragma unroll
            for (int ks = 0; ks < 4; ++ks) { const LAS unsigned* tp = (const LAS unsigned*)(ktT + (32 * kb + r) * 66 + 16 * ks + 8 * hh);
                union { unsigned d[4]; bf16x8v v; } bf; bf.d[0] = tp[0]; bf.d[1] = tp[1]; bf.d[2] = tp[2]; bf.d[3] = tp[3];
                U = __builtin_amdgcn_mfma_f32_32x32x16_bf16(Af[ks], bf.v, U, 0, 0, 0); }
            float* sp = Send + (unsigned)((32 * vb + 4 * hh) * DK + 32 * kb + r);
#pragma unroll
            for (int i = 0; i < 16; ++i) sp[((i & 3) + 8 * (i >> 2)) * DK] = U[i];
        }
    }
}
__device__ __forceinline__ void chains_phase(const MixArgs& p, const ConvArgs& cva, unsigned* sbq, LAS unsigned char* ldsraw) {
    LAS float* lds = (LAS float*)ldsraw;
    for (int u = blockIdx.x; u < 8 * NSEG; u += gridDim.x) chain_unit<0>(p, cva, u, u >> 3, u & 7, lds);
    LAS int* slot = (LAS int*)(ldsraw + 8 * 128 * 66 * 2);
    const int ptid = phase_tid(), wv = ptid >> 6, lane = ptid & 63;
    LAS bf16_t* ktT = (LAS bf16_t*)ldsraw + (size_t)wv * 128 * 66;
    for (;;) {
        __syncthreads();
        if (ptid == 0) slot[0] = (int)__hip_atomic_fetch_add(sbq, 8u, __ATOMIC_RELAXED, __HIP_MEMORY_SCOPE_AGENT);
        __syncthreads();
        const int base = slot[0];
        if (base >= 2048) break;
        const int u = base + wv; if (u < 1024) intra_unit<128>(p, u & 3, u >> 2, ktT, lane); else intra_unit<64>(p, (u - 1024) & 3, (u - 1024) >> 2, ktT, lane);
    }
}
__device__ __forceinline__ void sb_queue(const MixArgs& p, unsigned* sbq2, LAS unsigned char* ldsraw) {
    LAS int* slot = (LAS int*)(ldsraw + 8 * 128 * 66 * 2);
    const int ptid = phase_tid();
    for (;;) {
        __syncthreads();
        if (ptid == 0) slot[0] = (int)__hip_atomic_fetch_add(sbq2, 8u, __ATOMIC_RELAXED, __HIP_MEMORY_SCOPE_AGENT);
        __syncthreads();
        const int base = slot[0];
        if (base >= 2048) break;
        sb_phase(p, base, 1 << 30, 2048);
    }
}

__device__ __forceinline__ void carry_phase(const MixArgs& p, LAS unsigned char* ldsraw, const int part) {
    const int tid = phase_tid();
    if (part != 2) for (int u = blockIdx.x; u < 16; u += gridDim.x) {
        if (u < 8) {
            const int h = u;
            LAS float (*cur)[68] = (LAS float (*)[68])ldsraw; LAS float (*Pm)[68] = (LAS float (*)[68])(ldsraw + 64 * 68 * 4);
            const int v = tid >> 3, kb = (tid & 7) * 8;
            const size_t eo = (size_t)v * 64 + kb;
            float nv[8], nP[8], nS[8];
            { const f32x4v a0 = *(const f32x4v*)(p.SendR + ((size_t)0 * 8 + h) * 4096 + eo), a1 = *(const f32x4v*)(p.SendR + ((size_t)0 * 8 + h) * 4096 + eo + 4);
              nv[0] = a0.x; nv[1] = a0.y; nv[2] = a0.z; nv[3] = a0.w; nv[4] = a1.x; nv[5] = a1.y; nv[6] = a1.z; nv[7] = a1.w; }
            { const f32x4v a0 = *(const f32x4v*)(p.PendR + ((size_t)1 * 8 + h) * 4096 + eo), a1 = *(const f32x4v*)(p.PendR + ((size_t)1 * 8 + h) * 4096 + eo + 4);
              nP[0] = a0.x; nP[1] = a0.y; nP[2] = a0.z; nP[3] = a0.w; nP[4] = a1.x; nP[5] = a1.y; nP[6] = a1.z; nP[7] = a1.w;
              const f32x4v b0 = *(const f32x4v*)(p.SendR + ((size_t)1 * 8 + h) * 4096 + eo), b1 = *(const f32x4v*)(p.SendR + ((size_t)1 * 8 + h) * 4096 + eo + 4);
              nS[0] = b0.x; nS[1] = b0.y; nS[2] = b0.z; nS[3] = b0.w; nS[4] = b1.x; nS[5] = b1.y; nS[6] = b1.z; nS[7] = b1.w; }
            for (int s = 1; s < NSEG; ++s) {
                __syncthreads();
                { pg8::u32x4 w; w.x = pg8::cvt_pk_bf16(nv[0], nv[1]); w.y = pg8::cvt_pk_bf16(nv[2], nv[3]); w.z = pg8::cvt_pk_bf16(nv[4], nv[5]); w.w = pg8::cvt_pk_bf16(nv[6], nv[7]);
                  *(pg8::u32x4*)(p.SstR + ((size_t)s * 8 + h) * 4096 + eo) = w; }
                if (s == NSEG - 1) break;
#pragma unroll
                for (int e = 0; e < 8; ++e) { cur[v][kb + e] = nv[e]; Pm[v][kb + e] = nP[e]; nv[e] = nS[e]; }
                __syncthreads();
                if (s + 1 < NSEG - 1) {
                    const f32x4v a0 = *(const f32x4v*)(p.PendR + ((size_t)(s + 1) * 8 + h) * 4096 + eo), a1 = *(const f32x4v*)(p.PendR + ((size_t)(s + 1) * 8 + h) * 4096 + eo + 4);
                    nP[0] = a0.x; nP[1] = a0.y; nP[2] = a0.z; nP[3] = a0.w; nP[4] = a1.x; nP[5] = a1.y; nP[6] = a1.z; nP[7] = a1.w;
                    const f32x4v b0 = *(const f32x4v*)(p.SendR + ((size_t)(s + 1) * 8 + h) * 4096 + eo), b1 = *(const f32x4v*)(p.SendR + ((size_t)(s + 1) * 8 + h) * 4096 + eo + 4);
                    nS[0] = b0.x; nS[1] = b0.y; nS[2] = b0.z; nS[3] = b0.w; nS[4] = b1.x; nS[5] = b1.y; nS[6] = b1.z; nS[7] = b1.w;
                }
#pragma unroll 4
                for (int i4 = 0; i4 < 64; i4 += 4) { const f32x4v c4 = *(const LAS f32x4v*)&cur[v][i4];
#pragma unroll
                    for (int ii = 0; ii < 4; ++ii) { const f32x4v p0 = *(const LAS f32x4v*)&Pm[i4 + ii][kb], p1 = *(const LAS f32x4v*)&Pm[i4 + ii][kb + 4]; const float c = c4[ii];
                        nv[0] += c * p0.x; nv[1] += c * p0.y; nv[2] += c * p0.z; nv[3] += c * p0.w; nv[4] += c * p1.x; nv[5] += c * p1.y; nv[6] += c * p1.z; nv[7] += c * p1.w; } }
            }
            __syncthreads();
        }
    }
    if (part != 1) for (int u = blockIdx.x; u < 8 + 192; u += gridDim.x) {
        if (u < 8) continue;
        const bool isH = u < 8 + 128; const int idx = (isH ? (u - 8) : (u - 136)) * 512 + tid;
        const float* Ub = (isH ? p.SendH : p.SendG) + idx; bf16_t* Sb = (isH ? p.SstH : p.SstG) + idx; const size_t cstr = isH ? 65536 : 32768;
        const float* Gb = isH ? p.GamH + (idx >> 14) * 128 + (idx & 127) : p.GamG + (idx >> 13) * 64 + (idx & 63); const int gstr = isH ? 512 : 256;
        float S = 0.f;
        float uu[16], gg[16], un[16], gn[16];
#pragma unroll
        for (int j = 0; j < 16; ++j) { un[j] = Ub[(size_t)j * cstr]; gn[j] = Gb[(size_t)j * gstr]; }
        for (int c0 = 0; c0 < NCHK; c0 += 16) {
#pragma unroll
            for (int j = 0; j < 16; ++j) { uu[j] = un[j]; gg[j] = gn[j]; }
            if (c0 + 16 < NCHK) {
#pragma unroll
                for (int j = 0; j < 16; ++j) { un[j] = Ub[(size_t)(c0 + 16 + j) * cstr]; gn[j] = Gb[(size_t)(c0 + 16 + j) * gstr]; } }
#pragma unroll
            for (int j = 0; j < 16; ++j) { Sb[(size_t)(c0 + j) * cstr] = f2bf(S); S = gg[j] * (S + uu[j]); }
        }
    }
}

__device__ __forceinline__ void mixfin_phase(const MixArgs& p) {
    typedef short bf16x8v __attribute__((ext_vector_type(8)));
    const int tid = phase_tid(), wv = tid >> 6, lane = tid & 63, r = lane & 15, q = lane >> 4, L = p.layer;
    const int W = gridDim.x * 8;
    for (int u = blockIdx.x * 8 + wv; u < 16384; u += W) {
        if (u < 8192) {
            const int tt = u >> 3, h = u & 7, t0 = tt * 16, seg = t0 / LSEG;
            f32x4v acc[4];
#pragma unroll
            for (int nb = 0; nb < 4; ++nb) acc[nb] = (f32x4v){0.f, 0.f, 0.f, 0.f};
            if (seg >= 1) {
#pragma unroll
                for (int ks = 0; ks < 2; ++ks) { const bf16x8v A = *(const bf16x8v*)(p.cR + (size_t)(t0 + r) * 512 + h * 64 + ks * 32 + q * 8);
#pragma unroll
                    for (int nb = 0; nb < 4; ++nb) { const bf16x8v B = *(const bf16x8v*)(p.SstR + (((size_t)seg * 8 + h) * 64 + nb * 16 + r) * 64 + ks * 32 + q * 8);
                        acc[nb] = __builtin_amdgcn_mfma_f32_16x16x32_bf16(A, B, acc[nb], 0, 0, 0); } }
            }
#pragma unroll
            for (int i = 0; i < 4; ++i) { const size_t t = (size_t)t0 + 4 * q + i; float o[4]; float s = 0.f;
#pragma unroll
                for (int nb = 0; nb < 4; ++nb) { o[nb] = acc[nb][i] + p.oR[t * 512 + h * 64 + nb * 16 + r]; s += o[nb]; }
                const float mu = red16(s) * (1.0f / 64.0f); float d2 = 0.f;
#pragma unroll
                for (int nb = 0; nb < 4; ++nb) { o[nb] -= mu; d2 += o[nb] * o[nb]; }
                const float rstd = rsqrtf(red16(d2) * (1.0f / 64.0f) + 64e-5f);
#pragma unroll
                for (int nb = 0; nb < 4; ++nb) { const int c = h * 64 + nb * 16 + r; const float y = o[nb] * rstd * p.rw_ln_w[L * 512 + c] + p.rw_ln_b[L * 512 + c];
                    p.bo[(size_t)T * 512 + t * 512 + c] = f2bf((y + p.rBonus[t * 512 + c]) * p.rGate[t * 512 + c]); } }
        } else {
            const bool isH = u < 12288; const int qq = isH ? u - 8192 : u - 12288;
            const int tt = qq >> 2, h = qq & 3, t0 = tt * 16, seg = t0 >> 6;
            f32x4v acc[8];
#pragma unroll
            for (int nb = 0; nb < 8; ++nb) acc[nb] = (f32x4v){0.f, 0.f, 0.f, 0.f};
            if (seg >= 1) {
                if (isH) {
#pragma unroll
                    for (int ks = 0; ks < 4; ++ks) { const bf16x8v A = *(const bf16x8v*)(p.cH + (size_t)(t0 + r) * 512 + h * 128 + ks * 32 + q * 8);
#pragma unroll
                        for (int nb = 0; nb < 8; ++nb) { const bf16x8v B = *(const bf16x8v*)(p.SstH + (((size_t)seg * 4 + h) * 128 + nb * 16 + r) * 128 + ks * 32 + q * 8);
                            acc[nb] = __builtin_amdgcn_mfma_f32_16x16x32_bf16(A, B, acc[nb], 0, 0, 0); } }
                } else {
#pragma unroll
                    for (int ks = 0; ks < 2; ++ks) { const bf16x8v A = *(const bf16x8v*)(p.cG + (size_t)(t0 + r) * 256 + h * 64 + ks * 32 + q * 8);
#pragma unroll
                        for (int nb = 0; nb < 8; ++nb) { const bf16x8v B = *(const bf16x8v*)(p.SstG + (((size_t)seg * 4 + h) * 128 + nb * 16 + r) * 64 + ks * 32 + q * 8);
                            acc[nb] = __builtin_amdgcn_mfma_f32_16x16x32_bf16(A, B, acc[nb], 0, 0, 0); } }
                }
            }
            const float* ol = isH ? p.oH : p.oG; const float* gain = (isH ? p.hg_norm_w : p.gla_norm_w) + L * 512; const int gcol = isH ? HG_G : GL_R;
            bf16_t* bo = p.bo + (isH ? (size_t)0 : (size_t)3 * T * 512);
#pragma unroll
            for (int i = 0; i < 4; ++i) { const size_t t = (size_t)t0 + 4 * q + i; float o[8]; float ss = 0.f;
#pragma unroll
                for (int nb = 0; nb < 8; ++nb) { o[nb] = acc[nb][i] + ol[t * 512 + h * 128 + nb * 16 + r]; ss += o[nb] * o[nb]; }
                const float rs = rsqrtf(red16(ss) * (1.0f / 128.0f) + 1e-5f);
#pragma unroll
                for (int nb = 0; nb < 8; ++nb) { const int c = h * 128 + nb * 16 + r; const float g = bf2f(p.z[t * ZLD + gcol + c]);
                    bo[t * 512 + c] = f2bf(o[nb] * rs * gain[c] * siluf_(g)); } }
        }
    }
}
__device__ __forceinline__ void sb_phase(const MixArgs& p, const int wave0, const int W, const int uend) {
    typedef short bf16x8v __attribute__((ext_vector_type(8)));
    typedef float f32x16v __attribute__((ext_vector_type(16)));
    typedef __bf16 bf16x2n __attribute__((ext_vector_type(2)));
    const int tid = phase_tid(), wv = tid >> 6, lane = tid & 63, r = lane & 31, hh = lane >> 5;
    const float scale = 0.08838834764831845f;
    for (int u = wave0 + wv; u < uend; u += W) {
        const int h = u & 3, qb = u >> 2, q0 = qb * 32;
        bf16x8v Qf[8];
#pragma unroll
        for (int s = 0; s < 8; ++s) Qf[s] = *(const bf16x8v*)(p.z + (size_t)(q0 + r) * ZLD + SB_Q + h * 128 + s * 16 + hh * 8);
        f32x16v O[4];
#pragma unroll
        for (int db = 0; db < 4; ++db)
#pragma unroll
            for (int i = 0; i < 16; ++i) O[db][i] = 0.f;
        float R = 0.f;
        for (int kb = qb; kb >= 0; --kb) {
            const int k0 = kb * 32;
            f32x16v Sacc;
#pragma unroll
            for (int i = 0; i < 16; ++i) Sacc[i] = 0.f;
#pragma unroll
            for (int s = 0; s < 8; ++s) { const bf16x8v Kf = *(const bf16x8v*)(p.z + (size_t)(k0 + r) * ZLD + SB_K + h * 128 + s * 16 + hh * 8);
                Sacc = __builtin_amdgcn_mfma_f32_32x32x16_bf16(Kf, Qf[s], Sacc, 0, 0, 0); }
            float lk[16], zz[16]; bool valid[16];
            const bool diag = (kb == qb);
#pragma unroll
            for (int i = 0; i < 16; ++i) { const int kr = (i & 3) + 8 * (i >> 2) + 4 * hh;
                valid[i] = !diag || (kr < r);
                zz[i] = Sacc[i] * scale;
                const float sp = fmaxf(zz[i], 0.f) + __logf(1.0f + __expf(-fabsf(zz[i])));
                lk[i] = valid[i] ? -sp : 0.f; }
            float G[4], Gp[4];
#pragma unroll
            for (int g = 0; g < 4; ++g) { G[g] = (lk[4 * g] + lk[4 * g + 1]) + (lk[4 * g + 2] + lk[4 * g + 3]); Gp[g] = __shfl_xor(G[g], 32); }
            float Tq[4]; float run = 0.f;
#pragma unroll
            for (int g = 3; g >= 0; --g) { Tq[g] = run + (hh == 0 ? Gp[g] : 0.f); run += G[g] + Gp[g]; }
            float wgt[16];
#pragma unroll
            for (int g = 0; g < 4; ++g) { float ing = 0.f;
#pragma unroll
                for (int j = 3; j >= 0; --j) { const int i = 4 * g + j;
                    const float logw = zz[i] + lk[i] + (R + Tq[g] + ing);
                    wgt[i] = valid[i] ? __expf(logw) : 0.f;
                    ing += lk[i]; } }
            R += run;
            bf16x8v Pf[2];
#pragma unroll
            for (int s2 = 0; s2 < 2; ++s2) {
                union { bf16x2n h2[4]; bf16x8v v; } pk;
#pragma unroll
                for (int j = 0; j < 4; ++j) { f32x2v f; f.x = wgt[8 * s2 + 2 * j]; f.y = wgt[8 * s2 + 2 * j + 1]; pk.h2[j] = __builtin_convertvector(f, bf16x2n); }
                Pf[s2] = pk.v; }
#pragma unroll
            for (int db = 0; db < 4; ++db)
#pragma unroll
                for (int s2 = 0; s2 < 2; ++s2) { const bf16_t* vp = p.Vt + (size_t)(h * 128 + db * 32 + r) * T + k0 + 16 * s2 + 4 * hh;
                    union { pg8::u32x2 d[2]; bf16x8v v; } vf; vf.d[0] = *(const pg8::u32x2*)vp; vf.d[1] = *(const pg8::u32x2*)(vp + 8);
                    O[db] = __builtin_amdgcn_mfma_f32_32x32x16_bf16(vf.v, Pf[s2], O[db], 0, 0, 0); }
            if (__all(R < -104.0f)) break;
        }
        bf16_t* bo2 = p.bo + (size_t)2 * T * 512 + (size_t)(q0 + r) * 512 + h * 128;
#pragma unroll
        for (int db = 0; db < 4; ++db)
#pragma unroll
            for (int g = 0; g < 4; ++g) { pg8::u32x2 w; w.x = (unsigned)f2bf(O[db][4 * g]) | ((unsigned)f2bf(O[db][4 * g + 1]) << 16); w.y = (unsigned)f2bf(O[db][4 * g + 2]) | ((unsigned)f2bf(O[db][4 * g + 3]) << 16);
                *(pg8::u32x2*)(bo2 + db * 32 + 8 * g + 4 * hh) = w; }
    }
}

#define XB_TMO      128
#define XB_XCNT(j)  (256  + 64 * (j))
#define XB_XSUB(j)  (1280 + 64 * (j))
#define XB_XGEN(j)  (2304 + 64 * (j))
#define XB_TOP      3328
#define XB_TOPGEN   3392
#define XCD_BAR_WORDS 3456
#define XB_SPIN_CAP (1u << 18)
__device__ __forceinline__ unsigned xb_ld(unsigned* p)              { return __hip_atomic_load(p, __ATOMIC_RELAXED, __HIP_MEMORY_SCOPE_AGENT); }
__device__ __forceinline__ unsigned xb_add(unsigned* p, unsigned v) { return __hip_atomic_fetch_add(p, v, __ATOMIC_RELAXED, __HIP_MEMORY_SCOPE_AGENT); }
__device__ __forceinline__ unsigned xb_xcc_id() { return (unsigned)__builtin_amdgcn_s_getreg((3 << 11) | 20) & 0xFu; }
#define XB_SPIN(cond, bar) do { unsigned _sp = 0; while (cond) { __builtin_amdgcn_s_sleep(1); \
    if ((++_sp & 255u) == 0u) { if (xb_ld(&(bar)[XB_TMO])) break; if (_sp > XB_SPIN_CAP) { atomicAdd(&(bar)[XB_TMO], 1u); break; } } } } while (0)
struct XcdBarrier { unsigned* bar; unsigned x; volatile LAS unsigned* st; };
__device__ __forceinline__ XcdBarrier xcd_barrier_post(unsigned* bar, volatile LAS unsigned* st) {
    XcdBarrier b; b.bar = bar; b.x = xb_xcc_id(); b.st = st;
    if (threadIdx.x == 0) (void)xb_add(&bar[XB_XCNT(b.x)], 1u);
    return b;
}
__device__ __forceinline__ void xcd_barrier_complete(unsigned* bar, unsigned x, unsigned& nloc, unsigned& nx) {
    const unsigned G = gridDim.x * gridDim.y * gridDim.z;
    unsigned sum, cnt, mine, sp = 0u;
    for (;;) {
        sum = 0u; cnt = 0u; mine = 0u;
#pragma unroll
        for (unsigned j = 0; j < 16; ++j) { const unsigned c = xb_ld(&bar[XB_XCNT(j)]); sum += c; cnt += (c > 0u) ? 1u : 0u; mine = (j == x) ? c : mine; }
        if (sum == G) break;
        __builtin_amdgcn_s_sleep(1);
        if ((++sp & 255u) == 0u) { if (xb_ld(&bar[XB_TMO])) break; if (sp > XB_SPIN_CAP) { atomicAdd(&bar[XB_TMO], 1u); break; } }
    }
    nloc = mine > 0u ? mine : 1u; nx = cnt > 0u ? cnt : 1u;
}
__device__ __forceinline__ void xcd_barrier(const XcdBarrier& b) {
    asm volatile("s_waitcnt vmcnt(0)" ::: "memory");
    __syncthreads();
    if (threadIdx.x == 0) {
        unsigned* bar = b.bar;
        __builtin_amdgcn_s_waitcnt(0);
        unsigned nloc = b.st[0], nx = b.st[1];
        if (nloc == 0u) { xcd_barrier_complete(bar, b.x, nloc, nx); b.st[0] = nloc; b.st[1] = nx; }
        const unsigned old = xb_add(&bar[XB_XSUB(b.x)], 1u);
        const unsigned gen = old / nloc;
        if (old + 1u == (gen + 1u) * nloc) {
            __builtin_amdgcn_fence(__ATOMIC_RELEASE, "agent");
            asm volatile("s_waitcnt vmcnt(0)" ::: "memory");
            const unsigned og = xb_add(&bar[XB_TOP], 1u);
            const unsigned tg = og / nx;
            if (og + 1u == (tg + 1u) * nx) xb_add(&bar[XB_TOPGEN], 1u);
            else XB_SPIN(xb_ld(&bar[XB_TOPGEN]) == tg, bar);
            __builtin_amdgcn_fence(__ATOMIC_ACQUIRE, "agent");
            xb_add(&bar[XB_XGEN(b.x)], 1u);
            asm volatile("s_waitcnt vmcnt(0)" ::: "memory");
        } else {
            XB_SPIN(xb_ld(&bar[XB_XGEN(b.x)]) == gen, bar);
            __builtin_amdgcn_fence(__ATOMIC_ACQUIRE, "agent");
            asm volatile("s_waitcnt vmcnt(0)" ::: "memory");
        }
    }
    __syncthreads();
}


constexpr size_t al256(size_t x) { return (x + 255) & ~(size_t)255; }
constexpr size_t TS_ = (size_t)T * 512 * 4;
constexpr size_t OFF_BAR = 0;
constexpr size_t OFF_Z = al256(OFF_BAR + 3456 * 4);
constexpr size_t OFF_RS = OFF_Z + al256((size_t)T * ZLD * 2);
constexpr size_t OFF_XB = al256(OFF_RS + (size_t)8 * T * 384 * 4);
constexpr size_t OFF_REGM = al256(OFF_XB + (size_t)T * D * 2);
constexpr size_t OFF_KH = OFF_REGM, OFF_KG = OFF_KH + (size_t)T * 512 * 2, OFF_VTH = OFF_KG + (size_t)T * 256 * 2, OFF_VTG = OFF_VTH + (size_t)512 * T * 2, OFF_VT = OFF_VTG + (size_t)512 * T * 2;
constexpr size_t OFF_RGATE = OFF_VT + (size_t)512 * T * 2, OFF_RBONUS = OFF_RGATE + TS_;
constexpr size_t OFF_SENDH = OFF_RBONUS + TS_, OFF_SENDG = OFF_SENDH + (size_t)NCHK * 4 * 128 * 128 * 4, OFF_SSTH = OFF_SENDG + (size_t)NCHK * 4 * 128 * 64 * 4, OFF_SSTG = OFF_SSTH + (size_t)NCHK * 4 * 128 * 128 * 2;
constexpr size_t OFF_GAMH = OFF_SSTG + (size_t)NCHK * 4 * 128 * 64 * 2, OFF_GAMG = OFF_GAMH + (size_t)NCHK * 4 * 128 * 4, OFF_REGM_END = OFF_GAMG + (size_t)NCHK * 4 * 64 * 4;
constexpr size_t OFF_HBUF = OFF_REGM, OFF_X1 = OFF_REGM + (size_t)MAXROWS * FW * 2;
constexpr size_t OFF_OR = al256(OFF_REGM + (size_t)MAXROWS * FW * 2 + (size_t)T * D * 4);
constexpr size_t OFF_OH = OFF_OR + TS_, OFF_OG = OFF_OH + TS_, OFF_CR = OFF_OG + TS_, OFF_CH = OFF_CR + TS_ / 2, OFF_CG = OFF_CH + TS_ / 2;
constexpr size_t OFF_SENDR = OFF_CG + TS_ / 4, OFF_PENDR = OFF_SENDR + (size_t)NSEG * 8 * 64 * 64 * 4, OFF_SSTR = OFF_PENDR + (size_t)NSEG * 8 * 64 * 64 * 4;
constexpr size_t OFF_BO = al256(OFF_SSTR + (size_t)NSEG * 8 * 64 * 64 * 2);
constexpr size_t OFF_MERGED = OFF_BO + 4 * (size_t)T * 512 * 2, OFF_MERGEDB = OFF_MERGED + (size_t)T * D * 4, OFF_X1B = OFF_MERGEDB + (size_t)T * D * 2;
constexpr size_t OFF_WINT = OFF_X1B + (size_t)T * D * 2, OFF_WGUT = OFF_WINT + (size_t)ZLD * D * 2, OFF_WDT = OFF_WGUT + (size_t)65 * 1024 * D * 2, OFF_WBRT = OFF_WDT + (size_t)65 * D * FW * 2, OFF_WOUTT = OFF_WBRT + (size_t)4 * D * FW * 2;
constexpr size_t OFF_IDX = OFF_WOUTT + (size_t)D * D * 2, OFF_WSEL = OFF_IDX + (size_t)T * 8 * 4, OFF_HIST = OFF_WSEL + (size_t)T * 8 * 4, OFF_ROWTOK = OFF_HIST + 256 * 64 * 4;
constexpr size_t OFF_ROWW = OFF_ROWTOK + (size_t)MAXROWS * 4, OFF_SLOTPOS = OFF_ROWW + (size_t)MAXROWS * 4, OFF_PANEXP = OFF_SLOTPOS + (size_t)T * 8 * 4, OFF_NPAN = al256(OFF_PANEXP + MAXPANELS * 4);
constexpr size_t OFF_WRH = OFF_NPAN + 256, OFF_WRL = OFF_WRH + (size_t)2 * NE * D * 2;
constexpr size_t OFF_W2T = OFF_WRL + (size_t)2 * NE * D * 2, OFF_A2T = OFF_W2T + (size_t)2 * 512 * 32 * 2, OFF_G2T = OFF_A2T + (size_t)2 * 512 * 32 * 2, OFF_GGT = OFF_G2T + (size_t)2 * 512 * 96 * 2;
constexpr size_t WS_NEEDED = OFF_GGT + (size_t)2 * 256 * 32 * 2;
static_assert(OFF_RS + (size_t)8 * T * 384 * 4 - OFF_Z >= (size_t)MAXROWS * D * 2, "ybuf must fit in region Y");
static_assert(OFF_REGM_END <= OFF_OR, "region M");
static_assert(OFF_VTG == OFF_VTH + (size_t)512 * T * 2 && OFF_VT == OFF_VTG + (size_t)512 * T * 2, "prep writes VtH, VtG, Vt as one array of three");
__device__ __forceinline__ void ln_row(const float (&v)[32], float s, const float* __restrict__ w, const float* __restrict__ b, float* __restrict__ outf, bf16_t* __restrict__ outb, int lane) {
    const float mu = wave_sum(s) * (1.0f / D);
    float q = 0.f;
#pragma unroll
    for (int i = 0; i < 32; ++i) { const float d = v[i] - mu; q += d * d; }
    const float rstd = rsqrtf(wave_sum(q) * (1.0f / D) + 1e-5f);
#pragma unroll
    for (int i = 0; i < 8; ++i) {
        const unsigned c = (unsigned)(i * 256 + lane * 4);
        const float4 ww = *(const float4*)(w + c), bb = *(const float4*)(b + c);
        float4 o; o.x = (v[4 * i] - mu) * rstd * ww.x + bb.x; o.y = (v[4 * i + 1] - mu) * rstd * ww.y + bb.y; o.z = (v[4 * i + 2] - mu) * rstd * ww.z + bb.z; o.w = (v[4 * i + 3] - mu) * rstd * ww.w + bb.w;
        *(float4*)(outf + c) = o;
        if (outb) { pg8::u32x2 pk; pk.x = pg8::cvt_pk_bf16(o.x, o.y); pk.y = pg8::cvt_pk_bf16(o.z, o.w); *(pg8::u32x2*)(outb + c) = pk; }
    }
}
struct KArgs {
    const float* in[32]; char* ws; float* out;
};
struct MegaArgs {
    MixArgs mix;
    const float *x_in, *w_in, *w_br, *w_out, *ln1_w, *ln1_b, *w_router, *router_bias, *we_gate, *we_up, *we_down, *ws_gate, *ws_up, *ws_down, *ln2_w, *ln2_b;
    bf16_t *xb, *WinT, *WguT, *WdT, *WbrT, *WoutT, *mergedb, *x1b, *hbuf, *ybuf, *WrH, *WrL;
    float *merged, *x1, *out;
    int* idx; float* wsel; int *hist, *row_tok; float* row_w; int *slotpos, *panel_expert, *npanels;
    unsigned* bar;
};
__host__ __device__ __forceinline__ MegaArgs make_args(const KArgs& k) {
    MegaArgs a; char* ws = k.ws;
    a.x_in = k.in[0]; a.w_in = k.in[1];
    a.mix.hg_lb_logits = k.in[2]; a.mix.hg_norm_w = k.in[3]; a.mix.rw_mu = k.in[4]; a.mix.rw_w0 = k.in[5]; a.mix.rw_w2 = k.in[6]; a.mix.rw_a0 = k.in[7]; a.mix.rw_a2 = k.in[8]; a.mix.rw_g2 = k.in[9];
    a.mix.rw_kk = k.in[10]; a.mix.rw_ka = k.in[11]; a.mix.rw_rk = k.in[12]; a.mix.rw_ln_w = k.in[13]; a.mix.rw_ln_b = k.in[14]; a.mix.gla_g2 = k.in[15]; a.mix.gla_gb = k.in[16]; a.mix.gla_norm_w = k.in[17];
    a.w_br = k.in[18]; a.w_out = k.in[19]; a.ln1_w = k.in[20]; a.ln1_b = k.in[21]; a.w_router = k.in[22]; a.router_bias = k.in[23]; a.we_gate = k.in[24]; a.we_up = k.in[25]; a.we_down = k.in[26];
    a.ws_gate = k.in[27]; a.ws_up = k.in[28]; a.ws_down = k.in[29]; a.ln2_w = k.in[30]; a.ln2_b = k.in[31];
    a.bar = (unsigned*)(ws + OFF_BAR);
    a.mix.z = (const bf16_t*)(ws + OFF_Z); a.mix.RS = (float*)(ws + OFF_RS); a.ybuf = (bf16_t*)(ws + OFF_Z); a.xb = (bf16_t*)(ws + OFF_XB);
    a.mix.KH = (bf16_t*)(ws + OFF_KH); a.mix.KG = (bf16_t*)(ws + OFF_KG); a.mix.VtH = (bf16_t*)(ws + OFF_VTH); a.mix.VtG = (bf16_t*)(ws + OFF_VTG); a.mix.Vt = (bf16_t*)(ws + OFF_VT); a.mix.rGate = (float*)(ws + OFF_RGATE); a.mix.rBonus = (float*)(ws + OFF_RBONUS);
    a.hbuf = (bf16_t*)(ws + OFF_HBUF); a.x1 = (float*)(ws + OFF_X1);
    a.mix.oR = (float*)(ws + OFF_OR); a.mix.oH = (float*)(ws + OFF_OH); a.mix.oG = (float*)(ws + OFF_OG); a.mix.cR = (bf16_t*)(ws + OFF_CR); a.mix.cH = (bf16_t*)(ws + OFF_CH); a.mix.cG = (bf16_t*)(ws + OFF_CG);
    a.mix.SendR = (float*)(ws + OFF_SENDR); a.mix.PendR = (float*)(ws + OFF_PENDR); a.mix.SendH = (float*)(ws + OFF_SENDH); a.mix.SendG = (float*)(ws + OFF_SENDG); a.mix.GamH = (float*)(ws + OFF_GAMH); a.mix.GamG = (float*)(ws + OFF_GAMG);
    a.mix.SstR = (bf16_t*)(ws + OFF_SSTR); a.mix.SstH = (bf16_t*)(ws + OFF_SSTH); a.mix.SstG = (bf16_t*)(ws + OFF_SSTG);
    a.mix.bo = (bf16_t*)(ws + OFF_BO); a.merged = (float*)(ws + OFF_MERGED); a.mergedb = (bf16_t*)(ws + OFF_MERGEDB); a.x1b = (bf16_t*)(ws + OFF_X1B); a.out = k.out;
    a.WinT = (bf16_t*)(ws + OFF_WINT); a.WguT = (bf16_t*)(ws + OFF_WGUT); a.WdT = (bf16_t*)(ws + OFF_WDT); a.WbrT = (bf16_t*)(ws + OFF_WBRT); a.WoutT = (bf16_t*)(ws + OFF_WOUTT);
    a.idx = (int*)(ws + OFF_IDX); a.wsel = (float*)(ws + OFF_WSEL); a.hist = (int*)(ws + OFF_HIST); a.row_tok = (int*)(ws + OFF_ROWTOK); a.row_w = (float*)(ws + OFF_ROWW);
    a.slotpos = (int*)(ws + OFF_SLOTPOS); a.panel_expert = (int*)(ws + OFF_PANEXP); a.npanels = (int*)(ws + OFF_NPAN);
    a.WrH = (bf16_t*)(ws + OFF_WRH); a.WrL = (bf16_t*)(ws + OFF_WRL);
    a.mix.W2T = (const bf16_t*)(ws + OFF_W2T); a.mix.A2T = (const bf16_t*)(ws + OFF_A2T); a.mix.G2T = (const bf16_t*)(ws + OFF_G2T); a.mix.GGT = (const bf16_t*)(ws + OFF_GGT);
    a.mix.LW = (float*)(ws + OFF_MERGED); a.mix.LA = a.mix.LW + (size_t)T * 512; a.mix.LG = a.mix.LA + (size_t)T * 512; a.mix.LL = a.mix.LG + (size_t)T * 512;
    a.mix.layer = 0; a.mix.pad_ = 0;
    return a;
}
__device__ __forceinline__ void ln_router_phase(const MegaArgs& a, int L, LAS unsigned char* ldsraw) {
    LAS int* hs = (LAS int*)ldsraw;
    const int tid = phase_tid(), lane = tid & 63, wv = __builtin_amdgcn_readfirstlane(tid >> 6);
    const float* pre = a.merged; const float* wr = a.w_router + (size_t)L * D * NE;
    const float bias = a.router_bias[L * NE + lane];
    for (int vb = blockIdx.x; vb < 256; vb += gridDim.x) {
        __syncthreads();
        if (tid < 64) hs[tid] = 0;
        for (int i = 0; i < 8; ++i) {
            const size_t row = (size_t)vb * 64 + wv * 8 + i;
            const float* p = pre + row * D; float v[32]; float s = 0.f;
#pragma unroll
            for (int j = 0; j < 8; ++j) { const float4 x = *(const float4*)(p + j * 256 + lane * 4); v[4 * j] = x.x; v[4 * j + 1] = x.y; v[4 * j + 2] = x.z; v[4 * j + 3] = x.w; s += (x.x + x.y) + (x.z + x.w); }
            ln_row(v, s, a.ln1_w + L * D, a.ln1_b + L * D, a.x1 + row * D, a.x1b + row * D, lane);
        }
        asm volatile("s_waitcnt vmcnt(0)" ::: "memory");
        __syncthreads();
        {
            typedef short bf16x8v __attribute__((ext_vector_type(8)));
            typedef __bf16 bf16x2n __attribute__((ext_vector_type(2)));
            const int tile = wv >> 1, khalf = wv & 1, r = lane & 15, q = lane >> 4;
            const float* xrow = a.x1 + (size_t)(vb * 64 + tile * 16 + r) * D + khalf * 1024 + q * 8;
            const bf16_t* bh = a.WrH + (size_t)L * NE * D + (size_t)r * D + khalf * 1024 + q * 8; const bf16_t* bl = a.WrL + (size_t)L * NE * D + (size_t)r * D + khalf * 1024 + q * 8;
            f32x4v acc[4];
#pragma unroll
            for (int nb = 0; nb < 4; ++nb) acc[nb] = (f32x4v){0.f, 0.f, 0.f, 0.f};
#pragma unroll 2
            for (int ks = 0; ks < 32; ++ks) {
                const float4 x0 = *(const float4*)(xrow + ks * 32), x1v = *(const float4*)(xrow + ks * 32 + 4);
                const float xs[8] = {x0.x, x0.y, x0.z, x0.w, x1v.x, x1v.y, x1v.z, x1v.w};
                union { bf16x2n h2[4]; bf16x8v v; } ah, al;
#pragma unroll
                for (int j = 0; j < 4; ++j) { f32x2v f; f.x = xs[2 * j]; f.y = xs[2 * j + 1]; const bf16x2n hh = __builtin_convertvector(f, bf16x2n); ah.h2[j] = hh;
                    const f32x2v back = __builtin_convertvector(hh, f32x2v); al.h2[j] = __builtin_convertvector(f - back, bf16x2n); }
#pragma unroll
                for (int nb = 0; nb < 4; ++nb) { const bf16x8v Bh = *(const bf16x8v*)(bh + (size_t)nb * 16 * D + ks * 32), Bl = *(const bf16x8v*)(bl + (size_t)nb * 16 * D + ks * 32);
                    acc[nb] = __builtin_amdgcn_mfma_f32_16x16x32_bf16(ah.v, Bh, acc[nb], 0, 0, 0);
                    acc[nb] = __builtin_amdgcn_mfma_f32_16x16x32_bf16(al.v, Bh, acc[nb], 0, 0, 0);
                    acc[nb] = __builtin_amdgcn_mfma_f32_16x16x32_bf16(ah.v, Bl, acc[nb], 0, 0, 0); }
            }
            LAS float* lg = (LAS float*)(ldsraw + 1024) + (size_t)((tile * 2 + khalf) * 16) * 64;
#pragma unroll
            for (int nb = 0; nb < 4; ++nb)
#pragma unroll
                for (int i = 0; i < 4; ++i) lg[(4 * q + i) * 64 + nb * 16 + r] = acc[nb][i];
        }
        __syncthreads();
        for (int it = 0; it < 8; ++it) {
            {
                const int tk = wv * 8 + it, t = vb * 64 + tk;
                const LAS float* lg = (const LAS float*)(ldsraw + 1024) + (size_t)(((tk >> 4) * 2) * 16 + (tk & 15)) * 64;
                const float logit = lg[lane] + lg[16 * 64 + lane];
                const float score = sigmoidf_(logit);
                const float biased = score + bias;
                float m1 = biased;
                m1 = fmaxf(m1, __shfl_xor(m1, 1)); m1 = fmaxf(m1, __shfl_xor(m1, 2)); m1 = fmaxf(m1, __shfl_xor(m1, 4));
                int am = (biased == m1) ? lane : 64;
                am = min(am, __shfl_xor(am, 1)); am = min(am, __shfl_xor(am, 2)); am = min(am, __shfl_xor(am, 4));
                float m2 = (lane == am) ? -INFINITY : biased;
                m2 = fmaxf(m2, __shfl_xor(m2, 1)); m2 = fmaxf(m2, __shfl_xor(m2, 2)); m2 = fmaxf(m2, __shfl_xor(m2, 4));
                const float gs = m1 + m2;
                const int g = lane >> 3;
                int grank = 0;
#pragma unroll
                for (int g2 = 0; g2 < 8; ++g2) { const float o = __shfl(gs, g2 * 8); grank += (o > gs || (o == gs && g2 < g)) ? 1 : 0; }
                const float masked = (grank < 4) ? biased : -INFINITY;
                int rank = 0;
                for (int e2 = 0; e2 < 64; ++e2) { const float o = rdlane(masked, e2); rank += (o > masked || (o == masked && e2 < lane)) ? 1 : 0; }
                const bool sel = rank < 8;
                const float ssum = wave_sum(sel ? score : 0.f);
                if (sel) { a.idx[(size_t)t * 8 + rank] = lane; a.wsel[(size_t)t * 8 + rank] = 2.5f * score / ssum; atomicAdd((int*)&hs[lane], 1); }
            }
        }
        __syncthreads();
        if (tid < 64) a.hist[vb * 64 + tid] = hs[tid];
    }
}
__device__ __forceinline__ void dispatch_phase(const MegaArgs& a, LAS unsigned char* ldsraw) {
    LAS int* tot = (LAS int*)ldsraw; LAS int* bef = tot + 64; LAS int* pstart = tot + 128; LAS int* es = tot + 192; LAS int* np_s = tot + 704; LAS int* ptot = tot + 768; LAS int* pbef = tot + 1280;
    const int tid = phase_tid();
    for (int blk = blockIdx.x; blk < 256; blk += gridDim.x) {
        __syncthreads();
        { const int part = tid >> 6, e = tid & 63; int b = 0, sm = 0;
#pragma unroll 8
          for (int j = part * 32; j < part * 32 + 32; ++j) { const int cc = a.hist[j * 64 + e]; if (j < blk) b += cc; sm += cc; }
          ptot[tid] = sm; pbef[tid] = b; }
        __syncthreads();
        if (tid < 64) { int sm = 0, b = 0;
#pragma unroll
            for (int pp = 0; pp < 8; ++pp) { sm += ptot[pp * 64 + tid]; b += pbef[pp * 64 + tid]; }
            tot[tid] = sm; bef[tid] = b; }
        __syncthreads();
        if (tid == 0) { int acc = 0; for (int e = 0; e < 64; ++e) { pstart[e] = acc; acc += (tot[e] + 255) / 256 * 256; } np_s[0] = acc / 256; }
        const int t = blk * 64 + (tid >> 3), k = tid & 7;
        const int e = a.idx[(size_t)t * 8 + k];
        es[tid] = e;
        __syncthreads();
        int rank = 0;
        for (int j = 0; j < tid; ++j) rank += (es[j] == e) ? 1 : 0;
        const int pos = pstart[e] + bef[e] + rank;
        a.row_tok[pos] = t; a.row_w[pos] = a.wsel[(size_t)t * 8 + k]; a.slotpos[(size_t)t * 8 + k] = pos;
        const int NP = np_s[0];
        if (blk < 64) {
            const int ee = blk, st = pstart[ee], cnt = tot[ee], pad = (cnt + 255) / 256 * 256;
            for (int r = st + cnt + tid; r < st + pad; r += 512) { a.row_tok[r] = 0; a.row_w[r] = 0.f; }
            for (int pp = st / 256 + tid; pp < (st + pad) / 256; pp += 512) a.panel_expert[pp] = ee;
        }
        if (tid < 64) { const int tt = blk * 64 + tid; a.row_tok[NP * 256 + tt] = tt; a.row_w[NP * 256 + tt] = 1.0f; }
        if (blk == 0) { if (tid < 64) a.panel_expert[NP + tid] = 64; if (tid == 0) a.npanels[0] = NP + 64; }
    }
}
__device__ __forceinline__ void combine_phase(const MegaArgs& a, int L, LAS unsigned char* ldsraw) {
    const int ptid = phase_tid(); const int lane = ptid & 63, wv = ptid >> 6, pair = wv >> 1, half = wv & 1;
    LAS float* part = (LAS float*)ldsraw;
    const unsigned shared_base = (unsigned)(a.npanels[0] - 64) * 256u;
    const float* lw = a.ln2_w + L * D; const float* lbp = a.ln2_b + L * D;
    int it = 0;
    for (int t0 = blockIdx.x * 4; t0 < T; t0 += gridDim.x * 4, ++it) {
        const unsigned t = (unsigned)(t0 + pair);
        unsigned rows[9];
#pragma unroll
        for (int k = 0; k < 8; ++k) rows[k] = (unsigned)a.slotpos[t * 8 + k] * (unsigned)D;
        rows[8] = (shared_base + t) * (unsigned)D;
        float wk[9];
#pragma unroll
        for (int k = 0; k < 8; ++k) wk[k] = a.wsel[t * 8 + k];
        wk[8] = 1.0f;
        float v[16]; float s1 = 0.f, s2 = 0.f;
#pragma unroll
        for (int i = 0; i < 4; ++i) {
            const unsigned c = (unsigned)(half * 1024 + i * 256 + lane * 4);
            const float4 x = *(const float4*)(a.x1 + t * (unsigned)D + c);
            float a0 = 0.f, a1 = 0.f, a2 = 0.f, a3 = 0.f;
#pragma unroll
            for (int k = 0; k < 9; ++k) { const uint2 u = *(const uint2*)(a.ybuf + (rows[k] + c));
                a0 += wk[k] * __uint_as_float(u.x << 16); a1 += wk[k] * __uint_as_float(u.x & 0xffff0000u); a2 += wk[k] * __uint_as_float(u.y << 16); a3 += wk[k] * __uint_as_float(u.y & 0xffff0000u); }
            v[4 * i] = ALPHA * x.x + a0; v[4 * i + 1] = ALPHA * x.y + a1; v[4 * i + 2] = ALPHA * x.z + a2; v[4 * i + 3] = ALPHA * x.w + a3;
#pragma unroll
            for (int j = 0; j < 4; ++j) { s1 += v[4 * i + j]; s2 += v[4 * i + j] * v[4 * i + j]; }
            if (i & 1) asm volatile("" ::: "memory");
        }
        s1 = wave_sum(s1); s2 = wave_sum(s2);
        LAS float* slot = part + (((it & 1) * 4 + pair) * 2) * 2;
        if (lane == 0) { slot[half * 2] = s1; slot[half * 2 + 1] = s2; }
        __syncthreads();
        const float S1 = slot[0] + slot[2], S2 = slot[1] + slot[3];
        const float mu = S1 * (1.0f / D);
        const float rstd = rsqrtf(fmaxf(S2 * (1.0f / D) - mu * mu, 0.f) + 1e-5f);
        float* outf = a.out + t * (unsigned)D; bf16_t* outb = a.xb + t * (unsigned)D;
#pragma unroll
        for (int i = 0; i < 4; ++i) {
            const unsigned c = (unsigned)(half * 1024 + i * 256 + lane * 4);
            const float4 ww = *(const float4*)(lw + c), bb = *(const float4*)(lbp + c);
            float4 o; o.x = (v[4 * i] - mu) * rstd * ww.x + bb.x; o.y = (v[4 * i + 1] - mu) * rstd * ww.y + bb.y; o.z = (v[4 * i + 2] - mu) * rstd * ww.z + bb.z; o.w = (v[4 * i + 3] - mu) * rstd * ww.w + bb.w;
            *(float4*)(outf + c) = o;
            if (L == 0) { pg8::u32x2 pk; pk.x = pg8::cvt_pk_bf16(o.x, o.y); pk.y = pg8::cvt_pk_bf16(o.z, o.w); *(pg8::u32x2*)(outb + c) = pk; }
        }
    }
}

constexpr int NPHASE = 13;
constexpr int LDS_GEMM = pg8::STAGE_BYTES + pg8::GTAB_BYTES;
constexpr int LDS_BARW = LDS_GEMM;
constexpr int LDS_PETAB = LDS_GEMM + 64;
constexpr int LDS_ARGS = LDS_GEMM + 16;
constexpr int LDS_BYTES = LDS_GEMM + 512;
__device__ __forceinline__ void args_to_lds(const KArgs& ka, LAS unsigned char* lds) {
    const int t = (int)threadIdx.x;
    if (t < 34) { const unsigned long long v = (t < 32) ? (unsigned long long)ka.in[t] : (t == 32 ? (unsigned long long)ka.ws : (unsigned long long)ka.out);
        *(LAS unsigned long long*)(lds + LDS_ARGS + t * 8) = v; }
}
__device__ __forceinline__ unsigned long long lds_ptr_load(LAS unsigned char* lds, int i) {
    const LAS unsigned* p = (const LAS unsigned*)(lds + LDS_ARGS + i * 8);
    const unsigned lo = (unsigned)__builtin_amdgcn_readfirstlane((int)p[0]), hi = (unsigned)__builtin_amdgcn_readfirstlane((int)p[1]);
    return ((unsigned long long)hi << 32) | lo;
}
template <int PH> __device__ __forceinline__ void run_phase(const KArgs& kin, const int Lp, LAS unsigned char* lds_in) {
    const int L = Lp & 15, part = Lp >> 4;
    LAS unsigned char* lds = lds_in; asm volatile("" : "+s"(lds));
    size_t z0 = 0; asm volatile("" : "+s"(z0));
    KArgs ka;
#pragma unroll
    for (int i = 0; i < 32; ++i) ka.in[i] = (const float*)((const char*)kin.in[i] + z0);
    ka.ws = kin.ws + z0; ka.out = (float*)((char*)kin.out + z0);
    const MegaArgs a = make_args(ka);
    int G = (int)gridDim.x, c = (int)blockIdx.x; asm volatile("" : "+s"(G), "+s"(c));
    if constexpr (PH == 0) {
        if (L == 0) { const size_t n4 = (size_t)T * D / 4; const int ptid = phase_tid(); for (size_t i = (size_t)c * 512 + ptid; i < n4; i += (size_t)G * 512) { const float4 v = *(const float4*)(a.x_in + 4 * i);
            pg8::u32x2 pk; pk.x = pg8::cvt_pk_bf16(v.x, v.y); pk.y = pg8::cvt_pk_bf16(v.z, v.w); *(pg8::u32x2*)(a.xb + 4 * i) = pk; } }
        ConvArgs ca; ca.w_in = a.w_in; ca.we_gate = a.we_gate; ca.we_up = a.we_up; ca.we_down = a.we_down; ca.ws_gate = a.ws_gate; ca.ws_up = a.ws_up; ca.ws_down = a.ws_down; ca.w_br = a.w_br; ca.w_out = a.w_out;
        ca.WinT = a.WinT; ca.WguT = a.WguT; ca.WdT = a.WdT; ca.WbrT = a.WbrT; ca.WoutT = a.WoutT; ca.layer = L; ca.pad_ = 0;
        if (L == 0) convert_tiles(ca, 0, CV_SEG0, c, G, (LAS float (*)[65])lds);
        if (L == 0) { const int pt3 = phase_tid(); bf16_t* w2t = (bf16_t*)a.mix.W2T; bf16_t* a2t = (bf16_t*)a.mix.A2T; bf16_t* g2t = (bf16_t*)a.mix.G2T; bf16_t* ggt = (bf16_t*)a.mix.GGT;
          for (int i = c * 512 + pt3; i < 2 * 512 * 32; i += G * 512) { const int l2 = i >> 14, ch = (i >> 5) & 511, k = i & 31;
              w2t[i] = f2bf(a.mix.rw_w2[((size_t)l2 * 32 + k) * 512 + ch]); a2t[i] = f2bf(a.mix.rw_a2[((size_t)l2 * 32 + k) * 512 + ch]); }
          for (int i = c * 512 + pt3; i < 2 * 512 * 96; i += G * 512) { const int l2 = i / (512 * 96), rem = i - l2 * 512 * 96, ch = rem / 96, k = rem - ch * 96;
              g2t[i] = f2bf(a.mix.rw_g2[((size_t)l2 * 96 + k) * 512 + ch]); }
          for (int i = c * 512 + pt3; i < 2 * 256 * 32; i += G * 512) { const int l2 = i >> 13, ch = (i >> 5) & 255, k = i & 31;
              ggt[i] = (k < 16) ? f2bf(a.mix.gla_g2[((size_t)l2 * 16 + k) * 256 + ch]) : (bf16_t)0; } }
        if (L == 0) { const int ptid2 = phase_tid();
          for (int i = c * 512 + ptid2; i < 2 * NE * D; i += G * 512) { const int l2 = i >> 17, n = (i >> 11) & 63, k = i & 2047; const float v = a.w_router[(size_t)l2 * D * NE + (size_t)k * NE + n];
              const bf16_t hi = f2bf(v); a.WrH[i] = hi; a.WrL[i] = f2bf(v - bf2f(hi)); } }
    } else if constexpr (PH == 1) {
        pg8::StaticOrder S; S.init(a.xb, a.WinT, T, ZLD, D, G, c);
        pg8::EpiZ16 E; E.O = (bf16_t*)a.mix.z; E.ldc = ZLD; E.pad_ = 0;
        pg8::gemm_phase<pg8::EpiZ16, pg8::StaticOrder, false>(lds, D, S, E);
    } else if constexpr (PH == 2) { MixArgs m = a.mix; m.layer = L; prep_phase(m, lds);
    } else if constexpr (PH == 3) { MixArgs m = a.mix; m.layer = L;
        ConvArgs ca; ca.w_in = a.w_in; ca.we_gate = a.we_gate; ca.we_up = a.we_up; ca.we_down = a.we_down; ca.ws_gate = a.ws_gate; ca.ws_up = a.ws_up; ca.ws_down = a.ws_down; ca.w_br = a.w_br; ca.w_out = a.w_out;
        ca.WinT = a.WinT; ca.WguT = a.WguT; ca.WdT = a.WdT; ca.WbrT = a.WbrT; ca.WoutT = a.WoutT; ca.layer = L; ca.pad_ = 0;
        chains_phase(m, ca, a.bar + 8 + L, lds);
    } else if constexpr (PH == 4) { MixArgs m = a.mix; m.layer = L;
        carry_phase(m, lds, part);
        if (part == 0 && (c >= 8 || G <= 8)) sb_queue(m, a.bar + 12 + L, lds);
    } else if constexpr (PH == 5) { MixArgs m = a.mix; m.layer = L; mixfin_phase(m);
    } else if constexpr (PH == 6) {
        pg8::GateOrder S; S.init(a.mix.bo, a.WbrT, G, c);
        pg8::EpiGateAcc E; E.zg0 = a.mix.z + GATE0; E.mergedb = a.mergedb;
        pg8::gemm_phase<pg8::EpiGateAcc, pg8::GateOrder, false>(lds, FW, S, E);
    } else if constexpr (PH == 7) {
        pg8::StaticOrder S; S.init(a.mergedb, a.WoutT, T, D, D, G, c);
        pg8::EpiResid E; E.xin = (L == 0) ? a.x_in : a.out; E.pre = a.merged;
        pg8::gemm_phase<pg8::EpiResid, pg8::StaticOrder, false>(lds, D, S, E);
    } else if constexpr (PH == 8) { ln_router_phase(a, L, lds);
    } else if constexpr (PH == 9) { dispatch_phase(a, lds);
    } else if constexpr (PH == 10) {
        LAS int* petab = (LAS int*)(lds + LDS_PETAB); const int npan = a.npanels[0];
        pg8::MoeOrder::fill_table(petab, a.panel_expert, npan, 4, G, c, phase_tid());
        pg8::MoeOrder S; S.init(a.x1b, a.WguT, (size_t)1024 * D, petab, a.row_tok, npan, 4, D, G, c);
        pg8::EpiSwi E; E.h = a.hbuf;
        pg8::gemm_phase<pg8::EpiSwi, pg8::MoeOrder, true>(lds, D, S, E);
    } else if constexpr (PH == 11) {
        LAS int* petab = (LAS int*)(lds + LDS_PETAB); const int npan = a.npanels[0];
        pg8::MoeOrder::fill_table(petab, a.panel_expert, npan, 8, G, c, phase_tid());
        pg8::MoeOrder S; S.init(a.hbuf, a.WdT, (size_t)D * FW, petab, nullptr, npan, 8, FW, G, c);
        pg8::EpiDownW E; E.y = a.ybuf;
        pg8::gemm_phase<pg8::EpiDownW, pg8::MoeOrder, false>(lds, FW, S, E);
    } else { combine_phase(a, L, lds); }
}
#ifndef MK_MULTI
#define MK_MULTI 0
#endif
#ifndef MK_PART
#define MK_PART 0
#endif
#ifndef MK_DBL
#define MK_DBL 0
#endif
#if MK_MULTI
template <int PH> __global__ __launch_bounds__(512, 2) void k_one(KArgs a, int L, int pad_) {
    extern __shared__ __attribute__((aligned(16))) unsigned char shm[];
    run_phase<PH>(a, L, (LAS unsigned char*)shm);
}
#else
__device__ __forceinline__ void run_layer(const KArgs& a, const int L, LAS unsigned char* lds, const XcdBarrier& bar) {
#define MK_RUN(PH) do { run_phase<PH>(a, L, lds); xcd_barrier(bar); if ((MK_DBL >> PH) & 1) { run_phase<PH>(a, L | (MK_PART << 4), lds); xcd_barrier(bar); } } while (0)
    if (L == 0) { MK_RUN(0); }
    MK_RUN(1); MK_RUN(2); MK_RUN(3); MK_RUN(4); MK_RUN(5); MK_RUN(6); MK_RUN(7); MK_RUN(8); MK_RUN(9); MK_RUN(10); MK_RUN(11); MK_RUN(12);
#undef MK_RUN
}
__global__ __launch_bounds__(512, 2) void k_mega(KArgs a) {
    extern __shared__ __attribute__((aligned(16))) unsigned char shm[];
    LAS unsigned char* lds = (LAS unsigned char*)shm;
    if (threadIdx.x < 4) ((LAS unsigned*)(lds + LDS_BARW))[threadIdx.x] = 0u;
    __syncthreads();
    const XcdBarrier bar = xcd_barrier_post((unsigned*)(a.ws + OFF_BAR), (volatile LAS unsigned*)(lds + LDS_BARW));
    run_layer(a, 0, lds, bar);
    run_layer(a, 1, lds, bar);
}
#endif

#if MK_MULTI
template <int PH> static void launch_one(const KArgs& a, int L, int grid, hipStream_t stream) {
    static bool attr = false; if (!attr) { (void)hipFuncSetAttribute((const void*)k_one<PH>, hipFuncAttributeMaxDynamicSharedMemorySize, LDS_BYTES); attr = true; }
    k_one<PH><<<grid, 512, LDS_BYTES, stream>>>(a, L, 0);
}
#endif
extern "C" void kernel_launch(void* const* d_in, const int* in_sizes, int n_in, void* d_out, int out_size, void* d_ws, size_t ws_size, hipStream_t stream) {
    KArgs a; memset(&a, 0, sizeof a);
    for (int i = 0; i < 32; ++i) a.in[i] = (const float*)d_in[i];
    a.ws = (char*)d_ws; a.out = (float*)d_out;
    if (WS_NEEDED > ws_size || n_in < 32) { fprintf(stderr, "workspace too small: need %zu MiB, have %zu MiB (n_in %d)\n", WS_NEEDED >> 20, ws_size >> 20, n_in); return; }

    static int grid = 0;
    if (!grid) { int dev = 0, cus = 0; (void)hipGetDevice(&dev); (void)hipDeviceGetAttribute(&cus, hipDeviceAttributeMultiprocessorCount, dev); grid = cus > 0 ? cus : 256; if (grid > 256) grid = 256; }
#if MK_MULTI
    for (int L = 0; L < 2; ++L) {
        launch_one<0>(a, L, grid, stream); launch_one<1>(a, L, grid, stream); launch_one<2>(a, L, grid, stream); launch_one<3>(a, L, grid, stream); launch_one<4>(a, L, grid, stream);
        launch_one<5>(a, L, grid, stream); launch_one<6>(a, L, grid, stream); launch_one<7>(a, L, grid, stream); launch_one<8>(a, L, grid, stream); launch_one<9>(a, L, grid, stream);
        launch_one<10>(a, L, grid, stream); launch_one<11>(a, L, grid, stream); launch_one<12>(a, L, grid, stream);
    }
#else
    static bool attr = false;
    if (!attr) {
        if (hipFuncSetAttribute((const void*)k_mega, hipFuncAttributeMaxDynamicSharedMemorySize, LDS_BYTES) != hipSuccess) { fprintf(stderr, "hipFuncSetAttribute failed\n"); return; }
        int per_cu = 0; (void)hipOccupancyMaxActiveBlocksPerMultiprocessor(&per_cu, (const void*)k_mega, 512, LDS_BYTES);
        if (per_cu < 1) fprintf(stderr, "occupancy query reports %d workgroups per CU\n", per_cu);
        attr = true;
    }
    (void)hipMemsetAsync(a.ws + OFF_BAR, 0, XCD_BAR_WORDS * sizeof(unsigned), stream);
    k_mega<<<grid, 512, LDS_BYTES, stream>>>(a);
#endif
}
```

```cpp
#include <hip/hip_runtime.h>
#include <stdint.h>
#include <stdio.h>
#include <string.h>

typedef unsigned short bf16_t;

constexpr int T = 16384, D = 2048, ZW = 15024, ZLD = 15104, NE = 64, FW = 512;
constexpr int HG_Q = 0, HG_F = 512, HG_I = 1024, HG_G = 1536;
constexpr int RW_R = 2048, RW_K = 2560, RW_V = 3072, RW_LW = 3584;
constexpr int SB_Q = 3744, SB_K = 4256, SB_V = 4768;
constexpr int GL_Q = 5280, GL_K = 5536, GL_V = 5792, GL_LG = 6304, GL_R = 6320;
constexpr int GATE0 = 6832;
constexpr float ALPHA = 1.4142135623730951f;
constexpr int MAXPANELS = 640;
constexpr int MAXROWS = MAXPANELS * 256;
constexpr int NSEG = 32, LSEG = T / NSEG;
constexpr int NCHK = T / 64;

__device__ __forceinline__ float bf2f(bf16_t v) { return __uint_as_float(((unsigned)v) << 16); }
__device__ __forceinline__ bf16_t f2bf(float f) { unsigned u = __float_as_uint(f); u += 0x7FFFu + ((u >> 16) & 1u); return (bf16_t)(u >> 16); }
__device__ __forceinline__ float sigmoidf_(float x) { return 1.0f / (1.0f + expf(-x)); }
__device__ __forceinline__ float softplusf_(float x) { return fmaxf(x, 0.f) + log1pf(expf(-fabsf(x))); }
__device__ __forceinline__ float siluf_(float x) { return x / (1.0f + expf(-x)); }
__device__ __forceinline__ float fsig(float x) { return __builtin_amdgcn_rcpf(1.0f + __expf(-x)); }
__device__ __forceinline__ float fsoftplus(float x) { return fmaxf(x, 0.f) + __logf(1.0f + __expf(-fabsf(x))); }

template <int CTRL> __device__ __forceinline__ float dppmov(float x) {
    return __builtin_bit_cast(float, __builtin_amdgcn_update_dpp(0, __builtin_bit_cast(int, x), CTRL, 0xF, 0xF, true));
}
__device__ __forceinline__ float rdlane(float x, int l) { return __builtin_bit_cast(float, __builtin_amdgcn_readlane(__builtin_bit_cast(int, x), l)); }
__device__ __forceinline__ int phase_tid() { int t = (int)threadIdx.x; asm volatile("" : "+v"(t)); return t & 511; }
__device__ __forceinline__ float wave_sum(float x) {
    x += dppmov<0xB1>(x);
    x += dppmov<0x4E>(x);
    x += dppmov<0x141>(x);
    x += dppmov<0x140>(x);
    return (rdlane(x, 0) + rdlane(x, 16)) + (rdlane(x, 32) + rdlane(x, 48));
}
#define LAS __attribute__((address_space(3)))
namespace pg8 {
typedef short bf16x8 __attribute__((ext_vector_type(8)));
typedef float f32x4 __attribute__((ext_vector_type(4)));
typedef unsigned u32x4 __attribute__((ext_vector_type(4)));
typedef unsigned u32x2 __attribute__((ext_vector_type(2)));
constexpr int BM = 256, BK = 64, HALF = 128, HTB = HALF * BK * 2, STAGE_BYTES = 8 * HTB, NXCD = 8, WGM = 8;
constexpr int GTAB_BYTES = 512 * 16;
__host__ __device__ __forceinline__ int lds_byte(int r, int c) { const int st = (r >> 4) * 2 + (c >> 5), rr = r & 15, cc = c & 31, ob = rr * 64 + cc * 2; return st * 1024 + (ob ^ (((ob >> 9) & 1) << 5)); }
__host__ __device__ __forceinline__ void stage_rc(int b, int& R, int& C) { const int st = b / 1024, sb = b % 1024, swz = sb ^ (((sb >> 9) & 1) << 5); R = (st >> 1) * 16 + swz / 64; C = (st & 1) * 32 + (swz % 64) / 2; }
__host__ __device__ __forceinline__ int perm32(int rho) { const int n = rho >> 4, i = rho & 15; return 8 * (i >> 2) + 4 * n + (i & 3); }
struct Unit { int pm, pn, e; };
__device__ __forceinline__ unsigned cvt_pk_bf16(float lo, float hi) { unsigned r; asm volatile("v_cvt_pk_bf16_f32 %0, %1, %2" : "=v"(r) : "v"(lo), "v"(hi)); return r; }

struct StaticOrder {
    const bf16_t* A; const bf16_t* Bt; int K; int nM, nN, nwg, G, c;
    __device__ void init(const bf16_t* A_, const bf16_t* Bt_, int M, int N, int K_, int G_, int c_) { A = A_; Bt = Bt_; K = K_; nM = M / BM; nN = N / BM; nwg = nM * nN; G = G_; c = c_; }
    __device__ bool next(int i, Unit& u) const {
        const int L = i * G + c; if (L >= nwg) return false;
        int wgid = L; { const int q = nwg / NXCD, r = nwg % NXCD, xcd = wgid % NXCD, off = wgid / NXCD; wgid = (xcd < r ? xcd * (q + 1) : r * (q + 1) + (xcd - r) * q) + off; }
        const int nig = WGM * nN, gid = wgid / nig, fm = gid * WGM, gsz = (nM - fm) < WGM ? (nM - fm) : WGM;
        u.pm = fm + ((wgid % nig) % gsz); u.pn = (wgid % nig) / gsz; u.e = 0; return true;
    }
    __device__ __forceinline__ const char* a_base(const Unit& u) const { return (const char*)A + (size_t)u.pm * 256 * K * 2; }
    __device__ __forceinline__ const char* b_base(const Unit& u) const { return (const char*)Bt + (size_t)u.pn * 256 * K * 2; }
    __device__ __forceinline__ const int* rowmap() const { return nullptr; }
};
struct GateOrder {
    StaticOrder so; const bf16_t* A; const bf16_t* Bt; int per;
    __device__ void init(const bf16_t* bo, const bf16_t* WbrT, int G_, int c_) { so.init(bo, WbrT, T, D, FW, G_, c_); A = bo; Bt = WbrT; Unit t; per = 0; while (so.next(per, t)) ++per; }
    __device__ bool next(int i, Unit& u) const { if (per == 0 || i >= 4 * per) return false; const int g = i / per; const bool ok = so.next(i - g * per, u); u.e = g; return ok; }
    __device__ __forceinline__ const char* a_base(const Unit& u) const { return (const char*)(A + (size_t)u.e * T * 512) + (size_t)u.pm * 256 * FW * 2; }
    __device__ __forceinline__ const char* b_base(const Unit& u) const { return (const char*)(Bt + (size_t)u.e * D * FW) + (size_t)u.pn * 256 * FW * 2; }
    __device__ __forceinline__ const int* rowmap() const { return nullptr; }
};
struct MoeOrder {
    const bf16_t* A; const bf16_t* Bt; const int* rmap; const LAS int* petab; size_t estride; int K, NT, total, G, c;
    __device__ void init(const bf16_t* A_, const bf16_t* Bt_, size_t estride_, const LAS int* petab_, const int* rmap_, int npanels, int NT_, int K_, int G_, int c_) {
        A = A_; Bt = Bt_; estride = estride_; petab = petab_; rmap = rmap_; K = K_; NT = NT_; total = npanels * NT_; G = G_;
        c = remap(c_, G_);
    }
    static __device__ __forceinline__ int remap(int c_, int G_) { return (c_ & 7) * (G_ >> 3) + (c_ >> 3); }
    static __device__ __forceinline__ void fill_table(LAS int* tab, const int* panel_expert, int npanels, int NT_, int G_, int c_, int tid) {
        const int cc = remap(c_, G_), tot = npanels * NT_;
        if (tid < 64) { const int Lu = tid * G_ + cc; tab[tid] = (Lu < tot) ? panel_expert[Lu / NT_] : 0; }
        __syncthreads();
    }
    __device__ bool next(int i, Unit& u) const {
        const int L = i * G + c; if (L >= total) return false;
        u.pm = L / NT; u.pn = L % NT; u.e = petab[i]; return true;
    }
    __device__ __forceinline__ const char* a_base(const Unit& u) const { return rmap ? (const char*)A : (const char*)A + (size_t)u.pm * 256 * K * 2; }
    __device__ __forceinline__ const char* b_base(const Unit& u) const { return (const char*)(Bt + (size_t)u.e * estride) + (size_t)u.pn * 256 * K * 2; }
    __device__ __forceinline__ const int* rowmap() const { return rmap; }
};

struct EpiZ16 {
    static constexpr bool PERM = true;
    bf16_t* O; int ldc; int pad_;
    __device__ __forceinline__ void operator()(const f32x4 (&acc)[2][2][4][2], const Unit& u, int wr, int wc, int fr, int fq) const {
        const int row0 = u.pm * BM + wr * 64 + fr, col0 = u.pn * BM + wc * 32 + 8 * fq;
#pragma unroll
        for (int ai = 0; ai < 2; ++ai)
#pragma unroll
            for (int m = 0; m < 4; ++m) { bf16_t* rowp = O + (size_t)(row0 + ai * HALF + m * 16) * ldc + col0;
#pragma unroll
                for (int bj = 0; bj < 2; ++bj) { const f32x4 v0 = acc[ai][bj][m][0], v1 = acc[ai][bj][m][1];
                    u32x4 w; w.x = cvt_pk_bf16(v0[0], v0[1]); w.y = cvt_pk_bf16(v0[2], v0[3]); w.z = cvt_pk_bf16(v1[0], v1[1]); w.w = cvt_pk_bf16(v1[2], v1[3]);
                    *(u32x4*)(rowp + bj * HALF) = w; } }
    }
};
struct EpiGateAcc {
    static constexpr bool PERM = true;
    const bf16_t* zg0; bf16_t* mergedb;
    __device__ __forceinline__ void operator()(const f32x4 (&acc)[2][2][4][2], const Unit& u, int wr, int wc, int fr, int fq) const {
        const int g = u.e; const bf16_t* zg = zg0 + g * D;
        const int row0 = u.pm * BM + wr * 64 + fr, col0 = u.pn * BM + wc * 32 + 8 * fq;
#pragma unroll
        for (int ai = 0; ai < 2; ++ai) {
            u32x4 gzv[4][2], pvv[4][2];
#pragma unroll
            for (int m = 0; m < 4; ++m)
#pragma unroll
                for (int bj = 0; bj < 2; ++bj) { const size_t row = (size_t)(row0 + ai * HALF + m * 16); const int col = col0 + bj * HALF;
                    gzv[m][bj] = *(const u32x4*)(zg + row * ZLD + col);
                    pvv[m][bj] = (u32x4){0u, 0u, 0u, 0u}; if (g > 0) pvv[m][bj] = *(const u32x4*)(mergedb + row * D + col); }
#pragma unroll
            for (int m = 0; m < 4; ++m) { const size_t row = (size_t)(row0 + ai * HALF + m * 16);
#pragma unroll
                for (int bj = 0; bj < 2; ++bj) { const int col = col0 + bj * HALF;
                    const u32x4 gz = gzv[m][bj], pv = pvv[m][bj];
                    f32x4 g0, g1; g0[0] = __uint_as_float(gz.x << 16); g0[1] = __uint_as_float(gz.x & 0xffff0000u); g0[2] = __uint_as_float(gz.y << 16); g0[3] = __uint_as_float(gz.y & 0xffff0000u);
                    g1[0] = __uint_as_float(gz.z << 16); g1[1] = __uint_as_float(gz.z & 0xffff0000u); g1[2] = __uint_as_float(gz.w << 16); g1[3] = __uint_as_float(gz.w & 0xffff0000u);
                    f32x4 v0 = acc[ai][bj][m][0], v1 = acc[ai][bj][m][1];
#pragma unroll
                    for (int j = 0; j < 4; ++j) { v0[j] *= __builtin_amdgcn_rcpf(1.0f + __expf(-g0[j])); v1[j] *= __builtin_amdgcn_rcpf(1.0f + __expf(-g1[j])); }
                    v0[0] += __uint_as_float(pv.x << 16); v0[1] += __uint_as_float(pv.x & 0xffff0000u); v0[2] += __uint_as_float(pv.y << 16); v0[3] += __uint_as_float(pv.y & 0xffff0000u);
                    v1[0] += __uint_as_float(pv.z << 16); v1[1] += __uint_as_float(pv.z & 0xffff0000u); v1[2] += __uint_as_float(pv.w << 16); v1[3] += __uint_as_float(pv.w & 0xffff0000u);
                    u32x4 w; w.x = cvt_pk_bf16(v0[0], v0[1]); w.y = cvt_pk_bf16(v0[2], v0[3]); w.z = cvt_pk_bf16(v1[0], v1[1]); w.w = cvt_pk_bf16(v1[2], v1[3]);
                    *(u32x4*)(mergedb + row * D + col) = w; } }
            asm volatile("" ::: "memory");
        }
    }
};
struct EpiResid {
    static constexpr bool PERM = true;
    const float* xin; float* pre;
    __device__ __forceinline__ void operator()(const f32x4 (&acc)[2][2][4][2], const Unit& u, int wr, int wc, int fr, int fq) const {
        const int row0 = u.pm * BM + wr * 64 + fr, col0 = u.pn * BM + wc * 32 + 8 * fq;
#pragma unroll
        for (int ai = 0; ai < 2; ++ai) {
            f32x4 xv[4][2][2];
#pragma unroll
            for (int m = 0; m < 4; ++m) { const size_t ro = (size_t)(row0 + ai * HALF + m * 16) * D + col0;
#pragma unroll
                for (int bj = 0; bj < 2; ++bj)
#pragma unroll
                    for (int n = 0; n < 2; ++n) xv[m][bj][n] = *(const f32x4*)(xin + ro + bj * HALF + n * 4); }
#pragma unroll
            for (int m = 0; m < 4; ++m) { const size_t ro = (size_t)(row0 + ai * HALF + m * 16) * D + col0;
#pragma unroll
                for (int bj = 0; bj < 2; ++bj)
#pragma unroll
                    for (int n = 0; n < 2; ++n) *(f32x4*)(pre + ro + bj * HALF + n * 4) = xv[m][bj][n] * ALPHA + acc[ai][bj][m][n]; }
            asm volatile("" ::: "memory");
        }
    }
};
struct EpiSwi {
    static constexpr bool PERM = true;
    bf16_t* h;
    __device__ __forceinline__ void operator()(const f32x4 (&acc)[2][2][4][2], const Unit& u, int wr, int wc, int fr, int fq) const {
        const int row0 = u.pm * BM + wr * 64 + fr, col0 = u.pn * HALF + wc * 32 + 8 * fq;
#pragma unroll
        for (int ai = 0; ai < 2; ++ai)
#pragma unroll
            for (int m = 0; m < 4; ++m) { float o[8];
#pragma unroll
                for (int n = 0; n < 2; ++n)
#pragma unroll
                    for (int j = 0; j < 4; ++j) { const float gt = acc[ai][0][m][n][j], up = acc[ai][1][m][n][j]; o[4 * n + j] = gt / (1.0f + __expf(-gt)) * up; }
                u32x4 w; w.x = cvt_pk_bf16(o[0], o[1]); w.y = cvt_pk_bf16(o[2], o[3]); w.z = cvt_pk_bf16(o[4], o[5]); w.w = cvt_pk_bf16(o[6], o[7]);
                *(u32x4*)(h + (size_t)(row0 + ai * HALF + m * 16) * FW + col0) = w; }
    }
};
struct EpiDownW {
    static constexpr bool PERM = true;
    bf16_t* y;
    __device__ __forceinline__ void operator()(const f32x4 (&acc)[2][2][4][2], const Unit& u, int wr, int wc, int fr, int fq) const {
        const int row0 = u.pm * BM + wr * 64 + fr, col0 = u.pn * BM + wc * 32 + 8 * fq;
#pragma unroll
        for (int ai = 0; ai < 2; ++ai)
#pragma unroll
            for (int m = 0; m < 4; ++m) { const int row = row0 + ai * HALF + m * 16; bf16_t* rowp = y + (size_t)row * D + col0;
#pragma unroll
                for (int bj = 0; bj < 2; ++bj) { const f32x4 v0 = acc[ai][bj][m][0], v1 = acc[ai][bj][m][1];
                    u32x4 w; w.x = cvt_pk_bf16(v0[0], v0[1]); w.y = cvt_pk_bf16(v0[2], v0[3]); w.z = cvt_pk_bf16(v1[0], v1[1]); w.w = cvt_pk_bf16(v1[2], v1[3]);
                    *(u32x4*)(rowp + bj * HALF) = w; } }
    }
};

template <class Epi, class Sched, bool GATHER>
__device__ __forceinline__ void gemm_phase(LAS unsigned char* lds, const int K, const Sched& S, const Epi& E) {
    const int tid = phase_tid(), wid = __builtin_amdgcn_readfirstlane(tid >> 6), wr = wid >> 2, wc = wid & 3, lane = tid & 63, fr = lane & 15, fq = lane >> 4;
    const int nt = K / BK;
    unsigned voffA[2], voffB[2], voffG[2][2]; int gR[2], gC[2];
#pragma unroll
    for (int i = 0; i < 2; ++i) { int R, C; stage_rc(tid * 16 + i * 8192, R, C); const int Rb = Epi::PERM ? ((R & ~31) + perm32(R & 31)) : R;
        voffA[i] = (unsigned)(R * K + C) * 2u; voffB[i] = (unsigned)(Rb * K + C) * 2u; gR[i] = R; gC[i] = C; voffG[0][i] = 0u; voffG[1][i] = 0u; }
    const size_t kstep = (size_t)(BK * 2);
    const size_t hstep = (size_t)HALF * K * 2;
    const unsigned ldsw = (unsigned)wid * 1024u;
    const int aoff = lds_byte(wr * 64 + fr, fq * 8), boff = lds_byte(wc * 32 + fr, fq * 8);
    LAS u32x4* gtab = (LAS u32x4*)(lds + STAGE_BYTES) + tid;
#define PG8_SA(b, h) (((b) * 2 + (h)) * HTB)
#define PG8_SB(b, h) ((4 + (b) * 2 + (h)) * HTB)
#define PG8_STAGE(bufoff, gbase, voff) do { _Pragma("unroll") for (int _i = 0; _i < 2; ++_i) \
        __builtin_amdgcn_global_load_lds((const unsigned*)((const char*)(gbase) + (voff)[_i]), (LAS unsigned*)(lds + (bufoff) + ldsw + _i * 8192), 16, 0, 0); } while (0)
#define PG8_STAGE_A(bufoff, gbase, h) do { if constexpr (GATHER) PG8_STAGE(bufoff, gbase, voffG[h]); else PG8_STAGE(bufoff, (gbase) + (h) * hstep, voffA); } while (0)
#define PG8_LDA(dst, b, h) do { _Pragma("unroll") for (int m = 0; m < 4; ++m) _Pragma("unroll") for (int k = 0; k < 2; ++k) dst[m][k] = *(const LAS bf16x8*)(lds + PG8_SA(b, h) + aoff + m * 2048 + k * 1024); } while (0)
#define PG8_LDB(dst, b, h) do { _Pragma("unroll") for (int n = 0; n < 2; ++n) _Pragma("unroll") for (int k = 0; k < 2; ++k) dst[n][k] = *(const LAS bf16x8*)(lds + PG8_SB(b, h) + boff + n * 2048 + k * 1024); } while (0)
#define PG8_MMA(ai, bj, At, Bt) do { __builtin_amdgcn_s_setprio(1); _Pragma("unroll") for (int m = 0; m < 4; ++m) _Pragma("unroll") for (int n = 0; n < 2; ++n) _Pragma("unroll") for (int k = 0; k < 2; ++k) \
        acc[ai][bj][m][n] = __builtin_amdgcn_mfma_f32_16x16x32_bf16(Bt[n][k], At[m][k], acc[ai][bj][m][n], 0, 0, 0); __builtin_amdgcn_s_setprio(0); } while (0)
#define PG8_WAIT_V(n) asm volatile("s_waitcnt vmcnt(" #n ")" ::: "memory")
#define PG8_WAIT_L(n) asm volatile("s_waitcnt lgkmcnt(" #n ")" ::: "memory")
#define PG8_BAR __builtin_amdgcn_s_barrier()
#define PG8_SCHED __builtin_amdgcn_sched_barrier(0)
    auto gather_offs = [&](const Unit& u) -> u32x4 {
        const int* rm = S.rowmap(); u32x4 o;
        o.x = (unsigned)(rm[u.pm * 256 + gR[0]] * K + gC[0]) * 2u;       o.y = (unsigned)(rm[u.pm * 256 + gR[1]] * K + gC[1]) * 2u;
        o.z = (unsigned)(rm[u.pm * 256 + 128 + gR[0]] * K + gC[0]) * 2u; o.w = (unsigned)(rm[u.pm * 256 + 128 + gR[1]] * K + gC[1]) * 2u;
        return o; };
    Unit cur, nxt, nn; int ui = 0;
    if (!S.next(0, cur)) return;
    f32x4 acc[2][2][4][2];
#pragma unroll
    for (int a = 0; a < 2; ++a)
#pragma unroll
        for (int b = 0; b < 2; ++b)
#pragma unroll
            for (int m = 0; m < 4; ++m)
#pragma unroll
                for (int n = 0; n < 2; ++n) acc[a][b][m][n] = (f32x4){0.f, 0.f, 0.f, 0.f};
    bf16x8 At[4][2], B0[2][2], B1[2][2];
    const char* cA = S.a_base(cur); const char* cB = S.b_base(cur);
    if constexpr (GATHER) {
        const u32x4 o = gather_offs(cur); voffG[0][0] = o.x; voffG[0][1] = o.y; voffG[1][0] = o.z; voffG[1][1] = o.w;
        if (S.next(1, nn)) *gtab = gather_offs(nn);
        asm volatile("s_waitcnt vmcnt(0) lgkmcnt(0)" ::: "memory");
    }
    PG8_STAGE(PG8_SB(0, 0), cB, voffB); PG8_STAGE(PG8_SB(0, 1), cB + hstep, voffB); PG8_STAGE_A(PG8_SA(0, 0), cA, 0); PG8_STAGE_A(PG8_SA(0, 1), cA, 1);
    if (wr == 1) PG8_BAR;
    PG8_WAIT_V(2); PG8_BAR;
    PG8_STAGE(PG8_SB(1, 0), cB + kstep, voffB); PG8_STAGE_A(PG8_SA(1, 0), cA + kstep, 0); PG8_STAGE(PG8_SB(1, 1), cB + hstep + kstep, voffB);
    PG8_WAIT_V(6); PG8_BAR;
    for (;;) {
        const bool has_next = S.next(ui + 1, nxt);
        const char* nA = has_next ? S.a_base(nxt) : cA; const char* nB = has_next ? S.b_base(nxt) : cB;
        for (int t = 0; t < nt; t += 2) {
            const bool last = (t == nt - 2);
            const char* a1 = cA + (size_t)(t + 1) * kstep;
            const char* a2 = last ? nA : cA + (size_t)(t + 2) * kstep; const char* b2 = last ? nB : cB + (size_t)(t + 2) * kstep;
            const char* a3 = a2 + kstep; const char* b3 = b2 + kstep;
            PG8_LDB(B0, 0, 0); PG8_LDB(B1, 0, 1); PG8_SCHED; PG8_LDA(At, 0, 0); PG8_STAGE_A(PG8_SA(1, 1), a1, 1);
            if constexpr (GATHER) { if (last && has_next) { const u32x4 o = *gtab; voffG[0][0] = o.x; voffG[0][1] = o.y; voffG[1][0] = o.z; voffG[1][1] = o.w; } }
            PG8_WAIT_V(8); PG8_WAIT_L(0); PG8_BAR; PG8_MMA(0, 0, At, B0); PG8_MMA(0, 1, At, B1); PG8_BAR; PG8_SCHED;
            PG8_LDA(At, 0, 1); PG8_STAGE(PG8_SB(0, 0), b2, voffB); PG8_STAGE(PG8_SB(0, 1), b2 + hstep, voffB); PG8_STAGE_A(PG8_SA(0, 0), a2, 0);
            PG8_WAIT_V(8); PG8_WAIT_L(0); PG8_BAR; PG8_MMA(1, 0, At, B0); PG8_MMA(1, 1, At, B1); PG8_BAR; PG8_SCHED;
            PG8_LDB(B0, 1, 0); PG8_LDB(B1, 1, 1); PG8_SCHED; PG8_LDA(At, 1, 0); PG8_STAGE_A(PG8_SA(0, 1), a2, 1);
            PG8_WAIT_V(8); PG8_WAIT_L(0); PG8_BAR; PG8_MMA(0, 0, At, B0); PG8_MMA(0, 1, At, B1); PG8_BAR; PG8_SCHED;
            PG8_LDA(At, 1, 1); PG8_STAGE(PG8_SB(1, 0), b3, voffB); PG8_STAGE(PG8_SB(1, 1), b3 + hstep, voffB); PG8_STAGE_A(PG8_SA(1, 0), a3, 0);
            PG8_WAIT_V(8); PG8_WAIT_L(0); PG8_BAR; PG8_MMA(1, 0, At, B0); PG8_MMA(1, 1, At, B1); PG8_BAR; PG8_SCHED;
        }
        if (wr == 0) PG8_BAR;
        E(acc, cur, wr, wc, fr, fq);
        if constexpr (GATHER) { if (has_next && S.next(ui + 2, nn)) { *gtab = gather_offs(nn); } }
        if (!has_next) break;
#pragma unroll
        for (int a = 0; a < 2; ++a)
#pragma unroll
            for (int b = 0; b < 2; ++b)
#pragma unroll
                for (int m = 0; m < 4; ++m)
#pragma unroll
                    for (int n = 0; n < 2; ++n) acc[a][b][m][n] = (f32x4){0.f, 0.f, 0.f, 0.f};
        cur = nxt; cA = nA; cB = nB; ++ui;
        if (wr == 1) PG8_BAR;
    }
    PG8_WAIT_V(0);
    PG8_BAR;
#undef PG8_SA
#undef PG8_SB
#undef PG8_STAGE
#undef PG8_STAGE_A
#undef PG8_LDA
#undef PG8_LDB
#undef PG8_MMA
#undef PG8_WAIT_V
#undef PG8_WAIT_L
#undef PG8_BAR
#undef PG8_SCHED
}
}


struct ConvArgs { const float *w_in, *we_gate, *we_up, *we_down, *ws_gate, *ws_up, *ws_down, *w_br, *w_out; bf16_t *WinT, *WguT, *WdT, *WbrT, *WoutT; int layer, pad_; };
constexpr int CV_SEG0 = 32 * 236, CV_SEG1 = 65 * 2 * 32 * 8, CV_SEG2 = 65 * 8 * 32, CV_SEG3 = 4 * 8 * 32, CV_SEG4 = 32 * 32;
constexpr int CV_TOTAL = CV_SEG0 + CV_SEG1 + CV_SEG2 + CV_SEG3 + CV_SEG4;
struct CvJob { const float* src; bf16_t* dst; int ld, ldd, valid; };
__device__ __forceinline__ CvJob cv_decode(const ConvArgs& a, const int j, const int L) {
    CvJob o; o.valid = 64;
    if (j < CV_SEG0) { const int kb = j & 31, nb = j >> 5; o.ld = ZW; o.ldd = D;
        o.src = a.w_in + (size_t)L * D * ZW + (size_t)kb * 64 * ZW + nb * 64; int v = ZW - nb * 64; o.valid = v < 0 ? 0 : (v > 64 ? 64 : v);
        o.dst = a.WinT + (size_t)nb * 64 * D + kb * 64; }
    else if (j < CV_SEG0 + CV_SEG1) { int q = j - CV_SEG0; const int cb = q & 7; q >>= 3; const int kb = q & 31; q >>= 5; const int bj = q & 1; const int e = q >> 1; o.ld = FW; o.ldd = D;
        const float* m = (e < NE) ? ((bj ? a.we_up : a.we_gate) + ((size_t)L * NE + e) * D * FW) : ((bj ? a.ws_up : a.ws_gate) + (size_t)L * D * FW);
        o.src = m + (size_t)kb * 64 * FW + cb * 64;
        o.dst = a.WguT + ((size_t)e * 1024 + (cb >> 1) * 256 + bj * 128 + (cb & 1) * 64) * D + kb * 64; }
    else if (j < CV_SEG0 + CV_SEG1 + CV_SEG2) { int q = j - CV_SEG0 - CV_SEG1; const int nb = q & 31; q >>= 5; const int kb = q & 7; const int e = q >> 3; o.ld = D; o.ldd = FW;
        const float* m = (e < NE) ? (a.we_down + ((size_t)L * NE + e) * FW * D) : (a.ws_down + (size_t)L * FW * D);
        o.src = m + (size_t)kb * 64 * D + nb * 64; o.dst = a.WdT + ((size_t)e * D + nb * 64) * FW + kb * 64; }
    else if (j < CV_SEG0 + CV_SEG1 + CV_SEG2 + CV_SEG3) { int q = j - CV_SEG0 - CV_SEG1 - CV_SEG2; const int nb = q & 31; q >>= 5; const int kb = q & 7; const int g = q >> 3; o.ld = D; o.ldd = FW;
        o.src = a.w_br + ((size_t)L * 4 + g) * FW * D + (size_t)kb * 64 * D + nb * 64; o.dst = a.WbrT + ((size_t)g * D + nb * 64) * FW + kb * 64; }
    else { const int q = j - CV_SEG0 - CV_SEG1 - CV_SEG2 - CV_SEG3; const int nb = q & 31, kb = q >> 5; o.ld = D; o.ldd = D;
        o.src = a.w_out + (size_t)L * D * D + (size_t)kb * 64 * D + nb * 64; o.dst = a.WoutT + (size_t)nb * 64 * D + kb * 64; }
    return o;
}
__device__ __forceinline__ void convert_tiles(const ConvArgs& a, int j0, int j1, int jstart, int jstride, LAS float (*tile)[65]) {
    const int tid = phase_tid(), L = a.layer;
    for (int j = j0 + jstart; j < j1; j += jstride) {
        const CvJob jb = cv_decode(a, j, L);
        const float* src = jb.src; bf16_t* dst = jb.dst; const int ld = jb.ld, ldd = jb.ldd, valid = jb.valid;
        __syncthreads();
        { const int c4 = (tid & 15) * 4, k = tid >> 4;
#pragma unroll
          for (int h = 0; h < 2; ++h) { float4 v = make_float4(0.f, 0.f, 0.f, 0.f); if (c4 < valid) v = *(const float4*)(src + (size_t)(k + 32 * h) * ld + c4);
              tile[k + 32 * h][c4] = v.x; tile[k + 32 * h][c4 + 1] = v.y; tile[k + 32 * h][c4 + 2] = v.z; tile[k + 32 * h][c4 + 3] = v.w; } }
        __syncthreads();
        { const int n = tid >> 3, kc = (tid & 7) * 8; unsigned w[4];
#pragma unroll
          for (int q = 0; q < 4; ++q) w[q] = (unsigned)f2bf(tile[kc + 2 * q][n]) | ((unsigned)f2bf(tile[kc + 2 * q + 1][n]) << 16);
          *(uint4*)(dst + (size_t)n * ldd + kc) = make_uint4(w[0], w[1], w[2], w[3]); }
    }
}
constexpr int CVX_OWN = CV_TOTAL - CV_SEG0, CVX_TOTAL = CVX_OWN + CV_SEG0;
__device__ __forceinline__ bool cvx_job(const ConvArgs& a, const int n, const int L, CvJob& jb) {
    if (n < CVX_OWN) { jb = cv_decode(a, CV_SEG0 + n, L); return true; }
    if (n < CVX_TOTAL && L + 1 < 2) { jb = cv_decode(a, n - CVX_OWN, L + 1); return true; }
    return false;
}
typedef float f32x2v __attribute__((ext_vector_type(2)));
typedef float f32x4v __attribute__((ext_vector_type(4)));
struct MixArgs {
    const bf16_t* z;
    const float *hg_lb_logits, *hg_norm_w, *rw_mu, *rw_w0, *rw_w2, *rw_a0, *rw_a2, *rw_g2, *rw_kk, *rw_ka, *rw_rk, *rw_ln_w, *rw_ln_b, *gla_g2, *gla_gb, *gla_norm_w;
    float* RS; bf16_t *Vt, *KH, *KG, *VtH, *VtG; float *rGate, *rBonus;
    float *oR, *oH, *oG; bf16_t *cR, *cH, *cG;
    float *SendR, *PendR, *SendH, *SendG, *GamH, *GamG;
    bf16_t *SstR, *SstH, *SstG;
    bf16_t* bo;
    const bf16_t *W2T, *A2T, *G2T, *GGT;
    float *LW, *LA, *LG, *LL;
    int layer, pad_;
};
__device__ __forceinline__ float red8(float x) { x += dppmov<0xB1>(x); x += dppmov<0x4E>(x); x += dppmov<0x141>(x); return x; }
__device__ __forceinline__ float red16(float x) { x += dppmov<0xB1>(x); x += dppmov<0x4E>(x); x += dppmov<0x141>(x); x += dppmov<0x140>(x); return x; }

__device__ __forceinline__ void prep_phase(const MixArgs& p, LAS unsigned char* ldsraw) {
    LAS bf16_t (*vtile)[72] = (LAS bf16_t (*)[72])(ldsraw + 8192);
    const int c = phase_tid(), L = p.layer;
    const float mu_r = p.rw_mu[L * 1696 + c], mu_k = p.rw_mu[L * 1696 + 512 + c], mu_v = p.rw_mu[L * 1696 + 1024 + c];
    const float w0 = p.rw_w0[L * 512 + c], a0 = p.rw_a0[L * 512 + c], kkc = p.rw_kk[L * 512 + c], kac = p.rw_ka[L * 512 + c], rkc = p.rw_rk[L * 512 + c];
    float lb = 0.f;
    if (L == 1) { const float l0 = p.hg_lb_logits[c], l1 = p.hg_lb_logits[512 + c]; const float m = fmaxf(l0, l1); const float e0 = expf(l0 - m), e1 = expf(l1 - m); lb = e1 / (e0 + e1); }
    const float gbc = (c < 256) ? p.gla_gb[L * 256 + c] : 0.f;
    for (int tile = blockIdx.x; tile < T / 64; tile += gridDim.x) {
        const int t0 = tile * 64;
        {
            typedef short bf16x8v __attribute__((ext_vector_type(8)));
            typedef __bf16 bf16x2n __attribute__((ext_vector_type(2)));
            const int wvu = __builtin_amdgcn_readfirstlane(c >> 6), lane = c & 63, r = lane & 15, q = lane >> 4, mp = wvu >> 2, nq = wvu & 3;
            bf16x8v Af[2][6];
#pragma unroll
            for (int m = 0; m < 2; ++m) { const int t = t0 + 32 * mp + 16 * m + r;
#pragma unroll
                for (int ks = 0; ks < 5; ++ks) {
                    const pg8::u32x4 cu = *(const pg8::u32x4*)(p.z + (size_t)t * ZLD + RW_LW + 32 * ks + 8 * q);
                    pg8::u32x4 pv = (pg8::u32x4){0u, 0u, 0u, 0u}; if (t > 0) pv = *(const pg8::u32x4*)(p.z + (size_t)(t - 1) * ZLD + RW_LW + 32 * ks + 8 * q);
                    const float4 m0 = *(const float4*)(p.rw_mu + L * 1696 + 1536 + 32 * ks + 8 * q), m1 = *(const float4*)(p.rw_mu + L * 1696 + 1536 + 32 * ks + 8 * q + 4);
                    const float mu8[8] = {m0.x, m0.y, m0.z, m0.w, m1.x, m1.y, m1.z, m1.w};
                    const unsigned cw[4] = {cu.x, cu.y, cu.z, cu.w}, pw[4] = {pv.x, pv.y, pv.z, pv.w};
                    union { bf16x2n h2[4]; bf16x8v v; } pk;
#pragma unroll
                    for (int j = 0; j < 4; ++j) { f32x2v f;
                        { const float cur = __uint_as_float(cw[j] << 16), prv = __uint_as_float(pw[j] << 16); const float zs = cur + (prv - cur) * mu8[2 * j];
                          f.x = (ks == 0) ? (1.0f - 2.0f / (1.0f + __expf(2.0f * zs))) : (ks == 1 ? zs : fsig(zs)); }
                        { const float cur = __uint_as_float(cw[j] & 0xffff0000u), prv = __uint_as_float(pw[j] & 0xffff0000u); const float zs = cur + (prv - cur) * mu8[2 * j + 1];
                          f.y = (ks == 0) ? (1.0f - 2.0f / (1.0f + __expf(2.0f * zs))) : (ks == 1 ? zs : fsig(zs)); }
                        pk.h2[j] = __builtin_convertvector(f, bf16x2n); }
                    Af[m][ks] = pk.v; }
                { pg8::u32x4 gl = (pg8::u32x4){0u, 0u, 0u, 0u}; if (q < 2) gl = *(const pg8::u32x4*)(p.z + (size_t)t * ZLD + GL_LG + 8 * q);
                  union { pg8::u32x4 u; bf16x8v v; } cvu; cvu.u = gl; Af[m][5] = cvu.v; } }
            const bf16_t* w2t = p.W2T + (size_t)L * 512 * 32; const bf16_t* a2t = p.A2T + (size_t)L * 512 * 32; const bf16_t* g2t = p.G2T + (size_t)L * 512 * 96; const bf16_t* ggt = p.GGT + (size_t)L * 256 * 32;
#pragma unroll 2
            for (int nt = 0; nt < 8; ++nt) { const int ch = 128 * nq + 16 * nt + r;
                const bf16x8v Bw = *(const bf16x8v*)(w2t + ch * 32 + 8 * q), Ba = *(const bf16x8v*)(a2t + ch * 32 + 8 * q);
                const bf16x8v Bg0 = *(const bf16x8v*)(g2t + ch * 96 + 8 * q), Bg1 = *(const bf16x8v*)(g2t + ch * 96 + 32 + 8 * q), Bg2 = *(const bf16x8v*)(g2t + ch * 96 + 64 + 8 * q);
#pragma unroll
                for (int m = 0; m < 2; ++m) { const f32x4v zero = (f32x4v){0.f, 0.f, 0.f, 0.f};
                    const f32x4v aw = __builtin_amdgcn_mfma_f32_16x16x32_bf16(Af[m][0], Bw, zero, 0, 0, 0), aa = __builtin_amdgcn_mfma_f32_16x16x32_bf16(Af[m][1], Ba, zero, 0, 0, 0);
                    f32x4v ag = __builtin_amdgcn_mfma_f32_16x16x32_bf16(Af[m][2], Bg0, zero, 0, 0, 0); ag = __builtin_amdgcn_mfma_f32_16x16x32_bf16(Af[m][3], Bg1, ag, 0, 0, 0); ag = __builtin_amdgcn_mfma_f32_16x16x32_bf16(Af[m][4], Bg2, ag, 0, 0, 0);
#pragma unroll
                    for (int i = 0; i < 4; ++i) { const size_t o = (size_t)(t0 + 32 * mp + 16 * m + 4 * q + i) * 512 + ch; p.LW[o] = aw[i]; p.LA[o] = aa[i]; p.LG[o] = ag[i]; } } }
#pragma unroll 2
            for (int nt = 0; nt < 4; ++nt) { const int ch = 64 * nq + 16 * nt + r;
                const bf16x8v Bl = *(const bf16x8v*)(ggt + ch * 32 + 8 * q);
#pragma unroll
                for (int m = 0; m < 2; ++m) { const f32x4v al = __builtin_amdgcn_mfma_f32_16x16x32_bf16(Af[m][5], Bl, (f32x4v){0.f, 0.f, 0.f, 0.f}, 0, 0, 0);
#pragma unroll
                    for (int i = 0; i < 4; ++i) p.LL[(size_t)(t0 + 32 * mp + 16 * m + 4 * q + i) * 256 + ch] = al[i]; } }
        }
        asm volatile("s_waitcnt vmcnt(0)" ::: "memory");
        __syncthreads();
        float bH = 0.f, bG = 0.f;
        for (int tb = 0; tb < 8; ++tb) {
            const int tt0 = t0 + tb * 8;
            float accW[8], accA[8], accG[8], accL[8];
#pragma unroll
            for (int k = 0; k < 8; ++k) { const size_t o = (size_t)(tt0 + k) * 512 + c; accW[k] = w0 + p.LW[o]; accA[k] = a0 + p.LA[o]; accG[k] = p.LG[o]; accL[k] = (c < 256) ? gbc + p.LL[(size_t)(tt0 + k) * 256 + c] : 0.f; }
#pragma unroll
            for (int k = 0; k < 8; ++k) {
                const int t = tt0 + k;
                const bf16_t* zc = p.z + (size_t)t * ZLD; const bf16_t* zp = p.z + (size_t)(t > 0 ? t - 1 : 0) * ZLD;
                const float cr = bf2f(zc[RW_R + c]), ck = bf2f(zc[RW_K + c]), cv = bf2f(zc[RW_V + c]);
                const float pr = (t > 0) ? bf2f(zp[RW_R + c]) : 0.f, pk = (t > 0) ? bf2f(zp[RW_K + c]) : 0.f, pv = (t > 0) ? bf2f(zp[RW_V + c]) : 0.f;
                const float r = cr + (pr - cr) * mu_r, kx = ck + (pk - ck) * mu_k, v = cv + (pv - cv) * mu_v;
                const float w_raw = -fsoftplus(-accW[k]) - 0.5f;
                const float decay = __expf(-__expf(w_raw));
                const float iclr = fsig(accA[k]);
                const float kk = kx * kkc;
                const float nrm = sqrtf(wave_sum(kk * kk));
                const float kkn = kk / fmaxf(nrm, 1e-12f);
                const float kmod = kx * (1.0f + (iclr - 1.0f) * kac);
                const float bon = wave_sum(r * kmod * rkc) * v;
                { const int h = c >> 6, j = c & 63; float* rs = p.RS + ((size_t)h * T + t) * 384 + j;
                  rs[0] = -kkn; rs[64] = kkn * iclr; rs[128] = decay; rs[192] = kmod; rs[256] = r; rs[320] = v; }
                p.rGate[(size_t)t * 512 + c] = accG[k]; p.rBonus[(size_t)t * 512 + c] = bon;
                { const float q = bf2f(zc[HG_Q + c]), f = bf2f(zc[HG_F + c]);
                  const float omf = (1.0f - lb) * fsig(-f);
                  bH = fmaxf(bH + __logf(fmaxf(1.0f - omf, 1e-37f)), -85.0f);
                  p.cH[(size_t)t * 512 + c] = f2bf(q * fsig(q) * __expf(bH)); p.KH[(size_t)t * 512 + c] = f2bf(omf * __expf(-bH)); }
                if (c < 256) {
                  bG = fmaxf(bG - fsoftplus(-accL[k]) * (1.0f / 16.0f), -85.0f);
                  p.cG[(size_t)t * 256 + c] = f2bf(bf2f(zc[GL_Q + c]) * 0.125f * __expf(bG)); p.KG[(size_t)t * 256 + c] = f2bf(bf2f(zc[GL_K + c]) * __expf(-bG)); }
            }
        }
        { const int h = c >> 7, j = c & 127; p.GamH[((size_t)tile * 4 + h) * 128 + j] = __expf(bH); }
        if (c < 256) { const int h = c >> 6, j = c & 63; p.GamG[((size_t)tile * 4 + h) * 64 + j] = __expf(bG); }
#pragma unroll 1
        for (int pass = 0; pass < 3; ++pass) {
            const int col0 = pass == 0 ? HG_I : (pass == 1 ? GL_V : SB_V); bf16_t* dstT = p.VtH + (size_t)pass * 512 * T;
            __syncthreads();
            for (int i = 0; i < 64; ++i) vtile[c][i] = p.z[(size_t)(t0 + i) * ZLD + col0 + c];
            __syncthreads();
#pragma unroll
            for (int it = 0; it < 8; ++it) { const int row = it * 64 + (c >> 3), sg = c & 7;
                *(pg8::u32x4*)(dstT + (size_t)row * T + t0 + sg * 8) = *(const LAS pg8::u32x4*)&vtile[row][sg * 8]; }
        }
    }
}

template <int KIND>
__device__ __forceinline__ void chain_unit(const MixArgs& p, const ConvArgs& cva, const int unit, const int seg, const int h, LAS float* lds) {
    constexpr int SF = KIND == 2 ? 512 : (KIND == 3 ? 320 : 384);
    constexpr int EPL = KIND == 2 ? 16 : 8, E2 = EPL / 2, DK = EPL * 8;
    constexpr int CH = 16, NP = CH * SF * 4 / 1024;
    static_assert(KIND == 0, "only the RWKV-7 chain is left (HGRN2 / GLA: intra_unit + chunk scan)");
    const float* stream = p.RS + ((size_t)h * T + (size_t)seg * LSEG) * SF;
    const int tid = phase_tid(), wv = __builtin_amdgcn_readfirstlane(tid >> 6), lane = tid & 63, rg = lane >> 3, lj = lane & 7;
    const bool isP = (KIND == 0) && (wv >= 4);
    const bool active = !(isP && seg == 0);
    const bool wantc = (KIND != 0) && (seg >= 1);
    const int rowA = ((KIND == 0) ? (wv & 3) : wv) * 16 + rg, rowB = rowA + 8;
    const int orow = (isP ? 64 : 0) + rowA;
    LAS float* ob = lds + 2 * CH * SF;
    LAS float* cb = ob;
    constexpr int NT = 8;
    const int jb0 = unit * (LSEG / 16) * NT;
    LAS bf16_t (*cvt)[64][66] = (LAS bf16_t (*)[64][66])(ob + 2 * 16 * 128);
    const int L = p.layer;
    f32x2v SA[E2], SB[E2];
#pragma unroll
    for (int e = 0; e < E2; ++e) { SA[e] = (f32x2v){0.f, 0.f}; SB[e] = (f32x2v){0.f, 0.f};
        if (isP) { if (lj * 8 + 2 * e == rowA) SA[e].x = 1.f; if (lj * 8 + 2 * e + 1 == rowA) SA[e].y = 1.f; if (lj * 8 + 2 * e == rowB) SB[e].x = 1.f; if (lj * 8 + 2 * e + 1 == rowB) SB[e].y = 1.f; } }
    f32x2v gam = (f32x2v){1.f, 1.f};
    auto stage = [&](int ci, LAS float* dst) {
        const char* g = (const char*)(stream + (size_t)ci * CH * SF) + lane * 16;
        for (int pc = wv; pc < NP; pc += 8) __builtin_amdgcn_global_load_lds((const unsigned*)(g + pc * 1024), (LAS unsigned*)((LAS char*)dst + pc * 1024), 16, 0, 0);
    };
    auto writeout = [&](int ci, const LAS float* o, const LAS float* cc) {
#pragma unroll
        for (int q = 0; q < 4; ++q) { const int idx = tid + 512 * q, s = idx >> 7, r = idx & 127; const size_t t = (size_t)seg * LSEG + ci * CH + s; const float v = o[idx];
            if (KIND == 0) { if (r < 64) p.oR[t * 512 + h * 64 + r] = v; else if (seg >= 1) p.cR[t * 512 + h * 64 + (r - 64)] = f2bf(v); }
            else if (KIND == 2) p.oH[t * 512 + h * 128 + r] = v;
            else p.oG[t * 512 + h * 128 + r] = v; }
        if (wantc) {
#pragma unroll
            for (int q = 0; q < (DK * 16) / 512; ++q) { const int idx = tid + 512 * q, s = idx / DK, k = idx % DK; const size_t t = (size_t)seg * LSEG + ci * CH + s;
                if (KIND == 2) p.cH[t * 512 + h * 128 + k] = f2bf(cc[s * 128 + k]); else p.cG[t * 256 + h * 64 + k] = f2bf(cc[s * 128 + k]); }
        }
    };
    constexpr int NCH = LSEG / CH;
    struct OpsR { f32x4v a0, a1, b0, b1, w0, w1, r0, r1, k0, k1; float vA, vB; };
    struct OpsG { f32x4v q[EPL / 4], w[EPL / 4], k[EPL / 4]; float vA, vB; f32x2v gw, gq; };
    const float vscale = isP ? 0.f : 1.f;
    const int goff = (EPL == 8) ? (lj * 8 + wv) : (lj * 16 + 2 * wv);
    stage(0, lds);
    for (int ci = 0; ci < NCH; ++ci) {
        asm volatile("s_waitcnt vmcnt(0)" ::: "memory"); __syncthreads();
        const LAS float* cur = lds + (ci & 1) * CH * SF;
        if (ci + 1 < NCH) stage(ci + 1, lds + ((ci + 1) & 1) * CH * SF);
        if (ci > 0) writeout(ci - 1, ob + ((ci - 1) & 1) * 2048, cb + ((ci - 1) & 1) * 2048);
        LAS float* oc = ob + (ci & 1) * 2048; LAS float* ccur = cb + (ci & 1) * 2048;
        if (ci > 0) {
#pragma unroll
            for (int k4 = 0; k4 < NT; ++k4) { CvJob jb; if (cvx_job(cva, jb0 + (ci - 1) * NT + k4, L, jb)) { const int n = tid >> 3, kc = (tid & 7) * 8;
                const LAS unsigned* tp = (const LAS unsigned*)&cvt[k4][n][kc]; pg8::u32x4 w; w.x = tp[0]; w.y = tp[1]; w.z = tp[2]; w.w = tp[3];
                *(pg8::u32x4*)(jb.dst + (size_t)n * jb.ldd + kc) = w; } }
        }
        float4 cvr[NT][2]; bool cvok[NT];
#pragma unroll
        for (int k4 = 0; k4 < NT; ++k4) { CvJob jb; cvok[k4] = cvx_job(cva, jb0 + ci * NT + k4, L, jb);
            cvr[k4][0] = make_float4(0.f, 0.f, 0.f, 0.f); cvr[k4][1] = cvr[k4][0];
            if (cvok[k4]) { const int c4 = (tid & 15) * 4, kr = tid >> 4;
                if (c4 < jb.valid) { cvr[k4][0] = *(const float4*)(jb.src + (size_t)(2 * kr) * jb.ld + c4); cvr[k4][1] = *(const float4*)(jb.src + (size_t)(2 * kr + 1) * jb.ld + c4); } } }
        if (active) {
            if constexpr (KIND == 0) {
                auto ld = [&](int s) { const LAS float* sp = cur + s * SF + lj * 8; OpsR o;
                    o.a0 = *(const LAS f32x4v*)(sp); o.a1 = *(const LAS f32x4v*)(sp + 4); o.b0 = *(const LAS f32x4v*)(sp + 64); o.b1 = *(const LAS f32x4v*)(sp + 68);
                    o.w0 = *(const LAS f32x4v*)(sp + 128); o.w1 = *(const LAS f32x4v*)(sp + 132); o.k0 = *(const LAS f32x4v*)(sp + 192); o.k1 = *(const LAS f32x4v*)(sp + 196);
                    o.r0 = *(const LAS f32x4v*)(sp + 256); o.r1 = *(const LAS f32x4v*)(sp + 260);
                    o.vA = cur[s * SF + 320 + rowA]; o.vB = cur[s * SF + 320 + rowB]; return o; };
                OpsR nx = ld(0);
#pragma unroll
                for (int s = 0; s < CH; ++s) {
                    const OpsR o = nx;
                    if (s + 1 < CH) nx = ld(s + 1);
                    f32x2v pa = SA[0] * o.a0.xy, pb = SB[0] * o.a0.xy; pa = SA[1] * o.a0.zw + pa; pb = SB[1] * o.a0.zw + pb;
                    f32x2v qa = SA[2] * o.a1.xy, qb = SB[2] * o.a1.xy; qa = SA[3] * o.a1.zw + qa; qb = SB[3] * o.a1.zw + qb; pa += qa; pb += qb;
                    float sA = pa.x + pa.y, sB = pb.x + pb.y;
                    sA += dppmov<0xB1>(sA); sB += dppmov<0xB1>(sB); sA += dppmov<0x4E>(sA); sB += dppmov<0x4E>(sB); sA += dppmov<0x141>(sA); sB += dppmov<0x141>(sB);
                    const f32x2v savA = (f32x2v){sA, sA}, savB = (f32x2v){sB, sB};
                    const float vA = o.vA * vscale, vB = o.vB * vscale; const f32x2v vvA = (f32x2v){vA, vA}, vvB = (f32x2v){vB, vB};
                    SA[0] = SA[0] * o.w0.xy + (savA * o.b0.xy + vvA * o.k0.xy); SB[0] = SB[0] * o.w0.xy + (savB * o.b0.xy + vvB * o.k0.xy);
                    SA[1] = SA[1] * o.w0.zw + (savA * o.b0.zw + vvA * o.k0.zw); SB[1] = SB[1] * o.w0.zw + (savB * o.b0.zw + vvB * o.k0.zw);
                    SA[2] = SA[2] * o.w1.xy + (savA * o.b1.xy + vvA * o.k1.xy); SB[2] = SB[2] * o.w1.xy + (savB * o.b1.xy + vvB * o.k1.xy);
                    SA[3] = SA[3] * o.w1.zw + (savA * o.b1.zw + vvA * o.k1.zw); SB[3] = SB[3] * o.w1.zw + (savB * o.b1.zw + vvB * o.k1.zw);
                    f32x2v oa = SA[0] * o.r0.xy, obb = SB[0] * o.r0.xy; oa = SA[1] * o.r0.zw + oa; obb = SB[1] * o.r0.zw + obb;
                    f32x2v oa2 = SA[2] * o.r1.xy, ob2 = SB[2] * o.r1.xy; oa2 = SA[3] * o.r1.zw + oa2; ob2 = SB[3] * o.r1.zw + ob2; oa += oa2; obb += ob2;
                    float oA = oa.x + oa.y, oB = obb.x + obb.y;
                    oA += dppmov<0xB1>(oA); oB += dppmov<0xB1>(oB); oA += dppmov<0x4E>(oA); oB += dppmov<0x4E>(oB); oA += dppmov<0x141>(oA); oB += dppmov<0x141>(oB);
                    if (lj == 0) { oc[s * 128 + orow] = oA; oc[s * 128 + orow + 8] = oB; }
                }
            } else {
                auto ld = [&](int s) { const LAS float* sp = cur + s * SF + lj * EPL; OpsG o;
#pragma unroll
                    for (int e4 = 0; e4 < EPL / 4; ++e4) { o.q[e4] = *(const LAS f32x4v*)(sp + e4 * 4); o.w[e4] = *(const LAS f32x4v*)(sp + DK + e4 * 4); o.k[e4] = *(const LAS f32x4v*)(sp + 2 * DK + e4 * 4); }
                    o.vA = cur[s * SF + 3 * DK + rowA]; o.vB = cur[s * SF + 3 * DK + rowB];
                    if constexpr (EPL == 8) { o.gw = (f32x2v){cur[s * SF + DK + goff], 1.f}; o.gq = (f32x2v){cur[s * SF + goff], 0.f}; }
                    else { o.gw = *(const LAS f32x2v*)(cur + s * SF + DK + goff); o.gq = *(const LAS f32x2v*)(cur + s * SF + goff); }
                    return o; };
                OpsG nx = ld(0);
#pragma unroll
                for (int s = 0; s < CH; ++s) {
                    const OpsG o = nx;
                    if (s + 1 < CH) nx = ld(s + 1);
                    const f32x2v vvA = (f32x2v){o.vA, o.vA}, vvB = (f32x2v){o.vB, o.vB};
                    f32x2v oa = (f32x2v){0.f, 0.f}, oa2 = oa, obb = oa, ob2 = oa;
#pragma unroll
                    for (int e4 = 0; e4 < EPL / 4; ++e4) {
                        SA[2 * e4] = SA[2 * e4] * o.w[e4].xy + vvA * o.k[e4].xy; SA[2 * e4 + 1] = SA[2 * e4 + 1] * o.w[e4].zw + vvA * o.k[e4].zw;
                        SB[2 * e4] = SB[2 * e4] * o.w[e4].xy + vvB * o.k[e4].xy; SB[2 * e4 + 1] = SB[2 * e4 + 1] * o.w[e4].zw + vvB * o.k[e4].zw;
                        oa = SA[2 * e4] * o.q[e4].xy + oa; oa2 = SA[2 * e4 + 1] * o.q[e4].zw + oa2; obb = SB[2 * e4] * o.q[e4].xy + obb; ob2 = SB[2 * e4 + 1] * o.q[e4].zw + ob2;
                    }
                    oa += oa2; obb += ob2;
                    float oA = oa.x + oa.y, oB = obb.x + obb.y;
                    oA += dppmov<0xB1>(oA); oB += dppmov<0xB1>(oB); oA += dppmov<0x4E>(oA); oB += dppmov<0x4E>(oB); oA += dppmov<0x141>(oA); oB += dppmov<0x141>(oB);
                    if (lj == 0) { oc[s * 128 + rowA] = oA; oc[s * 128 + rowB] = oB; }
                    gam *= o.gw; const f32x2v cq = o.gq * gam;
                    if (wantc && rg == 0) { if constexpr (EPL == 8) ccur[s * 128 + goff] = cq.x; else *(LAS f32x2v*)(ccur + s * 128 + goff) = cq; }
                }
            }
        }
        __syncthreads();
#pragma unroll
        for (int k4 = 0; k4 < NT; ++k4) if (cvok[k4]) { const int c4 = (tid & 15) * 4, kr = tid >> 4; const float4 v0 = cvr[k4][0], v1 = cvr[k4][1];
            *(LAS unsigned*)&cvt[k4][c4][2 * kr] = pg8::cvt_pk_bf16(v0.x, v1.x); *(LAS unsigned*)&cvt[k4][c4 + 1][2 * kr] = pg8::cvt_pk_bf16(v0.y, v1.y);
            *(LAS unsigned*)&cvt[k4][c4 + 2][2 * kr] = pg8::cvt_pk_bf16(v0.z, v1.z); *(LAS unsigned*)&cvt[k4][c4 + 3][2 * kr] = pg8::cvt_pk_bf16(v0.w, v1.w); }
    }
    __syncthreads();
#pragma unroll
    for (int k4 = 0; k4 < NT; ++k4) { CvJob jb; if (cvx_job(cva, jb0 + (NCH - 1) * NT + k4, L, jb)) { const int n = tid >> 3, kc = (tid & 7) * 8;
        const LAS unsigned* tp = (const LAS unsigned*)&cvt[k4][n][kc]; pg8::u32x4 w; w.x = tp[0]; w.y = tp[1]; w.z = tp[2]; w.w = tp[3];
        *(pg8::u32x4*)(jb.dst + (size_t)n * jb.ldd + kc) = w; } }
    writeout(NCH - 1, ob + ((NCH - 1) & 1) * 2048, cb + ((NCH - 1) & 1) * 2048);
    if (active) {
        float* dA;
        if (KIND == 0) dA = (isP ? p.PendR : p.SendR) + (((size_t)seg * 8 + h) * 64 + rowA) * 64 + lj * 8;
        else if (KIND == 2) dA = p.SendH + (((size_t)seg * 4 + h) * 128 + rowA) * 128 + lj * 16;
        else dA = p.SendG + (((size_t)seg * 4 + h) * 128 + rowA) * 64 + lj * 8;
        float* dB = dA + 8 * DK;
#pragma unroll
        for (int e = 0; e < E2; ++e) { dA[2 * e] = SA[e].x; dA[2 * e + 1] = SA[e].y; dB[2 * e] = SB[e].x; dB[2 * e + 1] = SB[e].y; }
    }
    if (wantc && rg == 0) {
        if constexpr (EPL == 8) p.GamG[(size_t)seg * 256 + h * 64 + lj * 8 + wv] = gam.x;
        else { p.GamH[(size_t)seg * 512 + h * 128 + lj * 16 + 2 * wv] = gam.x; p.GamH[(size_t)seg * 512 + h * 128 + lj * 16 + 2 * wv + 1] = gam.y; }
    }
    __syncthreads();
}
__device__ __forceinline__ void sb_phase(const MixArgs& p, const int wave0, const int W, const int uend);
template <int DK>
__device__ __forceinline__ void intra_unit(const MixArgs& p, const int h, const int chunk, LAS bf16_t* ktT, const int lane) {
    typedef short bf16x8v __attribute__((ext_vector_type(8)));
    typedef float f32x16v __attribute__((ext_vector_type(16)));
    typedef __bf16 bf16x2n __attribute__((ext_vector_type(2)));
    constexpr int QP = DK * 4, NKS = DK / 16, NKB = DK / 32;
    const bf16_t* Qb = (DK == 128 ? p.cH : p.cG) + h * DK; const bf16_t* Kb = (DK == 128 ? p.KH : p.KG) + h * DK;
    const bf16_t* Vt = (DK == 128 ? p.VtH : p.VtG) + (size_t)h * 128 * T;
    float* ol = (DK == 128 ? p.oH : p.oG) + h * 128; float* Send = (DK == 128 ? p.SendH : p.SendG) + ((size_t)chunk * 4 + h) * 128 * DK;
    const int r = lane & 31, hh = lane >> 5, t0 = chunk * 64;
#pragma unroll 1
    for (int tb = 0; tb < 2; ++tb) {
        bf16x8v Qf[NKS];
#pragma unroll
        for (int ks = 0; ks < NKS; ++ks) Qf[ks] = *(const bf16x8v*)(Qb + (unsigned)((t0 + 32 * tb + r) * QP + 16 * ks + 8 * hh));
#pragma unroll 1
        for (int vh = 0; vh < 2; ++vh) {
            f32x16v O[2];
#pragma unroll
            for (int vb = 0; vb < 2; ++vb)
#pragma unroll
                for (int i = 0; i < 16; ++i) O[vb][i] = 0.f;
            for (int sb = 0; sb <= tb; ++sb) {
                f32x16v P;
#pragma unroll
                for (int i = 0; i < 16; ++i) P[i] = 0.f;
#pragma unroll
                for (int ks = 0; ks < NKS; ++ks) { const bf16x8v Kf = *(const bf16x8v*)(Kb + (unsigned)((t0 + 32 * sb + r) * QP + 16 * ks + 8 * hh));
                    P = __builtin_amdgcn_mfma_f32_32x32x16_bf16(Kf, Qf[ks], P, 0, 0, 0); }
                const bool diag = (sb == tb);
                bf16x8v Pf[2];
#pragma unroll
                for (int s2 = 0; s2 < 2; ++s2) {
                    union { bf16x2n h2[4]; bf16x8v v; } pk;
#pragma unroll
                    for (int j = 0; j < 4; ++j) { f32x2v f;
                        { const int i = 8 * s2 + 2 * j, kr = (i & 3) + 8 * (i >> 2) + 4 * hh; f.x = (!diag || kr <= r) ? P[i] : 0.f; }
                        { const int i = 8 * s2 + 2 * j + 1, kr = (i & 3) + 8 * (i >> 2) + 4 * hh; f.y = (!diag || kr <= r) ? P[i] : 0.f; }
                        pk.h2[j] = __builtin_convertvector(f, bf16x2n); }
                    Pf[s2] = pk.v; }
#pragma unroll
                for (int vb = 0; vb < 2; ++vb)
#pragma unroll
                    for (int s2 = 0; s2 < 2; ++s2) { const bf16_t* vp = Vt + (unsigned)((32 * (2 * vh + vb) + r) * T + t0 + 32 * sb + 16 * s2 + 4 * hh);
                        union { pg8::u32x2 d[2]; bf16x8v v; } vf; vf.d[0] = *(const pg8::u32x2*)vp; vf.d[1] = *(const pg8::u32x2*)(vp + 8);
                        O[vb] = __builtin_amdgcn_mfma_f32_32x32x16_bf16(vf.v, Pf[s2], O[vb], 0, 0, 0); }
            }
#pragma unroll
            for (int vb = 0; vb < 2; ++vb)
#pragma unroll
                for (int g = 0; g < 4; ++g) { f32x4v w; w.x = O[vb][4 * g]; w.y = O[vb][4 * g + 1]; w.z = O[vb][4 * g + 2]; w.w = O[vb][4 * g + 3];
                    *(f32x4v*)(ol + (unsigned)((t0 + 32 * tb + r) * 512 + 32 * (2 * vh + vb) + 8 * g + 4 * hh)) = w; }
        }
    }
#pragma unroll 4
    for (int it = 0; it < DK / 8; ++it) { const int pidx = it * 64 + lane, srow = pidx / (DK / 8), cb8 = pidx % (DK / 8);
        const pg8::u32x4 w = *(const pg8::u32x4*)(Kb + (unsigned)((t0 + srow) * QP + cb8 * 8));
        const unsigned ww[4] = {w.x, w.y, w.z, w.w};
#pragma unroll
        for (int j = 0; j < 4; ++j) { ktT[(cb8 * 8 + 2 * j) * 66 + srow] = (bf16_t)(ww[j] & 0xffffu); ktT[(cb8 * 8 + 2 * j + 1) * 66 + srow] = (bf16_t)(ww[j] >> 16); } }
#pragma unroll 1
    for (int vb = 0; vb < 4; ++vb) {
        bf16x8v Af[4];
#pragma unroll
        for (int ks = 0; ks < 4; ++ks) Af[ks] = *(const bf16x8v*)(Vt + (unsigned)((32 * vb + r) * T + t0 + 16 * ks + 8 * hh));
#pragma unroll 1
        for (int kb = 0; kb < NKB; ++kb) {
            f32x16v U;
#pragma unroll
            for (int i = 0; i < 16; ++i) U[i] = 0.f;
#pragma unroll
            for (int ks = 0; ks < 4; ++ks) { const LAS unsigned* tp = (const LAS unsigned*)(ktT + (32 * kb + r) * 66 + 16 * ks + 8 * hh);
                union { unsigned d[4]; bf16x8v v; } bf; bf.d[0] = tp[0]; bf.d[1] = tp[1]; bf.d[2] = tp[2]; bf.d[3] = tp[3];
                U = __builtin_amdgcn_mfma_f32_32x32x16_bf16(Af[ks], bf.v, U, 0, 0, 0); }
            float* sp = Send + (unsigned)((32 * vb + 4 * hh) * DK + 32 * kb + r);
#pragma unroll
            for (int i = 0; i < 16; ++i) sp[((i & 3) + 8 * (i >> 2)) * DK] = U[i];
        }
    }
}
__device__ __forceinline__ void chains_phase(const MixArgs& p, const ConvArgs& cva, unsigned* sbq, LAS unsigned char* ldsraw) {
    LAS float* lds = (LAS float*)ldsraw;
    for (int u = blockIdx.x; u < 8 * NSEG; u += gridDim.x) chain_unit<0>(p, cva, u, u >> 3, u & 7, lds);
    LAS int* slot = (LAS int*)(ldsraw + 8 * 128 * 66 * 2);
    const int ptid = phase_tid(), wv = ptid >> 6, lane = ptid & 63;
    LAS bf16_t* ktT = (LAS bf16_t*)ldsraw + (size_t)wv * 128 * 66;
    for (;;) {
        __syncthreads();
        if (ptid == 0) slot[0] = (int)__hip_atomic_fetch_add(sbq, 8u, __ATOMIC_RELAXED, __HIP_MEMORY_SCOPE_AGENT);
        __syncthreads();
        const int base = slot[0];
        if (base >= 2048) break;
        const int u = base + wv; if (u < 1024) intra_unit<128>(p, u & 3, u >> 2, ktT, lane); else intra_unit<64>(p, (u - 1024) & 3, (u - 1024) >> 2, ktT, lane);
    }
}
__device__ __forceinline__ void sb_queue(const MixArgs& p, unsigned* sbq2, LAS unsigned char* ldsraw) {
    LAS int* slot = (LAS int*)(ldsraw + 8 * 128 * 66 * 2);
    const int ptid = phase_tid();
    for (;;) {
        __syncthreads();
        if (ptid == 0) slot[0] = (int)__hip_atomic_fetch_add(sbq2, 8u, __ATOMIC_RELAXED, __HIP_MEMORY_SCOPE_AGENT);
        __syncthreads();
        const int base = slot[0];
        if (base >= 2048) break;
        sb_phase(p, base, 1 << 30, 2048);
    }
}

__device__ __forceinline__ void carry_phase(const MixArgs& p, LAS unsigned char* ldsraw, const int part) {
    const int tid = phase_tid();
    if (part != 2) for (int u = blockIdx.x; u < 16; u += gridDim.x) {
        if (u < 8) {
            const int h = u;
            LAS float (*cur)[68] = (LAS float (*)[68])ldsraw; LAS float (*Pm)[68] = (LAS float (*)[68])(ldsraw + 64 * 68 * 4);
            const int v = tid >> 3, kb = (tid & 7) * 8;
            const size_t eo = (size_t)v * 64 + kb;
            float nv[8], nP[8], nS[8];
            { const f32x4v a0 = *(const f32x4v*)(p.SendR + ((size_t)0 * 8 + h) * 4096 + eo), a1 = *(const f32x4v*)(p.SendR + ((size_t)0 * 8 + h) * 4096 + eo + 4);
              nv[0] = a0.x; nv[1] = a0.y; nv[2] = a0.z; nv[3] = a0.w; nv[4] = a1.x; nv[5] = a1.y; nv[6] = a1.z; nv[7] = a1.w; }
            { const f32x4v a0 = *(const f32x4v*)(p.PendR + ((size_t)1 * 8 + h) * 4096 + eo), a1 = *(const f32x4v*)(p.PendR + ((size_t)1 * 8 + h) * 4096 + eo + 4);
              nP[0] = a0.x; nP[1] = a0.y; nP[2] = a0.z; nP[3] = a0.w; nP[4] = a1.x; nP[5] = a1.y; nP[6] = a1.z; nP[7] = a1.w;
              const f32x4v b0 = *(const f32x4v*)(p.SendR + ((size_t)1 * 8 + h) * 4096 + eo), b1 = *(const f32x4v*)(p.SendR + ((size_t)1 * 8 + h) * 4096 + eo + 4);
              nS[0] = b0.x; nS[1] = b0.y; nS[2] = b0.z; nS[3] = b0.w; nS[4] = b1.x; nS[5] = b1.y; nS[6] = b1.z; nS[7] = b1.w; }
            for (int s = 1; s < NSEG; ++s) {
                __syncthreads();
                { pg8::u32x4 w; w.x = pg8::cvt_pk_bf16(nv[0], nv[1]); w.y = pg8::cvt_pk_bf16(nv[2], nv[3]); w.z = pg8::cvt_pk_bf16(nv[4], nv[5]); w.w = pg8::cvt_pk_bf16(nv[6], nv[7]);
                  *(pg8::u32x4*)(p.SstR + ((size_t)s * 8 + h) * 4096 + eo) = w; }
                if (s == NSEG - 1) break;
#pragma unroll
                for (int e = 0; e < 8; ++e) { cur[v][kb + e] = nv[e]; Pm[v][kb + e] = nP[e]; nv[e] = nS[e]; }
                __syncthreads();
                if (s + 1 < NSEG - 1) {
                    const f32x4v a0 = *(const f32x4v*)(p.PendR + ((size_t)(s + 1) * 8 + h) * 4096 + eo), a1 = *(const f32x4v*)(p.PendR + ((size_t)(s + 1) * 8 + h) * 4096 + eo + 4);
                    nP[0] = a0.x; nP[1] = a0.y; nP[2] = a0.z; nP[3] = a0.w; nP[4] = a1.x; nP[5] = a1.y; nP[6] = a1.z; nP[7] = a1.w;
                    const f32x4v b0 = *(const f32x4v*)(p.SendR + ((size_t)(s + 1) * 8 + h) * 4096 + eo), b1 = *(const f32x4v*)(p.SendR + ((size_t)(s + 1) * 8 + h) * 4096 + eo + 4);
                    nS[0] = b0.x; nS[1] = b0.y; nS[2] = b0.z; nS[3] = b0.w; nS[4] = b1.x; nS[5] = b1.y; nS[6] = b1.z; nS[7] = b1.w;
                }
#pragma unroll 4
                for (int i4 = 0; i4 < 64; i4 += 4) { const f32x4v c4 = *(const LAS f32x4v*)&cur[v][i4];
#pragma unroll
                    for (int ii = 0; ii < 4; ++ii) { const f32x4v p0 = *(const LAS f32x4v*)&Pm[i4 + ii][kb], p1 = *(const LAS f32x4v*)&Pm[i4 + ii][kb + 4]; const float c = c4[ii];
                        nv[0] += c * p0.x; nv[1] += c * p0.y; nv[2] += c * p0.z; nv[3] += c * p0.w; nv[4] += c * p1.x; nv[5] += c * p1.y; nv[6] += c * p1.z; nv[7] += c * p1.w; } }
            }
            __syncthreads();
        }
    }
    if (part != 1) for (int u = blockIdx.x; u < 8 + 192; u += gridDim.x) {
        if (u < 8) continue;
        const bool isH = u < 8 + 128; const int idx = (isH ? (u - 8) : (u - 136)) * 512 + tid;
        const float* Ub = (isH ? p.SendH : p.SendG) + idx; bf16_t* Sb = (isH ? p.SstH : p.SstG) + idx; const size_t cstr = isH ? 65536 : 32768;
        const float* Gb = isH ? p.GamH + (idx >> 14) * 128 + (idx & 127) : p.GamG + (idx >> 13) * 64 + (idx & 63); const int gstr = isH ? 512 : 256;
        float S = 0.f;
        float uu[16], gg[16], un[16], gn[16];
#pragma unroll
        for (int j = 0; j < 16; ++j) { un[j] = Ub[(size_t)j * cstr]; gn[j] = Gb[(size_t)j * gstr]; }
        for (int c0 = 0; c0 < NCHK; c0 += 16) {
#pragma unroll
            for (int j = 0; j < 16; ++j) { uu[j] = un[j]; gg[j] = gn[j]; }
            if (c0 + 16 < NCHK) {
#pragma unroll
                for (int j = 0; j < 16; ++j) { un[j] = Ub[(size_t)(c0 + 16 + j) * cstr]; gn[j] = Gb[(size_t)(c0 + 16 + j) * gstr]; } }
#pragma unroll
            for (int j = 0; j < 16; ++j) { Sb[(size_t)(c0 + j) * cstr] = f2bf(S); S = gg[j] * (S + uu[j]); }
        }
    }
}

__device__ __forceinline__ void mixfin_phase(const MixArgs& p) {
    typedef short bf16x8v __attribute__((ext_vector_type(8)));
    const int tid = phase_tid(), wv = tid >> 6, lane = tid & 63, r = lane & 15, q = lane >> 4, L = p.layer;
    const int W = gridDim.x * 8;
    for (int u = blockIdx.x * 8 + wv; u < 16384; u += W) {
        if (u < 8192) {
            const int tt = u >> 3, h = u & 7, t0 = tt * 16, seg = t0 / LSEG;
            f32x4v acc[4];
#pragma unroll
            for (int nb = 0; nb < 4; ++nb) acc[nb] = (f32x4v){0.f, 0.f, 0.f, 0.f};
            if (seg >= 1) {
#pragma unroll
                for (int ks = 0; ks < 2; ++ks) { const bf16x8v A = *(const bf16x8v*)(p.cR + (size_t)(t0 + r) * 512 + h * 64 + ks * 32 + q * 8);
#pragma unroll
                    for (int nb = 0; nb < 4; ++nb) { const bf16x8v B = *(const bf16x8v*)(p.SstR + (((size_t)seg * 8 + h) * 64 + nb * 16 + r) * 64 + ks * 32 + q * 8);
                        acc[nb] = __builtin_amdgcn_mfma_f32_16x16x32_bf16(A, B, acc[nb], 0, 0, 0); } }
            }
#pragma unroll
            for (int i = 0; i < 4; ++i) { const size_t t = (size_t)t0 + 4 * q + i; float o[4]; float s = 0.f;
#pragma unroll
                for (int nb = 0; nb < 4; ++nb) { o[nb] = acc[nb][i] + p.oR[t * 512 + h * 64 + nb * 16 + r]; s += o[nb]; }
                const float mu = red16(s) * (1.0f / 64.0f); float d2 = 0.f;
#pragma unroll
                for (int nb = 0; nb < 4; ++nb) { o[nb] -= mu; d2 += o[nb] * o[nb]; }
                const float rstd = rsqrtf(red16(d2) * (1.0f / 64.0f) + 64e-5f);
#pragma unroll
                for (int nb = 0; nb < 4; ++nb) { const int c = h * 64 + nb * 16 + r; const float y = o[nb] * rstd * p.rw_ln_w[L * 512 + c] + p.rw_ln_b[L * 512 + c];
                    p.bo[(size_t)T * 512 + t * 512 + c] = f2bf((y + p.rBonus[t * 512 + c]) * p.rGate[t * 512 + c]); } }
        } else {
            const bool isH = u < 12288; const int qq = isH ? u - 8192 : u - 12288;
            const int tt = qq >> 2, h = qq & 3, t0 = tt * 16, seg = t0 >> 6;
            f32x4v acc[8];
#pragma unroll
            for (int nb = 0; nb < 8; ++nb) acc[nb] = (f32x4v){0.f, 0.f, 0.f, 0.f};
            if (seg >= 1) {
                if (isH) {
#pragma unroll
                    for (int ks = 0; ks < 4; ++ks) { const bf16x8v A = *(const bf16x8v*)(p.cH + (size_t)(t0 + r) * 512 + h * 128 + ks * 32 + q * 8);
#pragma unroll
                        for (int nb = 0; nb < 8; ++nb) { const bf16x8v B = *(const bf16x8v*)(p.SstH + (((size_t)seg * 4 + h) * 128 + nb * 16 + r) * 128 + ks * 32 + q * 8);
                            acc[nb] = __builtin_amdgcn_mfma_f32_16x16x32_bf16(A, B, acc[nb], 0, 0, 0); } }
                } else {
#pragma unroll
                    for (int ks = 0; ks < 2; ++ks) { const bf16x8v A = *(const bf16x8v*)(p.cG + (size_t)(t0 + r) * 256 + h * 64 + ks * 32 + q * 8);
#pragma unroll
                        for (int nb = 0; nb < 8; ++nb) { const bf16x8v B = *(const bf16x8v*)(p.SstG + (((size_t)seg * 4 + h) * 128 + nb * 16 + r) * 64 + ks * 32 + q * 8);
                            acc[nb] = __builtin_amdgcn_mfma_f32_16x16x32_bf16(A, B, acc[nb], 0, 0, 0); } }
                }
            }
            const float* ol = isH ? p.oH : p.oG; const float* gain = (isH ? p.hg_norm_w : p.gla_norm_w) + L * 512; const int gcol = isH ? HG_G : GL_R;
            bf16_t* bo = p.bo + (isH ? (size_t)0 : (size_t)3 * T * 512);
#pragma unroll
            for (int i = 0; i < 4; ++i) { const size_t t = (size_t)t0 + 4 * q + i; float o[8]; float ss = 0.f;
#pragma unroll
                for (int nb = 0; nb < 8; ++nb) { o[nb] = acc[nb][i] + ol[t * 512 + h * 128 + nb * 16 + r]; ss += o[nb] * o[nb]; }
                const float rs = rsqrtf(red16(ss) * (1.0f / 128.0f) + 1e-5f);
#pragma unroll
                for (int nb = 0; nb < 8; ++nb) { const int c = h * 128 + nb * 16 + r; const float g = bf2f(p.z[t * ZLD + gcol + c]);
                    bo[t * 512 + c] = f2bf(o[nb] * rs * gain[c] * siluf_(g)); } }
        }
    }
}
__device__ __forceinline__ void sb_phase(const MixArgs& p, const int wave0, const int W, const int uend) {
    typedef short bf16x8v __attribute__((ext_vector_type(8)));
    typedef float f32x16v __attribute__((ext_vector_type(16)));
    typedef __bf16 bf16x2n __attribute__((ext_vector_type(2)));
    const int tid = phase_tid(), wv = tid >> 6, lane = tid & 63, r = lane & 31, hh = lane >> 5;
    const float scale = 0.08838834764831845f;
    for (int u = wave0 + wv; u < uend; u += W) {
        const int h = u & 3, qb = u >> 2, q0 = qb * 32;
        bf16x8v Qf[8];
#pragma unroll
        for (int s = 0; s < 8; ++s) Qf[s] = *(const bf16x8v*)(p.z + (size_t)(q0 + r) * ZLD + SB_Q + h * 128 + s * 16 + hh * 8);
        f32x16v O[4];
#pragma unroll
        for (int db = 0; db < 4; ++db)
#pragma unroll
            for (int i = 0; i < 16; ++i) O[db][i] = 0.f;
        float R = 0.f;
        for (int kb = qb; kb >= 0; --kb) {
            const int k0 = kb * 32;
            f32x16v Sacc;
#pragma unroll
            for (int i = 0; i < 16; ++i) Sacc[i] = 0.f;
#pragma unroll
            for (int s = 0; s < 8; ++s) { const bf16x8v Kf = *(const bf16x8v*)(p.z + (size_t)(k0 + r) * ZLD + SB_K + h * 128 + s * 16 + hh * 8);
                Sacc = __builtin_amdgcn_mfma_f32_32x32x16_bf16(Kf, Qf[s], Sacc, 0, 0, 0); }
            float lk[16], zz[16]; bool valid[16];
            const bool diag = (kb == qb);
#pragma unroll
            for (int i = 0; i < 16; ++i) { const int kr = (i & 3) + 8 * (i >> 2) + 4 * hh;
                valid[i] = !diag || (kr < r);
                zz[i] = Sacc[i] * scale;
                const float sp = fmaxf(zz[i], 0.f) + __logf(1.0f + __expf(-fabsf(zz[i])));
                lk[i] = valid[i] ? -sp : 0.f; }
            float G[4], Gp[4];
#pragma unroll
            for (int g = 0; g < 4; ++g) { G[g] = (lk[4 * g] + lk[4 * g + 1]) + (lk[4 * g + 2] + lk[4 * g + 3]); Gp[g] = __shfl_xor(G[g], 32); }
            float Tq[4]; float run = 0.f;
#pragma unroll
            for (int g = 3; g >= 0; --g) { Tq[g] = run + (hh == 0 ? Gp[g] : 0.f); run += G[g] + Gp[g]; }
            float wgt[16];
#pragma unroll
            for (int g = 0; g < 4; ++g) { float ing = 0.f;
#pragma unroll
                for (int j = 3; j >= 0; --j) { const int i = 4 * g + j;
                    const float logw = zz[i] + lk[i] + (R + Tq[g] + ing);
                    wgt[i] = valid[i] ? __expf(logw) : 0.f;
                    ing += lk[i]; } }
            R += run;
            bf16x8v Pf[2];
#pragma unroll
            for (int s2 = 0; s2 < 2; ++s2) {
                union { bf16x2n h2[4]; bf16x8v v; } pk;
#pragma unroll
                for (int j = 0; j < 4; ++j) { f32x2v f; f.x = wgt[8 * s2 + 2 * j]; f.y = wgt[8 * s2 + 2 * j + 1]; pk.h2[j] = __builtin_convertvector(f, bf16x2n); }
                Pf[s2] = pk.v; }
#pragma unroll
            for (int db = 0; db < 4; ++db)
#pragma unroll
                for (int s2 = 0; s2 < 2; ++s2) { const bf16_t* vp = p.Vt + (size_t)(h * 128 + db * 32 + r) * T + k0 + 16 * s2 + 4 * hh;
                    union { pg8::u32x2 d[2]; bf16x8v v; } vf; vf.d[0] = *(const pg8::u32x2*)vp; vf.d[1] = *(const pg8::u32x2*)(vp + 8);
                    O[db] = __builtin_amdgcn_mfma_f32_32x32x16_bf16(vf.v, Pf[s2], O[db], 0, 0, 0); }
            if (__all(R < -104.0f)) break;
        }
        bf16_t* bo2 = p.bo + (size_t)2 * T * 512 + (size_t)(q0 + r) * 512 + h * 128;
#pragma unroll
        for (int db = 0; db < 4; ++db)
#pragma unroll
            for (int g = 0; g < 4; ++g) { pg8::u32x2 w; w.x = (unsigned)f2bf(O[db][4 * g]) | ((unsigned)f2bf(O[db][4 * g + 1]) << 16); w.y = (unsigned)f2bf(O[db][4 * g + 2]) | ((unsigned)f2bf(O[db][4 * g + 3]) << 16);
                *(pg8::u32x2*)(bo2 + db * 32 + 8 * g + 4 * hh) = w; }
    }
}

#define XB_TMO      128
#define XB_XCNT(j)  (256  + 64 * (j))
#define XB_XSUB(j)  (1280 + 64 * (j))
#define XB_XGEN(j)  (2304 + 64 * (j))
#define XB_TOP      3328
#define XB_TOPGEN   3392
#define XCD_BAR_WORDS 3456
#define XB_SPIN_CAP (1u << 18)
__device__ __forceinline__ unsigned xb_ld(unsigned* p)              { return __hip_atomic_load(p, __ATOMIC_RELAXED, __HIP_MEMORY_SCOPE_AGENT); }
__device__ __forceinline__ unsigned xb_add(unsigned* p, unsigned v) { return __hip_atomic_fetch_add(p, v, __ATOMIC_RELAXED, __HIP_MEMORY_SCOPE_AGENT); }
__device__ __forceinline__ unsigned xb_xcc_id() { return (unsigned)__builtin_amdgcn_s_getreg((3 << 11) | 20) & 0xFu; }
#define XB_SPIN(cond, bar) do { unsigned _sp = 0; while (cond) { __builtin_amdgcn_s_sleep(1); \
    if ((++_sp & 255u) == 0u) { if (xb_ld(&(bar)[XB_TMO])) break; if (_sp > XB_SPIN_CAP) { atomicAdd(&(bar)[XB_TMO], 1u); break; } } } } while (0)
struct XcdBarrier { unsigned* bar; unsigned x; volatile LAS unsigned* st; };
__device__ __forceinline__ XcdBarrier xcd_barrier_post(unsigned* bar, volatile LAS unsigned* st) {
    XcdBarrier b; b.bar = bar; b.x = xb_xcc_id(); b.st = st;
    if (threadIdx.x == 0) (void)xb_add(&bar[XB_XCNT(b.x)], 1u);
    return b;
}
__device__ __forceinline__ void xcd_barrier_complete(unsigned* bar, unsigned x, unsigned& nloc, unsigned& nx) {
    const unsigned G = gridDim.x * gridDim.y * gridDim.z;
    unsigned sum, cnt, mine, sp = 0u;
    for (;;) {
        sum = 0u; cnt = 0u; mine = 0u;
#pragma unroll
        for (unsigned j = 0; j < 16; ++j) { const unsigned c = xb_ld(&bar[XB_XCNT(j)]); sum += c; cnt += (c > 0u) ? 1u : 0u; mine = (j == x) ? c : mine; }
        if (sum == G) break;
        __builtin_amdgcn_s_sleep(1);
        if ((++sp & 255u) == 0u) { if (xb_ld(&bar[XB_TMO])) break; if (sp > XB_SPIN_CAP) { atomicAdd(&bar[XB_TMO], 1u); break; } }
    }
    nloc = mine > 0u ? mine : 1u; nx = cnt > 0u ? cnt : 1u;
}
__device__ __forceinline__ void xcd_barrier(const XcdBarrier& b) {
    asm volatile("s_waitcnt vmcnt(0)" ::: "memory");
    __syncthreads();
    if (threadIdx.x == 0) {
        unsigned* bar = b.bar;
        __builtin_amdgcn_s_waitcnt(0);
        unsigned nloc = b.st[0], nx = b.st[1];
        if (nloc == 0u) { xcd_barrier_complete(bar, b.x, nloc, nx); b.st[0] = nloc; b.st[1] = nx; }
        const unsigned old = xb_add(&bar[XB_XSUB(b.x)], 1u);
        const unsigned gen = old / nloc;
        if (old + 1u == (gen + 1u) * nloc) {
            __builtin_amdgcn_fence(__ATOMIC_RELEASE, "agent");
            asm volatile("s_waitcnt vmcnt(0)" ::: "memory");
            const unsigned og = xb_add(&bar[XB_TOP], 1u);
            const unsigned tg = og / nx;
            if (og + 1u == (tg + 1u) * nx) xb_add(&bar[XB_TOPGEN], 1u);
            else XB_SPIN(xb_ld(&bar[XB_TOPGEN]) == tg, bar);
            __builtin_amdgcn_fence(__ATOMIC_ACQUIRE, "agent");
            xb_add(&bar[XB_XGEN(b.x)], 1u);
            asm volatile("s_waitcnt vmcnt(0)" ::: "memory");
        } else {
            XB_SPIN(xb_ld(&bar[XB_XGEN(b.x)]) == gen, bar);
            __builtin_amdgcn_fence(__ATOMIC_ACQUIRE, "agent");
            asm volatile("s_waitcnt vmcnt(0)" ::: "memory");
        }
    }
    __syncthreads();
}


constexpr size_t al256(size_t x) { return (x + 255) & ~(size_t)255; }
constexpr size_t TS_ = (size_t)T * 512 * 4;
constexpr size_t OFF_BAR = 0;
constexpr size_t OFF_Z = al256(OFF_BAR + 3456 * 4);
constexpr size_t OFF_RS = OFF_Z + al256((size_t)T * ZLD * 2);
constexpr size_t OFF_XB = al256(OFF_RS + (size_t)8 * T * 384 * 4);
constexpr size_t OFF_REGM = al256(OFF_XB + (size_t)T * D * 2);
constexpr size_t OFF_KH = OFF_REGM, OFF_KG = OFF_KH + (size_t)T * 512 * 2, OFF_VTH = OFF_KG + (size_t)T * 256 * 2, OFF_VTG = OFF_VTH + (size_t)512 * T * 2, OFF_VT = OFF_VTG + (size_t)512 * T * 2;
constexpr size_t OFF_RGATE = OFF_VT + (size_t)512 * T * 2, OFF_RBONUS = OFF_RGATE + TS_;
constexpr size_t OFF_SENDH = OFF_RBONUS + TS_, OFF_SENDG = OFF_SENDH + (size_t)NCHK * 4 * 128 * 128 * 4, OFF_SSTH = OFF_SENDG + (size_t)NCHK * 4 * 128 * 64 * 4, OFF_SSTG = OFF_SSTH + (size_t)NCHK * 4 * 128 * 128 * 2;
constexpr size_t OFF_GAMH = OFF_SSTG + (size_t)NCHK * 4 * 128 * 64 * 2, OFF_GAMG = OFF_GAMH + (size_t)NCHK * 4 * 128 * 4, OFF_REGM_END = OFF_GAMG + (size_t)NCHK * 4 * 64 * 4;
constexpr size_t OFF_HBUF = OFF_REGM, OFF_X1 = OFF_REGM + (size_t)MAXROWS * FW * 2;
constexpr size_t OFF_OR = al256(OFF_REGM + (size_t)MAXROWS * FW * 2 + (size_t)T * D * 4);
constexpr size_t OFF_OH = OFF_OR + TS_, OFF_OG = OFF_OH + TS_, OFF_CR = OFF_OG + TS_, OFF_CH = OFF_CR + TS_ / 2, OFF_CG = OFF_CH + TS_ / 2;
constexpr size_t OFF_SENDR = OFF_CG + TS_ / 4, OFF_PENDR = OFF_SENDR + (size_t)NSEG * 8 * 64 * 64 * 4, OFF_SSTR = OFF_PENDR + (size_t)NSEG * 8 * 64 * 64 * 4;
constexpr size_t OFF_BO = al256(OFF_SSTR + (size_t)NSEG * 8 * 64 * 64 * 2);
constexpr size_t OFF_MERGED = OFF_BO + 4 * (size_t)T * 512 * 2, OFF_MERGEDB = OFF_MERGED + (size_t)T * D * 4, OFF_X1B = OFF_MERGEDB + (size_t)T * D * 2;
constexpr size_t OFF_WINT = OFF_X1B + (size_t)T * D * 2, OFF_WGUT = OFF_WINT + (size_t)ZLD * D * 2, OFF_WDT = OFF_WGUT + (size_t)65 * 1024 * D * 2, OFF_WBRT = OFF_WDT + (size_t)65 * D * FW * 2, OFF_WOUTT = OFF_WBRT + (size_t)4 * D * FW * 2;
constexpr size_t OFF_IDX = OFF_WOUTT + (size_t)D * D * 2, OFF_WSEL = OFF_IDX + (size_t)T * 8 * 4, OFF_HIST = OFF_WSEL + (size_t)T * 8 * 4, OFF_ROWTOK = OFF_HIST + 256 * 64 * 4;
constexpr size_t OFF_ROWW = OFF_ROWTOK + (size_t)MAXROWS * 4, OFF_SLOTPOS = OFF_ROWW + (size_t)MAXROWS * 4, OFF_PANEXP = OFF_SLOTPOS + (size_t)T * 8 * 4, OFF_NPAN = al256(OFF_PANEXP + MAXPANELS * 4);
constexpr size_t OFF_WRH = OFF_NPAN + 256, OFF_WRL = OFF_WRH + (size_t)2 * NE * D * 2;
constexpr size_t OFF_W2T = OFF_WRL + (size_t)2 * NE * D * 2, OFF_A2T = OFF_W2T + (size_t)2 * 512 * 32 * 2, OFF_G2T = OFF_A2T + (size_t)2 * 512 * 32 * 2, OFF_GGT = OFF_G2T + (size_t)2 * 512 * 96 * 2;
constexpr size_t WS_NEEDED = OFF_GGT + (size_t)2 * 256 * 32 * 2;
static_assert(OFF_RS + (size_t)8 * T * 384 * 4 - OFF_Z >= (size_t)MAXROWS * D * 2, "ybuf must fit in region Y");
static_assert(OFF_REGM_END <= OFF_OR, "region M");
static_assert(OFF_VTG == OFF_VTH + (size_t)512 * T * 2 && OFF_VT == OFF_VTG + (size_t)512 * T * 2, "prep writes VtH, VtG, Vt as one array of three");
__device__ __forceinline__ void ln_row(const float (&v)[32], float s, const float* __restrict__ w, const float* __restrict__ b, float* __restrict__ outf, bf16_t* __restrict__ outb, int lane) {
    const float mu = wave_sum(s) * (1.0f / D);
    float q = 0.f;
#pragma unroll
    for (int i = 0; i < 32; ++i) { const float d = v[i] - mu; q += d * d; }
    const float rstd = rsqrtf(wave_sum(q) * (1.0f / D) + 1e-5f);
#pragma unroll
    for (int i = 0; i < 8; ++i) {
        const unsigned c = (unsigned)(i * 256 + lane * 4);
        const float4 ww = *(const float4*)(w + c), bb = *(const float4*)(b + c);
        float4 o; o.x = (v[4 * i] - mu) * rstd * ww.x + bb.x; o.y = (v[4 * i + 1] - mu) * rstd * ww.y + bb.y; o.z = (v[4 * i + 2] - mu) * rstd * ww.z + bb.z; o.w = (v[4 * i + 3] - mu) * rstd * ww.w + bb.w;
        *(float4*)(outf + c) = o;
        if (outb) { pg8::u32x2 pk; pk.x = pg8::cvt_pk_bf16(o.x, o.y); pk.y = pg8::cvt_pk_bf16(o.z, o.w); *(pg8::u32x2*)(outb + c) = pk; }
    }
}
struct KArgs {
    const float* in[32]; char* ws; float* out;
};
struct MegaArgs {
    MixArgs mix;
    const float *x_in, *w_in, *w_br, *w_out, *ln1_w, *ln1_b, *w_router, *router_bias, *we_gate, *we_up, *we_down, *ws_gate, *ws_up, *ws_down, *ln2_w, *ln2_b;
    bf16_t *xb, *WinT, *WguT, *WdT, *WbrT, *WoutT, *mergedb, *x1b, *hbuf, *ybuf, *WrH, *WrL;
    float *merged, *x1, *out;
    int* idx; float* wsel; int *hist, *row_tok; float* row_w; int *slotpos, *panel_expert, *npanels;
    unsigned* bar;
};
__host__ __device__ __forceinline__ MegaArgs make_args(const KArgs& k) {
    MegaArgs a; char* ws = k.ws;
    a.x_in = k.in[0]; a.w_in = k.in[1];
    a.mix.hg_lb_logits = k.in[2]; a.mix.hg_norm_w = k.in[3]; a.mix.rw_mu = k.in[4]; a.mix.rw_w0 = k.in[5]; a.mix.rw_w2 = k.in[6]; a.mix.rw_a0 = k.in[7]; a.mix.rw_a2 = k.in[8]; a.mix.rw_g2 = k.in[9];
    a.mix.rw_kk = k.in[10]; a.mix.rw_ka = k.in[11]; a.mix.rw_rk = k.in[12]; a.mix.rw_ln_w = k.in[13]; a.mix.rw_ln_b = k.in[14]; a.mix.gla_g2 = k.in[15]; a.mix.gla_gb = k.in[16]; a.mix.gla_norm_w = k.in[17];
    a.w_br = k.in[18]; a.w_out = k.in[19]; a.ln1_w = k.in[20]; a.ln1_b = k.in[21]; a.w_router = k.in[22]; a.router_bias = k.in[23]; a.we_gate = k.in[24]; a.we_up = k.in[25]; a.we_down = k.in[26];
    a.ws_gate = k.in[27]; a.ws_up = k.in[28]; a.ws_down = k.in[29]; a.ln2_w = k.in[30]; a.ln2_b = k.in[31];
    a.bar = (unsigned*)(ws + OFF_BAR);
    a.mix.z = (const bf16_t*)(ws + OFF_Z); a.mix.RS = (float*)(ws + OFF_RS); a.ybuf = (bf16_t*)(ws + OFF_Z); a.xb = (bf16_t*)(ws + OFF_XB);
    a.mix.KH = (bf16_t*)(ws + OFF_KH); a.mix.KG = (bf16_t*)(ws + OFF_KG); a.mix.VtH = (bf16_t*)(ws + OFF_VTH); a.mix.VtG = (bf16_t*)(ws + OFF_VTG); a.mix.Vt = (bf16_t*)(ws + OFF_VT); a.mix.rGate = (float*)(ws + OFF_RGATE); a.mix.rBonus = (float*)(ws + OFF_RBONUS);
    a.hbuf = (bf16_t*)(ws + OFF_HBUF); a.x1 = (float*)(ws + OFF_X1);
    a.mix.oR = (float*)(ws + OFF_OR); a.mix.oH = (float*)(ws + OFF_OH); a.mix.oG = (float*)(ws + OFF_OG); a.mix.cR = (bf16_t*)(ws + OFF_CR); a.mix.cH = (bf16_t*)(ws + OFF_CH); a.mix.cG = (bf16_t*)(ws + OFF_CG);
    a.mix.SendR = (float*)(ws + OFF_SENDR); a.mix.PendR = (float*)(ws + OFF_PENDR); a.mix.SendH = (float*)(ws + OFF_SENDH); a.mix.SendG = (float*)(ws + OFF_SENDG); a.mix.GamH = (float*)(ws + OFF_GAMH); a.mix.GamG = (float*)(ws + OFF_GAMG);
    a.mix.SstR = (bf16_t*)(ws + OFF_SSTR); a.mix.SstH = (bf16_t*)(ws + OFF_SSTH); a.mix.SstG = (bf16_t*)(ws + OFF_SSTG);
    a.mix.bo = (bf16_t*)(ws + OFF_BO); a.merged = (float*)(ws + OFF_MERGED); a.mergedb = (bf16_t*)(ws + OFF_MERGEDB); a.x1b = (bf16_t*)(ws + OFF_X1B); a.out = k.out;
    a.WinT = (bf16_t*)(ws + OFF_WINT); a.WguT = (bf16_t*)(ws + OFF_WGUT); a.WdT = (bf16_t*)(ws + OFF_WDT); a.WbrT = (bf16_t*)(ws + OFF_WBRT); a.WoutT = (bf16_t*)(ws + OFF_WOUTT);
    a.idx = (int*)(ws + OFF_IDX); a.wsel = (float*)(ws + OFF_WSEL); a.hist = (int*)(ws + OFF_HIST); a.row_tok = (int*)(ws + OFF_ROWTOK); a.row_w = (float*)(ws + OFF_ROWW);
    a.slotpos = (int*)(ws + OFF_SLOTPOS); a.panel_expert = (int*)(ws + OFF_PANEXP); a.npanels = (int*)(ws + OFF_NPAN);
    a.WrH = (bf16_t*)(ws + OFF_WRH); a.WrL = (bf16_t*)(ws + OFF_WRL);
    a.mix.W2T = (const bf16_t*)(ws + OFF_W2T); a.mix.A2T = (const bf16_t*)(ws + OFF_A2T); a.mix.G2T = (const bf16_t*)(ws + OFF_G2T); a.mix.GGT = (const bf16_t*)(ws + OFF_GGT);
    a.mix.LW = (float*)(ws + OFF_MERGED); a.mix.LA = a.mix.LW + (size_t)T * 512; a.mix.LG = a.mix.LA + (size_t)T * 512; a.mix.LL = a.mix.LG + (size_t)T * 512;
    a.mix.layer = 0; a.mix.pad_ = 0;
    return a;
}
__device__ __forceinline__ void ln_router_phase(const MegaArgs& a, int L, LAS unsigned char* ldsraw) {
    LAS int* hs = (LAS int*)ldsraw;
    const int tid = phase_tid(), lane = tid & 63, wv = __builtin_amdgcn_readfirstlane(tid >> 6);
    const float* pre = a.merged; const float* wr = a.w_router + (size_t)L * D * NE;
    const float bias = a.router_bias[L * NE + lane];
    for (int vb = blockIdx.x; vb < 256; vb += gridDim.x) {
        __syncthreads();
        if (tid < 64) hs[tid] = 0;
        for (int i = 0; i < 8; ++i) {
            const size_t row = (size_t)vb * 64 + wv * 8 + i;
            const float* p = pre + row * D; float v[32]; float s = 0.f;
#pragma unroll
            for (int j = 0; j < 8; ++j) { const float4 x = *(const float4*)(p + j * 256 + lane * 4); v[4 * j] = x.x; v[4 * j + 1] = x.y; v[4 * j + 2] = x.z; v[4 * j + 3] = x.w; s += (x.x + x.y) + (x.z + x.w); }
            ln_row(v, s, a.ln1_w + L * D, a.ln1_b + L * D, a.x1 + row * D, a.x1b + row * D, lane);
        }
        asm volatile("s_waitcnt vmcnt(0)" ::: "memory");
        __syncthreads();
        {
            typedef short bf16x8v __attribute__((ext_vector_type(8)));
            typedef __bf16 bf16x2n __attribute__((ext_vector_type(2)));
            const int tile = wv >> 1, khalf = wv & 1, r = lane & 15, q = lane >> 4;
            const float* xrow = a.x1 + (size_t)(vb * 64 + tile * 16 + r) * D + khalf * 1024 + q * 8;
            const bf16_t* bh = a.WrH + (size_t)L * NE * D + (size_t)r * D + khalf * 1024 + q * 8; const bf16_t* bl = a.WrL + (size_t)L * NE * D + (size_t)r * D + khalf * 1024 + q * 8;
            f32x4v acc[4];
#pragma unroll
            for (int nb = 0; nb < 4; ++nb) acc[nb] = (f32x4v){0.f, 0.f, 0.f, 0.f};
#pragma unroll 2
            for (int ks = 0; ks < 32; ++ks) {
                const float4 x0 = *(const float4*)(xrow + ks * 32), x1v = *(const float4*)(xrow + ks * 32 + 4);
                const float xs[8] = {x0.x, x0.y, x0.z, x0.w, x1v.x, x1v.y, x1v.z, x1v.w};
                union { bf16x2n h2[4]; bf16x8v v; } ah, al;
#pragma unroll
                for (int j = 0; j < 4; ++j) { f32x2v f; f.x = xs[2 * j]; f.y = xs[2 * j + 1]; const bf16x2n hh = __builtin_convertvector(f, bf16x2n); ah.h2[j] = hh;
                    const f32x2v back = __builtin_convertvector(hh, f32x2v); al.h2[j] = __builtin_convertvector(f - back, bf16x2n); }
#pragma unroll
                for (int nb = 0; nb < 4; ++nb) { const bf16x8v Bh = *(const bf16x8v*)(bh + (size_t)nb * 16 * D + ks * 32), Bl = *(const bf16x8v*)(bl + (size_t)nb * 16 * D + ks * 32);
                    acc[nb] = __builtin_amdgcn_mfma_f32_16x16x32_bf16(ah.v, Bh, acc[nb], 0, 0, 0);
                    acc[nb] = __builtin_amdgcn_mfma_f32_16x16x32_bf16(al.v, Bh, acc[nb], 0, 0, 0);
                    acc[nb] = __builtin_amdgcn_mfma_f32_16x16x32_bf16(ah.v, Bl, acc[nb], 0, 0, 0); }
            }
            LAS float* lg = (LAS float*)(ldsraw + 1024) + (size_t)((tile * 2 + khalf) * 16) * 64;
#pragma unroll
            for (int nb = 0; nb < 4; ++nb)
#pragma unroll
                for (int i = 0; i < 4; ++i) lg[(4 * q + i) * 64 + nb * 16 + r] = acc[nb][i];
        }
        __syncthreads();
        for (int it = 0; it < 8; ++it) {
            {
                const int tk = wv * 8 + it, t = vb * 64 + tk;
                const LAS float* lg = (const LAS float*)(ldsraw + 1024) + (size_t)(((tk >> 4) * 2) * 16 + (tk & 15)) * 64;
                const float logit = lg[lane] + lg[16 * 64 + lane];
                const float score = sigmoidf_(logit);
                const float biased = score + bias;
                float m1 = biased;
                m1 = fmaxf(m1, __shfl_xor(m1, 1)); m1 = fmaxf(m1, __shfl_xor(m1, 2)); m1 = fmaxf(m1, __shfl_xor(m1, 4));
                int am = (biased == m1) ? lane : 64;
                am = min(am, __shfl_xor(am, 1)); am = min(am, __shfl_xor(am, 2)); am = min(am, __shfl_xor(am, 4));
                float m2 = (lane == am) ? -INFINITY : biased;
                m2 = fmaxf(m2, __shfl_xor(m2, 1)); m2 = fmaxf(m2, __shfl_xor(m2, 2)); m2 = fmaxf(m2, __shfl_xor(m2, 4));
                const float gs = m1 + m2;
                const int g = lane >> 3;
                int grank = 0;
#pragma unroll
                for (int g2 = 0; g2 < 8; ++g2) { const float o = __shfl(gs, g2 * 8); grank += (o > gs || (o == gs && g2 < g)) ? 1 : 0; }
                const float masked = (grank < 4) ? biased : -INFINITY;
                int rank = 0;
                for (int e2 = 0; e2 < 64; ++e2) { const float o = rdlane(masked, e2); rank += (o > masked || (o == masked && e2 < lane)) ? 1 : 0; }
                const bool sel = rank < 8;
                const float ssum = wave_sum(sel ? score : 0.f);
                if (sel) { a.idx[(size_t)t * 8 + rank] = lane; a.wsel[(size_t)t * 8 + rank] = 2.5f * score / ssum; atomicAdd((int*)&hs[lane], 1); }
            }
        }
        __syncthreads();
        if (tid < 64) a.hist[vb * 64 + tid] = hs[tid];
    }
}
__device__ __forceinline__ void dispatch_phase(const MegaArgs& a, LAS unsigned char* ldsraw) {
    LAS int* tot = (LAS int*)ldsraw; LAS int* bef = tot + 64; LAS int* pstart = tot + 128; LAS int* es = tot + 192; LAS int* np_s = tot + 704; LAS int* ptot = tot + 768; LAS int* pbef = tot + 1280;
    const int tid = phase_tid();
    for (int blk = blockIdx.x; blk < 256; blk += gridDim.x) {
        __syncthreads();
        { const int part = tid >> 6, e = tid & 63; int b = 0, sm = 0;
#pragma unroll 8
          for (int j = part * 32; j < part * 32 + 32; ++j) { const int cc = a.hist[j * 64 + e]; if (j < blk) b += cc; sm += cc; }
          ptot[tid] = sm; pbef[tid] = b; }
        __syncthreads();
        if (tid < 64) { int sm = 0, b = 0;
#pragma unroll
            for (int pp = 0; pp < 8; ++pp) { sm += ptot[pp * 64 + tid]; b += pbef[pp * 64 + tid]; }
            tot[tid] = sm; bef[tid] = b; }
        __syncthreads();
        if (tid == 0) { int acc = 0; for (int e = 0; e < 64; ++e) { pstart[e] = acc; acc += (tot[e] + 255) / 256 * 256; } np_s[0] = acc / 256; }
        const int t = blk * 64 + (tid >> 3), k = tid & 7;
        const int e = a.idx[(size_t)t * 8 + k];
        es[tid] = e;
        __syncthreads();
        int rank = 0;
        for (int j = 0; j < tid; ++j) rank += (es[j] == e) ? 1 : 0;
        const int pos = pstart[e] + bef[e] + rank;
        a.row_tok[pos] = t; a.row_w[pos] = a.wsel[(size_t)t * 8 + k]; a.slotpos[(size_t)t * 8 + k] = pos;
        const int NP = np_s[0];
        if (blk < 64) {
            const int ee = blk, st = pstart[ee], cnt = tot[ee], pad = (cnt + 255) / 256 * 256;
            for (int r = st + cnt + tid; r < st + pad; r += 512) { a.row_tok[r] = 0; a.row_w[r] = 0.f; }
            for (int pp = st / 256 + tid; pp < (st + pad) / 256; pp += 512) a.panel_expert[pp] = ee;
        }
        if (tid < 64) { const int tt = blk * 64 + tid; a.row_tok[NP * 256 + tt] = tt; a.row_w[NP * 256 + tt] = 1.0f; }
        if (blk == 0) { if (tid < 64) a.panel_expert[NP + tid] = 64; if (tid == 0) a.npanels[0] = NP + 64; }
    }
}
__device__ __forceinline__ void combine_phase(const MegaArgs& a, int L, LAS unsigned char* ldsraw) {
    const int ptid = phase_tid(); const int lane = ptid & 63, wv = ptid >> 6, pair = wv >> 1, half = wv & 1;
    LAS float* part = (LAS float*)ldsraw;
    const unsigned shared_base = (unsigned)(a.npanels[0] - 64) * 256u;
    const float* lw = a.ln2_w + L * D; const float* lbp = a.ln2_b + L * D;
    int it = 0;
    for (int t0 = blockIdx.x * 4; t0 < T; t0 += gridDim.x * 4, ++it) {
        const unsigned t = (unsigned)(t0 + pair);
        unsigned rows[9];
#pragma unroll
        for (int k = 0; k < 8; ++k) rows[k] = (unsigned)a.slotpos[t * 8 + k] * (unsigned)D;
        rows[8] = (shared_base + t) * (unsigned)D;
        float wk[9];
#pragma unroll
        for (int k = 0; k < 8; ++k) wk[k] = a.wsel[t * 8 + k];
        wk[8] = 1.0f;
        float v[16]; float s1 = 0.f, s2 = 0.f;
#pragma unroll
        for (int i = 0; i < 4; ++i) {
            const unsigned c = (unsigned)(half * 1024 + i * 256 + lane * 4);
            const float4 x = *(const float4*)(a.x1 + t * (unsigned)D + c);
            float a0 = 0.f, a1 = 0.f, a2 = 0.f, a3 = 0.f;
#pragma unroll
            for (int k = 0; k < 9; ++k) { const uint2 u = *(const uint2*)(a.ybuf + (rows[k] + c));
                a0 += wk[k] * __uint_as_float(u.x << 16); a1 += wk[k] * __uint_as_float(u.x & 0xffff0000u); a2 += wk[k] * __uint_as_float(u.y << 16); a3 += wk[k] * __uint_as_float(u.y & 0xffff0000u); }
            v[4 * i] = ALPHA * x.x + a0; v[4 * i + 1] = ALPHA * x.y + a1; v[4 * i + 2] = ALPHA * x.z + a2; v[4 * i + 3] = ALPHA * x.w + a3;
#pragma unroll
            for (int j = 0; j < 4; ++j) { s1 += v[4 * i + j]; s2 += v[4 * i + j] * v[4 * i + j]; }
            if (i & 1) asm volatile("" ::: "memory");
        }
        s1 = wave_sum(s1); s2 = wave_sum(s2);
        LAS float* slot = part + (((it & 1) * 4 + pair) * 2) * 2;
        if (lane == 0) { slot[half * 2] = s1; slot[half * 2 + 1] = s2; }
        __syncthreads();
        const float S1 = slot[0] + slot[2], S2 = slot[1] + slot[3];
        const float mu = S1 * (1.0f / D);
        const float rstd = rsqrtf(fmaxf(S2 * (1.0f / D) - mu * mu, 0.f) + 1e-5f);
        float* outf = a.out + t * (unsigned)D; bf16_t* outb = a.xb + t * (unsigned)D;
#pragma unroll
        for (int i = 0; i < 4; ++i) {
            const unsigned c = (unsigned)(half * 1024 + i * 256 + lane * 4);
            const float4 ww = *(const float4*)(lw + c), bb = *(const float4*)(lbp + c);
            float4 o; o.x = (v[4 * i] - mu) * rstd * ww.x + bb.x; o.y = (v[4 * i + 1] - mu) * rstd * ww.y + bb.y; o.z = (v[4 * i + 2] - mu) * rstd * ww.z + bb.z; o.w = (v[4 * i + 3] - mu) * rstd * ww.w + bb.w;
            *(float4*)(outf + c) = o;
            if (L == 0) { pg8::u32x2 pk; pk.x = pg8::cvt_pk_bf16(o.x, o.y); pk.y = pg8::cvt_pk_bf16(o.z, o.w); *(pg8::u32x2*)(outb + c) = pk; }
        }
    }
}

constexpr int NPHASE = 13;
constexpr int LDS_GEMM = pg8::STAGE_BYTES + pg8::GTAB_BYTES;
constexpr int LDS_BARW = LDS_GEMM;
constexpr int LDS_PETAB = LDS_GEMM + 64;
constexpr int LDS_ARGS = LDS_GEMM + 16;
constexpr int LDS_BYTES = LDS_GEMM + 512;
__device__ __forceinline__ void args_to_lds(const KArgs& ka, LAS unsigned char* lds) {
    const int t = (int)threadIdx.x;
    if (t < 34) { const unsigned long long v = (t < 32) ? (unsigned long long)ka.in[t] : (t == 32 ? (unsigned long long)ka.ws : (unsigned long long)ka.out);
        *(LAS unsigned long long*)(lds + LDS_ARGS + t * 8) = v; }
}
__device__ __forceinline__ unsigned long long lds_ptr_load(LAS unsigned char* lds, int i) {
    const LAS unsigned* p = (const LAS unsigned*)(lds + LDS_ARGS + i * 8);
    const unsigned lo = (unsigned)__builtin_amdgcn_readfirstlane((int)p[0]), hi = (unsigned)__builtin_amdgcn_readfirstlane((int)p[1]);
    return ((unsigned long long)hi << 32) | lo;
}
template <int PH> __device__ __forceinline__ void run_phase(const KArgs& kin, const int Lp, LAS unsigned char* lds_in) {
    const int L = Lp & 15, part = Lp >> 4;
    LAS unsigned char* lds = lds_in; asm volatile("" : "+s"(lds));
    size_t z0 = 0; asm volatile("" : "+s"(z0));
    KArgs ka;
#pragma unroll
    for (int i = 0; i < 32; ++i) ka.in[i] = (const float*)((const char*)kin.in[i] + z0);
    ka.ws = kin.ws + z0; ka.out = (float*)((char*)kin.out + z0);
    const MegaArgs a = make_args(ka);
    int G = (int)gridDim.x, c = (int)blockIdx.x; asm volatile("" : "+s"(G), "+s"(c));
    if constexpr (PH == 0) {
        if (L == 0) { const size_t n4 = (size_t)T * D / 4; const int ptid = phase_tid(); for (size_t i = (size_t)c * 512 + ptid; i < n4; i += (size_t)G * 512) { const float4 v = *(const float4*)(a.x_in + 4 * i);
            pg8::u32x2 pk; pk.x = pg8::cvt_pk_bf16(v.x, v.y); pk.y = pg8::cvt_pk_bf16(v.z, v.w); *(pg8::u32x2*)(a.xb + 4 * i) = pk; } }
        ConvArgs ca; ca.w_in = a.w_in; ca.we_gate = a.we_gate; ca.we_up = a.we_up; ca.we_down = a.we_down; ca.ws_gate = a.ws_gate; ca.ws_up = a.ws_up; ca.ws_down = a.ws_down; ca.w_br = a.w_br; ca.w_out = a.w_out;
        ca.WinT = a.WinT; ca.WguT = a.WguT; ca.WdT = a.WdT; ca.WbrT = a.WbrT; ca.WoutT = a.WoutT; ca.layer = L; ca.pad_ = 0;
        if (L == 0) convert_tiles(ca, 0, CV_SEG0, c, G, (LAS float (*)[65])lds);
        if (L == 0) { const int pt3 = phase_tid(); bf16_t* w2t = (bf16_t*)a.mix.W2T; bf16_t* a2t = (bf16_t*)a.mix.A2T; bf16_t* g2t = (bf16_t*)a.mix.G2T; bf16_t* ggt = (bf16_t*)a.mix.GGT;
          for (int i = c * 512 + pt3; i < 2 * 512 * 32; i += G * 512) { const int l2 = i >> 14, ch = (i >> 5) & 511, k = i & 31;
              w2t[i] = f2bf(a.mix.rw_w2[((size_t)l2 * 32 + k) * 512 + ch]); a2t[i] = f2bf(a.mix.rw_a2[((size_t)l2 * 32 + k) * 512 + ch]); }
          for (int i = c * 512 + pt3; i < 2 * 512 * 96; i += G * 512) { const int l2 = i / (512 * 96), rem = i - l2 * 512 * 96, ch = rem / 96, k = rem - ch * 96;
              g2t[i] = f2bf(a.mix.rw_g2[((size_t)l2 * 96 + k) * 512 + ch]); }
          for (int i = c * 512 + pt3; i < 2 * 256 * 32; i += G * 512) { const int l2 = i >> 13, ch = (i >> 5) & 255, k = i & 31;
              ggt[i] = (k < 16) ? f2bf(a.mix.gla_g2[((size_t)l2 * 16 + k) * 256 + ch]) : (bf16_t)0; } }
        if (L == 0) { const int ptid2 = phase_tid();
          for (int i = c * 512 + ptid2; i < 2 * NE * D; i += G * 512) { const int l2 = i >> 17, n = (i >> 11) & 63, k = i & 2047; const float v = a.w_router[(size_t)l2 * D * NE + (size_t)k * NE + n];
              const bf16_t hi = f2bf(v); a.WrH[i] = hi; a.WrL[i] = f2bf(v - bf2f(hi)); } }
    } else if constexpr (PH == 1) {
        pg8::StaticOrder S; S.init(a.xb, a.WinT, T, ZLD, D, G, c);
        pg8::EpiZ16 E; E.O = (bf16_t*)a.mix.z; E.ldc = ZLD; E.pad_ = 0;
        pg8::gemm_phase<pg8::EpiZ16, pg8::StaticOrder, false>(lds, D, S, E);
    } else if constexpr (PH == 2) { MixArgs m = a.mix; m.layer = L; prep_phase(m, lds);
    } else if constexpr (PH == 3) { MixArgs m = a.mix; m.layer = L;
        ConvArgs ca; ca.w_in = a.w_in; ca.we_gate = a.we_gate; ca.we_up = a.we_up; ca.we_down = a.we_down; ca.ws_gate = a.ws_gate; ca.ws_up = a.ws_up; ca.ws_down = a.ws_down; ca.w_br = a.w_br; ca.w_out = a.w_out;
        ca.WinT = a.WinT; ca.WguT = a.WguT; ca.WdT = a.WdT; ca.WbrT = a.WbrT; ca.WoutT = a.WoutT; ca.layer = L; ca.pad_ = 0;
        chains_phase(m, ca, a.bar + 8 + L, lds);
    } else if constexpr (PH == 4) { MixArgs m = a.mix; m.layer = L;
        carry_phase(m, lds, part);
        if (part == 0 && (c >= 8 || G <= 8)) sb_queue(m, a.bar + 12 + L, lds);
    } else if constexpr (PH == 5) { MixArgs m = a.mix; m.layer = L; mixfin_phase(m);
    } else if constexpr (PH == 6) {
        pg8::GateOrder S; S.init(a.mix.bo, a.WbrT, G, c);
        pg8::EpiGateAcc E; E.zg0 = a.mix.z + GATE0; E.mergedb = a.mergedb;
        pg8::gemm_phase<pg8::EpiGateAcc, pg8::GateOrder, false>(lds, FW, S, E);
    } else if constexpr (PH == 7) {
        pg8::StaticOrder S; S.init(a.mergedb, a.WoutT, T, D, D, G, c);
        pg8::EpiResid E; E.xin = (L == 0) ? a.x_in : a.out; E.pre = a.merged;
        pg8::gemm_phase<pg8::EpiResid, pg8::StaticOrder, false>(lds, D, S, E);
    } else if constexpr (PH == 8) { ln_router_phase(a, L, lds);
    } else if constexpr (PH == 9) { dispatch_phase(a, lds);
    } else if constexpr (PH == 10) {
        LAS int* petab = (LAS int*)(lds + LDS_PETAB); const int npan = a.npanels[0];
        pg8::MoeOrder::fill_table(petab, a.panel_expert, npan, 4, G, c, phase_tid());
        pg8::MoeOrder S; S.init(a.x1b, a.WguT, (size_t)1024 * D, petab, a.row_tok, npan, 4, D, G, c);
        pg8::EpiSwi E; E.h = a.hbuf;
        pg8::gemm_phase<pg8::EpiSwi, pg8::MoeOrder, true>(lds, D, S, E);
    } else if constexpr (PH == 11) {
        LAS int* petab = (LAS int*)(lds + LDS_PETAB); const int npan = a.npanels[0];
        pg8::MoeOrder::fill_table(petab, a.panel_expert, npan, 8, G, c, phase_tid());
        pg8::MoeOrder S; S.init(a.hbuf, a.WdT, (size_t)D * FW, petab, nullptr, npan, 8, FW, G, c);
        pg8::EpiDownW E; E.y = a.ybuf;
        pg8::gemm_phase<pg8::EpiDownW, pg8::MoeOrder, false>(lds, FW, S, E);
    } else { combine_phase(a, L, lds); }
}
#ifndef MK_MULTI
#define MK_MULTI 0
#endif
#ifndef MK_PART
#define MK_PART 0
#endif
#ifndef MK_DBL
#define MK_DBL 0
#endif
#if MK_MULTI
template <int PH> __global__ __launch_bounds__(512, 2) void k_one(KArgs a, int L, int pad_) {
    extern __shared__ __attribute__((aligned(16))) unsigned char shm[];
    run_phase<PH>(a, L, (LAS unsigned char*)shm);
}
#else
__device__ __forceinline__ void run_layer(const KArgs& a, const int L, LAS unsigned char* lds, const XcdBarrier& bar) {
#define MK_RUN(PH) do { run_phase<PH>(a, L, lds); xcd_barrier(bar); if ((MK_DBL >> PH) & 1) { run_phase<PH>(a, L | (MK_PART << 4), lds); xcd_barrier(bar); } } while (0)
    if (L == 0) { MK_RUN(0); }
    MK_RUN(1); MK_RUN(2); MK_RUN(3); MK_RUN(4); MK_RUN(5); MK_RUN(6); MK_RUN(7); MK_RUN(8); MK_RUN(9); MK_RUN(10); MK_RUN(11); MK_RUN(12);
#undef MK_RUN
}
__global__ __launch_bounds__(512, 2) void k_mega(KArgs a) {
    extern __shared__ __attribute__((aligned(16))) unsigned char shm[];
    LAS unsigned char* lds = (LAS unsigned char*)shm;
    if (threadIdx.x < 4) ((LAS unsigned*)(lds + LDS_BARW))[threadIdx.x] = 0u;
    __syncthreads();
    const XcdBarrier bar = xcd_barrier_post((unsigned*)(a.ws + OFF_BAR), (volatile LAS unsigned*)(lds + LDS_BARW));
    run_layer(a, 0, lds, bar);
    run_layer(a, 1, lds, bar);
}
#endif

#if MK_MULTI
template <int PH> static void launch_one(const KArgs& a, int L, int grid, hipStream_t stream) {
    static bool attr = false; if (!attr) { (void)hipFuncSetAttribute((const void*)k_one<PH>, hipFuncAttributeMaxDynamicSharedMemorySize, LDS_BYTES); attr = true; }
    k_one<PH><<<grid, 512, LDS_BYTES, stream>>>(a, L, 0);
}
#endif
extern "C" void kernel_launch(void* const* d_in, const int* in_sizes, int n_in, void* d_out, int out_size, void* d_ws, size_t ws_size, hipStream_t stream) {
    KArgs a; memset(&a, 0, sizeof a);
    for (int i = 0; i < 32; ++i) a.in[i] = (const float*)d_in[i];
    a.ws = (char*)d_ws; a.out = (float*)d_out;
    if (WS_NEEDED > ws_size || n_in < 32) { fprintf(stderr, "workspace too small: need %zu MiB, have %zu MiB (n_in %d)\n", WS_NEEDED >> 20, ws_size >> 20, n_in); return; }

    static int grid = 0;
    if (!grid) { int dev = 0, cus = 0; (void)hipGetDevice(&dev); (void)hipDeviceGetAttribute(&cus, hipDeviceAttributeMultiprocessorCount, dev); grid = cus > 0 ? cus : 256; if (grid > 256) grid = 256; }
#if MK_MULTI
    for (int L = 0; L < 2; ++L) {
        launch_one<0>(a, L, grid, stream); launch_one<1>(a, L, grid, stream); launch_one<2>(a, L, grid, stream); launch_one<3>(a, L, grid, stream); launch_one<4>(a, L, grid, stream);
        launch_one<5>(a, L, grid, stream); launch_one<6>(a, L, grid, stream); launch_one<7>(a, L, grid, stream); launch_one<8>(a, L, grid, stream); launch_one<9>(a, L, grid, stream);
        launch_one<10>(a, L, grid, stream); launch_one<11>(a, L, grid, stream); launch_one<12>(a, L, grid, stream);
    }
#else
    static bool attr = false;
    if (!attr) {
        if (hipFuncSetAttribute((const void*)k_mega, hipFuncAttributeMaxDynamicSharedMemorySize, LDS_BYTES) != hipSuccess) { fprintf(stderr, "hipFuncSetAttribute failed\n"); return; }
        int per_cu = 0; (void)hipOccupancyMaxActiveBlocksPerMultiprocessor(&per_cu, (const void*)k_mega, 512, LDS_BYTES);
        if (per_cu < 1) fprintf(stderr, "occupancy query reports %d workgroups per CU\n", per_cu);
        attr = true;
    }
    (void)hipMemsetAsync(a.ws + OFF_BAR, 0, XCD_BAR_WORDS * sizeof(unsigned), stream);
    k_mega<<<grid, 512, LDS_BYTES, stream>>>(a);
#endif
}
```

```cpp
#include <hip/hip_runtime.h>
#include <stdint.h>
#include <stdio.h>
#include <string.h>

typedef unsigned short bf16_t;

constexpr int T = 16384, D = 2048, ZW = 15024, ZLD = 15104, NE = 64, FW = 512;
constexpr int HG_Q = 0, HG_F = 512, HG_I = 1024, HG_G = 1536;
constexpr int RW_R = 2048, RW_K = 2560, RW_V = 3072, RW_LW = 3584;
constexpr int SB_Q = 3744, SB_K = 4256, SB_V = 4768;
constexpr int GL_Q = 5280, GL_K = 5536, GL_V = 5792, GL_LG = 6304, GL_R = 6320;
constexpr int GATE0 = 6832;
constexpr float ALPHA = 1.4142135623730951f;
constexpr int MAXPANELS = 640;
constexpr int MAXROWS = MAXPANELS * 256;
constexpr int NSEG = 32, LSEG = T / NSEG;
constexpr int NCHK = T / 64;

__device__ __forceinline__ float bf2f(bf16_t v) { return __uint_as_float(((unsigned)v) << 16); }
__device__ __forceinline__ bf16_t f2bf(float f) { unsigned u = __float_as_uint(f); u += 0x7FFFu + ((u >> 16) & 1u); return (bf16_t)(u >> 16); }
__device__ __forceinline__ float sigmoidf_(float x) { return 1.0f / (1.0f + expf(-x)); }
__device__ __forceinline__ float softplusf_(float x) { return fmaxf(x, 0.f) + log1pf(expf(-fabsf(x))); }
__device__ __forceinline__ float siluf_(float x) { return x / (1.0f + expf(-x)); }
__device__ __forceinline__ float fsig(float x) { return __builtin_amdgcn_rcpf(1.0f + __expf(-x)); }
__device__ __forceinline__ float fsoftplus(float x) { return fmaxf(x, 0.f) + __logf(1.0f + __expf(-fabsf(x))); }

template <int CTRL> __device__ __forceinline__ float dppmov(float x) {
    return __builtin_bit_cast(float, __builtin_amdgcn_update_dpp(0, __builtin_bit_cast(int, x), CTRL, 0xF, 0xF, true));
}
__device__ __forceinline__ float rdlane(float x, int l) { return __builtin_bit_cast(float, __builtin_amdgcn_readlane(__builtin_bit_cast(int, x), l)); }
__device__ __forceinline__ int phase_tid() { int t = (int)threadIdx.x; asm volatile("" : "+v"(t)); return t & 511; }
__device__ __forceinline__ float wave_sum(float x) {
    x += dppmov<0xB1>(x);
    x += dppmov<0x4E>(x);
    x += dppmov<0x141>(x);
    x += dppmov<0x140>(x);
    return (rdlane(x, 0) + rdlane(x, 16)) + (rdlane(x, 32) + rdlane(x, 48));
}
#define LAS __attribute__((address_space(3)))
namespace pg8 {
typedef short bf16x8 __attribute__((ext_vector_type(8)));
typedef float f32x4 __attribute__((ext_vector_type(4)));
typedef unsigned u32x4 __attribute__((ext_vector_type(4)));
typedef unsigned u32x2 __attribute__((ext_vector_type(2)));
constexpr int BM = 256, BK = 64, HALF = 128, HTB = HALF * BK * 2, STAGE_BYTES = 8 * HTB, NXCD = 8, WGM = 8;
constexpr int GTAB_BYTES = 512 * 16;
__host__ __device__ __forceinline__ int lds_byte(int r, int c) { const int st = (r >> 4) * 2 + (c >> 5), rr = r & 15, cc = c & 31, ob = rr * 64 + cc * 2; return st * 1024 + (ob ^ (((ob >> 9) & 1) << 5)); }
__host__ __device__ __forceinline__ void stage_rc(int b, int& R, int& C) { const int st = b / 1024, sb = b % 1024, swz = sb ^ (((sb >> 9) & 1) << 5); R = (st >> 1) * 16 + swz / 64; C = (st & 1) * 32 + (swz % 64) / 2; }
__host__ __device__ __forceinline__ int perm32(int rho) { const int n = rho >> 4, i = rho & 15; return 8 * (i >> 2) + 4 * n + (i & 3); }
struct Unit { int pm, pn, e; };
__device__ __forceinline__ unsigned cvt_pk_bf16(float lo, float hi) { unsigned r; asm volatile("v_cvt_pk_bf16_f32 %0, %1, %2" : "=v"(r) : "v"(lo), "v"(hi)); return r; }

struct StaticOrder {
    const bf16_t* A; const bf16_t* Bt; int K; int nM, nN, nwg, G, c;
    __device__ void init(const bf16_t* A_, const bf16_t* Bt_, int M, int N, int K_, int G_, int c_) { A = A_; Bt = Bt_; K = K_; nM = M / BM; nN = N / BM; nwg = nM * nN; G = G_; c = c_; }
    __device__ bool next(int i, Unit& u) const {
        const int L = i * G + c; if (L >= nwg) return false;
        int wgid = L; { const int q = nwg / NXCD, r = nwg % NXCD, xcd = wgid % NXCD, off = wgid / NXCD; wgid = (xcd < r ? xcd * (q + 1) : r * (q + 1) + (xcd - r) * q) + off; }
        const int nig = WGM * nN, gid = wgid / nig, fm = gid * WGM, gsz = (nM - fm) < WGM ? (nM - fm) : WGM;
        u.pm = fm + ((wgid % nig) % gsz); u.pn = (wgid % nig) / gsz; u.e = 0; return true;
    }
    __device__ __forceinline__ const char* a_base(const Unit& u) const { return (const char*)A + (size_t)u.pm * 256 * K * 2; }
    __device__ __forceinline__ const char* b_base(const Unit& u) const { return (const char*)Bt + (size_t)u.pn * 256 * K * 2; }
    __device__ __forceinline__ const int* rowmap() const { return nullptr; }
};
struct GateOrder {
    StaticOrder so; const bf16_t* A; const bf16_t* Bt; int per;
    __device__ void init(const bf16_t* bo, const bf16_t* WbrT, int G_, int c_) { so.init(bo, WbrT, T, D, FW, G_, c_); A = bo; Bt = WbrT; Unit t; per = 0; while (so.next(per, t)) ++per; }
    __device__ bool next(int i, Unit& u) const { if (per == 0 || i >= 4 * per) return false; const int g = i / per; const bool ok = so.next(i - g * per, u); u.e = g; return ok; }
    __device__ __forceinline__ const char* a_base(const Unit& u) const { return (const char*)(A + (size_t)u.e * T * 512) + (size_t)u.pm * 256 * FW * 2; }
    __device__ __forceinline__ const char* b_base(const Unit& u) const { return (const char*)(Bt + (size_t)u.e * D * FW) + (size_t)u.pn * 256 * FW * 2; }
    __device__ __forceinline__ const int* rowmap() const { return nullptr; }
};
struct MoeOrder {
    const bf16_t* A; const bf16_t* Bt; const int* rmap; const LAS int* petab; size_t estride; int K, NT, total, G, c;
    __device__ void init(const bf16_t* A_, const bf16_t* Bt_, size_t estride_, const LAS int* petab_, const int* rmap_, int npanels, int NT_, int K_, int G_, int c_) {
        A = A_; Bt = Bt_; estride = estride_; petab = petab_; rmap = rmap_; K = K_; NT = NT_; total = npanels * NT_; G = G_;
        c = remap(c_, G_);
    }
    static __device__ __forceinline__ int remap(int c_, int G_) { return (c_ & 7) * (G_ >> 3) + (c_ >> 3); }
    static __device__ __forceinline__ void fill_table(LAS int* tab, const int* panel_expert, int npanels, int NT_, int G_, int c_, int tid) {
        const int cc = remap(c_, G_), tot = npanels * NT_;
        if (tid < 64) { const int Lu = tid * G_ + cc; tab[tid] = (Lu < tot) ? panel_expert[Lu / NT_] : 0; }
        __syncthreads();
    }
    __device__ bool next(int i, Unit& u) const {
        const int L = i * G + c; if (L >= total) return false;
        u.pm = L / NT; u.pn = L % NT; u.e = petab[i]; return true;
    }
    __device__ __forceinline__ const char* a_base(const Unit& u) const { return rmap ? (const char*)A : (const char*)A + (size_t)u.pm * 256 * K * 2; }
    __device__ __forceinline__ const char* b_base(const Unit& u) const { return (const char*)(Bt + (size_t)u.e * estride) + (size_t)u.pn * 256 * K * 2; }
    __device__ __forceinline__ const int* rowmap() const { return rmap; }
};

struct EpiZ16 {
    static constexpr bool PERM = true, W64 = false; static constexpr int NST = 16;
    bf16_t* O; int ldc; int pad_;
    __device__ __forceinline__ void operator()(const f32x4 (&acc)[2][2][4][2], const Unit& u, int wr, int wc, int fr, int fq) const {
        const int row0 = u.pm * BM + wr * 64 + fr, col0 = u.pn * BM + wc * 32 + 8 * fq;
#pragma unroll
        for (int ai = 0; ai < 2; ++ai)
#pragma unroll
            for (int m = 0; m < 4; ++m) { bf16_t* rowp = O + (size_t)(row0 + ai * HALF + m * 16) * ldc + col0;
#pragma unroll
                for (int bj = 0; bj < 2; ++bj) { const f32x4 v0 = acc[ai][bj][m][0], v1 = acc[ai][bj][m][1];
                    u32x4 w; w.x = cvt_pk_bf16(v0[0], v0[1]); w.y = cvt_pk_bf16(v0[2], v0[3]); w.z = cvt_pk_bf16(v1[0], v1[1]); w.w = cvt_pk_bf16(v1[2], v1[3]);
                    *(u32x4*)(rowp + bj * HALF) = w; } }
    }
};
struct EpiGateAcc {
    static constexpr bool PERM = true, W64 = false; static constexpr int NST = 8;
    const bf16_t* zg0; bf16_t* mergedb;
    __device__ __forceinline__ void operator()(const f32x4 (&acc)[2][2][4][2], const Unit& u, int wr, int wc, int fr, int fq) const {
        const int g = u.e; const bf16_t* zg = zg0 + g * D;
        const int row0 = u.pm * BM + wr * 64 + fr, col0 = u.pn * BM + wc * 32 + 8 * fq;
#pragma unroll
        for (int ai = 0; ai < 2; ++ai) {
            u32x4 gzv[4][2], pvv[4][2];
#pragma unroll
            for (int m = 0; m < 4; ++m)
#pragma unroll
                for (int bj = 0; bj < 2; ++bj) { const size_t row = (size_t)(row0 + ai * HALF + m * 16); const int col = col0 + bj * HALF;
                    gzv[m][bj] = *(const u32x4*)(zg + row * ZLD + col);
                    pvv[m][bj] = (u32x4){0u, 0u, 0u, 0u}; if (g > 0) pvv[m][bj] = *(const u32x4*)(mergedb + row * D + col); }
#pragma unroll
            for (int m = 0; m < 4; ++m) { const size_t row = (size_t)(row0 + ai * HALF + m * 16);
#pragma unroll
                for (int bj = 0; bj < 2; ++bj) { const int col = col0 + bj * HALF;
                    const u32x4 gz = gzv[m][bj], pv = pvv[m][bj];
                    f32x4 g0, g1; g0[0] = __uint_as_float(gz.x << 16); g0[1] = __uint_as_float(gz.x & 0xffff0000u); g0[2] = __uint_as_float(gz.y << 16); g0[3] = __uint_as_float(gz.y & 0xffff0000u);
                    g1[0] = __uint_as_float(gz.z << 16); g1[1] = __uint_as_float(gz.z & 0xffff0000u); g1[2] = __uint_as_float(gz.w << 16); g1[3] = __uint_as_float(gz.w & 0xffff0000u);
                    f32x4 v0 = acc[ai][bj][m][0], v1 = acc[ai][bj][m][1];
#pragma unroll
                    for (int j = 0; j < 4; ++j) { v0[j] *= __builtin_amdgcn_rcpf(1.0f + __expf(-g0[j])); v1[j] *= __builtin_amdgcn_rcpf(1.0f + __expf(-g1[j])); }
                    v0[0] += __uint_as_float(pv.x << 16); v0[1] += __uint_as_float(pv.x & 0xffff0000u); v0[2] += __uint_as_float(pv.y << 16); v0[3] += __uint_as_float(pv.y & 0xffff0000u);
                    v1[0] += __uint_as_float(pv.z << 16); v1[1] += __uint_as_float(pv.z & 0xffff0000u); v1[2] += __uint_as_float(pv.w << 16); v1[3] += __uint_as_float(pv.w & 0xffff0000u);
                    u32x4 w; w.x = cvt_pk_bf16(v0[0], v0[1]); w.y = cvt_pk_bf16(v0[2], v0[3]); w.z = cvt_pk_bf16(v1[0], v1[1]); w.w = cvt_pk_bf16(v1[2], v1[3]);
                    *(u32x4*)(mergedb + row * D + col) = w; } }
            asm volatile("" ::: "memory");
        }
    }
};
struct EpiResid {
    static constexpr bool PERM = true, W64 = false; static constexpr int NST = 8;
    const float* xin; bf16_t* pre;
    __device__ __forceinline__ void operator()(const f32x4 (&acc)[2][2][4][2], const Unit& u, int wr, int wc, int fr, int fq) const {
        const int row0 = u.pm * BM + wr * 64 + fr, col0 = u.pn * BM + wc * 32 + 8 * fq;
#pragma unroll
        for (int ai = 0; ai < 2; ++ai) {
            f32x4 xv[4][2][2];
#pragma unroll
            for (int m = 0; m < 4; ++m) { const size_t ro = (size_t)(row0 + ai * HALF + m * 16) * D + col0;
#pragma unroll
                for (int bj = 0; bj < 2; ++bj)
#pragma unroll
                    for (int n = 0; n < 2; ++n) xv[m][bj][n] = *(const f32x4*)(xin + ro + bj * HALF + n * 4); }
#pragma unroll
            for (int m = 0; m < 4; ++m) { const size_t ro = (size_t)(row0 + ai * HALF + m * 16) * D + col0;
#pragma unroll
                for (int bj = 0; bj < 2; ++bj) { const f32x4 v0 = xv[m][bj][0] * ALPHA + acc[ai][bj][m][0], v1 = xv[m][bj][1] * ALPHA + acc[ai][bj][m][1];
                    u32x4 w; w.x = cvt_pk_bf16(v0[0], v0[1]); w.y = cvt_pk_bf16(v0[2], v0[3]); w.z = cvt_pk_bf16(v1[0], v1[1]); w.w = cvt_pk_bf16(v1[2], v1[3]);
                    *(u32x4*)(pre + ro + bj * HALF) = w; } }
            asm volatile("" ::: "memory");
        }
    }
};
struct EpiSwi {
    static constexpr bool PERM = true, W64 = false; static constexpr int NST = 8;
    bf16_t* h;
    __device__ __forceinline__ void operator()(const f32x4 (&acc)[2][2][4][2], const Unit& u, int wr, int wc, int fr, int fq) const {
        const int row0 = u.pm * BM + wr * 64 + fr, col0 = u.pn * HALF + wc * 32 + 8 * fq;
#pragma unroll
        for (int ai = 0; ai < 2; ++ai)
#pragma unroll
            for (int m = 0; m < 4; ++m) { float o[8];
#pragma unroll
                for (int n = 0; n < 2; ++n)
#pragma unroll
                    for (int j = 0; j < 4; ++j) { const float gt = acc[ai][0][m][n][j], up = acc[ai][1][m][n][j]; o[4 * n + j] = gt / (1.0f + __expf(-gt)) * up; }
                u32x4 w; w.x = cvt_pk_bf16(o[0], o[1]); w.y = cvt_pk_bf16(o[2], o[3]); w.z = cvt_pk_bf16(o[4], o[5]); w.w = cvt_pk_bf16(o[6], o[7]);
                *(u32x4*)(h + (size_t)(row0 + ai * HALF + m * 16) * FW + col0) = w; }
    }
};
__device__ __forceinline__ u32x4 ror8x4(const u32x4 v) { u32x4 r;
    r.x = (unsigned)__builtin_amdgcn_update_dpp(0, (int)v.x, 0x128, 0xf, 0xf, false); r.y = (unsigned)__builtin_amdgcn_update_dpp(0, (int)v.y, 0x128, 0xf, 0xf, false);
    r.z = (unsigned)__builtin_amdgcn_update_dpp(0, (int)v.z, 0x128, 0xf, 0xf, false); r.w = (unsigned)__builtin_amdgcn_update_dpp(0, (int)v.w, 0x128, 0xf, 0xf, false); return r; }
struct EpiDownW {
    static constexpr bool PERM = true, W64 = true; static constexpr int NST = 16;
    bf16_t* y; int ld, pad_;
    __device__ __forceinline__ void operator()(const f32x4 (&acc)[2][2][4][2], const Unit& u, int wr, int wc, int fr, int fq) const {
        const bool hi = fr >= 8;
        const int row0 = u.pm * BM + wr * 64 + (fr & 7), col0 = u.pn * BM + wc * 64 + 8 * fq + (hi ? 32 : 0);
#pragma unroll
        for (int ai = 0; ai < 2; ++ai)
#pragma unroll
            for (int m = 0; m < 4; ++m) { bf16_t* rowp = y + (size_t)(row0 + ai * HALF + m * 16) * ld + col0;
                u32x4 w0, w1;
                { const f32x4 v0 = acc[ai][0][m][0], v1 = acc[ai][0][m][1]; w0.x = cvt_pk_bf16(v0[0], v0[1]); w0.y = cvt_pk_bf16(v0[2], v0[3]); w0.z = cvt_pk_bf16(v1[0], v1[1]); w0.w = cvt_pk_bf16(v1[2], v1[3]); }
                { const f32x4 v0 = acc[ai][1][m][0], v1 = acc[ai][1][m][1]; w1.x = cvt_pk_bf16(v0[0], v0[1]); w1.y = cvt_pk_bf16(v0[2], v0[3]); w1.z = cvt_pk_bf16(v1[0], v1[1]); w1.w = cvt_pk_bf16(v1[2], v1[3]); }
                const u32x4 snd = hi ? w0 : w1, rcv = ror8x4(snd);
                __builtin_nontemporal_store(hi ? rcv : w0, (u32x4*)rowp);
                __builtin_nontemporal_store(hi ? w1 : rcv, (u32x4*)(rowp + (size_t)8 * ld)); }
    }
};

template <class Epi, class Sched, bool GATHER>
__device__ __forceinline__ void gemm_phase(LAS unsigned char* lds, const int K, const Sched& S, const Epi& E) {
    const int tid = phase_tid(), wid = __builtin_amdgcn_readfirstlane(tid >> 6), wr = wid >> 2, wc = wid & 3, lane = tid & 63, fr = lane & 15, fq = lane >> 4;
    const int nt = K / BK;
    unsigned voffA[2], voffB[2], voffG[2][2]; int gR[2], gC[2];
#pragma unroll
    for (int i = 0; i < 2; ++i) { int R, C; stage_rc(tid * 16 + i * 8192, R, C); const int Rb = Epi::W64 ? (64 * (R >> 5) + perm32(R & 31)) : (Epi::PERM ? ((R & ~31) + perm32(R & 31)) : R);
        voffA[i] = (unsigned)(R * K + C) * 2u; voffB[i] = (unsigned)(Rb * K + C) * 2u; gR[i] = R; gC[i] = C; voffG[0][i] = 0u; voffG[1][i] = 0u; }
    const size_t kstep = (size_t)(BK * 2);
    const size_t hstep = (size_t)HALF * K * 2;
    const size_t hstepB = Epi::W64 ? (size_t)32 * K * 2 : hstep;
    const unsigned ldsw = (unsigned)wid * 1024u;
    const int aoff = lds_byte(wr * 64 + fr, fq * 8), boff = lds_byte(wc * 32 + fr, fq * 8);
    const LAS int* gtab = (const LAS int*)(lds + STAGE_BYTES) + tid;
#define PG8_SA(b, h) (((b) * 2 + (h)) * HTB)
#define PG8_SB(b, h) ((4 + (b) * 2 + (h)) * HTB)
#define PG8_STAGE(bufoff, gbase, voff) do { _Pragma("unroll") for (int _i = 0; _i < 2; ++_i) \
        __builtin_amdgcn_global_load_lds((const unsigned*)((const char*)(gbase) + (voff)[_i]), (LAS unsigned*)(lds + (bufoff) + ldsw + _i * 8192), 16, 0, 0); } while (0)
#define PG8_STAGE_A(bufoff, gbase, h) do { if constexpr (GATHER) PG8_STAGE(bufoff, gbase, voffG[h]); else PG8_STAGE(bufoff, (gbase) + (h) * hstep, voffA); } while (0)
#define PG8_LDA(dst, b, h) do { _Pragma("unroll") for (int m = 0; m < 4; ++m) _Pragma("unroll") for (int k = 0; k < 2; ++k) dst[m][k] = *(const LAS bf16x8*)(lds + PG8_SA(b, h) + aoff + m * 2048 + k * 1024); } while (0)
#define PG8_LDB(dst, b, h) do { _Pragma("unroll") for (int n = 0; n < 2; ++n) _Pragma("unroll") for (int k = 0; k < 2; ++k) dst[n][k] = *(const LAS bf16x8*)(lds + PG8_SB(b, h) + boff + n * 2048 + k * 1024); } while (0)
#define PG8_MMA(ai, bj, At, Bt) do { __builtin_amdgcn_s_setprio(1); _Pragma("unroll") for (int m = 0; m < 4; ++m) _Pragma("unroll") for (int n = 0; n < 2; ++n) _Pragma("unroll") for (int k = 0; k < 2; ++k) \
        acc[ai][bj][m][n] = __builtin_amdgcn_mfma_f32_16x16x32_bf16(Bt[n][k], At[m][k], acc[ai][bj][m][n], 0, 0, 0); __builtin_amdgcn_s_setprio(0); } while (0)
#define PG8_WAIT_V(n) asm volatile("s_waitcnt vmcnt(" #n ")" ::: "memory")
#define PG8_WAIT_VN(n) asm volatile("s_waitcnt vmcnt(%0)" :: "n"(n) : "memory")
#define PG8_WAIT_FRESH(f, n) asm volatile("v_cmp_ne_u32_e32 vcc, 0, %0\n\ts_cbranch_vccnz .Lpg8w%=\n\ts_waitcnt vmcnt(8)\n.Lpg8w%=:\n\ts_waitcnt vmcnt(%1)" :: "v"(f), "n"(n) : "memory", "vcc")
#define PG8_WAIT_L(n) asm volatile("s_waitcnt lgkmcnt(" #n ")" ::: "memory")
#define PG8_BAR __builtin_amdgcn_s_barrier()
#define PG8_SCHED __builtin_amdgcn_sched_barrier(0)
    auto gather_offs = [&](const Unit& u) -> u32x4 {
        const int* rm = S.rowmap(); u32x4 o;
        o.x = (unsigned)(rm[u.pm * 256 + gR[0]] * K + gC[0]) * 2u;       o.y = (unsigned)(rm[u.pm * 256 + gR[1]] * K + gC[1]) * 2u;
        o.z = (unsigned)(rm[u.pm * 256 + 128 + gR[0]] * K + gC[0]) * 2u; o.w = (unsigned)(rm[u.pm * 256 + 128 + gR[1]] * K + gC[1]) * 2u;
        return o; };
    auto gather_dma = [&](const Unit& u) { const int* rm = S.rowmap() + u.pm * 256;
#pragma unroll
        for (int k = 0; k < 4; ++k) __builtin_amdgcn_global_load_lds((const unsigned*)(rm + (k >> 1) * 128 + gR[k & 1]), (LAS unsigned*)(lds + STAGE_BYTES + k * 2048 + wid * 256), 4, 0, 0); };
    Unit cur, nxt, nn; int ui = 0;
    if (!S.next(0, cur)) return;
    f32x4 acc[2][2][4][2];
#pragma unroll
    for (int a = 0; a < 2; ++a)
#pragma unroll
        for (int b = 0; b < 2; ++b)
#pragma unroll
            for (int m = 0; m < 4; ++m)
#pragma unroll
                for (int n = 0; n < 2; ++n) acc[a][b][m][n] = (f32x4){0.f, 0.f, 0.f, 0.f};
    bf16x8 At[4][2], B0[2][2], B1[2][2];
    const char* cA = S.a_base(cur); const char* cB = S.b_base(cur);
    if constexpr (GATHER) {
        const u32x4 o = gather_offs(cur); voffG[0][0] = o.x; voffG[0][1] = o.y; voffG[1][0] = o.z; voffG[1][1] = o.w;
        if (S.next(1, nn)) gather_dma(nn);
        asm volatile("s_waitcnt vmcnt(0) lgkmcnt(0)" ::: "memory");
    }
    PG8_STAGE(PG8_SB(0, 0), cB, voffB); PG8_STAGE(PG8_SB(0, 1), cB + hstepB, voffB); PG8_STAGE_A(PG8_SA(0, 0), cA, 0); PG8_STAGE_A(PG8_SA(0, 1), cA, 1);
    if (wr == 1) PG8_BAR;
    PG8_WAIT_V(2); PG8_BAR;
    PG8_STAGE(PG8_SB(1, 0), cB + kstep, voffB); PG8_STAGE_A(PG8_SA(1, 0), cA + kstep, 0); PG8_STAGE(PG8_SB(1, 1), cB + hstepB + kstep, voffB);
    PG8_WAIT_V(6); PG8_BAR;
    for (;;) {
        const bool has_next = S.next(ui + 1, nxt);
        const char* nA = has_next ? S.a_base(nxt) : cA; const char* nB = has_next ? S.b_base(nxt) : cB;
        for (int t = 0; t < nt; t += 2) {
            const bool last = (t == nt - 2); const int fresh = (t == 0 && ui > 0) ? 1 : 0;
            const char* a1 = cA + (size_t)(t + 1) * kstep;
            const char* a2 = last ? nA : cA + (size_t)(t + 2) * kstep; const char* b2 = last ? nB : cB + (size_t)(t + 2) * kstep;
            const char* a3 = a2 + kstep; const char* b3 = b2 + kstep;
            PG8_LDB(B0, 0, 0); PG8_LDB(B1, 0, 1); PG8_SCHED; PG8_LDA(At, 0, 0); PG8_STAGE_A(PG8_SA(1, 1), a1, 1);
            if constexpr (GATHER) { if (last && has_next) {
#pragma unroll
                for (int k = 0; k < 4; ++k) voffG[k >> 1][k & 1] = (unsigned)(gtab[k * 512] * K + gC[k & 1]) * 2u; } }
            PG8_WAIT_FRESH(fresh, 8 + Epi::NST);
            PG8_WAIT_L(0); PG8_BAR; PG8_MMA(0, 0, At, B0); PG8_MMA(0, 1, At, B1); PG8_BAR; PG8_SCHED;
            PG8_LDA(At, 0, 1); PG8_STAGE(PG8_SB(0, 0), b2, voffB); PG8_STAGE(PG8_SB(0, 1), b2 + hstepB, voffB); PG8_STAGE_A(PG8_SA(0, 0), a2, 0);
            PG8_WAIT_FRESH(fresh, 8 + Epi::NST);
            PG8_WAIT_L(0); PG8_BAR; PG8_MMA(1, 0, At, B0); PG8_MMA(1, 1, At, B1); PG8_BAR; PG8_SCHED;
            PG8_LDB(B0, 1, 0); PG8_LDB(B1, 1, 1); PG8_SCHED; PG8_LDA(At, 1, 0); PG8_STAGE_A(PG8_SA(0, 1), a2, 1);
            PG8_WAIT_V(8); PG8_WAIT_L(0); PG8_BAR; PG8_MMA(0, 0, At, B0); PG8_MMA(0, 1, At, B1); PG8_BAR; PG8_SCHED;
            PG8_LDA(At, 1, 1); PG8_STAGE(PG8_SB(1, 0), b3, voffB); PG8_STAGE(PG8_SB(1, 1), b3 + hstepB, voffB); PG8_STAGE_A(PG8_SA(1, 0), a3, 0);
            PG8_WAIT_V(8); PG8_WAIT_L(0); PG8_BAR; PG8_MMA(1, 0, At, B0); PG8_MMA(1, 1, At, B1); PG8_BAR; PG8_SCHED;
        }
        if (wr == 0) PG8_BAR;
        if constexpr (GATHER) { if (has_next && S.next(ui + 2, nn)) gather_dma(nn); }
        E(acc, cur, wr, wc, fr, fq);
        if (!has_next) break;
#pragma unroll
        for (int a = 0; a < 2; ++a)
#pragma unroll
            for (int b = 0; b < 2; ++b)
#pragma unroll
                for (int m = 0; m < 4; ++m)
#pragma unroll
                    for (int n = 0; n < 2; ++n) acc[a][b][m][n] = (f32x4){0.f, 0.f, 0.f, 0.f};
        cur = nxt; cA = nA; cB = nB; ++ui;
        if (wr == 1) PG8_BAR;
    }
    PG8_WAIT_V(0);
    PG8_BAR;
#undef PG8_SA
#undef PG8_SB
#undef PG8_STAGE
#undef PG8_STAGE_A
#undef PG8_LDA
#undef PG8_LDB
#undef PG8_MMA
#undef PG8_WAIT_V
#undef PG8_WAIT_L
#undef PG8_BAR
#undef PG8_SCHED
}
}


struct ConvArgs { const float *w_in, *we_gate, *we_up, *we_down, *ws_gate, *ws_up, *ws_down, *w_br, *w_out; bf16_t *WinT, *WguT, *WdT, *WbrT, *WoutT; int layer, pad_; };
constexpr int CV_SEG0 = 32 * 236, CV_SEG1 = 65 * 2 * 32 * 8, CV_SEG2 = 65 * 8 * 32, CV_SEG3 = 4 * 8 * 32, CV_SEG4 = 32 * 32;
constexpr int CV_TOTAL = CV_SEG0 + CV_SEG1 + CV_SEG2 + CV_SEG3 + CV_SEG4;
struct CvJob { const float* src; bf16_t* dst; int ld, ldd, valid; };
__device__ __forceinline__ CvJob cv_decode(const ConvArgs& a, const int j, const int L) {
    CvJob o; o.valid = 64;
    if (j < CV_SEG0) { const int kb = j & 31, nb = j >> 5; o.ld = ZW; o.ldd = D;
        o.src = a.w_in + (size_t)L * D * ZW + (size_t)kb * 64 * ZW + nb * 64; int v = ZW - nb * 64; o.valid = v < 0 ? 0 : (v > 64 ? 64 : v);
        o.dst = a.WinT + (size_t)nb * 64 * D + kb * 64; }
    else if (j < CV_SEG0 + CV_SEG1) { int q = j - CV_SEG0; const int cb = q & 7; q >>= 3; const int kb = q & 31; q >>= 5; const int bj = q & 1; const int e = q >> 1; o.ld = FW; o.ldd = D;
        const float* m = (e < NE) ? ((bj ? a.we_up : a.we_gate) + ((size_t)L * NE + e) * D * FW) : ((bj ? a.ws_up : a.ws_gate) + (size_t)L * D * FW);
        o.src = m + (size_t)kb * 64 * FW + cb * 64;
        o.dst = a.WguT + ((size_t)e * 1024 + (cb >> 1) * 256 + bj * 128 + (cb & 1) * 64) * D + kb * 64; }
    else if (j < CV_SEG0 + CV_SEG1 + CV_SEG2) { int q = j - CV_SEG0 - CV_SEG1; const int nb = q & 31; q >>= 5; const int kb = q & 7; const int e = q >> 3; o.ld = D; o.ldd = FW;
        const float* m = (e < NE) ? (a.we_down + ((size_t)L * NE + e) * FW * D) : (a.ws_down + (size_t)L * FW * D);
        o.src = m + (size_t)kb * 64 * D + nb * 64; o.dst = a.WdT + ((size_t)e * D + nb * 64) * FW + kb * 64; }
    else if (j < CV_SEG0 + CV_SEG1 + CV_SEG2 + CV_SEG3) { int q = j - CV_SEG0 - CV_SEG1 - CV_SEG2; const int nb = q & 31; q >>= 5; const int kb = q & 7; const int g = q >> 3; o.ld = D; o.ldd = FW;
        o.src = a.w_br + ((size_t)L * 4 + g) * FW * D + (size_t)kb * 64 * D + nb * 64; o.dst = a.WbrT + ((size_t)g * D + nb * 64) * FW + kb * 64; }
    else { const int q = j - CV_SEG0 - CV_SEG1 - CV_SEG2 - CV_SEG3; const int nb = q & 31, kb = q >> 5; o.ld = D; o.ldd = D;
        o.src = a.w_out + (size_t)L * D * D + (size_t)kb * 64 * D + nb * 64; o.dst = a.WoutT + (size_t)nb * 64 * D + kb * 64; }
    return o;
}
__device__ __forceinline__ void convert_tiles(const ConvArgs& a, int j0, int j1, int jstart, int jstride, LAS float (*tile)[65]) {
    const int tid = phase_tid(), L = a.layer;
    for (int j = j0 + jstart; j < j1; j += jstride) {
        const CvJob jb = cv_decode(a, j, L);
        const float* src = jb.src; bf16_t* dst = jb.dst; const int ld = jb.ld, ldd = jb.ldd, valid = jb.valid;
        __syncthreads();
        { const int c4 = (tid & 15) * 4, k = tid >> 4;
#pragma unroll
          for (int h = 0; h < 2; ++h) { float4 v = make_float4(0.f, 0.f, 0.f, 0.f); if (c4 < valid) v = *(const float4*)(src + (size_t)(k + 32 * h) * ld + c4);
              tile[k + 32 * h][c4] = v.x; tile[k + 32 * h][c4 + 1] = v.y; tile[k + 32 * h][c4 + 2] = v.z; tile[k + 32 * h][c4 + 3] = v.w; } }
        __syncthreads();
        { const int n = tid >> 3, kc = (tid & 7) * 8; unsigned w[4];
#pragma unroll
          for (int q = 0; q < 4; ++q) w[q] = (unsigned)f2bf(tile[kc + 2 * q][n]) | ((unsigned)f2bf(tile[kc + 2 * q + 1][n]) << 16);
          *(uint4*)(dst + (size_t)n * ldd + kc) = make_uint4(w[0], w[1], w[2], w[3]); }
    }
}
constexpr int CVX_OWN = CV_TOTAL - CV_SEG0, CVX_TOTAL = CVX_OWN + CV_SEG0;
__device__ __forceinline__ bool cvx_job(const ConvArgs& a, const int n, const int L, CvJob& jb) {
    if (n < CVX_OWN) { jb = cv_decode(a, CV_SEG0 + n, L); return true; }
    if (n < CVX_TOTAL && L + 1 < 2) { jb = cv_decode(a, n - CVX_OWN, L + 1); return true; }
    return false;
}
typedef float f32x2v __attribute__((ext_vector_type(2)));
typedef float f32x4v __attribute__((ext_vector_type(4)));
struct MixArgs {
    const bf16_t* z;
    const float *hg_lb_logits, *hg_norm_w, *rw_mu, *rw_w0, *rw_w2, *rw_a0, *rw_a2, *rw_g2, *rw_kk, *rw_ka, *rw_rk, *rw_ln_w, *rw_ln_b, *gla_g2, *gla_gb, *gla_norm_w;
    float* RS; bf16_t *Vt, *KH, *KG, *VtH, *VtG; bf16_t *rGate, *rBonus;
    float *oR, *oH, *oG; bf16_t *cR, *cH, *cG;
    float *SendR, *PendR, *SendH, *SendG, *GamH, *GamG;
    bf16_t *SstR, *SstH, *SstG;
    bf16_t* bo;
    const bf16_t *W2T, *A2T, *G2T, *GGT;
    float *LW, *LA, *LG, *LL;
    int layer, pad_;
};
__device__ __forceinline__ float red8(float x) { x += dppmov<0xB1>(x); x += dppmov<0x4E>(x); x += dppmov<0x141>(x); return x; }
__device__ __forceinline__ float red16(float x) { x += dppmov<0xB1>(x); x += dppmov<0x4E>(x); x += dppmov<0x141>(x); x += dppmov<0x140>(x); return x; }

__device__ __forceinline__ void prep_phase(const MixArgs& p, LAS unsigned char* ldsraw) {
    LAS bf16_t (*vtile)[72] = (LAS bf16_t (*)[72])(ldsraw + 8192);
    LAS float* lW = (LAS float*)ldsraw; LAS float* lA = lW + 16 * 516; LAS float* lG = lA + 16 * 516; LAS float* lL = lG + 16 * 516;
    const int c = phase_tid(), L = p.layer;
    const float mu_r = p.rw_mu[L * 1696 + c], mu_k = p.rw_mu[L * 1696 + 512 + c], mu_v = p.rw_mu[L * 1696 + 1024 + c];
    const float w0 = p.rw_w0[L * 512 + c], a0 = p.rw_a0[L * 512 + c], kkc = p.rw_kk[L * 512 + c], kac = p.rw_ka[L * 512 + c], rkc = p.rw_rk[L * 512 + c];
    float lb = 0.f;
    if (L == 1) { const float l0 = p.hg_lb_logits[c], l1 = p.hg_lb_logits[512 + c]; const float m = fmaxf(l0, l1); const float e0 = expf(l0 - m), e1 = expf(l1 - m); lb = e1 / (e0 + e1); }
    const float gbc = (c < 256) ? p.gla_gb[L * 256 + c] : 0.f;
    for (int tile = blockIdx.x; tile < T / 64; tile += gridDim.x) {
        const int t0 = tile * 64;
        float bH = 0.f, bG = 0.f;
#pragma unroll 1
        for (int g16 = 0; g16 < 4; ++g16) {
            const int tg0 = t0 + 16 * g16;
            typedef short bf16x8v __attribute__((ext_vector_type(8)));
            typedef __bf16 bf16x2n __attribute__((ext_vector_type(2)));
            {
                const int wvu = __builtin_amdgcn_readfirstlane(c >> 6), lane = c & 63, r = lane & 15, q = lane >> 4;
                bf16x8v Af[6];
                { const int t = tg0 + r;
#pragma unroll
                    for (int ks = 0; ks < 5; ++ks) {
                        const pg8::u32x4 cu = *(const pg8::u32x4*)(p.z + (size_t)t * ZLD + RW_LW + 32 * ks + 8 * q);
                        pg8::u32x4 pv = (pg8::u32x4){0u, 0u, 0u, 0u}; if (t > 0) pv = *(const pg8::u32x4*)(p.z + (size_t)(t - 1) * ZLD + RW_LW + 32 * ks + 8 * q);
                        const float4 m0 = *(const float4*)(p.rw_mu + L * 1696 + 1536 + 32 * ks + 8 * q), m1 = *(const float4*)(p.rw_mu + L * 1696 + 1536 + 32 * ks + 8 * q + 4);
                        const float mu8[8] = {m0.x, m0.y, m0.z, m0.w, m1.x, m1.y, m1.z, m1.w};
                        const unsigned cw[4] = {cu.x, cu.y, cu.z, cu.w}, pw[4] = {pv.x, pv.y, pv.z, pv.w};
                        union { bf16x2n h2[4]; bf16x8v v; } pk;
#pragma unroll
                        for (int j = 0; j < 4; ++j) { f32x2v f;
                            { const float cur = __uint_as_float(cw[j] << 16), prv = __uint_as_float(pw[j] << 16); const float zs = cur + (prv - cur) * mu8[2 * j];
                              f.x = (ks == 0) ? (1.0f - 2.0f / (1.0f + __expf(2.0f * zs))) : (ks == 1 ? zs : fsig(zs)); }
                            { const float cur = __uint_as_float(cw[j] & 0xffff0000u), prv = __uint_as_float(pw[j] & 0xffff0000u); const float zs = cur + (prv - cur) * mu8[2 * j + 1];
                              f.y = (ks == 0) ? (1.0f - 2.0f / (1.0f + __expf(2.0f * zs))) : (ks == 1 ? zs : fsig(zs)); }
                            pk.h2[j] = __builtin_convertvector(f, bf16x2n); }
                        Af[ks] = pk.v; }
                    { pg8::u32x4 gl = (pg8::u32x4){0u, 0u, 0u, 0u}; if (q < 2) gl = *(const pg8::u32x4*)(p.z + (size_t)t * ZLD + GL_LG + 8 * q);
                      union { pg8::u32x4 u; bf16x8v v; } cvu; cvu.u = gl; Af[5] = cvu.v; } }
                const bf16_t* w2t = p.W2T + (size_t)L * 512 * 32; const bf16_t* a2t = p.A2T + (size_t)L * 512 * 32; const bf16_t* g2t = p.G2T + (size_t)L * 512 * 96; const bf16_t* ggt = p.GGT + (size_t)L * 256 * 32;
                __syncthreads();
#pragma unroll 2
                for (int nt = 0; nt < 4; ++nt) { const int ch = 64 * wvu + 16 * nt + r;
                    const bf16x8v Bw = *(const bf16x8v*)(w2t + ch * 32 + 8 * q), Ba = *(const bf16x8v*)(a2t + ch * 32 + 8 * q);
                    const bf16x8v Bg0 = *(const bf16x8v*)(g2t + ch * 96 + 8 * q), Bg1 = *(const bf16x8v*)(g2t + ch * 96 + 32 + 8 * q), Bg2 = *(const bf16x8v*)(g2t + ch * 96 + 64 + 8 * q);
                    const f32x4v zero = (f32x4v){0.f, 0.f, 0.f, 0.f};
                    const f32x4v aw = __builtin_amdgcn_mfma_f32_16x16x32_bf16(Af[0], Bw, zero, 0, 0, 0), aa = __builtin_amdgcn_mfma_f32_16x16x32_bf16(Af[1], Ba, zero, 0, 0, 0);
                    f32x4v ag = __builtin_amdgcn_mfma_f32_16x16x32_bf16(Af[2], Bg0, zero, 0, 0, 0); ag = __builtin_amdgcn_mfma_f32_16x16x32_bf16(Af[3], Bg1, ag, 0, 0, 0); ag = __builtin_amdgcn_mfma_f32_16x16x32_bf16(Af[4], Bg2, ag, 0, 0, 0);
#pragma unroll
                    for (int i = 0; i < 4; ++i) { const int o = (4 * q + i) * 516 + ch; lW[o] = aw[i]; lA[o] = aa[i]; lG[o] = ag[i]; } }
#pragma unroll
                for (int nt = 0; nt < 2; ++nt) { const int ch = 32 * wvu + 16 * nt + r;
                    const bf16x8v Bl = *(const bf16x8v*)(ggt + ch * 32 + 8 * q);
                    const f32x4v al = __builtin_amdgcn_mfma_f32_16x16x32_bf16(Af[5], Bl, (f32x4v){0.f, 0.f, 0.f, 0.f}, 0, 0, 0);
#pragma unroll
                    for (int i = 0; i < 4; ++i) lL[(4 * q + i) * 260 + ch] = al[i]; }
                __syncthreads();
            }
        for (int tb = 0; tb < 2; ++tb) {
            const int tt0 = tg0 + tb * 8;
            float accW[8], accA[8], accG[8], accL[8];
#pragma unroll
            for (int k = 0; k < 8; ++k) { const int o = (tb * 8 + k) * 516 + c; accW[k] = w0 + lW[o]; accA[k] = a0 + lA[o]; accG[k] = lG[o]; accL[k] = (c < 256) ? gbc + lL[(tb * 8 + k) * 260 + c] : 0.f; }
            float zr[9], zk[9], zv[9], zq[8], zf[8], zgq[8], zgk[8];
            { const bool has_prev = tt0 > 0; const bf16_t* zp0 = p.z + (size_t)(has_prev ? tt0 - 1 : 0) * ZLD;
              const float hp = has_prev ? 1.f : 0.f; zr[0] = bf2f(zp0[RW_R + c]) * hp; zk[0] = bf2f(zp0[RW_K + c]) * hp; zv[0] = bf2f(zp0[RW_V + c]) * hp; }
#pragma unroll
            for (int k = 0; k < 8; ++k) { const bf16_t* zc = p.z + (size_t)(tt0 + k) * ZLD;
                zr[k + 1] = bf2f(zc[RW_R + c]); zk[k + 1] = bf2f(zc[RW_K + c]); zv[k + 1] = bf2f(zc[RW_V + c]); zq[k] = bf2f(zc[HG_Q + c]); zf[k] = bf2f(zc[HG_F + c]);
                zgq[k] = bf2f(zc[GL_Q + (c & 255)]); zgk[k] = bf2f(zc[GL_K + (c & 255)]); }
            asm volatile("" ::: "memory");
            float sv[2][12];
#pragma unroll
            for (int k = 0; k < 8; ++k) {
                const int t = tt0 + k;
                const float cr = zr[k + 1], ck = zk[k + 1], cv = zv[k + 1];
                const float pr = zr[k], pk = zk[k], pv = zv[k];
                const float r = cr + (pr - cr) * mu_r, kx = ck + (pk - ck) * mu_k, v = cv + (pv - cv) * mu_v;
                const float w_raw = -fsoftplus(-accW[k]) - 0.5f;
                const float decay = __expf(-__expf(w_raw));
                const float iclr = fsig(accA[k]);
                const float kk = kx * kkc;
                const float nrm = sqrtf(wave_sum(kk * kk));
                const float kkn = kk / fmaxf(nrm, 1e-12f);
                const float kmod = kx * (1.0f + (iclr - 1.0f) * kac);
                const float bon = wave_sum(r * kmod * rkc) * v;
                float* svk = sv[k & 1];
                svk[0] = -kkn; svk[1] = kkn * iclr; svk[2] = decay; svk[3] = kmod; svk[4] = r; svk[5] = v; svk[6] = accG[k]; svk[7] = bon;
                { const float q = zq[k], f = zf[k];
                  const float omf = (1.0f - lb) * fsig(-f);
                  bH = fmaxf(bH + __logf(fmaxf(1.0f - omf, 1e-37f)), -85.0f);
                  svk[8] = q * fsig(q) * __expf(bH); svk[9] = omf * __expf(-bH); }
                svk[10] = 0.f; svk[11] = 0.f;
                if (c < 256) {
                  bG = fmaxf(bG - fsoftplus(-accL[k]) * (1.0f / 16.0f), -85.0f);
                  svk[10] = zgq[k] * 0.125f * __expf(bG); svk[11] = zgk[k] * __expf(-bG); }
                if (k & 1) {
                    const bool odd = (c & 1) != 0; const int cp = c & ~1; const size_t tp = (size_t)(t - 1 + (odd ? 1 : 0));
                    float lo[12], hi[12];
#pragma unroll
                    for (int st = 0; st < 12; ++st) { const float mine = odd ? sv[1][st] : sv[0][st], send = odd ? sv[0][st] : sv[1][st]; const float recv = dppmov<0xB1>(send);
                        lo[st] = odd ? recv : mine; hi[st] = odd ? mine : recv; }
                    { float* rs = p.RS + ((size_t)(c >> 6) * T + tp) * 384 + (cp & 63);
#pragma unroll
                      for (int st = 0; st < 6; ++st) *(f32x2v*)(rs + 64 * st) = (f32x2v){lo[st], hi[st]}; }
                    *(unsigned*)(p.rGate + tp * 512 + cp) = pg8::cvt_pk_bf16(lo[6], hi[6]); *(unsigned*)(p.rBonus + tp * 512 + cp) = pg8::cvt_pk_bf16(lo[7], hi[7]);
                    *(unsigned*)(p.cH + tp * 512 + cp) = pg8::cvt_pk_bf16(lo[8], hi[8]); *(unsigned*)(p.KH + tp * 512 + cp) = pg8::cvt_pk_bf16(lo[9], hi[9]);
                    if (c < 256) { *(unsigned*)(p.cG + tp * 256 + cp) = pg8::cvt_pk_bf16(lo[10], hi[10]); *(unsigned*)(p.KG + tp * 256 + cp) = pg8::cvt_pk_bf16(lo[11], hi[11]); }
                }
            }
        }
        }
        { const int h = c >> 7, j = c & 127; p.GamH[((size_t)tile * 4 + h) * 128 + j] = __expf(bH); }
        if (c < 256) { const int h = c >> 6, j = c & 63; p.GamG[((size_t)tile * 4 + h) * 64 + j] = __expf(bG); }
        __syncthreads();
        { const int wvt = c >> 6, lt = c & 63;
#pragma unroll 1
        for (int pass = 0; pass < 3; ++pass) {
            const int col0 = pass == 0 ? HG_I : (pass == 1 ? GL_V : SB_V); bf16_t* dstT = p.VtH + (size_t)pass * 512 * T;
            const bf16_t* src = p.z + (size_t)(t0 + lt) * ZLD + col0 + 64 * wvt;
            pg8::u32x4 xr[8];
#pragma unroll
            for (int j = 0; j < 8; ++j) xr[j] = *(const pg8::u32x4*)(src + 8 * j);
#pragma unroll
            for (int j = 0; j < 8; ++j) { const unsigned xw[4] = {xr[j].x, xr[j].y, xr[j].z, xr[j].w};
#pragma unroll
                for (int e = 0; e < 4; ++e) { vtile[64 * wvt + 8 * j + 2 * e][lt] = (bf16_t)(xw[e] & 0xffffu); vtile[64 * wvt + 8 * j + 2 * e + 1][lt] = (bf16_t)(xw[e] >> 16); } }
#pragma unroll
            for (int it = 0; it < 8; ++it) { const int row = 64 * wvt + it * 8 + (lt >> 3), sg = lt & 7;
                *(pg8::u32x4*)(dstT + (size_t)row * T + t0 + sg * 8) = *(const LAS pg8::u32x4*)&vtile[row][sg * 8]; }
        } }
    }
}

template <int KIND>
__device__ __forceinline__ void chain_unit(const MixArgs& p, const ConvArgs& cva, const int unit, const int seg, const int h, LAS float* lds) {
    constexpr int SF = KIND == 2 ? 512 : (KIND == 3 ? 320 : 384);
    constexpr int EPL = KIND == 2 ? 16 : 8, E2 = EPL / 2, DK = EPL * 8;
    constexpr int CH = 16, NP = CH * SF * 4 / 1024;
    static_assert(KIND == 0, "only the RWKV-7 chain is left (HGRN2 / GLA: intra_unit + chunk scan)");
    const float* stream = p.RS + ((size_t)h * T + (size_t)seg * LSEG) * SF;
    const int tid = phase_tid(), wv = __builtin_amdgcn_readfirstlane(tid >> 6), lane = tid & 63, rg = lane >> 3, lj = lane & 7;
    const bool isP = (KIND == 0) && (wv >= 4);
    const bool active = !(isP && seg == 0);
    const bool wantc = (KIND != 0) && (seg >= 1);
    const int rowA = ((KIND == 0) ? (wv & 3) : wv) * 16 + rg, rowB = rowA + 8;
    const int orow = (isP ? 64 : 0) + rowA;
    LAS float* ob = lds + 2 * CH * SF;
    LAS float* cb = ob;
    constexpr int NT = 8;
    const int jb0 = unit * (LSEG / 16) * NT;
    LAS bf16_t (*cvt)[64][66] = (LAS bf16_t (*)[64][66])(ob + 2 * 16 * 128);
    const int L = p.layer;
    f32x2v SA[E2], SB[E2];
#pragma unroll
    for (int e = 0; e < E2; ++e) { SA[e] = (f32x2v){0.f, 0.f}; SB[e] = (f32x2v){0.f, 0.f};
        if (isP) { if (lj * 8 + 2 * e == rowA) SA[e].x = 1.f; if (lj * 8 + 2 * e + 1 == rowA) SA[e].y = 1.f; if (lj * 8 + 2 * e == rowB) SB[e].x = 1.f; if (lj * 8 + 2 * e + 1 == rowB) SB[e].y = 1.f; } }
    f32x2v gam = (f32x2v){1.f, 1.f};
    auto stage = [&](int ci, LAS float* dst) {
        const char* g = (const char*)(stream + (size_t)ci * CH * SF) + lane * 16;
        for (int pc = wv; pc < NP; pc += 8) __builtin_amdgcn_global_load_lds((const unsigned*)(g + pc * 1024), (LAS unsigned*)((LAS char*)dst + pc * 1024), 16, 0, 0);
    };
    auto writeout = [&](int ci, const LAS float* o, const LAS float* cc) {
#pragma unroll
        for (int q = 0; q < 4; ++q) { const int idx = tid + 512 * q, s = idx >> 7, r = idx & 127; const size_t t = (size_t)seg * LSEG + ci * CH + s; const float v = o[idx];
            if (KIND == 0) { if (r < 64) p.oR[t * 512 + h * 64 + r] = v; else if (seg >= 1) p.cR[t * 512 + h * 64 + (r - 64)] = f2bf(v); }
            else if (KIND == 2) p.oH[t * 512 + h * 128 + r] = v;
            else p.oG[t * 512 + h * 128 + r] = v; }
        if (wantc) {
#pragma unroll
            for (int q = 0; q < (DK * 16) / 512; ++q) { const int idx = tid + 512 * q, s = idx / DK, k = idx % DK; const size_t t = (size_t)seg * LSEG + ci * CH + s;
                if (KIND == 2) p.cH[t * 512 + h * 128 + k] = f2bf(cc[s * 128 + k]); else p.cG[t * 256 + h * 64 + k] = f2bf(cc[s * 128 + k]); }
        }
    };
    constexpr int NCH = LSEG / CH;
    struct OpsR { f32x4v a0, a1, b0, b1, w0, w1, r0, r1, k0, k1; float vA, vB; };
    struct OpsG { f32x4v q[EPL / 4], w[EPL / 4], k[EPL / 4]; float vA, vB; f32x2v gw, gq; };
    const float vscale = isP ? 0.f : 1.f;
    const int goff = (EPL == 8) ? (lj * 8 + wv) : (lj * 16 + 2 * wv);
    stage(0, lds);
    for (int ci = 0; ci < NCH; ++ci) {
        asm volatile("s_waitcnt vmcnt(0)" ::: "memory"); __syncthreads();
        const LAS float* cur = lds + (ci & 1) * CH * SF;
        if (ci + 1 < NCH) stage(ci + 1, lds + ((ci + 1) & 1) * CH * SF);
        if (ci > 0) writeout(ci - 1, ob + ((ci - 1) & 1) * 2048, cb + ((ci - 1) & 1) * 2048);
        LAS float* oc = ob + (ci & 1) * 2048; LAS float* ccur = cb + (ci & 1) * 2048;
        if (ci > 0) {
#pragma unroll
            for (int k4 = 0; k4 < NT; ++k4) { CvJob jb; if (cvx_job(cva, jb0 + (ci - 1) * NT + k4, L, jb)) { const int n = tid >> 3, kc = (tid & 7) * 8;
                const LAS unsigned* tp = (const LAS unsigned*)&cvt[k4][n][kc]; pg8::u32x4 w; w.x = tp[0]; w.y = tp[1]; w.z = tp[2]; w.w = tp[3];
                *(pg8::u32x4*)(jb.dst + (size_t)n * jb.ldd + kc) = w; } }
        }
        float4 cvr[NT][2]; bool cvok[NT];
#pragma unroll
        for (int k4 = 0; k4 < NT; ++k4) { CvJob jb; cvok[k4] = cvx_job(cva, jb0 + ci * NT + k4, L, jb);
            cvr[k4][0] = make_float4(0.f, 0.f, 0.f, 0.f); cvr[k4][1] = cvr[k4][0];
            if (cvok[k4]) { const int c4 = (tid & 15) * 4, kr = tid >> 4;
                if (c4 < jb.valid) { cvr[k4][0] = *(const float4*)(jb.src + (size_t)(2 * kr) * jb.ld + c4); cvr[k4][1] = *(const float4*)(jb.src + (size_t)(2 * kr + 1) * jb.ld + c4); } } }
        if (active) {
            if constexpr (KIND == 0) {
                auto ld = [&](int s) { const LAS float* sp = cur + s * SF + lj * 8; OpsR o;
                    o.a0 = *(const LAS f32x4v*)(sp); o.a1 = *(const LAS f32x4v*)(sp + 4); o.b0 = *(const LAS f32x4v*)(sp + 64); o.b1 = *(const LAS f32x4v*)(sp + 68);
                    o.w0 = *(const LAS f32x4v*)(sp + 128); o.w1 = *(const LAS f32x4v*)(sp + 132); o.k0 = *(const LAS f32x4v*)(sp + 192); o.k1 = *(const LAS f32x4v*)(sp + 196);
                    o.r0 = *(const LAS f32x4v*)(sp + 256); o.r1 = *(const LAS f32x4v*)(sp + 260);
                    o.vA = cur[s * SF + 320 + rowA]; o.vB = cur[s * SF + 320 + rowB]; return o; };
                OpsR nx = ld(0);
#pragma unroll
                for (int s = 0; s < CH; ++s) {
                    const OpsR o = nx;
                    if (s + 1 < CH) nx = ld(s + 1);
                    f32x2v pa = SA[0] * o.a0.xy, pb = SB[0] * o.a0.xy; pa = SA[1] * o.a0.zw + pa; pb = SB[1] * o.a0.zw + pb;
                    f32x2v qa = SA[2] * o.a1.xy, qb = SB[2] * o.a1.xy; qa = SA[3] * o.a1.zw + qa; qb = SB[3] * o.a1.zw + qb; pa += qa; pb += qb;
                    float sA = pa.x + pa.y, sB = pb.x + pb.y;
                    sA += dppmov<0xB1>(sA); sB += dppmov<0xB1>(sB); sA += dppmov<0x4E>(sA); sB += dppmov<0x4E>(sB); sA += dppmov<0x141>(sA); sB += dppmov<0x141>(sB);
                    const f32x2v savA = (f32x2v){sA, sA}, savB = (f32x2v){sB, sB};
                    const float vA = o.vA * vscale, vB = o.vB * vscale; const f32x2v vvA = (f32x2v){vA, vA}, vvB = (f32x2v){vB, vB};
                    SA[0] = SA[0] * o.w0.xy + (savA * o.b0.xy + vvA * o.k0.xy); SB[0] = SB[0] * o.w0.xy + (savB * o.b0.xy + vvB * o.k0.xy);
                    SA[1] = SA[1] * o.w0.zw + (savA * o.b0.zw + vvA * o.k0.zw); SB[1] = SB[1] * o.w0.zw + (savB * o.b0.zw + vvB * o.k0.zw);
                    SA[2] = SA[2] * o.w1.xy + (savA * o.b1.xy + vvA * o.k1.xy); SB[2] = SB[2] * o.w1.xy + (savB * o.b1.xy + vvB * o.k1.xy);
                    SA[3] = SA[3] * o.w1.zw + (savA * o.b1.zw + vvA * o.k1.zw); SB[3] = SB[3] * o.w1.zw + (savB * o.b1.zw + vvB * o.k1.zw);
                    f32x2v oa = SA[0] * o.r0.xy, obb = SB[0] * o.r0.xy; oa = SA[1] * o.r0.zw + oa; obb = SB[1] * o.r0.zw + obb;
                    f32x2v oa2 = SA[2] * o.r1.xy, ob2 = SB[2] * o.r1.xy; oa2 = SA[3] * o.r1.zw + oa2; ob2 = SB[3] * o.r1.zw + ob2; oa += oa2; obb += ob2;
                    float oA = oa.x + oa.y, oB = obb.x + obb.y;
                    oA += dppmov<0xB1>(oA); oB += dppmov<0xB1>(oB); oA += dppmov<0x4E>(oA); oB += dppmov<0x4E>(oB); oA += dppmov<0x141>(oA); oB += dppmov<0x141>(oB);
                    if (lj == 0) { oc[s * 128 + orow] = oA; oc[s * 128 + orow + 8] = oB; }
                }
            } else {
                auto ld = [&](int s) { const LAS float* sp = cur + s * SF + lj * EPL; OpsG o;
#pragma unroll
                    for (int e4 = 0; e4 < EPL / 4; ++e4) { o.q[e4] = *(const LAS f32x4v*)(sp + e4 * 4); o.w[e4] = *(const LAS f32x4v*)(sp + DK + e4 * 4); o.k[e4] = *(const LAS f32x4v*)(sp + 2 * DK + e4 * 4); }
                    o.vA = cur[s * SF + 3 * DK + rowA]; o.vB = cur[s * SF + 3 * DK + rowB];
                    if constexpr (EPL == 8) { o.gw = (f32x2v){cur[s * SF + DK + goff], 1.f}; o.gq = (f32x2v){cur[s * SF + goff], 0.f}; }
                    else { o.gw = *(const LAS f32x2v*)(cur + s * SF + DK + goff); o.gq = *(const LAS f32x2v*)(cur + s * SF + goff); }
                    return o; };
                OpsG nx = ld(0);
#pragma unroll
                for (int s = 0; s < CH; ++s) {
                    const OpsG o = nx;
                    if (s + 1 < CH) nx = ld(s + 1);
                    const f32x2v vvA = (f32x2v){o.vA, o.vA}, vvB = (f32x2v){o.vB, o.vB};
                    f32x2v oa = (f32x2v){0.f, 0.f}, oa2 = oa, obb = oa, ob2 = oa;
#pragma unroll
                    for (int e4 = 0; e4 < EPL / 4; ++e4) {
                        SA[2 * e4] = SA[2 * e4] * o.w[e4].xy + vvA * o.k[e4].xy; SA[2 * e4 + 1] = SA[2 * e4 + 1] * o.w[e4].zw + vvA * o.k[e4].zw;
                        SB[2 * e4] = SB[2 * e4] * o.w[e4].xy + vvB * o.k[e4].xy; SB[2 * e4 + 1] = SB[2 * e4 + 1] * o.w[e4].zw + vvB * o.k[e4].zw;
                        oa = SA[2 * e4] * o.q[e4].xy + oa; oa2 = SA[2 * e4 + 1] * o.q[e4].zw + oa2; obb = SB[2 * e4] * o.q[e4].xy + obb; ob2 = SB[2 * e4 + 1] * o.q[e4].zw + ob2;
                    }
                    oa += oa2; obb += ob2;
                    float oA = oa.x + oa.y, oB = obb.x + obb.y;
                    oA += dppmov<0xB1>(oA); oB += dppmov<0xB1>(oB); oA += dppmov<0x4E>(oA); oB += dppmov<0x4E>(oB); oA += dppmov<0x141>(oA); oB += dppmov<0x141>(oB);
                    if (lj == 0) { oc[s * 128 + rowA] = oA; oc[s * 128 + rowB] = oB; }
                    gam *= o.gw; const f32x2v cq = o.gq * gam;
                    if (wantc && rg == 0) { if constexpr (EPL == 8) ccur[s * 128 + goff] = cq.x; else *(LAS f32x2v*)(ccur + s * 128 + goff) = cq; }
                }
            }
        }
        __syncthreads();
#pragma unroll
        for (int k4 = 0; k4 < NT; ++k4) if (cvok[k4]) { const int c4 = (tid & 15) * 4, kr = tid >> 4; const float4 v0 = cvr[k4][0], v1 = cvr[k4][1];
            *(LAS unsigned*)&cvt[k4][c4][2 * kr] = pg8::cvt_pk_bf16(v0.x, v1.x); *(LAS unsigned*)&cvt[k4][c4 + 1][2 * kr] = pg8::cvt_pk_bf16(v0.y, v1.y);
            *(LAS unsigned*)&cvt[k4][c4 + 2][2 * kr] = pg8::cvt_pk_bf16(v0.z, v1.z); *(LAS unsigned*)&cvt[k4][c4 + 3][2 * kr] = pg8::cvt_pk_bf16(v0.w, v1.w); }
    }
    __syncthreads();
#pragma unroll
    for (int k4 = 0; k4 < NT; ++k4) { CvJob jb; if (cvx_job(cva, jb0 + (NCH - 1) * NT + k4, L, jb)) { const int n = tid >> 3, kc = (tid & 7) * 8;
        const LAS unsigned* tp = (const LAS unsigned*)&cvt[k4][n][kc]; pg8::u32x4 w; w.x = tp[0]; w.y = tp[1]; w.z = tp[2]; w.w = tp[3];
        *(pg8::u32x4*)(jb.dst + (size_t)n * jb.ldd + kc) = w; } }
    writeout(NCH - 1, ob + ((NCH - 1) & 1) * 2048, cb + ((NCH - 1) & 1) * 2048);
    if (active) {
        float* dA;
        if (KIND == 0) dA = (isP ? p.PendR : p.SendR) + (((size_t)seg * 8 + h) * 64 + rowA) * 64 + lj * 8;
        else if (KIND == 2) dA = p.SendH + (((size_t)seg * 4 + h) * 128 + rowA) * 128 + lj * 16;
        else dA = p.SendG + (((size_t)seg * 4 + h) * 128 + rowA) * 64 + lj * 8;
        float* dB = dA + 8 * DK;
#pragma unroll
        for (int e = 0; e < E2; ++e) { dA[2 * e] = SA[e].x; dA[2 * e + 1] = SA[e].y; dB[2 * e] = SB[e].x; dB[2 * e + 1] = SB[e].y; }
    }
    if (wantc && rg == 0) {
        if constexpr (EPL == 8) p.GamG[(size_t)seg * 256 + h * 64 + lj * 8 + wv] = gam.x;
        else { p.GamH[(size_t)seg * 512 + h * 128 + lj * 16 + 2 * wv] = gam.x; p.GamH[(size_t)seg * 512 + h * 128 + lj * 16 + 2 * wv + 1] = gam.y; }
    }
    __syncthreads();
}
__device__ __forceinline__ void sb_phase(const MixArgs& p, const int wave0, const int W, const int uend);
template <int DK>
__device__ __forceinline__ void intra_unit(const MixArgs& p, const int h, const int chunk, LAS bf16_t* ktT, const int lane) {
    typedef short bf16x8v __attribute__((ext_vector_type(8)));
    typedef float f32x16v __attribute__((ext_vector_type(16)));
    typedef __bf16 bf16x2n __attribute__((ext_vector_type(2)));
    constexpr int QP = DK * 4, NKS = DK / 16, NKB = DK / 32;
    const bf16_t* Qb = (DK == 128 ? p.cH : p.cG) + h * DK; const bf16_t* Kb = (DK == 128 ? p.KH : p.KG) + h * DK;
    const bf16_t* Vt = (DK == 128 ? p.VtH : p.VtG) + (size_t)h * 128 * T;
    float* ol = (DK == 128 ? p.oH : p.oG) + h * 128; float* Send = (DK == 128 ? p.SendH : p.SendG) + ((size_t)chunk * 4 + h) * 128 * DK;
    const int r = lane & 31, hh = lane >> 5, t0 = chunk * 64;
#pragma unroll 1
    for (int tb = 0; tb < 2; ++tb) {
        bf16x8v Qf[NKS];
#pragma unroll
        for (int ks = 0; ks < NKS; ++ks) Qf[ks] = *(const bf16x8v*)(Qb + (unsigned)((t0 + 32 * tb + r) * QP + 16 * ks + 8 * hh));
#pragma unroll 1
        for (int vh = 0; vh < 2; ++vh) {
            f32x16v O[2];
#pragma unroll
            for (int vb = 0; vb < 2; ++vb)
#pragma unroll
                for (int i = 0; i < 16; ++i) O[vb][i] = 0.f;
            for (int sb = 0; sb <= tb; ++sb) {
                f32x16v P;
#pragma unroll
                for (int i = 0; i < 16; ++i) P[i] = 0.f;
#pragma unroll
                for (int ks = 0; ks < NKS; ++ks) { const bf16x8v Kf = *(const bf16x8v*)(Kb + (unsigned)((t0 + 32 * sb + r) * QP + 16 * ks + 8 * hh));
                    P = __builtin_amdgcn_mfma_f32_32x32x16_bf16(Kf, Qf[ks], P, 0, 0, 0); }
                const bool diag = (sb == tb);
                bf16x8v Pf[2];
#pragma unroll
                for (int s2 = 0; s2 < 2; ++s2) {
                    union { bf16x2n h2[4]; bf16x8v v; } pk;
#pragma unroll
                    for (int j = 0; j < 4; ++j) { f32x2v f;
                        { const int i = 8 * s2 + 2 * j, kr = (i & 3) + 8 * (i >> 2) + 4 * hh; f.x = (!diag || kr <= r) ? P[i] : 0.f; }
                        { const int i = 8 * s2 + 2 * j + 1, kr = (i & 3) + 8 * (i >> 2) + 4 * hh; f.y = (!diag || kr <= r) ? P[i] : 0.f; }
                        pk.h2[j] = __builtin_convertvector(f, bf16x2n); }
                    Pf[s2] = pk.v; }
#pragma unroll
                for (int vb = 0; vb < 2; ++vb)
#pragma unroll
                    for (int s2 = 0; s2 < 2; ++s2) { const bf16_t* vp = Vt + (unsigned)((32 * (2 * vh + vb) + r) * T + t0 + 32 * sb + 16 * s2 + 4 * hh);
                        union { pg8::u32x2 d[2]; bf16x8v v; } vf; vf.d[0] = *(const pg8::u32x2*)vp; vf.d[1] = *(const pg8::u32x2*)(vp + 8);
                        O[vb] = __builtin_amdgcn_mfma_f32_32x32x16_bf16(vf.v, Pf[s2], O[vb], 0, 0, 0); }
            }
#pragma unroll
            for (int vb = 0; vb < 2; ++vb)
#pragma unroll
                for (int g = 0; g < 4; ++g) { f32x4v w; w.x = O[vb][4 * g]; w.y = O[vb][4 * g + 1]; w.z = O[vb][4 * g + 2]; w.w = O[vb][4 * g + 3];
                    *(f32x4v*)(ol + (unsigned)((t0 + 32 * tb + r) * 512 + 32 * (2 * vh + vb) + 8 * g + 4 * hh)) = w; }
        }
    }
#pragma unroll 8
    for (int it = 0; it < DK / 8; ++it) { const int pidx = it * 64 + lane, srow = pidx / (DK / 8), cb8 = pidx % (DK / 8);
        const pg8::u32x4 w = *(const pg8::u32x4*)(Kb + (unsigned)((t0 + srow) * QP + cb8 * 8));
        const unsigned ww[4] = {w.x, w.y, w.z, w.w};
#pragma unroll
        for (int j = 0; j < 4; ++j) { ktT[(cb8 * 8 + 2 * j) * 66 + srow] = (bf16_t)(ww[j] & 0xffffu); ktT[(cb8 * 8 + 2 * j + 1) * 66 + srow] = (bf16_t)(ww[j] >> 16); } }
    bf16x8v AfAll[4][4];
#pragma unroll
    for (int vb = 0; vb < 4; ++vb)
#pragma unroll
        for (int ks = 0; ks < 4; ++ks) AfAll[vb][ks] = *(const bf16x8v*)(Vt + (unsigned)((32 * vb + r) * T + t0 + 16 * ks + 8 * hh));
#pragma unroll
    for (int vb = 0; vb < 4; ++vb) {
        const bf16x8v (&Af)[4] = AfAll[vb];
#pragma unroll 1
        for (int kb = 0; kb < NKB; ++kb) {
            f32x16v U;
#pragma unroll
            for (int i = 0; i < 16; ++i) U[i] = 0.f;
#pragma unroll
            for (int ks = 0; ks < 4; ++ks) { const LAS unsigned* tp = (const LAS unsigned*)(ktT + (32 * kb + r) * 66 + 16 * ks + 8 * hh);
                union { unsigned d[4]; bf16x8v v; } bf; bf.d[0] = tp[0]; bf.d[1] = tp[1]; bf.d[2] = tp[2]; bf.d[3] = tp[3];
                U = __builtin_amdgcn_mfma_f32_32x32x16_bf16(Af[ks], bf.v, U, 0, 0, 0); }
            float* sp = Send + (unsigned)((32 * vb + 4 * hh) * DK + 32 * kb + r);
#pragma unroll
            for (int i = 0; i < 16; ++i) sp[((i & 3) + 8 * (i >> 2)) * DK] = U[i];
        }
    }
}
__device__ __forceinline__ void chains_phase(const MixArgs& p, const ConvArgs& cva, unsigned* sbq, LAS unsigned char* ldsraw) {
    LAS float* lds = (LAS float*)ldsraw;
    for (int u = blockIdx.x; u < 8 * NSEG; u += gridDim.x) chain_unit<0>(p, cva, u, u >> 3, u & 7, lds);
    LAS int* slot = (LAS int*)(ldsraw + 8 * 128 * 66 * 2);
    const int ptid = phase_tid(), wv = ptid >> 6, lane = ptid & 63;
    LAS bf16_t* ktT = (LAS bf16_t*)ldsraw + (size_t)wv * 128 * 66;
    for (;;) {
        __syncthreads();
        if (ptid == 0) slot[0] = (int)__hip_atomic_fetch_add(sbq, 8u, __ATOMIC_RELAXED, __HIP_MEMORY_SCOPE_AGENT);
        __syncthreads();
        const int base = slot[0];
        if (base >= 2048) break;
        const int u = base + wv; if (u < 1024) intra_unit<128>(p, u & 3, u >> 2, ktT, lane); else intra_unit<64>(p, (u - 1024) & 3, (u - 1024) >> 2, ktT, lane);
    }
}
__device__ __forceinline__ void sb_queue(const MixArgs& p, unsigned* sbq2, LAS unsigned char* ldsraw) {
    LAS int* slot = (LAS int*)(ldsraw + 8 * 128 * 66 * 2);
    const int ptid = phase_tid();
    for (;;) {
        __syncthreads();
        if (ptid == 0) slot[0] = (int)__hip_atomic_fetch_add(sbq2, 8u, __ATOMIC_RELAXED, __HIP_MEMORY_SCOPE_AGENT);
        __syncthreads();
        const int base = slot[0];
        if (base >= 2048) break;
        sb_phase(p, base, 1 << 30, 2048);
    }
}

__device__ __forceinline__ void carry_phase(const MixArgs& p, LAS unsigned char* ldsraw, const int part) {
    const int tid = phase_tid();
    if (part != 2) for (int u = blockIdx.x; u < 32; u += gridDim.x) {
        const int h = u >> 2, vq = u & 3;
        LAS float (*cur)[68] = (LAS float (*)[68])ldsraw; LAS float (*Pm)[68] = (LAS float (*)[68])(ldsraw + 16 * 68 * 4);
        const int vl = tid >> 5, kb = (tid & 31) * 2;
        const int pv = tid >> 3, pk = (tid & 7) * 8;
        const size_t eoS = (size_t)(16 * vq + vl) * 64 + kb, eoP = (size_t)pv * 64 + pk;
        f32x2v nv; f32x4v rP0[4], rP1[4]; f32x2v rS[4];
        nv = *(const f32x2v*)(p.SendR + ((size_t)0 * 8 + h) * 4096 + eoS);
#pragma unroll
        for (int j = 1; j < 4; ++j) { rP0[j] = *(const f32x4v*)(p.PendR + ((size_t)j * 8 + h) * 4096 + eoP); rP1[j] = *(const f32x4v*)(p.PendR + ((size_t)j * 8 + h) * 4096 + eoP + 4);
            rS[j] = *(const f32x2v*)(p.SendR + ((size_t)j * 8 + h) * 4096 + eoS); }
        rP0[0] = rP0[1]; rP1[0] = rP1[1]; rS[0] = rS[1];
        for (int sb = 0; sb < NSEG; sb += 4) {
#pragma unroll
            for (int j = 0; j < 4; ++j) { const int s = sb + j;
                if (s >= 1) {
                    __syncthreads();
                    *(unsigned*)(p.SstR + ((size_t)s * 8 + h) * 4096 + eoS) = pg8::cvt_pk_bf16(nv.x, nv.y);
                    if (s < NSEG - 1) {
                        *(LAS f32x2v*)&cur[vl][kb] = nv;
                        *(LAS f32x4v*)&Pm[pv][pk] = rP0[j]; *(LAS f32x4v*)&Pm[pv][pk + 4] = rP1[j];
                        nv = rS[j];
                        __syncthreads();
                        if (s + 3 < NSEG - 1) { constexpr int dummy = 0; (void)dummy; const int jn = (j + 3) & 3;
                            rP0[jn] = *(const f32x4v*)(p.PendR + ((size_t)(s + 3) * 8 + h) * 4096 + eoP); rP1[jn] = *(const f32x4v*)(p.PendR + ((size_t)(s + 3) * 8 + h) * 4096 + eoP + 4);
                            rS[jn] = *(const f32x2v*)(p.SendR + ((size_t)(s + 3) * 8 + h) * 4096 + eoS); }
#pragma unroll 4
                        for (int i4 = 0; i4 < 64; i4 += 4) { const f32x4v c4 = *(const LAS f32x4v*)&cur[vl][i4];
#pragma unroll
                            for (int ii = 0; ii < 4; ++ii) { const f32x2v p2 = *(const LAS f32x2v*)&Pm[i4 + ii][kb]; const float c = c4[ii]; nv = (f32x2v){c, c} * p2 + nv; } }
                    }
                }
            }
        }
        __syncthreads();
    }
    if (part != 1) for (int u = blockIdx.x; u < 32 + 192; u += gridDim.x) {
        if (u < 32) continue;
        const bool isH = u < 32 + 128; const int idx = (isH ? (u - 32) : (u - 160)) * 512 + tid;
        const float* Ub = (isH ? p.SendH : p.SendG) + idx; bf16_t* Sb = (isH ? p.SstH : p.SstG) + idx; const size_t cstr = isH ? 65536 : 32768;
        const float* Gb = isH ? p.GamH + (idx >> 14) * 128 + (idx & 127) : p.GamG + (idx >> 13) * 64 + (idx & 63); const int gstr = isH ? 512 : 256;
        float S = 0.f;
        float uu[16], gg[16], un[16], gn[16];
#pragma unroll
        for (int j = 0; j < 16; ++j) { un[j] = Ub[(size_t)j * cstr]; gn[j] = Gb[(size_t)j * gstr]; }
        for (int c0 = 0; c0 < NCHK; c0 += 16) {
#pragma unroll
            for (int j = 0; j < 16; ++j) { uu[j] = un[j]; gg[j] = gn[j]; }
            if (c0 + 16 < NCHK) {
#pragma unroll
                for (int j = 0; j < 16; ++j) { un[j] = Ub[(size_t)(c0 + 16 + j) * cstr]; gn[j] = Gb[(size_t)(c0 + 16 + j) * gstr]; } }
#pragma unroll
            for (int j = 0; j < 16; ++j) { Sb[(size_t)(c0 + j) * cstr] = f2bf(S); S = gg[j] * (S + uu[j]); }
        }
    }
}

__device__ __forceinline__ void mixfin_phase(const MixArgs& p) {
    typedef short bf16x8v __attribute__((ext_vector_type(8)));
    const int tid = phase_tid(), wv = tid >> 6, lane = tid & 63, r = lane & 15, q = lane >> 4, L = p.layer;
    const int W = gridDim.x * 8;
    for (int u = blockIdx.x * 8 + wv; u < 16384; u += W) {
        if (u < 8192) {
            const int tt = u >> 3, h = u & 7, t0 = tt * 16, seg = t0 / LSEG;
            f32x4v acc[4];
#pragma unroll
            for (int nb = 0; nb < 4; ++nb) acc[nb] = (f32x4v){0.f, 0.f, 0.f, 0.f};
            if (seg >= 1) {
#pragma unroll
                for (int ks = 0; ks < 2; ++ks) { const bf16x8v A = *(const bf16x8v*)(p.cR + (size_t)(t0 + r) * 512 + h * 64 + ks * 32 + q * 8);
#pragma unroll
                    for (int nb = 0; nb < 4; ++nb) { const bf16x8v B = *(const bf16x8v*)(p.SstR + (((size_t)seg * 8 + h) * 64 + nb * 16 + r) * 64 + ks * 32 + q * 8);
                        acc[nb] = __builtin_amdgcn_mfma_f32_16x16x32_bf16(A, B, acc[nb], 0, 0, 0); } }
            }
            float oin[4][4], bon[4][4], gat[4][4], lnw[4], lnb[4];
#pragma unroll
            for (int nb = 0; nb < 4; ++nb) { const int c = h * 64 + nb * 16 + r; lnw[nb] = p.rw_ln_w[L * 512 + c]; lnb[nb] = p.rw_ln_b[L * 512 + c];
#pragma unroll
                for (int i = 0; i < 4; ++i) { const size_t t = (size_t)t0 + 4 * q + i; oin[i][nb] = p.oR[t * 512 + c]; bon[i][nb] = bf2f(p.rBonus[t * 512 + c]); gat[i][nb] = bf2f(p.rGate[t * 512 + c]); } }
#pragma unroll
            for (int i = 0; i < 4; ++i) { const size_t t = (size_t)t0 + 4 * q + i; float o[4]; float s = 0.f;
#pragma unroll
                for (int nb = 0; nb < 4; ++nb) { o[nb] = acc[nb][i] + oin[i][nb]; s += o[nb]; }
                const float mu = red16(s) * (1.0f / 64.0f); float d2 = 0.f;
#pragma unroll
                for (int nb = 0; nb < 4; ++nb) { o[nb] -= mu; d2 += o[nb] * o[nb]; }
                const float rstd = rsqrtf(red16(d2) * (1.0f / 64.0f) + 64e-5f);
#pragma unroll
                for (int nb = 0; nb < 4; ++nb) { const int c = h * 64 + nb * 16 + r; const float y = o[nb] * rstd * lnw[nb] + lnb[nb];
                    p.bo[(size_t)T * 512 + t * 512 + c] = f2bf((y + bon[i][nb]) * gat[i][nb]); } }
        } else {
            const bool isH = u < 12288; const int qq = isH ? u - 8192 : u - 12288;
            const int tt = qq >> 2, h = qq & 3, t0 = tt * 16, seg = t0 >> 6;
            f32x4v acc[8];
#pragma unroll
            for (int nb = 0; nb < 8; ++nb) acc[nb] = (f32x4v){0.f, 0.f, 0.f, 0.f};
            if (seg >= 1) {
                if (isH) {
#pragma unroll
                    for (int ks = 0; ks < 4; ++ks) { const bf16x8v A = *(const bf16x8v*)(p.cH + (size_t)(t0 + r) * 512 + h * 128 + ks * 32 + q * 8);
#pragma unroll
                        for (int nb = 0; nb < 8; ++nb) { const bf16x8v B = *(const bf16x8v*)(p.SstH + (((size_t)seg * 4 + h) * 128 + nb * 16 + r) * 128 + ks * 32 + q * 8);
                            acc[nb] = __builtin_amdgcn_mfma_f32_16x16x32_bf16(A, B, acc[nb], 0, 0, 0); } }
                } else {
#pragma unroll
                    for (int ks = 0; ks < 2; ++ks) { const bf16x8v A = *(const bf16x8v*)(p.cG + (size_t)(t0 + r) * 256 + h * 64 + ks * 32 + q * 8);
#pragma unroll
                        for (int nb = 0; nb < 8; ++nb) { const bf16x8v B = *(const bf16x8v*)(p.SstG + (((size_t)seg * 4 + h) * 128 + nb * 16 + r) * 64 + ks * 32 + q * 8);
                            acc[nb] = __builtin_amdgcn_mfma_f32_16x16x32_bf16(A, B, acc[nb], 0, 0, 0); } }
                }
            }
            const float* ol = isH ? p.oH : p.oG; const float* gain = (isH ? p.hg_norm_w : p.gla_norm_w) + L * 512; const int gcol = isH ? HG_G : GL_R;
            bf16_t* bo = p.bo + (isH ? (size_t)0 : (size_t)3 * T * 512);
            float oin[4][8], gin[4][8], gn[8];
#pragma unroll
            for (int nb = 0; nb < 8; ++nb) { const int c = h * 128 + nb * 16 + r; gn[nb] = gain[c];
#pragma unroll
                for (int i = 0; i < 4; ++i) { const size_t t = (size_t)t0 + 4 * q + i; oin[i][nb] = ol[t * 512 + c]; gin[i][nb] = bf2f(p.z[t * ZLD + gcol + c]); } }
#pragma unroll
            for (int i = 0; i < 4; ++i) { const size_t t = (size_t)t0 + 4 * q + i; float o[8]; float ss = 0.f;
#pragma unroll
                for (int nb = 0; nb < 8; ++nb) { o[nb] = acc[nb][i] + oin[i][nb]; ss += o[nb] * o[nb]; }
                const float rs = rsqrtf(red16(ss) * (1.0f / 128.0f) + 1e-5f);
#pragma unroll
                for (int nb = 0; nb < 8; ++nb) { const int c = h * 128 + nb * 16 + r;
                    bo[t * 512 + c] = f2bf(o[nb] * rs * gn[nb] * siluf_(gin[i][nb])); } }
        }
    }
}
__device__ __forceinline__ void sb_phase(const MixArgs& p, const int wave0, const int W, const int uend) {
    typedef short bf16x8v __attribute__((ext_vector_type(8)));
    typedef float f32x16v __attribute__((ext_vector_type(16)));
    typedef __bf16 bf16x2n __attribute__((ext_vector_type(2)));
    const int tid = phase_tid(), wv = tid >> 6, lane = tid & 63, r = lane & 31, hh = lane >> 5;
    const float scale = 0.08838834764831845f;
    for (int u = wave0 + wv; u < uend; u += W) {
        const int h = u & 3, qb = u >> 2, q0 = qb * 32;
        bf16x8v Qf[8];
#pragma unroll
        for (int s = 0; s < 8; ++s) Qf[s] = *(const bf16x8v*)(p.z + (size_t)(q0 + r) * ZLD + SB_Q + h * 128 + s * 16 + hh * 8);
        f32x16v O[4];
#pragma unroll
        for (int db = 0; db < 4; ++db)
#pragma unroll
            for (int i = 0; i < 16; ++i) O[db][i] = 0.f;
        float R = 0.f;
        bf16x8v Kn[8];
#pragma unroll
        for (int s = 0; s < 8; ++s) Kn[s] = *(const bf16x8v*)(p.z + (size_t)(qb * 32 + r) * ZLD + SB_K + h * 128 + s * 16 + hh * 8);
        for (int kb = qb; kb >= 0; --kb) {
            const int k0 = kb * 32;
            f32x16v Sacc;
#pragma unroll
            for (int i = 0; i < 16; ++i) Sacc[i] = 0.f;
#pragma unroll
            for (int s = 0; s < 8; ++s) Sacc = __builtin_amdgcn_mfma_f32_32x32x16_bf16(Kn[s], Qf[s], Sacc, 0, 0, 0);
            { const int kn0 = (kb > 0 ? kb - 1 : 0) * 32;
#pragma unroll
              for (int s = 0; s < 8; ++s) Kn[s] = *(const bf16x8v*)(p.z + (size_t)(kn0 + r) * ZLD + SB_K + h * 128 + s * 16 + hh * 8); }
            float lk[16], zz[16]; bool valid[16];
            const bool diag = (kb == qb);
#pragma unroll
            for (int i = 0; i < 16; ++i) { const int kr = (i & 3) + 8 * (i >> 2) + 4 * hh;
                valid[i] = !diag || (kr < r);
                zz[i] = Sacc[i] * scale;
                const float sp = fmaxf(zz[i], 0.f) + __logf(1.0f + __expf(-fabsf(zz[i])));
                lk[i] = valid[i] ? -sp : 0.f; }
            float G[4], Gp[4];
#pragma unroll
            for (int g = 0; g < 4; ++g) { G[g] = (lk[4 * g] + lk[4 * g + 1]) + (lk[4 * g + 2] + lk[4 * g + 3]); Gp[g] = __shfl_xor(G[g], 32); }
            float Tq[4]; float run = 0.f;
#pragma unroll
            for (int g = 3; g >= 0; --g) { Tq[g] = run + (hh == 0 ? Gp[g] : 0.f); run += G[g] + Gp[g]; }
            float wgt[16];
#pragma unroll
            for (int g = 0; g < 4; ++g) { float ing = 0.f;
#pragma unroll
                for (int j = 3; j >= 0; --j) { const int i = 4 * g + j;
                    const float logw = zz[i] + lk[i] + (R + Tq[g] + ing);
                    wgt[i] = valid[i] ? __expf(logw) : 0.f;
                    ing += lk[i]; } }
            R += run;
            bf16x8v Pf[2];
#pragma unroll
            for (int s2 = 0; s2 < 2; ++s2) {
                union { bf16x2n h2[4]; bf16x8v v; } pk;
#pragma unroll
                for (int j = 0; j < 4; ++j) { f32x2v f; f.x = wgt[8 * s2 + 2 * j]; f.y = wgt[8 * s2 + 2 * j + 1]; pk.h2[j] = __builtin_convertvector(f, bf16x2n); }
                Pf[s2] = pk.v; }
#pragma unroll
            for (int db = 0; db < 4; ++db)
#pragma unroll
                for (int s2 = 0; s2 < 2; ++s2) { const bf16_t* vp = p.Vt + (size_t)(h * 128 + db * 32 + r) * T + k0 + 16 * s2 + 4 * hh;
                    union { pg8::u32x2 d[2]; bf16x8v v; } vf; vf.d[0] = *(const pg8::u32x2*)vp; vf.d[1] = *(const pg8::u32x2*)(vp + 8);
                    O[db] = __builtin_amdgcn_mfma_f32_32x32x16_bf16(vf.v, Pf[s2], O[db], 0, 0, 0); }
            if (__all(R < -104.0f)) break;
        }
        bf16_t* bo2 = p.bo + (size_t)2 * T * 512 + (size_t)(q0 + r) * 512 + h * 128;
#pragma unroll
        for (int db = 0; db < 4; ++db)
#pragma unroll
            for (int g = 0; g < 4; ++g) { pg8::u32x2 w; w.x = (unsigned)f2bf(O[db][4 * g]) | ((unsigned)f2bf(O[db][4 * g + 1]) << 16); w.y = (unsigned)f2bf(O[db][4 * g + 2]) | ((unsigned)f2bf(O[db][4 * g + 3]) << 16);
                *(pg8::u32x2*)(bo2 + db * 32 + 8 * g + 4 * hh) = w; }
    }
}

#define XB_TMO      128
#define XB_XCNT(j)  (256  + 64 * (j))
#define XB_XSUB(j)  (1280 + 64 * (j))
#define XB_XGEN(j)  (2304 + 64 * (j))
#define XB_TOP      3328
#define XB_TOPGEN   3392
#define XCD_BAR_WORDS 3456
#define XB_SPIN_CAP (1u << 18)
__device__ __forceinline__ unsigned xb_ld(unsigned* p)              { return __hip_atomic_load(p, __ATOMIC_RELAXED, __HIP_MEMORY_SCOPE_AGENT); }
__device__ __forceinline__ unsigned xb_add(unsigned* p, unsigned v) { return __hip_atomic_fetch_add(p, v, __ATOMIC_RELAXED, __HIP_MEMORY_SCOPE_AGENT); }
__device__ __forceinline__ unsigned xb_xcc_id() { return (unsigned)__builtin_amdgcn_s_getreg((3 << 11) | 20) & 0xFu; }
#define XB_SPIN(cond, bar) do { unsigned _sp = 0; while (cond) { __builtin_amdgcn_s_sleep(1); \
    if ((++_sp & 255u) == 0u) { if (xb_ld(&(bar)[XB_TMO])) break; if (_sp > XB_SPIN_CAP) { atomicAdd(&(bar)[XB_TMO], 1u); break; } } } } while (0)
struct XcdBarrier { unsigned* bar; unsigned x; volatile LAS unsigned* st; };
__device__ __forceinline__ XcdBarrier xcd_barrier_post(unsigned* bar, volatile LAS unsigned* st) {
    XcdBarrier b; b.bar = bar; b.x = xb_xcc_id(); b.st = st;
    if (threadIdx.x == 0) (void)xb_add(&bar[XB_XCNT(b.x)], 1u);
    return b;
}
__device__ __forceinline__ void xcd_barrier_complete(unsigned* bar, unsigned x, unsigned& nloc, unsigned& nx) {
    const unsigned G = gridDim.x * gridDim.y * gridDim.z;
    unsigned sum, cnt, mine, sp = 0u;
    for (;;) {
        sum = 0u; cnt = 0u; mine = 0u;
#pragma unroll
        for (unsigned j = 0; j < 16; ++j) { const unsigned c = xb_ld(&bar[XB_XCNT(j)]); sum += c; cnt += (c > 0u) ? 1u : 0u; mine = (j == x) ? c : mine; }
        if (sum == G) break;
        __builtin_amdgcn_s_sleep(1);
        if ((++sp & 255u) == 0u) { if (xb_ld(&bar[XB_TMO])) break; if (sp > XB_SPIN_CAP) { atomicAdd(&bar[XB_TMO], 1u); break; } }
    }
    nloc = mine > 0u ? mine : 1u; nx = cnt > 0u ? cnt : 1u;
}
__device__ __forceinline__ void xcd_barrier(const XcdBarrier& b) {
    asm volatile("s_waitcnt vmcnt(0)" ::: "memory");
    __syncthreads();
    if (threadIdx.x == 0) {
        unsigned* bar = b.bar;
        __builtin_amdgcn_s_waitcnt(0);
        unsigned nloc = b.st[0], nx = b.st[1];
        if (nloc == 0u) { xcd_barrier_complete(bar, b.x, nloc, nx); b.st[0] = nloc; b.st[1] = nx; }
        const unsigned old = xb_add(&bar[XB_XSUB(b.x)], 1u);
        const unsigned gen = old / nloc;
        if (old + 1u == (gen + 1u) * nloc) {
            __builtin_amdgcn_fence(__ATOMIC_RELEASE, "agent");
            asm volatile("s_waitcnt vmcnt(0)" ::: "memory");
            const unsigned og = xb_add(&bar[XB_TOP], 1u);
            const unsigned tg = og / nx;
            if (og + 1u == (tg + 1u) * nx) xb_add(&bar[XB_TOPGEN], 1u);
            else XB_SPIN(xb_ld(&bar[XB_TOPGEN]) == tg, bar);
            __builtin_amdgcn_fence(__ATOMIC_ACQUIRE, "agent");
            xb_add(&bar[XB_XGEN(b.x)], 1u);
            asm volatile("s_waitcnt vmcnt(0)" ::: "memory");
        } else {
            XB_SPIN(xb_ld(&bar[XB_XGEN(b.x)]) == gen, bar);
            __builtin_amdgcn_fence(__ATOMIC_ACQUIRE, "agent");
            asm volatile("s_waitcnt vmcnt(0)" ::: "memory");
        }
    }
    __syncthreads();
}


constexpr size_t al256(size_t x) { return (x + 255) & ~(size_t)255; }
constexpr size_t TS_ = (size_t)T * 512 * 4;
constexpr int YLD = D + 64;
constexpr size_t OFF_BAR = 0;
constexpr size_t OFF_Z = al256(OFF_BAR + 3456 * 4);
constexpr size_t OFF_RS = OFF_Z + al256((size_t)T * ZLD * 2);
constexpr size_t OFF_XB = al256(OFF_RS + (size_t)8 * T * 384 * 4);
constexpr size_t OFF_REGM = al256(OFF_XB + (size_t)T * D * 2);
constexpr size_t OFF_KH = OFF_REGM, OFF_KG = OFF_KH + (size_t)T * 512 * 2, OFF_VTH = OFF_KG + (size_t)T * 256 * 2, OFF_VTG = OFF_VTH + (size_t)512 * T * 2, OFF_VT = OFF_VTG + (size_t)512 * T * 2;
constexpr size_t OFF_RGATE = OFF_VT + (size_t)512 * T * 2, OFF_RBONUS = OFF_RGATE + TS_;
constexpr size_t OFF_SENDH = OFF_RBONUS + TS_, OFF_SENDG = OFF_SENDH + (size_t)NCHK * 4 * 128 * 128 * 4, OFF_SSTH = OFF_SENDG + (size_t)NCHK * 4 * 128 * 64 * 4, OFF_SSTG = OFF_SSTH + (size_t)NCHK * 4 * 128 * 128 * 2;
constexpr size_t OFF_GAMH = OFF_SSTG + (size_t)NCHK * 4 * 128 * 64 * 2, OFF_GAMG = OFF_GAMH + (size_t)NCHK * 4 * 128 * 4, OFF_REGM_END = OFF_GAMG + (size_t)NCHK * 4 * 64 * 4;
constexpr size_t OFF_HBUF = OFF_REGM, OFF_X1 = OFF_REGM + (size_t)MAXROWS * FW * 2;
constexpr size_t OFF_OR = al256(OFF_REGM + (size_t)MAXROWS * FW * 2 + (size_t)T * D * 4);
constexpr size_t OFF_OH = OFF_OR + TS_, OFF_OG = OFF_OH + TS_, OFF_CR = OFF_OG + TS_, OFF_CH = OFF_CR + TS_ / 2, OFF_CG = OFF_CH + TS_ / 2;
constexpr size_t OFF_SENDR = OFF_CG + TS_ / 4, OFF_PENDR = OFF_SENDR + (size_t)NSEG * 8 * 64 * 64 * 4, OFF_SSTR = OFF_PENDR + (size_t)NSEG * 8 * 64 * 64 * 4;
constexpr size_t OFF_BO = al256(OFF_SSTR + (size_t)NSEG * 8 * 64 * 64 * 2);
constexpr size_t OFF_MERGED = OFF_BO + 4 * (size_t)T * 512 * 2, OFF_MERGEDB = OFF_MERGED + (size_t)T * D * 4, OFF_X1B = OFF_MERGEDB + (size_t)T * D * 2;
constexpr size_t OFF_WINT = OFF_X1B + (size_t)T * D * 2, OFF_WGUT = OFF_WINT + (size_t)ZLD * D * 2, OFF_WDT = OFF_WGUT + (size_t)65 * 1024 * D * 2, OFF_WBRT = OFF_WDT + (size_t)65 * D * FW * 2, OFF_WOUTT = OFF_WBRT + (size_t)4 * D * FW * 2;
constexpr size_t OFF_IDX = OFF_WOUTT + (size_t)D * D * 2, OFF_WSEL = OFF_IDX + (size_t)T * 8 * 4, OFF_HIST = OFF_WSEL + (size_t)T * 8 * 4, OFF_ROWTOK = OFF_HIST + 256 * 64 * 4;
constexpr size_t OFF_ROWW = OFF_ROWTOK + (size_t)MAXROWS * 4, OFF_SLOTPOS = OFF_ROWW + (size_t)MAXROWS * 4, OFF_PANEXP = OFF_SLOTPOS + (size_t)T * 8 * 4, OFF_NPAN = al256(OFF_PANEXP + MAXPANELS * 4);
constexpr size_t OFF_WRH = OFF_NPAN + 256, OFF_WRL = OFF_WRH + (size_t)2 * NE * D * 2;
constexpr size_t OFF_W2T = OFF_WRL + (size_t)2 * NE * D * 2, OFF_A2T = OFF_W2T + (size_t)2 * 512 * 32 * 2, OFF_G2T = OFF_A2T + (size_t)2 * 512 * 32 * 2, OFF_GGT = OFF_G2T + (size_t)2 * 512 * 96 * 2;
constexpr size_t WS_NEEDED = OFF_GGT + (size_t)2 * 256 * 32 * 2;
static_assert(OFF_RS + (size_t)8 * T * 384 * 4 - OFF_Z >= (size_t)MAXROWS * YLD * 2, "ybuf must fit in region Y");
static_assert(OFF_REGM_END <= OFF_OR, "region M");
static_assert(OFF_VTG == OFF_VTH + (size_t)512 * T * 2 && OFF_VT == OFF_VTG + (size_t)512 * T * 2, "prep writes VtH, VtG, Vt as one array of three");
__device__ __forceinline__ void ln_row(const float (&v)[32], float s, const float* __restrict__ w, const float* __restrict__ b, float* __restrict__ outf, bf16_t* __restrict__ outb, int lane) {
    const float mu = wave_sum(s) * (1.0f / D);
    float q = 0.f;
#pragma unroll
    for (int i = 0; i < 32; ++i) { const float d = v[i] - mu; q += d * d; }
    const float rstd = rsqrtf(wave_sum(q) * (1.0f / D) + 1e-5f);
    float4 wv_[8], bv_[8];
#pragma unroll
    for (int i = 0; i < 8; ++i) { const unsigned c = (unsigned)(i * 256 + lane * 4); wv_[i] = *(const float4*)(w + c); bv_[i] = *(const float4*)(b + c); }
#pragma unroll
    for (int i = 0; i < 8; ++i) {
        const unsigned c = (unsigned)(i * 256 + lane * 4);
        const float4 ww = wv_[i], bb = bv_[i];
        float4 o; o.x = (v[4 * i] - mu) * rstd * ww.x + bb.x; o.y = (v[4 * i + 1] - mu) * rstd * ww.y + bb.y; o.z = (v[4 * i + 2] - mu) * rstd * ww.z + bb.z; o.w = (v[4 * i + 3] - mu) * rstd * ww.w + bb.w;
        *(float4*)(outf + c) = o;
        if (outb) { pg8::u32x2 pk; pk.x = pg8::cvt_pk_bf16(o.x, o.y); pk.y = pg8::cvt_pk_bf16(o.z, o.w); *(pg8::u32x2*)(outb + c) = pk; }
    }
}
struct KArgs {
    const float* in[32]; char* ws; float* out;
};
struct MegaArgs {
    MixArgs mix;
    const float *x_in, *w_in, *w_br, *w_out, *ln1_w, *ln1_b, *w_router, *router_bias, *we_gate, *we_up, *we_down, *ws_gate, *ws_up, *ws_down, *ln2_w, *ln2_b;
    bf16_t *xb, *WinT, *WguT, *WdT, *WbrT, *WoutT, *mergedb, *x1b, *hbuf, *ybuf, *WrH, *WrL;
    float *merged, *x1, *out;
    int* idx; float* wsel; int *hist, *row_tok; float* row_w; int *slotpos, *panel_expert, *npanels;
    unsigned* bar;
};
__host__ __device__ __forceinline__ MegaArgs make_args(const KArgs& k) {
    MegaArgs a; char* ws = k.ws;
    a.x_in = k.in[0]; a.w_in = k.in[1];
    a.mix.hg_lb_logits = k.in[2]; a.mix.hg_norm_w = k.in[3]; a.mix.rw_mu = k.in[4]; a.mix.rw_w0 = k.in[5]; a.mix.rw_w2 = k.in[6]; a.mix.rw_a0 = k.in[7]; a.mix.rw_a2 = k.in[8]; a.mix.rw_g2 = k.in[9];
    a.mix.rw_kk = k.in[10]; a.mix.rw_ka = k.in[11]; a.mix.rw_rk = k.in[12]; a.mix.rw_ln_w = k.in[13]; a.mix.rw_ln_b = k.in[14]; a.mix.gla_g2 = k.in[15]; a.mix.gla_gb = k.in[16]; a.mix.gla_norm_w = k.in[17];
    a.w_br = k.in[18]; a.w_out = k.in[19]; a.ln1_w = k.in[20]; a.ln1_b = k.in[21]; a.w_router = k.in[22]; a.router_bias = k.in[23]; a.we_gate = k.in[24]; a.we_up = k.in[25]; a.we_down = k.in[26];
    a.ws_gate = k.in[27]; a.ws_up = k.in[28]; a.ws_down = k.in[29]; a.ln2_w = k.in[30]; a.ln2_b = k.in[31];
    a.bar = (unsigned*)(ws + OFF_BAR);
    a.mix.z = (const bf16_t*)(ws + OFF_Z); a.mix.RS = (float*)(ws + OFF_RS); a.ybuf = (bf16_t*)(ws + OFF_Z); a.xb = (bf16_t*)(ws + OFF_XB);
    a.mix.KH = (bf16_t*)(ws + OFF_KH); a.mix.KG = (bf16_t*)(ws + OFF_KG); a.mix.VtH = (bf16_t*)(ws + OFF_VTH); a.mix.VtG = (bf16_t*)(ws + OFF_VTG); a.mix.Vt = (bf16_t*)(ws + OFF_VT); a.mix.rGate = (bf16_t*)(ws + OFF_RGATE); a.mix.rBonus = (bf16_t*)(ws + OFF_RBONUS);
    a.hbuf = (bf16_t*)(ws + OFF_HBUF); a.x1 = (float*)(ws + OFF_X1);
    a.mix.oR = (float*)(ws + OFF_OR); a.mix.oH = (float*)(ws + OFF_OH); a.mix.oG = (float*)(ws + OFF_OG); a.mix.cR = (bf16_t*)(ws + OFF_CR); a.mix.cH = (bf16_t*)(ws + OFF_CH); a.mix.cG = (bf16_t*)(ws + OFF_CG);
    a.mix.SendR = (float*)(ws + OFF_SENDR); a.mix.PendR = (float*)(ws + OFF_PENDR); a.mix.SendH = (float*)(ws + OFF_SENDH); a.mix.SendG = (float*)(ws + OFF_SENDG); a.mix.GamH = (float*)(ws + OFF_GAMH); a.mix.GamG = (float*)(ws + OFF_GAMG);
    a.mix.SstR = (bf16_t*)(ws + OFF_SSTR); a.mix.SstH = (bf16_t*)(ws + OFF_SSTH); a.mix.SstG = (bf16_t*)(ws + OFF_SSTG);
    a.mix.bo = (bf16_t*)(ws + OFF_BO); a.merged = (float*)(ws + OFF_MERGED); a.mergedb = (bf16_t*)(ws + OFF_MERGEDB); a.x1b = (bf16_t*)(ws + OFF_X1B); a.out = k.out;
    a.WinT = (bf16_t*)(ws + OFF_WINT); a.WguT = (bf16_t*)(ws + OFF_WGUT); a.WdT = (bf16_t*)(ws + OFF_WDT); a.WbrT = (bf16_t*)(ws + OFF_WBRT); a.WoutT = (bf16_t*)(ws + OFF_WOUTT);
    a.idx = (int*)(ws + OFF_IDX); a.wsel = (float*)(ws + OFF_WSEL); a.hist = (int*)(ws + OFF_HIST); a.row_tok = (int*)(ws + OFF_ROWTOK); a.row_w = (float*)(ws + OFF_ROWW);
    a.slotpos = (int*)(ws + OFF_SLOTPOS); a.panel_expert = (int*)(ws + OFF_PANEXP); a.npanels = (int*)(ws + OFF_NPAN);
    a.WrH = (bf16_t*)(ws + OFF_WRH); a.WrL = (bf16_t*)(ws + OFF_WRL);
    a.mix.W2T = (const bf16_t*)(ws + OFF_W2T); a.mix.A2T = (const bf16_t*)(ws + OFF_A2T); a.mix.G2T = (const bf16_t*)(ws + OFF_G2T); a.mix.GGT = (const bf16_t*)(ws + OFF_GGT);
    a.mix.LW = (float*)(ws + OFF_MERGED); a.mix.LA = a.mix.LW + (size_t)T * 512; a.mix.LG = a.mix.LA + (size_t)T * 512; a.mix.LL = a.mix.LG + (size_t)T * 512;
    a.mix.layer = 0; a.mix.pad_ = 0;
    return a;
}
__device__ __forceinline__ void ln_router_phase(const MegaArgs& a, int L, LAS unsigned char* ldsraw) {
    LAS int* hs = (LAS int*)ldsraw;
    const int tid = phase_tid(), lane = tid & 63, wv = __builtin_amdgcn_readfirstlane(tid >> 6);
    const bf16_t* pre = (const bf16_t*)a.merged; const float* wr = a.w_router + (size_t)L * D * NE;
    const float bias = a.router_bias[L * NE + lane];
    for (int vb = blockIdx.x; vb < 256; vb += gridDim.x) {
        __syncthreads();
        if (tid < 64) hs[tid] = 0;
        pg8::u32x2 raw[8];
#pragma unroll
        for (int j = 0; j < 8; ++j) raw[j] = *(const pg8::u32x2*)(pre + ((size_t)vb * 64 + wv * 8) * D + j * 256 + lane * 4);
        for (int i = 0; i < 8; ++i) {
            const size_t row = (size_t)vb * 64 + wv * 8 + i;
            float v[32]; float s = 0.f;
#pragma unroll
            for (int j = 0; j < 8; ++j) { const pg8::u32x2 xx = raw[j]; float4 x; x.x = __uint_as_float(xx.x << 16); x.y = __uint_as_float(xx.x & 0xffff0000u); x.z = __uint_as_float(xx.y << 16); x.w = __uint_as_float(xx.y & 0xffff0000u);
                v[4 * j] = x.x; v[4 * j + 1] = x.y; v[4 * j + 2] = x.z; v[4 * j + 3] = x.w; s += (x.x + x.y) + (x.z + x.w); }
            { const size_t rown = (i < 7) ? row + 1 : row;
#pragma unroll
              for (int j = 0; j < 8; ++j) raw[j] = *(const pg8::u32x2*)(pre + rown * D + j * 256 + lane * 4); }
            ln_row(v, s, a.ln1_w + L * D, a.ln1_b + L * D, a.x1 + row * D, a.x1b + row * D, lane);
        }
        asm volatile("s_waitcnt vmcnt(0)" ::: "memory");
        __syncthreads();
        {
            typedef short bf16x8v __attribute__((ext_vector_type(8)));
            typedef __bf16 bf16x2n __attribute__((ext_vector_type(2)));
            const int tile = wv >> 1, khalf = wv & 1, r = lane & 15, q = lane >> 4;
            const float* xrow = a.x1 + (size_t)(vb * 64 + tile * 16 + r) * D + khalf * 1024 + q * 8;
            const bf16_t* bh = a.WrH + (size_t)L * NE * D + (size_t)r * D + khalf * 1024 + q * 8; const bf16_t* bl = a.WrL + (size_t)L * NE * D + (size_t)r * D + khalf * 1024 + q * 8;
            f32x4v acc[4];
#pragma unroll
            for (int nb = 0; nb < 4; ++nb) acc[nb] = (f32x4v){0.f, 0.f, 0.f, 0.f};
#pragma unroll 2
            for (int ks = 0; ks < 32; ++ks) {
                const float4 x0 = *(const float4*)(xrow + ks * 32), x1v = *(const float4*)(xrow + ks * 32 + 4);
                const float xs[8] = {x0.x, x0.y, x0.z, x0.w, x1v.x, x1v.y, x1v.z, x1v.w};
                union { bf16x2n h2[4]; bf16x8v v; } ah, al;
#pragma unroll
                for (int j = 0; j < 4; ++j) { f32x2v f; f.x = xs[2 * j]; f.y = xs[2 * j + 1]; const bf16x2n hh = __builtin_convertvector(f, bf16x2n); ah.h2[j] = hh;
                    const f32x2v back = __builtin_convertvector(hh, f32x2v); al.h2[j] = __builtin_convertvector(f - back, bf16x2n); }
#pragma unroll
                for (int nb = 0; nb < 4; ++nb) { const bf16x8v Bh = *(const bf16x8v*)(bh + (size_t)nb * 16 * D + ks * 32), Bl = *(const bf16x8v*)(bl + (size_t)nb * 16 * D + ks * 32);
                    acc[nb] = __builtin_amdgcn_mfma_f32_16x16x32_bf16(ah.v, Bh, acc[nb], 0, 0, 0);
                    acc[nb] = __builtin_amdgcn_mfma_f32_16x16x32_bf16(al.v, Bh, acc[nb], 0, 0, 0);
                    acc[nb] = __builtin_amdgcn_mfma_f32_16x16x32_bf16(ah.v, Bl, acc[nb], 0, 0, 0); }
            }
            LAS float* lg = (LAS float*)(ldsraw + 1024) + (size_t)((tile * 2 + khalf) * 16) * 64;
#pragma unroll
            for (int nb = 0; nb < 4; ++nb)
#pragma unroll
                for (int i = 0; i < 4; ++i) lg[(4 * q + i) * 64 + nb * 16 + r] = acc[nb][i];
        }
        __syncthreads();
        for (int it = 0; it < 8; ++it) {
            {
                const int tk = wv * 8 + it, t = vb * 64 + tk;
                const LAS float* lg = (const LAS float*)(ldsraw + 1024) + (size_t)(((tk >> 4) * 2) * 16 + (tk & 15)) * 64;
                const float logit = lg[lane] + lg[16 * 64 + lane];
                const float score = sigmoidf_(logit);
                const float biased = score + bias;
                float m1 = biased;
                m1 = fmaxf(m1, __shfl_xor(m1, 1)); m1 = fmaxf(m1, __shfl_xor(m1, 2)); m1 = fmaxf(m1, __shfl_xor(m1, 4));
                int am = (biased == m1) ? lane : 64;
                am = min(am, __shfl_xor(am, 1)); am = min(am, __shfl_xor(am, 2)); am = min(am, __shfl_xor(am, 4));
                float m2 = (lane == am) ? -INFINITY : biased;
                m2 = fmaxf(m2, __shfl_xor(m2, 1)); m2 = fmaxf(m2, __shfl_xor(m2, 2)); m2 = fmaxf(m2, __shfl_xor(m2, 4));
                const float gs = m1 + m2;
                const int g = lane >> 3;
                int grank = 0;
#pragma unroll
                for (int g2 = 0; g2 < 8; ++g2) { const float o = __shfl(gs, g2 * 8); grank += (o > gs || (o == gs && g2 < g)) ? 1 : 0; }
                const float masked = (grank < 4) ? biased : -INFINITY;
                int rank = 0;
                for (int e2 = 0; e2 < 64; ++e2) { const float o = rdlane(masked, e2); rank += (o > masked || (o == masked && e2 < lane)) ? 1 : 0; }
                const bool sel = rank < 8;
                const float ssum = wave_sum(sel ? score : 0.f);
                if (sel) { a.idx[(size_t)t * 8 + rank] = lane; a.wsel[(size_t)t * 8 + rank] = 2.5f * score / ssum; atomicAdd((int*)&hs[lane], 1); }
            }
        }
        __syncthreads();
        if (tid < 64) a.hist[vb * 64 + tid] = hs[tid];
    }
}
__device__ __forceinline__ void dispatch_phase(const MegaArgs& a, LAS unsigned char* ldsraw) {
    LAS int* tot = (LAS int*)ldsraw; LAS int* bef = tot + 64; LAS int* pstart = tot + 128; LAS int* es = tot + 192; LAS int* np_s = tot + 704; LAS int* ptot = tot + 768; LAS int* pbef = tot + 1280;
    const int tid = phase_tid();
    for (int blk = blockIdx.x; blk < 256; blk += gridDim.x) {
        __syncthreads();
        { const int part = tid >> 6, e = tid & 63; int b = 0, sm = 0;
#pragma unroll 8
          for (int j = part * 32; j < part * 32 + 32; ++j) { const int cc = a.hist[j * 64 + e]; if (j < blk) b += cc; sm += cc; }
          ptot[tid] = sm; pbef[tid] = b; }
        __syncthreads();
        if (tid < 64) { int sm = 0, b = 0;
#pragma unroll
            for (int pp = 0; pp < 8; ++pp) { sm += ptot[pp * 64 + tid]; b += pbef[pp * 64 + tid]; }
            tot[tid] = sm; bef[tid] = b; }
        __syncthreads();
        if (tid == 0) { int acc = 0; for (int e = 0; e < 64; ++e) { pstart[e] = acc; acc += (tot[e] + 255) / 256 * 256; } np_s[0] = acc / 256; }
        const int t = blk * 64 + (tid >> 3), k = tid & 7;
        const int e = a.idx[(size_t)t * 8 + k];
        es[tid] = e;
        __syncthreads();
        int rank = 0;
        for (int j = 0; j < tid; ++j) rank += (es[j] == e) ? 1 : 0;
        const int pos = pstart[e] + bef[e] + rank;
        a.row_tok[pos] = t; a.row_w[pos] = a.wsel[(size_t)t * 8 + k]; a.slotpos[(size_t)t * 8 + k] = pos;
        const int NP = np_s[0];
        if (blk < 64) {
            const int ee = blk, st = pstart[ee], cnt = tot[ee], pad = (cnt + 255) / 256 * 256;
            for (int r = st + cnt + tid; r < st + pad; r += 512) { a.row_tok[r] = 0; a.row_w[r] = 0.f; }
            for (int pp = st / 256 + tid; pp < (st + pad) / 256; pp += 512) a.panel_expert[pp] = ee;
        }
        if (tid < 64) { const int tt = blk * 64 + tid; a.row_tok[NP * 256 + tt] = tt; a.row_w[NP * 256 + tt] = 1.0f; }
        if (blk == 0) { if (tid < 64) a.panel_expert[NP + tid] = 64; if (tid == 0) a.npanels[0] = NP + 64; }
    }
}
__device__ __forceinline__ void combine_phase(const MegaArgs& a, int L, LAS unsigned char* ldsraw) {
    const int ptid = phase_tid(); const int lane = ptid & 63, wv = ptid >> 6, pair = wv >> 1, half = wv & 1;
    LAS float* part = (LAS float*)ldsraw;
    const unsigned shared_base = (unsigned)(a.npanels[0] - 64) * 256u;
    const float* lw = a.ln2_w + L * D; const float* lbp = a.ln2_b + L * D;
    int it = 0;
    int spn[8]; float wkn[8];
    { const unsigned tf = (unsigned)(blockIdx.x * 4 + pair);
#pragma unroll
      for (int k = 0; k < 8; ++k) { spn[k] = 0; wkn[k] = 0.f; if (tf < (unsigned)T) { spn[k] = a.slotpos[tf * 8 + k]; wkn[k] = a.wsel[tf * 8 + k]; } } }
    for (int t0 = blockIdx.x * 4; t0 < T; t0 += gridDim.x * 4, ++it) {
        const unsigned t = (unsigned)(t0 + pair);
        unsigned rows[9];
#pragma unroll
        for (int k = 0; k < 8; ++k) rows[k] = (unsigned)spn[k] * (unsigned)YLD;
        rows[8] = (shared_base + t) * (unsigned)YLD;
        float wk[9];
#pragma unroll
        for (int k = 0; k < 8; ++k) wk[k] = wkn[k];
        wk[8] = 1.0f;
        { const unsigned tn = t + (unsigned)gridDim.x * 4u; const unsigned tc = tn < (unsigned)T ? tn : t;
#pragma unroll
          for (int k = 0; k < 8; ++k) { spn[k] = a.slotpos[tc * 8 + k]; wkn[k] = a.wsel[tc * 8 + k]; } }
        float4 wv_[4], bv_[4];
#pragma unroll
        for (int i = 0; i < 4; ++i) { const unsigned c = (unsigned)(half * 1024 + i * 256 + lane * 4); wv_[i] = *(const float4*)(lw + c); bv_[i] = *(const float4*)(lbp + c); }
        float v[16]; float s1 = 0.f, s2 = 0.f;
#pragma unroll
        for (int i = 0; i < 4; ++i) {
            const unsigned c = (unsigned)(half * 1024 + i * 256 + lane * 4);
            float4 x; { const pg8::u32x2 xx = *(const pg8::u32x2*)(a.x1b + t * (unsigned)D + c); x.x = __uint_as_float(xx.x << 16); x.y = __uint_as_float(xx.x & 0xffff0000u); x.z = __uint_as_float(xx.y << 16); x.w = __uint_as_float(xx.y & 0xffff0000u); }
            float a0 = 0.f, a1 = 0.f, a2 = 0.f, a3 = 0.f;
#pragma unroll
            for (int k = 0; k < 9; ++k) { const uint2 u = *(const uint2*)(a.ybuf + (rows[k] + c));
                a0 += wk[k] * __uint_as_float(u.x << 16); a1 += wk[k] * __uint_as_float(u.x & 0xffff0000u); a2 += wk[k] * __uint_as_float(u.y << 16); a3 += wk[k] * __uint_as_float(u.y & 0xffff0000u); }
            v[4 * i] = ALPHA * x.x + a0; v[4 * i + 1] = ALPHA * x.y + a1; v[4 * i + 2] = ALPHA * x.z + a2; v[4 * i + 3] = ALPHA * x.w + a3;
#pragma unroll
            for (int j = 0; j < 4; ++j) { s1 += v[4 * i + j]; s2 += v[4 * i + j] * v[4 * i + j]; }
            if (i & 1) asm volatile("" ::: "memory");
        }
        s1 = wave_sum(s1); s2 = wave_sum(s2);
        LAS float* slot = part + (((it & 1) * 4 + pair) * 2) * 2;
        if (lane == 0) { slot[half * 2] = s1; slot[half * 2 + 1] = s2; }
        __syncthreads();
        const float S1 = slot[0] + slot[2], S2 = slot[1] + slot[3];
        const float mu = S1 * (1.0f / D);
        const float rstd = rsqrtf(fmaxf(S2 * (1.0f / D) - mu * mu, 0.f) + 1e-5f);
        float* outf = a.out + t * (unsigned)D; bf16_t* outb = a.xb + t * (unsigned)D;
#pragma unroll
        for (int i = 0; i < 4; ++i) {
            const unsigned c = (unsigned)(half * 1024 + i * 256 + lane * 4);
            const float4 ww = wv_[i], bb = bv_[i];
            float4 o; o.x = (v[4 * i] - mu) * rstd * ww.x + bb.x; o.y = (v[4 * i + 1] - mu) * rstd * ww.y + bb.y; o.z = (v[4 * i + 2] - mu) * rstd * ww.z + bb.z; o.w = (v[4 * i + 3] - mu) * rstd * ww.w + bb.w;
            *(float4*)(outf + c) = o;
            if (L == 0) { pg8::u32x2 pk; pk.x = pg8::cvt_pk_bf16(o.x, o.y); pk.y = pg8::cvt_pk_bf16(o.z, o.w); *(pg8::u32x2*)(outb + c) = pk; }
        }
    }
}

constexpr int NPHASE = 13;
constexpr int LDS_GEMM = pg8::STAGE_BYTES + pg8::GTAB_BYTES;
constexpr int LDS_BARW = LDS_GEMM;
constexpr int LDS_PETAB = LDS_GEMM + 64;
constexpr int LDS_ARGS = LDS_GEMM + 16;
constexpr int LDS_BYTES = LDS_GEMM + 512;
__device__ __forceinline__ void args_to_lds(const KArgs& ka, LAS unsigned char* lds) {
    const int t = (int)threadIdx.x;
    if (t < 34) { const unsigned long long v = (t < 32) ? (unsigned long long)ka.in[t] : (t == 32 ? (unsigned long long)ka.ws : (unsigned long long)ka.out);
        *(LAS unsigned long long*)(lds + LDS_ARGS + t * 8) = v; }
}
__device__ __forceinline__ unsigned long long lds_ptr_load(LAS unsigned char* lds, int i) {
    const LAS unsigned* p = (const LAS unsigned*)(lds + LDS_ARGS + i * 8);
    const unsigned lo = (unsigned)__builtin_amdgcn_readfirstlane((int)p[0]), hi = (unsigned)__builtin_amdgcn_readfirstlane((int)p[1]);
    return ((unsigned long long)hi << 32) | lo;
}
template <int PH> __device__ __forceinline__ void run_phase(const KArgs& kin, const int Lp, LAS unsigned char* lds_in) {
    const int L = Lp & 15, part = Lp >> 4;
    LAS unsigned char* lds = lds_in; asm volatile("" : "+s"(lds));
    size_t z0 = 0; asm volatile("" : "+s"(z0));
    KArgs ka;
#pragma unroll
    for (int i = 0; i < 32; ++i) ka.in[i] = (const float*)((const char*)kin.in[i] + z0);
    ka.ws = kin.ws + z0; ka.out = (float*)((char*)kin.out + z0);
    const MegaArgs a = make_args(ka);
    int G = (int)gridDim.x, c = (int)blockIdx.x; asm volatile("" : "+s"(G), "+s"(c));
    if constexpr (PH == 0) {
        if (L == 0) { const size_t n4 = (size_t)T * D / 4; const int ptid = phase_tid(); for (size_t i = (size_t)c * 512 + ptid; i < n4; i += (size_t)G * 512) { const float4 v = *(const float4*)(a.x_in + 4 * i);
            pg8::u32x2 pk; pk.x = pg8::cvt_pk_bf16(v.x, v.y); pk.y = pg8::cvt_pk_bf16(v.z, v.w); *(pg8::u32x2*)(a.xb + 4 * i) = pk; } }
        ConvArgs ca; ca.w_in = a.w_in; ca.we_gate = a.we_gate; ca.we_up = a.we_up; ca.we_down = a.we_down; ca.ws_gate = a.ws_gate; ca.ws_up = a.ws_up; ca.ws_down = a.ws_down; ca.w_br = a.w_br; ca.w_out = a.w_out;
        ca.WinT = a.WinT; ca.WguT = a.WguT; ca.WdT = a.WdT; ca.WbrT = a.WbrT; ca.WoutT = a.WoutT; ca.layer = L; ca.pad_ = 0;
        if (L == 0) convert_tiles(ca, 0, CV_SEG0, c, G, (LAS float (*)[65])lds);
        if (L == 0) { const int pt3 = phase_tid(); bf16_t* w2t = (bf16_t*)a.mix.W2T; bf16_t* a2t = (bf16_t*)a.mix.A2T; bf16_t* g2t = (bf16_t*)a.mix.G2T; bf16_t* ggt = (bf16_t*)a.mix.GGT;
          for (int i = c * 512 + pt3; i < 2 * 512 * 32; i += G * 512) { const int l2 = i >> 14, ch = (i >> 5) & 511, k = i & 31;
              w2t[i] = f2bf(a.mix.rw_w2[((size_t)l2 * 32 + k) * 512 + ch]); a2t[i] = f2bf(a.mix.rw_a2[((size_t)l2 * 32 + k) * 512 + ch]); }
          for (int i = c * 512 + pt3; i < 2 * 512 * 96; i += G * 512) { const int l2 = i / (512 * 96), rem = i - l2 * 512 * 96, ch = rem / 96, k = rem - ch * 96;
              g2t[i] = f2bf(a.mix.rw_g2[((size_t)l2 * 96 + k) * 512 + ch]); }
          for (int i = c * 512 + pt3; i < 2 * 256 * 32; i += G * 512) { const int l2 = i >> 13, ch = (i >> 5) & 255, k = i & 31;
              ggt[i] = (k < 16) ? f2bf(a.mix.gla_g2[((size_t)l2 * 16 + k) * 256 + ch]) : (bf16_t)0; } }
        if (L == 0) { const int ptid2 = phase_tid();
          for (int i = c * 512 + ptid2; i < 2 * NE * D; i += G * 512) { const int l2 = i >> 17, n = (i >> 11) & 63, k = i & 2047; const float v = a.w_router[(size_t)l2 * D * NE + (size_t)k * NE + n];
              const bf16_t hi = f2bf(v); a.WrH[i] = hi; a.WrL[i] = f2bf(v - bf2f(hi)); } }
    } else if constexpr (PH == 1) {
        pg8::StaticOrder S; S.init(a.xb, a.WinT, T, ZLD, D, G, c);
        pg8::EpiZ16 E; E.O = (bf16_t*)a.mix.z; E.ldc = ZLD; E.pad_ = 0;
        pg8::gemm_phase<pg8::EpiZ16, pg8::StaticOrder, false>(lds, D, S, E);
    } else if constexpr (PH == 2) { MixArgs m = a.mix; m.layer = L; prep_phase(m, lds);
    } else if constexpr (PH == 3) { MixArgs m = a.mix; m.layer = L;
        ConvArgs ca; ca.w_in = a.w_in; ca.we_gate = a.we_gate; ca.we_up = a.we_up; ca.we_down = a.we_down; ca.ws_gate = a.ws_gate; ca.ws_up = a.ws_up; ca.ws_down = a.ws_down; ca.w_br = a.w_br; ca.w_out = a.w_out;
        ca.WinT = a.WinT; ca.WguT = a.WguT; ca.WdT = a.WdT; ca.WbrT = a.WbrT; ca.WoutT = a.WoutT; ca.layer = L; ca.pad_ = 0;
        chains_phase(m, ca, a.bar + 8 + L, lds);
    } else if constexpr (PH == 4) { MixArgs m = a.mix; m.layer = L;
        carry_phase(m, lds, part);
        if (part == 0 && (c >= 32 || G <= 32)) sb_queue(m, a.bar + 12 + L, lds);
    } else if constexpr (PH == 5) { MixArgs m = a.mix; m.layer = L; mixfin_phase(m);
    } else if constexpr (PH == 6) {
        pg8::GateOrder S; S.init(a.mix.bo, a.WbrT, G, c);
        pg8::EpiGateAcc E; E.zg0 = a.mix.z + GATE0; E.mergedb = a.mergedb;
        pg8::gemm_phase<pg8::EpiGateAcc, pg8::GateOrder, false>(lds, FW, S, E);
    } else if constexpr (PH == 7) {
        pg8::StaticOrder S; S.init(a.mergedb, a.WoutT, T, D, D, G, c);
        pg8::EpiResid E; E.xin = (L == 0) ? a.x_in : a.out; E.pre = (bf16_t*)a.merged;
        pg8::gemm_phase<pg8::EpiResid, pg8::StaticOrder, false>(lds, D, S, E);
    } else if constexpr (PH == 8) { ln_router_phase(a, L, lds);
    } else if constexpr (PH == 9) { dispatch_phase(a, lds);
    } else if constexpr (PH == 10) {
        LAS int* petab = (LAS int*)(lds + LDS_PETAB); const int npan = a.npanels[0];
        pg8::MoeOrder::fill_table(petab, a.panel_expert, npan, 4, G, c, phase_tid());
        pg8::MoeOrder S; S.init(a.x1b, a.WguT, (size_t)1024 * D, petab, a.row_tok, npan, 4, D, G, c);
        pg8::EpiSwi E; E.h = a.hbuf;
        pg8::gemm_phase<pg8::EpiSwi, pg8::MoeOrder, true>(lds, D, S, E);
    } else if constexpr (PH == 11) {
        LAS int* petab = (LAS int*)(lds + LDS_PETAB); const int npan = a.npanels[0];
        pg8::MoeOrder::fill_table(petab, a.panel_expert, npan, 8, G, c, phase_tid());
        pg8::MoeOrder S; S.init(a.hbuf, a.WdT, (size_t)D * FW, petab, nullptr, npan, 8, FW, G, c);
        pg8::EpiDownW E; E.y = a.ybuf; E.ld = YLD; E.pad_ = 0;
        pg8::gemm_phase<pg8::EpiDownW, pg8::MoeOrder, false>(lds, FW, S, E);
    } else { combine_phase(a, L, lds); }
}
#ifndef MK_MULTI
#define MK_MULTI 0
#endif
#ifndef MK_PART
#define MK_PART 0
#endif
#ifndef MK_DBL
#define MK_DBL 0
#endif
#if MK_MULTI
template <int PH> __global__ __launch_bounds__(512, 2) void k_one(KArgs a, int L, int pad_) {
    extern __shared__ __attribute__((aligned(16))) unsigned char shm[];
    run_phase<PH>(a, L, (LAS unsigned char*)shm);
}
#else
__device__ __forceinline__ void run_layer(const KArgs& a, const int L, LAS unsigned char* lds, const XcdBarrier& bar) {
#define MK_RUN(PH) do { run_phase<PH>(a, L, lds); xcd_barrier(bar); if ((MK_DBL >> PH) & 1) { run_phase<PH>(a, L | (MK_PART << 4), lds); xcd_barrier(bar); } } while (0)
    if (L == 0) { MK_RUN(0); }
    MK_RUN(1); MK_RUN(2); MK_RUN(3); MK_RUN(4); MK_RUN(5); MK_RUN(6); MK_RUN(7); MK_RUN(8); MK_RUN(9); MK_RUN(10); MK_RUN(11); MK_RUN(12);
#undef MK_RUN
}
__global__ __launch_bounds__(512, 2) void k_mega(KArgs a) {
    extern __shared__ __attribute__((aligned(16))) unsigned char shm[];
    LAS unsigned char* lds = (LAS unsigned char*)shm;
    if (threadIdx.x < 4) ((LAS unsigned*)(lds + LDS_BARW))[threadIdx.x] = 0u;
    __syncthreads();
    const XcdBarrier bar = xcd_barrier_post((unsigned*)(a.ws + OFF_BAR), (volatile LAS unsigned*)(lds + LDS_BARW));
    run_layer(a, 0, lds, bar);
    run_layer(a, 1, lds, bar);
}
#endif

#if MK_MULTI
template <int PH> static void launch_one(const KArgs& a, int L, int grid, hipStream_t stream) {
    static bool attr = false; if (!attr) { (void)hipFuncSetAttribute((const void*)k_one<PH>, hipFuncAttributeMaxDynamicSharedMemorySize, LDS_BYTES); attr = true; }
    k_one<PH><<<grid, 512, LDS_BYTES, stream>>>(a, L, 0);
}
#endif
extern "C" void kernel_launch(void* const* d_in, const int* in_sizes, int n_in, void* d_out, int out_size, void* d_ws, size_t ws_size, hipStream_t stream) {
    KArgs a; memset(&a, 0, sizeof a);
    for (int i = 0; i < 32; ++i) a.in[i] = (const float*)d_in[i];
    a.ws = (char*)d_ws; a.out = (float*)d_out;
    if (WS_NEEDED > ws_size || n_in < 32) { fprintf(stderr, "workspace too small: need %zu MiB, have %zu MiB (n_in %d)\n", WS_NEEDED >> 20, ws_size >> 20, n_in); return; }

    static int grid = 0;
    if (!grid) { int dev = 0, cus = 0; (void)hipGetDevice(&dev); (void)hipDeviceGetAttribute(&cus, hipDeviceAttributeMultiprocessorCount, dev); grid = cus > 0 ? cus : 256; if (grid > 256) grid = 256; }
#if MK_MULTI
    for (int L = 0; L < 2; ++L) {
        launch_one<0>(a, L, grid, stream); launch_one<1>(a, L, grid, stream); launch_one<2>(a, L, grid, stream); launch_one<3>(a, L, grid, stream); launch_one<4>(a, L, grid, stream);
        launch_one<5>(a, L, grid, stream); launch_one<6>(a, L, grid, stream); launch_one<7>(a, L, grid, stream); launch_one<8>(a, L, grid, stream); launch_one<9>(a, L, grid, stream);
        launch_one<10>(a, L, grid, stream); launch_one<11>(a, L, grid, stream); launch_one<12>(a, L, grid, stream);
    }
#else
    static bool attr = false;
    if (!attr) {
        if (hipFuncSetAttribute((const void*)k_mega, hipFuncAttributeMaxDynamicSharedMemorySize, LDS_BYTES) != hipSuccess) { fprintf(stderr, "hipFuncSetAttribute failed\n"); return; }
        int per_cu = 0; (void)hipOccupancyMaxActiveBlocksPerMultiprocessor(&per_cu, (const void*)k_mega, 512, LDS_BYTES);
        if (per_cu < 1) fprintf(stderr, "occupancy query reports %d workgroups per CU\n", per_cu);
        attr = true;
    }
    (void)hipMemsetAsync(a.ws + OFF_BAR, 0, XCD_BAR_WORDS * sizeof(unsigned), stream);
    k_mega<<<grid, 512, LDS_BYTES, stream>>>(a);
#endif
}
```

```cpp
#include <hip/hip_runtime.h>
#include <stdint.h>
#include <stdio.h>
#include <string.h>

typedef unsigned short bf16_t;

constexpr int T = 16384, D = 2048, ZW = 15024, ZLD = 15104, NE = 64, FW = 512;
constexpr int HG_Q = 0, HG_F = 512, HG_I = 1024, HG_G = 1536;
constexpr int RW_R = 2048, RW_K = 2560, RW_V = 3072, RW_LW = 3584;
constexpr int SB_Q = 3744, SB_K = 4256, SB_V = 4768;
constexpr int GL_Q = 5280, GL_K = 5536, GL_V = 5792, GL_LG = 6304, GL_R = 6320;
constexpr int GATE0 = 6832;
constexpr float ALPHA = 1.4142135623730951f;
constexpr int MAXPANELS = 640;
constexpr int MAXROWS = MAXPANELS * 256;
constexpr int NSEG = 32, LSEG = T / NSEG;
constexpr int NCHK = T / 64;

__device__ __forceinline__ float bf2f(bf16_t v) { return __uint_as_float(((unsigned)v) << 16); }
__device__ __forceinline__ bf16_t f2bf(float f) { unsigned u = __float_as_uint(f); u += 0x7FFFu + ((u >> 16) & 1u); return (bf16_t)(u >> 16); }
__device__ __forceinline__ float sigmoidf_(float x) { return 1.0f / (1.0f + expf(-x)); }
__device__ __forceinline__ float softplusf_(float x) { return fmaxf(x, 0.f) + log1pf(expf(-fabsf(x))); }
__device__ __forceinline__ float siluf_(float x) { return x / (1.0f + expf(-x)); }
__device__ __forceinline__ float fsig(float x) { return __builtin_amdgcn_rcpf(1.0f + __expf(-x)); }
__device__ __forceinline__ float fsoftplus(float x) { return fmaxf(x, 0.f) + __logf(1.0f + __expf(-fabsf(x))); }

template <int CTRL> __device__ __forceinline__ float dppmov(float x) {
    return __builtin_bit_cast(float, __builtin_amdgcn_update_dpp(0, __builtin_bit_cast(int, x), CTRL, 0xF, 0xF, true));
}
__device__ __forceinline__ float rdlane(float x, int l) { return __builtin_bit_cast(float, __builtin_amdgcn_readlane(__builtin_bit_cast(int, x), l)); }
__device__ __forceinline__ int phase_tid() { int t = (int)threadIdx.x; asm volatile("" : "+v"(t)); return t & 511; }
__device__ __forceinline__ float wave_sum(float x) {
    x += dppmov<0xB1>(x);
    x += dppmov<0x4E>(x);
    x += dppmov<0x141>(x);
    x += dppmov<0x140>(x);
    return (rdlane(x, 0) + rdlane(x, 16)) + (rdlane(x, 32) + rdlane(x, 48));
}
#define LAS __attribute__((address_space(3)))
namespace pg8 {
typedef short bf16x8 __attribute__((ext_vector_type(8)));
typedef float f32x4 __attribute__((ext_vector_type(4)));
typedef unsigned u32x4 __attribute__((ext_vector_type(4)));
typedef unsigned u32x2 __attribute__((ext_vector_type(2)));
constexpr int BM = 256, BK = 64, HALF = 128, HTB = HALF * BK * 2, STAGE_BYTES = 8 * HTB, NXCD = 8, WGM = 8;
constexpr int GTAB_BYTES = 512 * 16;
__host__ __device__ __forceinline__ int lds_byte(int r, int c) { const int st = (r >> 4) * 2 + (c >> 5), rr = r & 15, cc = c & 31, ob = rr * 64 + cc * 2; return st * 1024 + (ob ^ (((ob >> 9) & 1) << 5)); }
__host__ __device__ __forceinline__ void stage_rc(int b, int& R, int& C) { const int st = b / 1024, sb = b % 1024, swz = sb ^ (((sb >> 9) & 1) << 5); R = (st >> 1) * 16 + swz / 64; C = (st & 1) * 32 + (swz % 64) / 2; }
__host__ __device__ __forceinline__ int perm32(int rho) { const int n = rho >> 4, i = rho & 15; return 8 * (i >> 2) + 4 * n + (i & 3); }
struct Unit { int pm, pn, e; };
__device__ __forceinline__ unsigned cvt_pk_bf16(float lo, float hi) { unsigned r; asm volatile("v_cvt_pk_bf16_f32 %0, %1, %2" : "=v"(r) : "v"(lo), "v"(hi)); return r; }

struct StaticOrder {
    const bf16_t* A; const bf16_t* Bt; int K; int nM, nN, nwg, G, c;
    __device__ void init(const bf16_t* A_, const bf16_t* Bt_, int M, int N, int K_, int G_, int c_) { A = A_; Bt = Bt_; K = K_; nM = M / BM; nN = N / BM; nwg = nM * nN; G = G_; c = c_; }
    __device__ bool next(int i, Unit& u) const {
        const int L = i * G + c; if (L >= nwg) return false;
        int wgid = L; { const int q = nwg / NXCD, r = nwg % NXCD, xcd = wgid % NXCD, off = wgid / NXCD; wgid = (xcd < r ? xcd * (q + 1) : r * (q + 1) + (xcd - r) * q) + off; }
        const int nig = WGM * nN, gid = wgid / nig, fm = gid * WGM, gsz = (nM - fm) < WGM ? (nM - fm) : WGM;
        u.pm = fm + ((wgid % nig) % gsz); u.pn = (wgid % nig) / gsz; u.e = 0; return true;
    }
    __device__ __forceinline__ const char* a_base(const Unit& u) const { return (const char*)A + (size_t)u.pm * 256 * K * 2; }
    __device__ __forceinline__ const char* b_base(const Unit& u) const { return (const char*)Bt + (size_t)u.pn * 256 * K * 2; }
    __device__ __forceinline__ const int* rowmap() const { return nullptr; }
};
struct GateOrder {
    StaticOrder so; const bf16_t* A; const bf16_t* Bt; int per;
    __device__ void init(const bf16_t* bo, const bf16_t* WbrT, int G_, int c_) { so.init(bo, WbrT, T, D, FW, G_, c_); A = bo; Bt = WbrT; Unit t; per = 0; while (so.next(per, t)) ++per; }
    __device__ bool next(int i, Unit& u) const { if (per == 0 || i >= 4 * per) return false; const int g = i / per; const bool ok = so.next(i - g * per, u); u.e = g; return ok; }
    __device__ __forceinline__ const char* a_base(const Unit& u) const { return (const char*)(A + (size_t)u.e * T * 512) + (size_t)u.pm * 256 * FW * 2; }
    __device__ __forceinline__ const char* b_base(const Unit& u) const { return (const char*)(Bt + (size_t)u.e * D * FW) + (size_t)u.pn * 256 * FW * 2; }
    __device__ __forceinline__ const int* rowmap() const { return nullptr; }
};
struct MoeOrder {
    const bf16_t* A; const bf16_t* Bt; const int* rmap; const LAS int* petab; size_t estride; int K, NT, total, G, c;
    __device__ void init(const bf16_t* A_, const bf16_t* Bt_, size_t estride_, const LAS int* petab_, const int* rmap_, int npanels, int NT_, int K_, int G_, int c_) {
        A = A_; Bt = Bt_; estride = estride_; petab = petab_; rmap = rmap_; K = K_; NT = NT_; total = npanels * NT_; G = G_;
        c = remap(c_, G_);
    }
    static __device__ __forceinline__ int remap(int c_, int G_) { return (c_ & 7) * (G_ >> 3) + (c_ >> 3); }
    static __device__ __forceinline__ void fill_table(LAS int* tab, const int* panel_expert, int npanels, int NT_, int G_, int c_, int tid) {
        const int cc = remap(c_, G_), tot = npanels * NT_;
        if (tid < 64) { const int Lu = tid * G_ + cc; tab[tid] = (Lu < tot) ? panel_expert[Lu / NT_] : 0; }
        __syncthreads();
    }
    __device__ bool next(int i, Unit& u) const {
        const int L = i * G + c; if (L >= total) return false;
        u.pm = L / NT; u.pn = L % NT; u.e = petab[i]; return true;
    }
    __device__ __forceinline__ const char* a_base(const Unit& u) const { return rmap ? (const char*)A : (const char*)A + (size_t)u.pm * 256 * K * 2; }
    __device__ __forceinline__ const char* b_base(const Unit& u) const { return (const char*)(Bt + (size_t)u.e * estride) + (size_t)u.pn * 256 * K * 2; }
    __device__ __forceinline__ const int* rowmap() const { return rmap; }
};

struct EpiZ16 {
    static constexpr bool PERM = true, W64 = false; static constexpr int NST = 16;
    bf16_t* O; int ldc; int pad_;
    __device__ __forceinline__ void operator()(const f32x4 (&acc)[2][2][4][2], const Unit& u, int wr, int wc, int fr, int fq) const {
        const int row0 = u.pm * BM + wr * 64 + fr, col0 = u.pn * BM + wc * 32 + 8 * fq;
#pragma unroll
        for (int ai = 0; ai < 2; ++ai)
#pragma unroll
            for (int m = 0; m < 4; ++m) { bf16_t* rowp = O + (size_t)(row0 + ai * HALF + m * 16) * ldc + col0;
#pragma unroll
                for (int bj = 0; bj < 2; ++bj) { const f32x4 v0 = acc[ai][bj][m][0], v1 = acc[ai][bj][m][1];
                    u32x4 w; w.x = cvt_pk_bf16(v0[0], v0[1]); w.y = cvt_pk_bf16(v0[2], v0[3]); w.z = cvt_pk_bf16(v1[0], v1[1]); w.w = cvt_pk_bf16(v1[2], v1[3]);
                    *(u32x4*)(rowp + bj * HALF) = w; } }
    }
};
struct EpiGateAcc {
    static constexpr bool PERM = true, W64 = false; static constexpr int NST = 8;
    const bf16_t* zg0; bf16_t* mergedb;
    __device__ __forceinline__ void operator()(const f32x4 (&acc)[2][2][4][2], const Unit& u, int wr, int wc, int fr, int fq) const {
        const int g = u.e; const bf16_t* zg = zg0 + g * D;
        const int row0 = u.pm * BM + wr * 64 + fr, col0 = u.pn * BM + wc * 32 + 8 * fq;
#pragma unroll
        for (int ai = 0; ai < 2; ++ai) {
            u32x4 gzv[4][2], pvv[4][2];
#pragma unroll
            for (int m = 0; m < 4; ++m)
#pragma unroll
                for (int bj = 0; bj < 2; ++bj) { const size_t row = (size_t)(row0 + ai * HALF + m * 16); const int col = col0 + bj * HALF;
                    gzv[m][bj] = *(const u32x4*)(zg + row * ZLD + col);
                    pvv[m][bj] = (u32x4){0u, 0u, 0u, 0u}; if (g > 0) pvv[m][bj] = *(const u32x4*)(mergedb + row * D + col); }
#pragma unroll
            for (int m = 0; m < 4; ++m) { const size_t row = (size_t)(row0 + ai * HALF + m * 16);
#pragma unroll
                for (int bj = 0; bj < 2; ++bj) { const int col = col0 + bj * HALF;
                    const u32x4 gz = gzv[m][bj], pv = pvv[m][bj];
                    f32x4 g0, g1; g0[0] = __uint_as_float(gz.x << 16); g0[1] = __uint_as_float(gz.x & 0xffff0000u); g0[2] = __uint_as_float(gz.y << 16); g0[3] = __uint_as_float(gz.y & 0xffff0000u);
                    g1[0] = __uint_as_float(gz.z << 16); g1[1] = __uint_as_float(gz.z & 0xffff0000u); g1[2] = __uint_as_float(gz.w << 16); g1[3] = __uint_as_float(gz.w & 0xffff0000u);
                    f32x4 v0 = acc[ai][bj][m][0], v1 = acc[ai][bj][m][1];
#pragma unroll
                    for (int j = 0; j < 4; ++j) { v0[j] *= __builtin_amdgcn_rcpf(1.0f + __expf(-g0[j])); v1[j] *= __builtin_amdgcn_rcpf(1.0f + __expf(-g1[j])); }
                    v0[0] += __uint_as_float(pv.x << 16); v0[1] += __uint_as_float(pv.x & 0xffff0000u); v0[2] += __uint_as_float(pv.y << 16); v0[3] += __uint_as_float(pv.y & 0xffff0000u);
                    v1[0] += __uint_as_float(pv.z << 16); v1[1] += __uint_as_float(pv.z & 0xffff0000u); v1[2] += __uint_as_float(pv.w << 16); v1[3] += __uint_as_float(pv.w & 0xffff0000u);
                    u32x4 w; w.x = cvt_pk_bf16(v0[0], v0[1]); w.y = cvt_pk_bf16(v0[2], v0[3]); w.z = cvt_pk_bf16(v1[0], v1[1]); w.w = cvt_pk_bf16(v1[2], v1[3]);
                    *(u32x4*)(mergedb + row * D + col) = w; } }
            asm volatile("" ::: "memory");
        }
    }
};
struct EpiResid {
    static constexpr bool PERM = true, W64 = false; static constexpr int NST = 8;
    const float* xin; bf16_t* pre;
    __device__ __forceinline__ void operator()(const f32x4 (&acc)[2][2][4][2], const Unit& u, int wr, int wc, int fr, int fq) const {
        const int row0 = u.pm * BM + wr * 64 + fr, col0 = u.pn * BM + wc * 32 + 8 * fq;
#pragma unroll
        for (int ai = 0; ai < 2; ++ai) {
            f32x4 xv[4][2][2];
#pragma unroll
            for (int m = 0; m < 4; ++m) { const size_t ro = (size_t)(row0 + ai * HALF + m * 16) * D + col0;
#pragma unroll
                for (int bj = 0; bj < 2; ++bj)
#pragma unroll
                    for (int n = 0; n < 2; ++n) xv[m][bj][n] = *(const f32x4*)(xin + ro + bj * HALF + n * 4); }
#pragma unroll
            for (int m = 0; m < 4; ++m) { const size_t ro = (size_t)(row0 + ai * HALF + m * 16) * D + col0;
#pragma unroll
                for (int bj = 0; bj < 2; ++bj) { const f32x4 v0 = xv[m][bj][0] * ALPHA + acc[ai][bj][m][0], v1 = xv[m][bj][1] * ALPHA + acc[ai][bj][m][1];
                    u32x4 w; w.x = cvt_pk_bf16(v0[0], v0[1]); w.y = cvt_pk_bf16(v0[2], v0[3]); w.z = cvt_pk_bf16(v1[0], v1[1]); w.w = cvt_pk_bf16(v1[2], v1[3]);
                    *(u32x4*)(pre + ro + bj * HALF) = w; } }
            asm volatile("" ::: "memory");
        }
    }
};
struct EpiSwi {
    static constexpr bool PERM = true, W64 = false; static constexpr int NST = 8;
    bf16_t* h;
    __device__ __forceinline__ void operator()(const f32x4 (&acc)[2][2][4][2], const Unit& u, int wr, int wc, int fr, int fq) const {
        const int row0 = u.pm * BM + wr * 64 + fr, col0 = u.pn * HALF + wc * 32 + 8 * fq;
#pragma unroll
        for (int ai = 0; ai < 2; ++ai)
#pragma unroll
            for (int m = 0; m < 4; ++m) { float o[8];
#pragma unroll
                for (int n = 0; n < 2; ++n)
#pragma unroll
                    for (int j = 0; j < 4; ++j) { const float gt = acc[ai][0][m][n][j], up = acc[ai][1][m][n][j]; o[4 * n + j] = gt / (1.0f + __expf(-gt)) * up; }
                u32x4 w; w.x = cvt_pk_bf16(o[0], o[1]); w.y = cvt_pk_bf16(o[2], o[3]); w.z = cvt_pk_bf16(o[4], o[5]); w.w = cvt_pk_bf16(o[6], o[7]);
                *(u32x4*)(h + (size_t)(row0 + ai * HALF + m * 16) * FW + col0) = w; }
    }
};
__device__ __forceinline__ u32x4 ror8x4(const u32x4 v) { u32x4 r;
    r.x = (unsigned)__builtin_amdgcn_update_dpp(0, (int)v.x, 0x128, 0xf, 0xf, false); r.y = (unsigned)__builtin_amdgcn_update_dpp(0, (int)v.y, 0x128, 0xf, 0xf, false);
    r.z = (unsigned)__builtin_amdgcn_update_dpp(0, (int)v.z, 0x128, 0xf, 0xf, false); r.w = (unsigned)__builtin_amdgcn_update_dpp(0, (int)v.w, 0x128, 0xf, 0xf, false); return r; }
struct EpiDownW {
    static constexpr bool PERM = true, W64 = true; static constexpr int NST = 16;
    bf16_t* y; int ld, pad_;
    __device__ __forceinline__ void operator()(const f32x4 (&acc)[2][2][4][2], const Unit& u, int wr, int wc, int fr, int fq) const {
        const bool hi = fr >= 8;
        const int row0 = u.pm * BM + wr * 64 + (fr & 7), col0 = u.pn * BM + wc * 64 + 8 * fq + (hi ? 32 : 0);
#pragma unroll
        for (int ai = 0; ai < 2; ++ai)
#pragma unroll
            for (int m = 0; m < 4; ++m) { bf16_t* rowp = y + (size_t)(row0 + ai * HALF + m * 16) * ld + col0;
                u32x4 w0, w1;
                { const f32x4 v0 = acc[ai][0][m][0], v1 = acc[ai][0][m][1]; w0.x = cvt_pk_bf16(v0[0], v0[1]); w0.y = cvt_pk_bf16(v0[2], v0[3]); w0.z = cvt_pk_bf16(v1[0], v1[1]); w0.w = cvt_pk_bf16(v1[2], v1[3]); }
                { const f32x4 v0 = acc[ai][1][m][0], v1 = acc[ai][1][m][1]; w1.x = cvt_pk_bf16(v0[0], v0[1]); w1.y = cvt_pk_bf16(v0[2], v0[3]); w1.z = cvt_pk_bf16(v1[0], v1[1]); w1.w = cvt_pk_bf16(v1[2], v1[3]); }
                const u32x4 snd = hi ? w0 : w1, rcv = ror8x4(snd);
                __builtin_nontemporal_store(hi ? rcv : w0, (u32x4*)rowp);
                __builtin_nontemporal_store(hi ? w1 : rcv, (u32x4*)(rowp + (size_t)8 * ld)); }
    }
};

template <class Epi, class Sched, bool GATHER>
__device__ __forceinline__ void gemm_phase(LAS unsigned char* lds, const int K, const Sched& S, const Epi& E) {
    const int tid = phase_tid(), wid = __builtin_amdgcn_readfirstlane(tid >> 6), wr = wid >> 2, wc = wid & 3, lane = tid & 63, fr = lane & 15, fq = lane >> 4;
    const int nt = K / BK;
    unsigned voffA[2], voffB[2], voffG[2][2]; int gR[2], gC[2];
#pragma unroll
    for (int i = 0; i < 2; ++i) { int R, C; stage_rc(tid * 16 + i * 8192, R, C); const int Rb = Epi::W64 ? (64 * (R >> 5) + perm32(R & 31)) : (Epi::PERM ? ((R & ~31) + perm32(R & 31)) : R);
        voffA[i] = (unsigned)(R * K + C) * 2u; voffB[i] = (unsigned)(Rb * K + C) * 2u; gR[i] = R; gC[i] = C; voffG[0][i] = 0u; voffG[1][i] = 0u; }
    const size_t kstep = (size_t)(BK * 2);
    const size_t hstep = (size_t)HALF * K * 2;
    const size_t hstepB = Epi::W64 ? (size_t)32 * K * 2 : hstep;
    const unsigned ldsw = (unsigned)wid * 1024u;
    const int aoff = lds_byte(wr * 64 + fr, fq * 8), boff = lds_byte(wc * 32 + fr, fq * 8);
    const LAS int* gtab = (const LAS int*)(lds + STAGE_BYTES) + tid;
#define PG8_SA(b, h) (((b) * 2 + (h)) * HTB)
#define PG8_SB(b, h) ((4 + (b) * 2 + (h)) * HTB)
#define PG8_STAGE(bufoff, gbase, voff) do { _Pragma("unroll") for (int _i = 0; _i < 2; ++_i) \
        __builtin_amdgcn_global_load_lds((const unsigned*)((const char*)(gbase) + (voff)[_i]), (LAS unsigned*)(lds + (bufoff) + ldsw + _i * 8192), 16, 0, 0); } while (0)
#define PG8_STAGE_A(bufoff, gbase, h) do { if constexpr (GATHER) PG8_STAGE(bufoff, gbase, voffG[h]); else PG8_STAGE(bufoff, (gbase) + (h) * hstep, voffA); } while (0)
#define PG8_LDA(dst, b, h) do { _Pragma("unroll") for (int m = 0; m < 4; ++m) _Pragma("unroll") for (int k = 0; k < 2; ++k) dst[m][k] = *(const LAS bf16x8*)(lds + PG8_SA(b, h) + aoff + m * 2048 + k * 1024); } while (0)
#define PG8_LDB(dst, b, h) do { _Pragma("unroll") for (int n = 0; n < 2; ++n) _Pragma("unroll") for (int k = 0; k < 2; ++k) dst[n][k] = *(const LAS bf16x8*)(lds + PG8_SB(b, h) + boff + n * 2048 + k * 1024); } while (0)
#define PG8_MMA(ai, bj, At, Bt) do { __builtin_amdgcn_s_setprio(1); _Pragma("unroll") for (int m = 0; m < 4; ++m) _Pragma("unroll") for (int n = 0; n < 2; ++n) _Pragma("unroll") for (int k = 0; k < 2; ++k) \
        acc[ai][bj][m][n] = __builtin_amdgcn_mfma_f32_16x16x32_bf16(Bt[n][k], At[m][k], acc[ai][bj][m][n], 0, 0, 0); __builtin_amdgcn_s_setprio(0); } while (0)
#define PG8_WAIT_V(n) asm volatile("s_waitcnt vmcnt(" #n ")" ::: "memory")
#define PG8_WAIT_VN(n) asm volatile("s_waitcnt vmcnt(%0)" :: "n"(n) : "memory")
#define PG8_WAIT_FRESH(f, n) asm volatile("v_cmp_ne_u32_e32 vcc, 0, %0\n\ts_cbranch_vccnz .Lpg8w%=\n\ts_waitcnt vmcnt(8)\n.Lpg8w%=:\n\ts_waitcnt vmcnt(%1)" :: "v"(f), "n"(n) : "memory", "vcc")
#define PG8_WAIT_L(n) asm volatile("s_waitcnt lgkmcnt(" #n ")" ::: "memory")
#define PG8_BAR __builtin_amdgcn_s_barrier()
#define PG8_SCHED __builtin_amdgcn_sched_barrier(0)
    auto gather_offs = [&](const Unit& u) -> u32x4 {
        const int* rm = S.rowmap(); u32x4 o;
        o.x = (unsigned)(rm[u.pm * 256 + gR[0]] * K + gC[0]) * 2u;       o.y = (unsigned)(rm[u.pm * 256 + gR[1]] * K + gC[1]) * 2u;
        o.z = (unsigned)(rm[u.pm * 256 + 128 + gR[0]] * K + gC[0]) * 2u; o.w = (unsigned)(rm[u.pm * 256 + 128 + gR[1]] * K + gC[1]) * 2u;
        return o; };
    auto gather_dma = [&](const Unit& u) { const int* rm = S.rowmap() + u.pm * 256;
#pragma unroll
        for (int k = 0; k < 4; ++k) __builtin_amdgcn_global_load_lds((const unsigned*)(rm + (k >> 1) * 128 + gR[k & 1]), (LAS unsigned*)(lds + STAGE_BYTES + k * 2048 + wid * 256), 4, 0, 0); };
    Unit cur, nxt, nn; int ui = 0;
    if (!S.next(0, cur)) return;
    f32x4 acc[2][2][4][2];
#pragma unroll
    for (int a = 0; a < 2; ++a)
#pragma unroll
        for (int b = 0; b < 2; ++b)
#pragma unroll
            for (int m = 0; m < 4; ++m)
#pragma unroll
                for (int n = 0; n < 2; ++n) acc[a][b][m][n] = (f32x4){0.f, 0.f, 0.f, 0.f};
    bf16x8 At[4][2], B0[2][2], B1[2][2];
    const char* cA = S.a_base(cur); const char* cB = S.b_base(cur);
    if constexpr (GATHER) {
        const u32x4 o = gather_offs(cur); voffG[0][0] = o.x; voffG[0][1] = o.y; voffG[1][0] = o.z; voffG[1][1] = o.w;
        if (S.next(1, nn)) gather_dma(nn);
        asm volatile("s_waitcnt vmcnt(0) lgkmcnt(0)" ::: "memory");
    }
    PG8_STAGE(PG8_SB(0, 0), cB, voffB); PG8_STAGE(PG8_SB(0, 1), cB + hstepB, voffB); PG8_STAGE_A(PG8_SA(0, 0), cA, 0); PG8_STAGE_A(PG8_SA(0, 1), cA, 1);
    if (wr == 1) PG8_BAR;
    PG8_WAIT_V(2); PG8_BAR;
    PG8_STAGE(PG8_SB(1, 0), cB + kstep, voffB); PG8_STAGE_A(PG8_SA(1, 0), cA + kstep, 0); PG8_STAGE(PG8_SB(1, 1), cB + hstepB + kstep, voffB);
    PG8_WAIT_V(6); PG8_BAR;
    for (;;) {
        const bool has_next = S.next(ui + 1, nxt);
        const char* nA = has_next ? S.a_base(nxt) : cA; const char* nB = has_next ? S.b_base(nxt) : cB;
        for (int t = 0; t < nt; t += 2) {
            const bool last = (t == nt - 2); const int fresh = (t == 0 && ui > 0) ? 1 : 0;
            const char* a1 = cA + (size_t)(t + 1) * kstep;
            const char* a2 = last ? nA : cA + (size_t)(t + 2) * kstep; const char* b2 = last ? nB : cB + (size_t)(t + 2) * kstep;
            const char* a3 = a2 + kstep; const char* b3 = b2 + kstep;
            PG8_LDB(B0, 0, 0); PG8_LDB(B1, 0, 1); PG8_SCHED; PG8_LDA(At, 0, 0); PG8_STAGE_A(PG8_SA(1, 1), a1, 1);
            if constexpr (GATHER) { if (last && has_next) {
#pragma unroll
                for (int k = 0; k < 4; ++k) voffG[k >> 1][k & 1] = (unsigned)(gtab[k * 512] * K + gC[k & 1]) * 2u; } }
            PG8_WAIT_FRESH(fresh, 8 + Epi::NST);
            PG8_WAIT_L(0); PG8_BAR; PG8_MMA(0, 0, At, B0); PG8_MMA(0, 1, At, B1); PG8_BAR; PG8_SCHED;
            PG8_LDA(At, 0, 1); PG8_STAGE(PG8_SB(0, 0), b2, voffB); PG8_STAGE(PG8_SB(0, 1), b2 + hstepB, voffB); PG8_STAGE_A(PG8_SA(0, 0), a2, 0);
            PG8_WAIT_FRESH(fresh, 8 + Epi::NST);
            PG8_WAIT_L(0); PG8_BAR; PG8_MMA(1, 0, At, B0); PG8_MMA(1, 1, At, B1); PG8_BAR; PG8_SCHED;
            PG8_LDB(B0, 1, 0); PG8_LDB(B1, 1, 1); PG8_SCHED; PG8_LDA(At, 1, 0); PG8_STAGE_A(PG8_SA(0, 1), a2, 1);
            PG8_WAIT_V(8); PG8_WAIT_L(0); PG8_BAR; PG8_MMA(0, 0, At, B0); PG8_MMA(0, 1, At, B1); PG8_BAR; PG8_SCHED;
            PG8_LDA(At, 1, 1); PG8_STAGE(PG8_SB(1, 0), b3, voffB); PG8_STAGE(PG8_SB(1, 1), b3 + hstepB, voffB); PG8_STAGE_A(PG8_SA(1, 0), a3, 0);
            PG8_WAIT_V(8); PG8_WAIT_L(0); PG8_BAR; PG8_MMA(1, 0, At, B0); PG8_MMA(1, 1, At, B1); PG8_BAR; PG8_SCHED;
        }
        if (wr == 0) PG8_BAR;
        if constexpr (GATHER) { if (has_next && S.next(ui + 2, nn)) gather_dma(nn); }
        E(acc, cur, wr, wc, fr, fq);
        if (!has_next) break;
#pragma unroll
        for (int a = 0; a < 2; ++a)
#pragma unroll
            for (int b = 0; b < 2; ++b)
#pragma unroll
                for (int m = 0; m < 4; ++m)
#pragma unroll
                    for (int n = 0; n < 2; ++n) acc[a][b][m][n] = (f32x4){0.f, 0.f, 0.f, 0.f};
        cur = nxt; cA = nA; cB = nB; ++ui;
        if (wr == 1) PG8_BAR;
    }
    PG8_WAIT_V(0);
    PG8_BAR;
#undef PG8_SA
#undef PG8_SB
#undef PG8_STAGE
#undef PG8_STAGE_A
#undef PG8_LDA
#undef PG8_LDB
#undef PG8_MMA
#undef PG8_WAIT_V
#undef PG8_WAIT_L
#undef PG8_BAR
#undef PG8_SCHED
}
}


struct ConvArgs { const float *w_in, *we_gate, *we_up, *we_down, *ws_gate, *ws_up, *ws_down, *w_br, *w_out; bf16_t *WinT, *WguT, *WdT, *WbrT, *WoutT; int layer, pad_; };
constexpr int CV_SEG0 = 32 * 236, CV_SEG1 = 65 * 2 * 32 * 8, CV_SEG2 = 65 * 8 * 32, CV_SEG3 = 4 * 8 * 32, CV_SEG4 = 32 * 32;
constexpr int CV_TOTAL = CV_SEG0 + CV_SEG1 + CV_SEG2 + CV_SEG3 + CV_SEG4;
struct CvJob { const float* src; bf16_t* dst; int ld, ldd, valid; };
__device__ __forceinline__ CvJob cv_decode(const ConvArgs& a, const int j, const int L) {
    CvJob o; o.valid = 64;
    if (j < CV_SEG0) { const int kb = j & 31, nb = j >> 5; o.ld = ZW; o.ldd = D;
        o.src = a.w_in + (size_t)L * D * ZW + (size_t)kb * 64 * ZW + nb * 64; int v = ZW - nb * 64; o.valid = v < 0 ? 0 : (v > 64 ? 64 : v);
        o.dst = a.WinT + (size_t)nb * 64 * D + kb * 64; }
    else if (j < CV_SEG0 + CV_SEG1) { int q = j - CV_SEG0; const int cb = q & 7; q >>= 3; const int kb = q & 31; q >>= 5; const int bj = q & 1; const int e = q >> 1; o.ld = FW; o.ldd = D;
        const float* m = (e < NE) ? ((bj ? a.we_up : a.we_gate) + ((size_t)L * NE + e) * D * FW) : ((bj ? a.ws_up : a.ws_gate) + (size_t)L * D * FW);
        o.src = m + (size_t)kb * 64 * FW + cb * 64;
        o.dst = a.WguT + ((size_t)e * 1024 + (cb >> 1) * 256 + bj * 128 + (cb & 1) * 64) * D + kb * 64; }
    else if (j < CV_SEG0 + CV_SEG1 + CV_SEG2) { int q = j - CV_SEG0 - CV_SEG1; const int nb = q & 31; q >>= 5; const int kb = q & 7; const int e = q >> 3; o.ld = D; o.ldd = FW;
        const float* m = (e < NE) ? (a.we_down + ((size_t)L * NE + e) * FW * D) : (a.ws_down + (size_t)L * FW * D);
        o.src = m + (size_t)kb * 64 * D + nb * 64; o.dst = a.WdT + ((size_t)e * D + nb * 64) * FW + kb * 64; }
    else if (j < CV_SEG0 + CV_SEG1 + CV_SEG2 + CV_SEG3) { int q = j - CV_SEG0 - CV_SEG1 - CV_SEG2; const int nb = q & 31; q >>= 5; const int kb = q & 7; const int g = q >> 3; o.ld = D; o.ldd = FW;
        o.src = a.w_br + ((size_t)L * 4 + g) * FW * D + (size_t)kb * 64 * D + nb * 64; o.dst = a.WbrT + ((size_t)g * D + nb * 64) * FW + kb * 64; }
    else { const int q = j - CV_SEG0 - CV_SEG1 - CV_SEG2 - CV_SEG3; const int nb = q & 31, kb = q >> 5; o.ld = D; o.ldd = D;
        o.src = a.w_out + (size_t)L * D * D + (size_t)kb * 64 * D + nb * 64; o.dst = a.WoutT + (size_t)nb * 64 * D + kb * 64; }
    return o;
}
__device__ __forceinline__ void convert_tiles(const ConvArgs& a, int j0, int j1, int jstart, int jstride, LAS float (*tile)[65]) {
    const int tid = phase_tid(), L = a.layer;
    for (int j = j0 + jstart; j < j1; j += jstride) {
        const CvJob jb = cv_decode(a, j, L);
        const float* src = jb.src; bf16_t* dst = jb.dst; const int ld = jb.ld, ldd = jb.ldd, valid = jb.valid;
        __syncthreads();
        { const int c4 = (tid & 15) * 4, k = tid >> 4;
#pragma unroll
          for (int h = 0; h < 2; ++h) { float4 v = make_float4(0.f, 0.f, 0.f, 0.f); if (c4 < valid) v = *(const float4*)(src + (size_t)(k + 32 * h) * ld + c4);
              tile[k + 32 * h][c4] = v.x; tile[k + 32 * h][c4 + 1] = v.y; tile[k + 32 * h][c4 + 2] = v.z; tile[k + 32 * h][c4 + 3] = v.w; } }
        __syncthreads();
        { const int n = tid >> 3, kc = (tid & 7) * 8; unsigned w[4];
#pragma unroll
          for (int q = 0; q < 4; ++q) w[q] = (unsigned)f2bf(tile[kc + 2 * q][n]) | ((unsigned)f2bf(tile[kc + 2 * q + 1][n]) << 16);
          *(uint4*)(dst + (size_t)n * ldd + kc) = make_uint4(w[0], w[1], w[2], w[3]); }
    }
}
constexpr int CVX_OWN = CV_TOTAL - CV_SEG0, CVX_TOTAL = CVX_OWN + CV_SEG0;
__device__ __forceinline__ bool cvx_job(const ConvArgs& a, const int n, const int L, CvJob& jb) {
    if (n < CVX_OWN) { jb = cv_decode(a, CV_SEG0 + n, L); return true; }
    if (n < CVX_TOTAL && L + 1 < 2) { jb = cv_decode(a, n - CVX_OWN, L + 1); return true; }
    return false;
}
typedef float f32x2v __attribute__((ext_vector_type(2)));
typedef float f32x4v __attribute__((ext_vector_type(4)));
struct MixArgs {
    const bf16_t* z;
    const float *hg_lb_logits, *hg_norm_w, *rw_mu, *rw_w0, *rw_w2, *rw_a0, *rw_a2, *rw_g2, *rw_kk, *rw_ka, *rw_rk, *rw_ln_w, *rw_ln_b, *gla_g2, *gla_gb, *gla_norm_w;
    float* RS; bf16_t *Vt, *KH, *KG, *VtH, *VtG; bf16_t *rGate, *rBonus;
    float *oR, *oH, *oG; bf16_t *cR, *cH, *cG;
    float *SendR, *PendR, *SendH, *SendG, *GamH, *GamG;
    bf16_t *SstR, *SstH, *SstG;
    bf16_t* bo;
    const bf16_t *W2T, *A2T, *G2T, *GGT;
    float *LW, *LA, *LG, *LL;
    int layer, pad_;
};
__device__ __forceinline__ float red8(float x) { x += dppmov<0xB1>(x); x += dppmov<0x4E>(x); x += dppmov<0x141>(x); return x; }
__device__ __forceinline__ float red16(float x) { x += dppmov<0xB1>(x); x += dppmov<0x4E>(x); x += dppmov<0x141>(x); x += dppmov<0x140>(x); return x; }

__device__ __forceinline__ void prep_phase(const MixArgs& p, LAS unsigned char* ldsraw) {
    LAS bf16_t (*vtile)[72] = (LAS bf16_t (*)[72])(ldsraw + 8192);
    LAS float* lW = (LAS float*)ldsraw; LAS float* lA = lW + 16 * 516; LAS float* lG = lA + 16 * 516; LAS float* lL = lG + 16 * 516;
    const int c = phase_tid(), L = p.layer;
    const float mu_r = p.rw_mu[L * 1696 + c], mu_k = p.rw_mu[L * 1696 + 512 + c], mu_v = p.rw_mu[L * 1696 + 1024 + c];
    const float w0 = p.rw_w0[L * 512 + c], a0 = p.rw_a0[L * 512 + c], kkc = p.rw_kk[L * 512 + c], kac = p.rw_ka[L * 512 + c], rkc = p.rw_rk[L * 512 + c];
    float lb = 0.f;
    if (L == 1) { const float l0 = p.hg_lb_logits[c], l1 = p.hg_lb_logits[512 + c]; const float m = fmaxf(l0, l1); const float e0 = expf(l0 - m), e1 = expf(l1 - m); lb = e1 / (e0 + e1); }
    const float gbc = (c < 256) ? p.gla_gb[L * 256 + c] : 0.f;
    for (int tile = blockIdx.x; tile < T / 64; tile += gridDim.x) {
        const int t0 = tile * 64;
        float bH = 0.f, bG = 0.f;
#pragma unroll 1
        for (int g16 = 0; g16 < 4; ++g16) {
            const int tg0 = t0 + 16 * g16;
            typedef short bf16x8v __attribute__((ext_vector_type(8)));
            typedef __bf16 bf16x2n __attribute__((ext_vector_type(2)));
            {
                const int wvu = __builtin_amdgcn_readfirstlane(c >> 6), lane = c & 63, r = lane & 15, q = lane >> 4;
                bf16x8v Af[6];
                { const int t = tg0 + r;
#pragma unroll
                    for (int ks = 0; ks < 5; ++ks) {
                        const pg8::u32x4 cu = *(const pg8::u32x4*)(p.z + (size_t)t * ZLD + RW_LW + 32 * ks + 8 * q);
                        pg8::u32x4 pv = (pg8::u32x4){0u, 0u, 0u, 0u}; if (t > 0) pv = *(const pg8::u32x4*)(p.z + (size_t)(t - 1) * ZLD + RW_LW + 32 * ks + 8 * q);
                        const float4 m0 = *(const float4*)(p.rw_mu + L * 1696 + 1536 + 32 * ks + 8 * q), m1 = *(const float4*)(p.rw_mu + L * 1696 + 1536 + 32 * ks + 8 * q + 4);
                        const float mu8[8] = {m0.x, m0.y, m0.z, m0.w, m1.x, m1.y, m1.z, m1.w};
                        const unsigned cw[4] = {cu.x, cu.y, cu.z, cu.w}, pw[4] = {pv.x, pv.y, pv.z, pv.w};
                        union { bf16x2n h2[4]; bf16x8v v; } pk;
#pragma unroll
                        for (int j = 0; j < 4; ++j) { f32x2v f;
                            { const float cur = __uint_as_float(cw[j] << 16), prv = __uint_as_float(pw[j] << 16); const float zs = cur + (prv - cur) * mu8[2 * j];
                              f.x = (ks == 0) ? (1.0f - 2.0f / (1.0f + __expf(2.0f * zs))) : (ks == 1 ? zs : fsig(zs)); }
                            { const float cur = __uint_as_float(cw[j] & 0xffff0000u), prv = __uint_as_float(pw[j] & 0xffff0000u); const float zs = cur + (prv - cur) * mu8[2 * j + 1];
                              f.y = (ks == 0) ? (1.0f - 2.0f / (1.0f + __expf(2.0f * zs))) : (ks == 1 ? zs : fsig(zs)); }
                            pk.h2[j] = __builtin_convertvector(f, bf16x2n); }
                        Af[ks] = pk.v; }
                    { pg8::u32x4 gl = (pg8::u32x4){0u, 0u, 0u, 0u}; if (q < 2) gl = *(const pg8::u32x4*)(p.z + (size_t)t * ZLD + GL_LG + 8 * q);
                      union { pg8::u32x4 u; bf16x8v v; } cvu; cvu.u = gl; Af[5] = cvu.v; } }
                const bf16_t* w2t = p.W2T + (size_t)L * 512 * 32; const bf16_t* a2t = p.A2T + (size_t)L * 512 * 32; const bf16_t* g2t = p.G2T + (size_t)L * 512 * 96; const bf16_t* ggt = p.GGT + (size_t)L * 256 * 32;
                __syncthreads();
#pragma unroll 2
                for (int nt = 0; nt < 4; ++nt) { const int ch = 64 * wvu + 16 * nt + r;
                    const bf16x8v Bw = *(const bf16x8v*)(w2t + ch * 32 + 8 * q), Ba = *(const bf16x8v*)(a2t + ch * 32 + 8 * q);
                    const bf16x8v Bg0 = *(const bf16x8v*)(g2t + ch * 96 + 8 * q), Bg1 = *(const bf16x8v*)(g2t + ch * 96 + 32 + 8 * q), Bg2 = *(const bf16x8v*)(g2t + ch * 96 + 64 + 8 * q);
                    const f32x4v zero = (f32x4v){0.f, 0.f, 0.f, 0.f};
                    const f32x4v aw = __builtin_amdgcn_mfma_f32_16x16x32_bf16(Af[0], Bw, zero, 0, 0, 0), aa = __builtin_amdgcn_mfma_f32_16x16x32_bf16(Af[1], Ba, zero, 0, 0, 0);
                    f32x4v ag = __builtin_amdgcn_mfma_f32_16x16x32_bf16(Af[2], Bg0, zero, 0, 0, 0); ag = __builtin_amdgcn_mfma_f32_16x16x32_bf16(Af[3], Bg1, ag, 0, 0, 0); ag = __builtin_amdgcn_mfma_f32_16x16x32_bf16(Af[4], Bg2, ag, 0, 0, 0);
#pragma unroll
                    for (int i = 0; i < 4; ++i) { const int o = (4 * q + i) * 516 + ch; lW[o] = aw[i]; lA[o] = aa[i]; lG[o] = ag[i]; } }
#pragma unroll
                for (int nt = 0; nt < 2; ++nt) { const int ch = 32 * wvu + 16 * nt + r;
                    const bf16x8v Bl = *(const bf16x8v*)(ggt + ch * 32 + 8 * q);
                    const f32x4v al = __builtin_amdgcn_mfma_f32_16x16x32_bf16(Af[5], Bl, (f32x4v){0.f, 0.f, 0.f, 0.f}, 0, 0, 0);
#pragma unroll
                    for (int i = 0; i < 4; ++i) lL[(4 * q + i) * 260 + ch] = al[i]; }
                __syncthreads();
            }
        for (int tb = 0; tb < 2; ++tb) {
            const int tt0 = tg0 + tb * 8;
            float accW[8], accA[8], accG[8], accL[8];
#pragma unroll
            for (int k = 0; k < 8; ++k) { const int o = (tb * 8 + k) * 516 + c; accW[k] = w0 + lW[o]; accA[k] = a0 + lA[o]; accG[k] = lG[o]; accL[k] = (c < 256) ? gbc + lL[(tb * 8 + k) * 260 + c] : 0.f; }
            float zr[9], zk[9], zv[9], zq[8], zf[8], zgq[8], zgk[8];
            { const bool has_prev = tt0 > 0; const bf16_t* zp0 = p.z + (size_t)(has_prev ? tt0 - 1 : 0) * ZLD;
              const float hp = has_prev ? 1.f : 0.f; zr[0] = bf2f(zp0[RW_R + c]) * hp; zk[0] = bf2f(zp0[RW_K + c]) * hp; zv[0] = bf2f(zp0[RW_V + c]) * hp; }
#pragma unroll
            for (int k = 0; k < 8; ++k) { const bf16_t* zc = p.z + (size_t)(tt0 + k) * ZLD;
                zr[k + 1] = bf2f(zc[RW_R + c]); zk[k + 1] = bf2f(zc[RW_K + c]); zv[k + 1] = bf2f(zc[RW_V + c]); zq[k] = bf2f(zc[HG_Q + c]); zf[k] = bf2f(zc[HG_F + c]);
                zgq[k] = bf2f(zc[GL_Q + (c & 255)]); zgk[k] = bf2f(zc[GL_K + (c & 255)]); }
            asm volatile("" ::: "memory");
            float sv[2][12];
#pragma unroll
            for (int k = 0; k < 8; ++k) {
                const int t = tt0 + k;
                const float cr = zr[k + 1], ck = zk[k + 1], cv = zv[k + 1];
                const float pr = zr[k], pk = zk[k], pv = zv[k];
                const float r = cr + (pr - cr) * mu_r, kx = ck + (pk - ck) * mu_k, v = cv + (pv - cv) * mu_v;
                const float w_raw = -fsoftplus(-accW[k]) - 0.5f;
                const float decay = __expf(-__expf(w_raw));
                const float iclr = fsig(accA[k]);
                const float kk = kx * kkc;
                const float nrm = sqrtf(wave_sum(kk * kk));
                const float kkn = kk / fmaxf(nrm, 1e-12f);
                const float kmod = kx * (1.0f + (iclr - 1.0f) * kac);
                const float bon = wave_sum(r * kmod * rkc) * v;
                float* svk = sv[k & 1];
                svk[0] = -kkn; svk[1] = kkn * iclr; svk[2] = decay; svk[3] = kmod; svk[4] = r; svk[5] = v; svk[6] = accG[k]; svk[7] = bon;
                { const float q = zq[k], f = zf[k];
                  const float omf = (1.0f - lb) * fsig(-f);
                  bH = fmaxf(bH + __logf(fmaxf(1.0f - omf, 1e-37f)), -85.0f);
                  svk[8] = q * fsig(q) * __expf(bH); svk[9] = omf * __expf(-bH); }
                svk[10] = 0.f; svk[11] = 0.f;
                if (c < 256) {
                  bG = fmaxf(bG - fsoftplus(-accL[k]) * (1.0f / 16.0f), -85.0f);
                  svk[10] = zgq[k] * 0.125f * __expf(bG); svk[11] = zgk[k] * __expf(-bG); }
                if (k & 1) {
                    const bool odd = (c & 1) != 0; const int cp = c & ~1; const size_t tp = (size_t)(t - 1 + (odd ? 1 : 0));
                    float lo[12], hi[12];
#pragma unroll
                    for (int st = 0; st < 12; ++st) { const float mine = odd ? sv[1][st] : sv[0][st], send = odd ? sv[0][st] : sv[1][st]; const float recv = dppmov<0xB1>(send);
                        lo[st] = odd ? recv : mine; hi[st] = odd ? mine : recv; }
                    { float* rs = p.RS + ((size_t)(c >> 6) * T + tp) * 384 + (cp & 63);
#pragma unroll
                      for (int st = 0; st < 6; ++st) *(f32x2v*)(rs + 64 * st) = (f32x2v){lo[st], hi[st]}; }
                    *(unsigned*)(p.rGate + tp * 512 + cp) = pg8::cvt_pk_bf16(lo[6], hi[6]); *(unsigned*)(p.rBonus + tp * 512 + cp) = pg8::cvt_pk_bf16(lo[7], hi[7]);
                    *(unsigned*)(p.cH + tp * 512 + cp) = pg8::cvt_pk_bf16(lo[8], hi[8]); *(unsigned*)(p.KH + tp * 512 + cp) = pg8::cvt_pk_bf16(lo[9], hi[9]);
                    if (c < 256) { *(unsigned*)(p.cG + tp * 256 + cp) = pg8::cvt_pk_bf16(lo[10], hi[10]); *(unsigned*)(p.KG + tp * 256 + cp) = pg8::cvt_pk_bf16(lo[11], hi[11]); }
                }
            }
        }
        }
        { const int h = c >> 7, j = c & 127; p.GamH[((size_t)tile * 4 + h) * 128 + j] = __expf(bH); }
        if (c < 256) { const int h = c >> 6, j = c & 63; p.GamG[((size_t)tile * 4 + h) * 64 + j] = __expf(bG); }
        __syncthreads();
        { const int wvt = c >> 6, lt = c & 63;
#pragma unroll 1
        for (int pass = 0; pass < 3; ++pass) {
            const int col0 = pass == 0 ? HG_I : (pass == 1 ? GL_V : SB_V); bf16_t* dstT = p.VtH + (size_t)pass * 512 * T;
            const bf16_t* src = p.z + (size_t)(t0 + lt) * ZLD + col0 + 64 * wvt;
            pg8::u32x4 xr[8];
#pragma unroll
            for (int j = 0; j < 8; ++j) xr[j] = *(const pg8::u32x4*)(src + 8 * j);
#pragma unroll
            for (int j = 0; j < 8; ++j) { const unsigned xw[4] = {xr[j].x, xr[j].y, xr[j].z, xr[j].w};
#pragma unroll
                for (int e = 0; e < 4; ++e) { vtile[64 * wvt + 8 * j + 2 * e][lt] = (bf16_t)(xw[e] & 0xffffu); vtile[64 * wvt + 8 * j + 2 * e + 1][lt] = (bf16_t)(xw[e] >> 16); } }
#pragma unroll
            for (int it = 0; it < 8; ++it) { const int row = 64 * wvt + it * 8 + (lt >> 3), sg = lt & 7;
                *(pg8::u32x4*)(dstT + (size_t)row * T + t0 + sg * 8) = *(const LAS pg8::u32x4*)&vtile[row][sg * 8]; }
        } }
    }
}

template <int KIND>
__device__ __forceinline__ void chain_unit(const MixArgs& p, const ConvArgs& cva, const int unit, const int seg, const int h, LAS float* lds) {
    constexpr int SF = KIND == 2 ? 512 : (KIND == 3 ? 320 : 384);
    constexpr int EPL = KIND == 2 ? 16 : 8, E2 = EPL / 2, DK = EPL * 8;
    constexpr int CH = 16, NP = CH * SF * 4 / 1024;
    static_assert(KIND == 0, "only the RWKV-7 chain is left (HGRN2 / GLA: intra_unit + chunk scan)");
    const float* stream = p.RS + ((size_t)h * T + (size_t)seg * LSEG) * SF;
    const int tid = phase_tid(), wv = __builtin_amdgcn_readfirstlane(tid >> 6), lane = tid & 63, rg = lane >> 3, lj = lane & 7;
    const bool isP = (KIND == 0) && (wv >= 4);
    const bool active = !(isP && seg == 0);
    const bool wantc = (KIND != 0) && (seg >= 1);
    const int rowA = ((KIND == 0) ? (wv & 3) : wv) * 16 + rg, rowB = rowA + 8;
    const int orow = (isP ? 64 : 0) + rowA;
    LAS float* ob = lds + 2 * CH * SF;
    LAS float* cb = ob;
    constexpr int NT = 8;
    const int jb0 = unit * (LSEG / 16) * NT;
    LAS bf16_t (*cvt)[64][66] = (LAS bf16_t (*)[64][66])(ob + 2 * 16 * 128);
    const int L = p.layer;
    f32x2v SA[E2], SB[E2];
#pragma unroll
    for (int e = 0; e < E2; ++e) { SA[e] = (f32x2v){0.f, 0.f}; SB[e] = (f32x2v){0.f, 0.f};
        if (isP) { if (lj * 8 + 2 * e == rowA) SA[e].x = 1.f; if (lj * 8 + 2 * e + 1 == rowA) SA[e].y = 1.f; if (lj * 8 + 2 * e == rowB) SB[e].x = 1.f; if (lj * 8 + 2 * e + 1 == rowB) SB[e].y = 1.f; } }
    f32x2v gam = (f32x2v){1.f, 1.f};
    auto stage = [&](int ci, LAS float* dst) {
        const char* g = (const char*)(stream + (size_t)ci * CH * SF) + lane * 16;
        for (int pc = wv; pc < NP; pc += 8) __builtin_amdgcn_global_load_lds((const unsigned*)(g + pc * 1024), (LAS unsigned*)((LAS char*)dst + pc * 1024), 16, 0, 0);
    };
    auto writeout = [&](int ci, const LAS float* o, const LAS float* cc) {
#pragma unroll
        for (int q = 0; q < 4; ++q) { const int idx = tid + 512 * q, s = idx >> 7, r = idx & 127; const size_t t = (size_t)seg * LSEG + ci * CH + s; const float v = o[idx];
            if (KIND == 0) { if (r < 64) p.oR[t * 512 + h * 64 + r] = v; else if (seg >= 1) p.cR[t * 512 + h * 64 + (r - 64)] = f2bf(v); }
            else if (KIND == 2) p.oH[t * 512 + h * 128 + r] = v;
            else p.oG[t * 512 + h * 128 + r] = v; }
        if (wantc) {
#pragma unroll
            for (int q = 0; q < (DK * 16) / 512; ++q) { const int idx = tid + 512 * q, s = idx / DK, k = idx % DK; const size_t t = (size_t)seg * LSEG + ci * CH + s;
                if (KIND == 2) p.cH[t * 512 + h * 128 + k] = f2bf(cc[s * 128 + k]); else p.cG[t * 256 + h * 64 + k] = f2bf(cc[s * 128 + k]); }
        }
    };
    constexpr int NCH = LSEG / CH;
    struct OpsR { f32x4v a0, a1, b0, b1, w0, w1, r0, r1, k0, k1; float vA, vB; };
    struct OpsG { f32x4v q[EPL / 4], w[EPL / 4], k[EPL / 4]; float vA, vB; f32x2v gw, gq; };
    const float vscale = isP ? 0.f : 1.f;
    const int goff = (EPL == 8) ? (lj * 8 + wv) : (lj * 16 + 2 * wv);
    stage(0, lds);
    for (int ci = 0; ci < NCH; ++ci) {
        asm volatile("s_waitcnt vmcnt(0)" ::: "memory"); __syncthreads();
        const LAS float* cur = lds + (ci & 1) * CH * SF;
        if (ci + 1 < NCH) stage(ci + 1, lds + ((ci + 1) & 1) * CH * SF);
        if (ci > 0) writeout(ci - 1, ob + ((ci - 1) & 1) * 2048, cb + ((ci - 1) & 1) * 2048);
        LAS float* oc = ob + (ci & 1) * 2048; LAS float* ccur = cb + (ci & 1) * 2048;
        if (ci > 0) {
#pragma unroll
            for (int k4 = 0; k4 < NT; ++k4) { CvJob jb; if (cvx_job(cva, jb0 + (ci - 1) * NT + k4, L, jb)) { const int n = tid >> 3, kc = (tid & 7) * 8;
                const LAS unsigned* tp = (const LAS unsigned*)&cvt[k4][n][kc]; pg8::u32x4 w; w.x = tp[0]; w.y = tp[1]; w.z = tp[2]; w.w = tp[3];
                *(pg8::u32x4*)(jb.dst + (size_t)n * jb.ldd + kc) = w; } }
        }
        float4 cvr[NT][2]; bool cvok[NT];
#pragma unroll
        for (int k4 = 0; k4 < NT; ++k4) { CvJob jb; cvok[k4] = cvx_job(cva, jb0 + ci * NT + k4, L, jb);
            cvr[k4][0] = make_float4(0.f, 0.f, 0.f, 0.f); cvr[k4][1] = cvr[k4][0];
            if (cvok[k4]) { const int c4 = (tid & 15) * 4, kr = tid >> 4;
                if (c4 < jb.valid) { cvr[k4][0] = *(const float4*)(jb.src + (size_t)(2 * kr) * jb.ld + c4); cvr[k4][1] = *(const float4*)(jb.src + (size_t)(2 * kr + 1) * jb.ld + c4); } } }
        if (active) {
            if constexpr (KIND == 0) {
                auto ld = [&](int s) { const LAS float* sp = cur + s * SF + lj * 8; OpsR o;
                    o.a0 = *(const LAS f32x4v*)(sp); o.a1 = *(const LAS f32x4v*)(sp + 4); o.b0 = *(const LAS f32x4v*)(sp + 64); o.b1 = *(const LAS f32x4v*)(sp + 68);
                    o.w0 = *(const LAS f32x4v*)(sp + 128); o.w1 = *(const LAS f32x4v*)(sp + 132); o.k0 = *(const LAS f32x4v*)(sp + 192); o.k1 = *(const LAS f32x4v*)(sp + 196);
                    o.r0 = *(const LAS f32x4v*)(sp + 256); o.r1 = *(const LAS f32x4v*)(sp + 260);
                    o.vA = cur[s * SF + 320 + rowA]; o.vB = cur[s * SF + 320 + rowB]; return o; };
                OpsR nx = ld(0);
#pragma unroll
                for (int s = 0; s < CH; ++s) {
                    const OpsR o = nx;
                    if (s + 1 < CH) nx = ld(s + 1);
                    f32x2v pa = SA[0] * o.a0.xy, pb = SB[0] * o.a0.xy; pa = SA[1] * o.a0.zw + pa; pb = SB[1] * o.a0.zw + pb;
                    f32x2v qa = SA[2] * o.a1.xy, qb = SB[2] * o.a1.xy; qa = SA[3] * o.a1.zw + qa; qb = SB[3] * o.a1.zw + qb; pa += qa; pb += qb;
                    float sA = pa.x + pa.y, sB = pb.x + pb.y;
                    sA += dppmov<0xB1>(sA); sB += dppmov<0xB1>(sB); sA += dppmov<0x4E>(sA); sB += dppmov<0x4E>(sB); sA += dppmov<0x141>(sA); sB += dppmov<0x141>(sB);
                    const f32x2v savA = (f32x2v){sA, sA}, savB = (f32x2v){sB, sB};
                    const float vA = o.vA * vscale, vB = o.vB * vscale; const f32x2v vvA = (f32x2v){vA, vA}, vvB = (f32x2v){vB, vB};
                    SA[0] = SA[0] * o.w0.xy + (savA * o.b0.xy + vvA * o.k0.xy); SB[0] = SB[0] * o.w0.xy + (savB * o.b0.xy + vvB * o.k0.xy);
                    SA[1] = SA[1] * o.w0.zw + (savA * o.b0.zw + vvA * o.k0.zw); SB[1] = SB[1] * o.w0.zw + (savB * o.b0.zw + vvB * o.k0.zw);
                    SA[2] = SA[2] * o.w1.xy + (savA * o.b1.xy + vvA * o.k1.xy); SB[2] = SB[2] * o.w1.xy + (savB * o.b1.xy + vvB * o.k1.xy);
                    SA[3] = SA[3] * o.w1.zw + (savA * o.b1.zw + vvA * o.k1.zw); SB[3] = SB[3] * o.w1.zw + (savB * o.b1.zw + vvB * o.k1.zw);
                    f32x2v oa = SA[0] * o.r0.xy, obb = SB[0] * o.r0.xy; oa = SA[1] * o.r0.zw + oa; obb = SB[1] * o.r0.zw + obb;
                    f32x2v oa2 = SA[2] * o.r1.xy, ob2 = SB[2] * o.r1.xy; oa2 = SA[3] * o.r1.zw + oa2; ob2 = SB[3] * o.r1.zw + ob2; oa += oa2; obb += ob2;
                    float oA = oa.x + oa.y, oB = obb.x + obb.y;
                    oA += dppmov<0xB1>(oA); oB += dppmov<0xB1>(oB); oA += dppmov<0x4E>(oA); oB += dppmov<0x4E>(oB); oA += dppmov<0x141>(oA); oB += dppmov<0x141>(oB);
                    if (lj == 0) { oc[s * 128 + orow] = oA; oc[s * 128 + orow + 8] = oB; }
                }
            } else {
                auto ld = [&](int s) { const LAS float* sp = cur + s * SF + lj * EPL; OpsG o;
#pragma unroll
                    for (int e4 = 0; e4 < EPL / 4; ++e4) { o.q[e4] = *(const LAS f32x4v*)(sp + e4 * 4); o.w[e4] = *(const LAS f32x4v*)(sp + DK + e4 * 4); o.k[e4] = *(const LAS f32x4v*)(sp + 2 * DK + e4 * 4); }
                    o.vA = cur[s * SF + 3 * DK + rowA]; o.vB = cur[s * SF + 3 * DK + rowB];
                    if constexpr (EPL == 8) { o.gw = (f32x2v){cur[s * SF + DK + goff], 1.f}; o.gq = (f32x2v){cur[s * SF + goff], 0.f}; }
                    else { o.gw = *(const LAS f32x2v*)(cur + s * SF + DK + goff); o.gq = *(const LAS f32x2v*)(cur + s * SF + goff); }
                    return o; };
                OpsG nx = ld(0);
#pragma unroll
                for (int s = 0; s < CH; ++s) {
                    const OpsG o = nx;
                    if (s + 1 < CH) nx = ld(s + 1);
                    const f32x2v vvA = (f32x2v){o.vA, o.vA}, vvB = (f32x2v){o.vB, o.vB};
                    f32x2v oa = (f32x2v){0.f, 0.f}, oa2 = oa, obb = oa, ob2 = oa;
#pragma unroll
                    for (int e4 = 0; e4 < EPL / 4; ++e4) {
                        SA[2 * e4] = SA[2 * e4] * o.w[e4].xy + vvA * o.k[e4].xy; SA[2 * e4 + 1] = SA[2 * e4 + 1] * o.w[e4].zw + vvA * o.k[e4].zw;
                        SB[2 * e4] = SB[2 * e4] * o.w[e4].xy + vvB * o.k[e4].xy; SB[2 * e4 + 1] = SB[2 * e4 + 1] * o.w[e4].zw + vvB * o.k[e4].zw;
                        oa = SA[2 * e4] * o.q[e4].xy + oa; oa2 = SA[2 * e4 + 1] * o.q[e4].zw + oa2; obb = SB[2 * e4] * o.q[e4].xy + obb; ob2 = SB[2 * e4 + 1] * o.q[e4].zw + ob2;
                    }
                    oa += oa2; obb += ob2;
                    float oA = oa.x + oa.y, oB = obb.x + obb.y;
                    oA += dppmov<0xB1>(oA); oB += dppmov<0xB1>(oB); oA += dppmov<0x4E>(oA); oB += dppmov<0x4E>(oB); oA += dppmov<0x141>(oA); oB += dppmov<0x141>(oB);
                    if (lj == 0) { oc[s * 128 + rowA] = oA; oc[s * 128 + rowB] = oB; }
                    gam *= o.gw; const f32x2v cq = o.gq * gam;
                    if (wantc && rg == 0) { if constexpr (EPL == 8) ccur[s * 128 + goff] = cq.x; else *(LAS f32x2v*)(ccur + s * 128 + goff) = cq; }
                }
            }
        }
        __syncthreads();
#pragma unroll
        for (int k4 = 0; k4 < NT; ++k4) if (cvok[k4]) { const int c4 = (tid & 15) * 4, kr = tid >> 4; const float4 v0 = cvr[k4][0], v1 = cvr[k4][1];
            *(LAS unsigned*)&cvt[k4][c4][2 * kr] = pg8::cvt_pk_bf16(v0.x, v1.x); *(LAS unsigned*)&cvt[k4][c4 + 1][2 * kr] = pg8::cvt_pk_bf16(v0.y, v1.y);
            *(LAS unsigned*)&cvt[k4][c4 + 2][2 * kr] = pg8::cvt_pk_bf16(v0.z, v1.z); *(LAS unsigned*)&cvt[k4][c4 + 3][2 * kr] = pg8::cvt_pk_bf16(v0.w, v1.w); }
    }
    __syncthreads();
#pragma unroll
    for (int k4 = 0; k4 < NT; ++k4) { CvJob jb; if (cvx_job(cva, jb0 + (NCH - 1) * NT + k4, L, jb)) { const int n = tid >> 3, kc = (tid & 7) * 8;
        const LAS unsigned* tp = (const LAS unsigned*)&cvt[k4][n][kc]; pg8::u32x4 w; w.x = tp[0]; w.y = tp[1]; w.z = tp[2]; w.w = tp[3];
        *(pg8::u32x4*)(jb.dst + (size_t)n * jb.ldd + kc) = w; } }
    writeout(NCH - 1, ob + ((NCH - 1) & 1) * 2048, cb + ((NCH - 1) & 1) * 2048);
    if (active) {
        float* dA;
        if (KIND == 0) dA = (isP ? p.PendR : p.SendR) + (((size_t)seg * 8 + h) * 64 + rowA) * 64 + lj * 8;
        else if (KIND == 2) dA = p.SendH + (((size_t)seg * 4 + h) * 128 + rowA) * 128 + lj * 16;
        else dA = p.SendG + (((size_t)seg * 4 + h) * 128 + rowA) * 64 + lj * 8;
        float* dB = dA + 8 * DK;
#pragma unroll
        for (int e = 0; e < E2; ++e) { dA[2 * e] = SA[e].x; dA[2 * e + 1] = SA[e].y; dB[2 * e] = SB[e].x; dB[2 * e + 1] = SB[e].y; }
    }
    if (wantc && rg == 0) {
        if constexpr (EPL == 8) p.GamG[(size_t)seg * 256 + h * 64 + lj * 8 + wv] = gam.x;
        else { p.GamH[(size_t)seg * 512 + h * 128 + lj * 16 + 2 * wv] = gam.x; p.GamH[(size_t)seg * 512 + h * 128 + lj * 16 + 2 * wv + 1] = gam.y; }
    }
    __syncthreads();
}
__device__ __forceinline__ void sb_phase(const MixArgs& p, const int wave0, const int W, const int uend);
template <int DK>
__device__ __forceinline__ void intra_unit(const MixArgs& p, const int h, const int chunk, LAS bf16_t* ktT, const int lane) {
    typedef short bf16x8v __attribute__((ext_vector_type(8)));
    typedef float f32x16v __attribute__((ext_vector_type(16)));
    typedef __bf16 bf16x2n __attribute__((ext_vector_type(2)));
    constexpr int QP = DK * 4, NKS = DK / 16, NKB = DK / 32;
    const bf16_t* Qb = (DK == 128 ? p.cH : p.cG) + h * DK; const bf16_t* Kb = (DK == 128 ? p.KH : p.KG) + h * DK;
    const bf16_t* Vt = (DK == 128 ? p.VtH : p.VtG) + (size_t)h * 128 * T;
    float* ol = (DK == 128 ? p.oH : p.oG) + h * 128; float* Send = (DK == 128 ? p.SendH : p.SendG) + ((size_t)chunk * 4 + h) * 128 * DK;
    const int r = lane & 31, hh = lane >> 5, t0 = chunk * 64;
#pragma unroll 1
    for (int tb = 0; tb < 2; ++tb) {
        bf16x8v Qf[NKS];
#pragma unroll
        for (int ks = 0; ks < NKS; ++ks) Qf[ks] = *(const bf16x8v*)(Qb + (unsigned)((t0 + 32 * tb + r) * QP + 16 * ks + 8 * hh));
#pragma unroll 1
        for (int vh = 0; vh < 2; ++vh) {
            f32x16v O[2];
#pragma unroll
            for (int vb = 0; vb < 2; ++vb)
#pragma unroll
                for (int i = 0; i < 16; ++i) O[vb][i] = 0.f;
            for (int sb = 0; sb <= tb; ++sb) {
                f32x16v P;
#pragma unroll
                for (int i = 0; i < 16; ++i) P[i] = 0.f;
#pragma unroll
                for (int ks = 0; ks < NKS; ++ks) { const bf16x8v Kf = *(const bf16x8v*)(Kb + (unsigned)((t0 + 32 * sb + r) * QP + 16 * ks + 8 * hh));
                    P = __builtin_amdgcn_mfma_f32_32x32x16_bf16(Kf, Qf[ks], P, 0, 0, 0); }
                const bool diag = (sb == tb);
                bf16x8v Pf[2];
#pragma unroll
                for (int s2 = 0; s2 < 2; ++s2) {
                    union { bf16x2n h2[4]; bf16x8v v; } pk;
#pragma unroll
                    for (int j = 0; j < 4; ++j) { f32x2v f;
                        { const int i = 8 * s2 + 2 * j, kr = (i & 3) + 8 * (i >> 2) + 4 * hh; f.x = (!diag || kr <= r) ? P[i] : 0.f; }
                        { const int i = 8 * s2 + 2 * j + 1, kr = (i & 3) + 8 * (i >> 2) + 4 * hh; f.y = (!diag || kr <= r) ? P[i] : 0.f; }
                        pk.h2[j] = __builtin_convertvector(f, bf16x2n); }
                    Pf[s2] = pk.v; }
#pragma unroll
                for (int vb = 0; vb < 2; ++vb)
#pragma unroll
                    for (int s2 = 0; s2 < 2; ++s2) { const bf16_t* vp = Vt + (unsigned)((32 * (2 * vh + vb) + r) * T + t0 + 32 * sb + 16 * s2 + 4 * hh);
                        union { pg8::u32x2 d[2]; bf16x8v v; } vf; vf.d[0] = *(const pg8::u32x2*)vp; vf.d[1] = *(const pg8::u32x2*)(vp + 8);
                        O[vb] = __builtin_amdgcn_mfma_f32_32x32x16_bf16(vf.v, Pf[s2], O[vb], 0, 0, 0); }
            }
#pragma unroll
            for (int vb = 0; vb < 2; ++vb)
#pragma unroll
                for (int g = 0; g < 4; ++g) { f32x4v w; w.x = O[vb][4 * g]; w.y = O[vb][4 * g + 1]; w.z = O[vb][4 * g + 2]; w.w = O[vb][4 * g + 3];
                    *(f32x4v*)(ol + (unsigned)((t0 + 32 * tb + r) * 512 + 32 * (2 * vh + vb) + 8 * g + 4 * hh)) = w; }
        }
    }
#pragma unroll 8
    for (int it = 0; it < DK / 8; ++it) { const int pidx = it * 64 + lane, srow = pidx / (DK / 8), cb8 = pidx % (DK / 8);
        const pg8::u32x4 w = *(const pg8::u32x4*)(Kb + (unsigned)((t0 + srow) * QP + cb8 * 8));
        const unsigned ww[4] = {w.x, w.y, w.z, w.w};
#pragma unroll
        for (int j = 0; j < 4; ++j) { ktT[(cb8 * 8 + 2 * j) * 66 + srow] = (bf16_t)(ww[j] & 0xffffu); ktT[(cb8 * 8 + 2 * j + 1) * 66 + srow] = (bf16_t)(ww[j] >> 16); } }
    bf16x8v AfAll[4][4];
#pragma unroll
    for (int vb = 0; vb < 4; ++vb)
#pragma unroll
        for (int ks = 0; ks < 4; ++ks) AfAll[vb][ks] = *(const bf16x8v*)(Vt + (unsigned)((32 * vb + r) * T + t0 + 16 * ks + 8 * hh));
#pragma unroll
    for (int vb = 0; vb < 4; ++vb) {
        const bf16x8v (&Af)[4] = AfAll[vb];
#pragma unroll 1
        for (int kb = 0; kb < NKB; ++kb) {
            f32x16v U;
#pragma unroll
            for (int i = 0; i < 16; ++i) U[i] = 0.f;
#pragma unroll
            for (int ks = 0; ks < 4; ++ks) { const LAS unsigned* tp = (const LAS unsigned*)(ktT + (32 * kb + r) * 66 + 16 * ks + 8 * hh);
                union { unsigned d[4]; bf16x8v v; } bf; bf.d[0] = tp[0]; bf.d[1] = tp[1]; bf.d[2] = tp[2]; bf.d[3] = tp[3];
                U = __builtin_amdgcn_mfma_f32_32x32x16_bf16(Af[ks], bf.v, U, 0, 0, 0); }
            float* sp = Send + (unsigned)((32 * vb + 4 * hh) * DK + 32 * kb + r);
#pragma unroll
            for (int i = 0; i < 16; ++i) sp[((i & 3) + 8 * (i >> 2)) * DK] = U[i];
        }
    }
}
__device__ __forceinline__ void chains_phase(const MixArgs& p, const ConvArgs& cva, unsigned* sbq, LAS unsigned char* ldsraw) {
    LAS float* lds = (LAS float*)ldsraw;
    for (int u = blockIdx.x; u < 8 * NSEG; u += gridDim.x) chain_unit<0>(p, cva, u, u >> 3, u & 7, lds);
    LAS int* slot = (LAS int*)(ldsraw + 8 * 128 * 66 * 2);
    const int ptid = phase_tid(), wv = ptid >> 6, lane = ptid & 63;
    LAS bf16_t* ktT = (LAS bf16_t*)ldsraw + (size_t)wv * 128 * 66;
    for (;;) {
        __syncthreads();
        if (ptid == 0) slot[0] = (int)__hip_atomic_fetch_add(sbq, 8u, __ATOMIC_RELAXED, __HIP_MEMORY_SCOPE_AGENT);
        __syncthreads();
        const int base = slot[0];
        if (base >= 2048) break;
        const int u = base + wv; if (u < 1024) intra_unit<128>(p, u & 3, u >> 2, ktT, lane); else intra_unit<64>(p, (u - 1024) & 3, (u - 1024) >> 2, ktT, lane);
    }
}
__device__ __forceinline__ void sb_queue(const MixArgs& p, unsigned* sbq2, LAS unsigned char* ldsraw) {
    LAS int* slot = (LAS int*)(ldsraw + 8 * 128 * 66 * 2);
    const int ptid = phase_tid();
    for (;;) {
        __syncthreads();
        if (ptid == 0) slot[0] = (int)__hip_atomic_fetch_add(sbq2, 8u, __ATOMIC_RELAXED, __HIP_MEMORY_SCOPE_AGENT);
        __syncthreads();
        const int base = slot[0];
        if (base >= 2048) break;
        sb_phase(p, base, 1 << 30, 2048);
    }
}

__device__ __forceinline__ void carry_phase(const MixArgs& p, LAS unsigned char* ldsraw, const int part) {
    const int tid = phase_tid();
    if (part != 2) for (int u = blockIdx.x; u < 32; u += gridDim.x) {
        const int h = u >> 2, vq = u & 3;
        LAS float (*cur)[68] = (LAS float (*)[68])ldsraw; LAS float (*Pm)[68] = (LAS float (*)[68])(ldsraw + 16 * 68 * 4);
        const int vl = tid >> 5, kb = (tid & 31) * 2;
        const int pv = tid >> 3, pk = (tid & 7) * 8;
        const size_t eoS = (size_t)(16 * vq + vl) * 64 + kb, eoP = (size_t)pv * 64 + pk;
        f32x2v nv; f32x4v rP0[4], rP1[4]; f32x2v rS[4];
        nv = *(const f32x2v*)(p.SendR + ((size_t)0 * 8 + h) * 4096 + eoS);
#pragma unroll
        for (int j = 1; j < 4; ++j) { rP0[j] = *(const f32x4v*)(p.PendR + ((size_t)j * 8 + h) * 4096 + eoP); rP1[j] = *(const f32x4v*)(p.PendR + ((size_t)j * 8 + h) * 4096 + eoP + 4);
            rS[j] = *(const f32x2v*)(p.SendR + ((size_t)j * 8 + h) * 4096 + eoS); }
        rP0[0] = rP0[1]; rP1[0] = rP1[1]; rS[0] = rS[1];
        for (int sb = 0; sb < NSEG; sb += 4) {
#pragma unroll
            for (int j = 0; j < 4; ++j) { const int s = sb + j;
                if (s >= 1) {
                    __syncthreads();
                    *(unsigned*)(p.SstR + ((size_t)s * 8 + h) * 4096 + eoS) = pg8::cvt_pk_bf16(nv.x, nv.y);
                    if (s < NSEG - 1) {
                        *(LAS f32x2v*)&cur[vl][kb] = nv;
                        *(LAS f32x4v*)&Pm[pv][pk] = rP0[j]; *(LAS f32x4v*)&Pm[pv][pk + 4] = rP1[j];
                        nv = rS[j];
                        __syncthreads();
                        if (s + 3 < NSEG - 1) { constexpr int dummy = 0; (void)dummy; const int jn = (j + 3) & 3;
                            rP0[jn] = *(const f32x4v*)(p.PendR + ((size_t)(s + 3) * 8 + h) * 4096 + eoP); rP1[jn] = *(const f32x4v*)(p.PendR + ((size_t)(s + 3) * 8 + h) * 4096 + eoP + 4);
                            rS[jn] = *(const f32x2v*)(p.SendR + ((size_t)(s + 3) * 8 + h) * 4096 + eoS); }
#pragma unroll 4
                        for (int i4 = 0; i4 < 64; i4 += 4) { const f32x4v c4 = *(const LAS f32x4v*)&cur[vl][i4];
#pragma unroll
                            for (int ii = 0; ii < 4; ++ii) { const f32x2v p2 = *(const LAS f32x2v*)&Pm[i4 + ii][kb]; const float c = c4[ii]; nv = (f32x2v){c, c} * p2 + nv; } }
                    }
                }
            }
        }
        __syncthreads();
    }
    if (part != 1) for (int u = blockIdx.x; u < 32 + 192; u += gridDim.x) {
        if (u < 32) continue;
        const bool isH = u < 32 + 128; const int idx = (isH ? (u - 32) : (u - 160)) * 512 + tid;
        const float* Ub = (isH ? p.SendH : p.SendG) + idx; bf16_t* Sb = (isH ? p.SstH : p.SstG) + idx; const size_t cstr = isH ? 65536 : 32768;
        const float* Gb = isH ? p.GamH + (idx >> 14) * 128 + (idx & 127) : p.GamG + (idx >> 13) * 64 + (idx & 63); const int gstr = isH ? 512 : 256;
        float S = 0.f;
        float uu[16], gg[16], un[16], gn[16];
#pragma unroll
        for (int j = 0; j < 16; ++j) { un[j] = Ub[(size_t)j * cstr]; gn[j] = Gb[(size_t)j * gstr]; }
        for (int c0 = 0; c0 < NCHK; c0 += 16) {
#pragma unroll
            for (int j = 0; j < 16; ++j) { uu[j] = un[j]; gg[j] = gn[j]; }
            if (c0 + 16 < NCHK) {
#pragma unroll
                for (int j = 0; j < 16; ++j) { un[j] = Ub[(size_t)(c0 + 16 + j) * cstr]; gn[j] = Gb[(size_t)(c0 + 16 + j) * gstr]; } }
#pragma unroll
            for (int j = 0; j < 16; ++j) { Sb[(size_t)(c0 + j) * cstr] = f2bf(S); S = gg[j] * (S + uu[j]); }
        }
    }
}

__device__ __forceinline__ void mixfin_phase(const MixArgs& p) {
    typedef short bf16x8v __attribute__((ext_vector_type(8)));
    const int tid = phase_tid(), wv = tid >> 6, lane = tid & 63, r = lane & 15, q = lane >> 4, L = p.layer;
    const int W = gridDim.x * 8;
    for (int u = blockIdx.x * 8 + wv; u < 16384; u += W) {
        if (u < 8192) {
            const int tt = u >> 3, h = u & 7, t0 = tt * 16, seg = t0 / LSEG;
            f32x4v acc[4];
#pragma unroll
            for (int nb = 0; nb < 4; ++nb) acc[nb] = (f32x4v){0.f, 0.f, 0.f, 0.f};
            if (seg >= 1) {
#pragma unroll
                for (int ks = 0; ks < 2; ++ks) { const bf16x8v A = *(const bf16x8v*)(p.cR + (size_t)(t0 + r) * 512 + h * 64 + ks * 32 + q * 8);
#pragma unroll
                    for (int nb = 0; nb < 4; ++nb) { const bf16x8v B = *(const bf16x8v*)(p.SstR + (((size_t)seg * 8 + h) * 64 + nb * 16 + r) * 64 + ks * 32 + q * 8);
                        acc[nb] = __builtin_amdgcn_mfma_f32_16x16x32_bf16(A, B, acc[nb], 0, 0, 0); } }
            }
            float oin[4][4], bon[4][4], gat[4][4], lnw[4], lnb[4];
#pragma unroll
            for (int nb = 0; nb < 4; ++nb) { const int c = h * 64 + nb * 16 + r; lnw[nb] = p.rw_ln_w[L * 512 + c]; lnb[nb] = p.rw_ln_b[L * 512 + c];
#pragma unroll
                for (int i = 0; i < 4; ++i) { const size_t t = (size_t)t0 + 4 * q + i; oin[i][nb] = p.oR[t * 512 + c]; bon[i][nb] = bf2f(p.rBonus[t * 512 + c]); gat[i][nb] = bf2f(p.rGate[t * 512 + c]); } }
#pragma unroll
            for (int i = 0; i < 4; ++i) { const size_t t = (size_t)t0 + 4 * q + i; float o[4]; float s = 0.f;
#pragma unroll
                for (int nb = 0; nb < 4; ++nb) { o[nb] = acc[nb][i] + oin[i][nb]; s += o[nb]; }
                const float mu = red16(s) * (1.0f / 64.0f); float d2 = 0.f;
#pragma unroll
                for (int nb = 0; nb < 4; ++nb) { o[nb] -= mu; d2 += o[nb] * o[nb]; }
                const float rstd = rsqrtf(red16(d2) * (1.0f / 64.0f) + 64e-5f);
#pragma unroll
                for (int nb = 0; nb < 4; ++nb) { const int c = h * 64 + nb * 16 + r; const float y = o[nb] * rstd * lnw[nb] + lnb[nb];
                    p.bo[(size_t)T * 512 + t * 512 + c] = f2bf((y + bon[i][nb]) * gat[i][nb]); } }
        } else {
            const bool isH = u < 12288; const int qq = isH ? u - 8192 : u - 12288;
            const int tt = qq >> 2, h = qq & 3, t0 = tt * 16, seg = t0 >> 6;
            f32x4v acc[8];
#pragma unroll
            for (int nb = 0; nb < 8; ++nb) acc[nb] = (f32x4v){0.f, 0.f, 0.f, 0.f};
            if (seg >= 1) {
                if (isH) {
#pragma unroll
                    for (int ks = 0; ks < 4; ++ks) { const bf16x8v A = *(const bf16x8v*)(p.cH + (size_t)(t0 + r) * 512 + h * 128 + ks * 32 + q * 8);
#pragma unroll
                        for (int nb = 0; nb < 8; ++nb) { const bf16x8v B = *(const bf16x8v*)(p.SstH + (((size_t)seg * 4 + h) * 128 + nb * 16 + r) * 128 + ks * 32 + q * 8);
                            acc[nb] = __builtin_amdgcn_mfma_f32_16x16x32_bf16(A, B, acc[nb], 0, 0, 0); } }
                } else {
#pragma unroll
                    for (int ks = 0; ks < 2; ++ks) { const bf16x8v A = *(const bf16x8v*)(p.cG + (size_t)(t0 + r) * 256 + h * 64 + ks * 32 + q * 8);
#pragma unroll
                        for (int nb = 0; nb < 8; ++nb) { const bf16x8v B = *(const bf16x8v*)(p.SstG + (((size_t)seg * 4 + h) * 128 + nb * 16 + r) * 64 + ks * 32 + q * 8);
                            acc[nb] = __builtin_amdgcn_mfma_f32_16x16x32_bf16(A, B, acc[nb], 0, 0, 0); } }
                }
            }
            const float* ol = isH ? p.oH : p.oG; const float* gain = (isH ? p.hg_norm_w : p.gla_norm_w) + L * 512; const int gcol = isH ? HG_G : GL_R;
            bf16_t* bo = p.bo + (isH ? (size_t)0 : (size_t)3 * T * 512);
            float oin[4][8], gin[4][8], gn[8];
#pragma unroll
            for (int nb = 0; nb < 8; ++nb) { const int c = h * 128 + nb * 16 + r; gn[nb] = gain[c];
#pragma unroll
                for (int i = 0; i < 4; ++i) { const size_t t = (size_t)t0 + 4 * q + i; oin[i][nb] = ol[t * 512 + c]; gin[i][nb] = bf2f(p.z[t * ZLD + gcol + c]); } }
#pragma unroll
            for (int i = 0; i < 4; ++i) { const size_t t = (size_t)t0 + 4 * q + i; float o[8]; float ss = 0.f;
#pragma unroll
                for (int nb = 0; nb < 8; ++nb) { o[nb] = acc[nb][i] + oin[i][nb]; ss += o[nb] * o[nb]; }
                const float rs = rsqrtf(red16(ss) * (1.0f / 128.0f) + 1e-5f);
#pragma unroll
                for (int nb = 0; nb < 8; ++nb) { const int c = h * 128 + nb * 16 + r;
                    bo[t * 512 + c] = f2bf(o[nb] * rs * gn[nb] * siluf_(gin[i][nb])); } }
        }
    }
}
__device__ __forceinline__ void sb_phase(const MixArgs& p, const int wave0, const int W, const int uend) {
    typedef short bf16x8v __attribute__((ext_vector_type(8)));
    typedef float f32x16v __attribute__((ext_vector_type(16)));
    typedef __bf16 bf16x2n __attribute__((ext_vector_type(2)));
    const int tid = phase_tid(), wv = tid >> 6, lane = tid & 63, r = lane & 31, hh = lane >> 5;
    const float scale = 0.08838834764831845f;
    for (int u = wave0 + wv; u < uend; u += W) {
        const int h = u & 3, qb = u >> 2, q0 = qb * 32;
        bf16x8v Qf[8];
#pragma unroll
        for (int s = 0; s < 8; ++s) Qf[s] = *(const bf16x8v*)(p.z + (size_t)(q0 + r) * ZLD + SB_Q + h * 128 + s * 16 + hh * 8);
        f32x16v O[4];
#pragma unroll
        for (int db = 0; db < 4; ++db)
#pragma unroll
            for (int i = 0; i < 16; ++i) O[db][i] = 0.f;
        float R = 0.f;
        bf16x8v Kn[8];
#pragma unroll
        for (int s = 0; s < 8; ++s) Kn[s] = *(const bf16x8v*)(p.z + (size_t)(qb * 32 + r) * ZLD + SB_K + h * 128 + s * 16 + hh * 8);
        for (int kb = qb; kb >= 0; --kb) {
            const int k0 = kb * 32;
            f32x16v Sacc;
#pragma unroll
            for (int i = 0; i < 16; ++i) Sacc[i] = 0.f;
#pragma unroll
            for (int s = 0; s < 8; ++s) Sacc = __builtin_amdgcn_mfma_f32_32x32x16_bf16(Kn[s], Qf[s], Sacc, 0, 0, 0);
            { const int kn0 = (kb > 0 ? kb - 1 : 0) * 32;
#pragma unroll
              for (int s = 0; s < 8; ++s) Kn[s] = *(const bf16x8v*)(p.z + (size_t)(kn0 + r) * ZLD + SB_K + h * 128 + s * 16 + hh * 8); }
            float lk[16], zz[16]; bool valid[16];
            const bool diag = (kb == qb);
#pragma unroll
            for (int i = 0; i < 16; ++i) { const int kr = (i & 3) + 8 * (i >> 2) + 4 * hh;
                valid[i] = !diag || (kr < r);
                zz[i] = Sacc[i] * scale;
                const float sp = fmaxf(zz[i], 0.f) + __logf(1.0f + __expf(-fabsf(zz[i])));
                lk[i] = valid[i] ? -sp : 0.f; }
            float G[4], Gp[4];
#pragma unroll
            for (int g = 0; g < 4; ++g) { G[g] = (lk[4 * g] + lk[4 * g + 1]) + (lk[4 * g + 2] + lk[4 * g + 3]); Gp[g] = __shfl_xor(G[g], 32); }
            float Tq[4]; float run = 0.f;
#pragma unroll
            for (int g = 3; g >= 0; --g) { Tq[g] = run + (hh == 0 ? Gp[g] : 0.f); run += G[g] + Gp[g]; }
            float wgt[16];
#pragma unroll
            for (int g = 0; g < 4; ++g) { float ing = 0.f;
#pragma unroll
                for (int j = 3; j >= 0; --j) { const int i = 4 * g + j;
                    const float logw = zz[i] + lk[i] + (R + Tq[g] + ing);
                    wgt[i] = valid[i] ? __expf(logw) : 0.f;
                    ing += lk[i]; } }
            R += run;
            bf16x8v Pf[2];
#pragma unroll
            for (int s2 = 0; s2 < 2; ++s2) {
                union { bf16x2n h2[4]; bf16x8v v; } pk;
#pragma unroll
                for (int j = 0; j < 4; ++j) { f32x2v f; f.x = wgt[8 * s2 + 2 * j]; f.y = wgt[8 * s2 + 2 * j + 1]; pk.h2[j] = __builtin_convertvector(f, bf16x2n); }
                Pf[s2] = pk.v; }
#pragma unroll
            for (int db = 0; db < 4; ++db)
#pragma unroll
                for (int s2 = 0; s2 < 2; ++s2) { const bf16_t* vp = p.Vt + (size_t)(h * 128 + db * 32 + r) * T + k0 + 16 * s2 + 4 * hh;
                    union { pg8::u32x2 d[2]; bf16x8v v; } vf; vf.d[0] = *(const pg8::u32x2*)vp; vf.d[1] = *(const pg8::u32x2*)(vp + 8);
                    O[db] = __builtin_amdgcn_mfma_f32_32x32x16_bf16(vf.v, Pf[s2], O[db], 0, 0, 0); }
            if (__all(R < -104.0f)) break;
        }
        bf16_t* bo2 = p.bo + (size_t)2 * T * 512 + (size_t)(q0 + r) * 512 + h * 128;
#pragma unroll
        for (int db = 0; db < 4; ++db)
#pragma unroll
            for (int g = 0; g < 4; ++g) { pg8::u32x2 w; w.x = (unsigned)f2bf(O[db][4 * g]) | ((unsigned)f2bf(O[db][4 * g + 1]) << 16); w.y = (unsigned)f2bf(O[db][4 * g + 2]) | ((unsigned)f2bf(O[db][4 * g + 3]) << 16);
                *(pg8::u32x2*)(bo2 + db * 32 + 8 * g + 4 * hh) = w; }
    }
}

#define XB_TMO      128
#define XB_XCNT(j)  (256  + 64 * (j))
#define XB_XSUB(j)  (1280 + 64 * (j))
#define XB_XGEN(j)  (2304 + 64 * (j))
#define XB_TOP      3328
#define XB_TOPGEN   3392
#define XCD_BAR_WORDS 3456
#define XB_SPIN_CAP (1u << 18)
__device__ __forceinline__ unsigned xb_ld(unsigned* p)              { return __hip_atomic_load(p, __ATOMIC_RELAXED, __HIP_MEMORY_SCOPE_AGENT); }
__device__ __forceinline__ unsigned xb_add(unsigned* p, unsigned v) { return __hip_atomic_fetch_add(p, v, __ATOMIC_RELAXED, __HIP_MEMORY_SCOPE_AGENT); }
__device__ __forceinline__ unsigned xb_xcc_id() { return (unsigned)__builtin_amdgcn_s_getreg((3 << 11) | 20) & 0xFu; }
#define XB_SPIN(cond, bar) do { unsigned _sp = 0; while (cond) { __builtin_amdgcn_s_sleep(1); \
    if ((++_sp & 255u) == 0u) { if (xb_ld(&(bar)[XB_TMO])) break; if (_sp > XB_SPIN_CAP) { atomicAdd(&(bar)[XB_TMO], 1u); break; } } } } while (0)
struct XcdBarrier { unsigned* bar; unsigned x; volatile LAS unsigned* st; };
__device__ __forceinline__ XcdBarrier xcd_barrier_post(unsigned* bar, volatile LAS unsigned* st) {
    XcdBarrier b; b.bar = bar; b.x = xb_xcc_id(); b.st = st;
    if (threadIdx.x == 0) (void)xb_add(&bar[XB_XCNT(b.x)], 1u);
    return b;
}
__device__ __forceinline__ void xcd_barrier_complete(unsigned* bar, unsigned x, unsigned& nloc, unsigned& nx) {
    const unsigned G = gridDim.x * gridDim.y * gridDim.z;
    unsigned sum, cnt, mine, sp = 0u;
    for (;;) {
        sum = 0u; cnt = 0u; mine = 0u;
#pragma unroll
        for (unsigned j = 0; j < 16; ++j) { const unsigned c = xb_ld(&bar[XB_XCNT(j)]); sum += c; cnt += (c > 0u) ? 1u : 0u; mine = (j == x) ? c : mine; }
        if (sum == G) break;
        __builtin_amdgcn_s_sleep(1);
        if ((++sp & 255u) == 0u) { if (xb_ld(&bar[XB_TMO])) break; if (sp > XB_SPIN_CAP) { atomicAdd(&bar[XB_TMO], 1u); break; } }
    }
    nloc = mine > 0u ? mine : 1u; nx = cnt > 0u ? cnt : 1u;
}
__device__ __forceinline__ void xcd_barrier(const XcdBarrier& b) {
    asm volatile("s_waitcnt vmcnt(0)" ::: "memory");
    __syncthreads();
    if (threadIdx.x == 0) {
        unsigned* bar = b.bar;
        __builtin_amdgcn_s_waitcnt(0);
        unsigned nloc = b.st[0], nx = b.st[1];
        if (nloc == 0u) { xcd_barrier_complete(bar, b.x, nloc, nx); b.st[0] = nloc; b.st[1] = nx; }
        const unsigned old = xb_add(&bar[XB_XSUB(b.x)], 1u);
        const unsigned gen = old / nloc;
        if (old + 1u == (gen + 1u) * nloc) {
            __builtin_amdgcn_fence(__ATOMIC_RELEASE, "agent");
            asm volatile("s_waitcnt vmcnt(0)" ::: "memory");
            const unsigned og = xb_add(&bar[XB_TOP], 1u);
            const unsigned tg = og / nx;
            if (og + 1u == (tg + 1u) * nx) xb_add(&bar[XB_TOPGEN], 1u);
            else XB_SPIN(xb_ld(&bar[XB_TOPGEN]) == tg, bar);
            __builtin_amdgcn_fence(__ATOMIC_ACQUIRE, "agent");
            xb_add(&bar[XB_XGEN(b.x)], 1u);
            asm volatile("s_waitcnt vmcnt(0)" ::: "memory");
        } else {
            XB_SPIN(xb_ld(&bar[XB_XGEN(b.x)]) == gen, bar);
            __builtin_amdgcn_fence(__ATOMIC_ACQUIRE, "agent");
            asm volatile("s_waitcnt vmcnt(0)" ::: "memory");
        }
    }
    __syncthreads();
}


constexpr size_t al256(size_t x) { return (x + 255) & ~(size_t)255; }
constexpr size_t TS_ = (size_t)T * 512 * 4;
constexpr int YLD = D + 64;
constexpr size_t OFF_BAR = 0;
constexpr size_t OFF_Z = al256(OFF_BAR + 3456 * 4);
constexpr size_t OFF_RS = OFF_Z + al256((size_t)T * ZLD * 2);
constexpr size_t OFF_XB = al256(OFF_RS + (size_t)8 * T * 384 * 4);
constexpr size_t OFF_REGM = al256(OFF_XB + (size_t)T * D * 2);
constexpr size_t OFF_KH = OFF_REGM, OFF_KG = OFF_KH + (size_t)T * 512 * 2, OFF_VTH = OFF_KG + (size_t)T * 256 * 2, OFF_VTG = OFF_VTH + (size_t)512 * T * 2, OFF_VT = OFF_VTG + (size_t)512 * T * 2;
constexpr size_t OFF_RGATE = OFF_VT + (size_t)512 * T * 2, OFF_RBONUS = OFF_RGATE + TS_;
constexpr size_t OFF_SENDH = OFF_RBONUS + TS_, OFF_SENDG = OFF_SENDH + (size_t)NCHK * 4 * 128 * 128 * 4, OFF_SSTH = OFF_SENDG + (size_t)NCHK * 4 * 128 * 64 * 4, OFF_SSTG = OFF_SSTH + (size_t)NCHK * 4 * 128 * 128 * 2;
constexpr size_t OFF_GAMH = OFF_SSTG + (size_t)NCHK * 4 * 128 * 64 * 2, OFF_GAMG = OFF_GAMH + (size_t)NCHK * 4 * 128 * 4, OFF_REGM_END = OFF_GAMG + (size_t)NCHK * 4 * 64 * 4;
constexpr size_t OFF_HBUF = OFF_REGM, OFF_X1 = OFF_REGM + (size_t)MAXROWS * FW * 2;
constexpr size_t OFF_OR = al256(OFF_REGM + (size_t)MAXROWS * FW * 2 + (size_t)T * D * 4);
constexpr size_t OFF_OH = OFF_OR + TS_, OFF_OG = OFF_OH + TS_, OFF_CR = OFF_OG + TS_, OFF_CH = OFF_CR + TS_ / 2, OFF_CG = OFF_CH + TS_ / 2;
constexpr size_t OFF_SENDR = OFF_CG + TS_ / 4, OFF_PENDR = OFF_SENDR + (size_t)NSEG * 8 * 64 * 64 * 4, OFF_SSTR = OFF_PENDR + (size_t)NSEG * 8 * 64 * 64 * 4;
constexpr size_t OFF_BO = al256(OFF_SSTR + (size_t)NSEG * 8 * 64 * 64 * 2);
constexpr size_t OFF_MERGED = OFF_BO + 4 * (size_t)T * 512 * 2, OFF_MERGEDB = OFF_MERGED + (size_t)T * D * 4, OFF_X1B = OFF_MERGEDB + (size_t)T * D * 2;
constexpr size_t OFF_WINT = OFF_X1B + (size_t)T * D * 2, OFF_WGUT = OFF_WINT + (size_t)ZLD * D * 2, OFF_WDT = OFF_WGUT + (size_t)65 * 1024 * D * 2, OFF_WBRT = OFF_WDT + (size_t)65 * D * FW * 2, OFF_WOUTT = OFF_WBRT + (size_t)4 * D * FW * 2;
constexpr size_t OFF_IDX = OFF_WOUTT + (size_t)D * D * 2, OFF_WSEL = OFF_IDX + (size_t)T * 8 * 4, OFF_HIST = OFF_WSEL + (size_t)T * 8 * 4, OFF_ROWTOK = OFF_HIST + 256 * 64 * 4;
constexpr size_t OFF_ROWW = OFF_ROWTOK + (size_t)MAXROWS * 4, OFF_SLOTPOS = OFF_ROWW + (size_t)MAXROWS * 4, OFF_PANEXP = OFF_SLOTPOS + (size_t)T * 8 * 4, OFF_NPAN = al256(OFF_PANEXP + MAXPANELS * 4);
constexpr size_t OFF_WRH = OFF_NPAN + 256, OFF_WRL = OFF_WRH + (size_t)2 * NE * D * 2;
constexpr size_t OFF_W2T = OFF_WRL + (size_t)2 * NE * D * 2, OFF_A2T = OFF_W2T + (size_t)2 * 512 * 32 * 2, OFF_G2T = OFF_A2T + (size_t)2 * 512 * 32 * 2, OFF_GGT = OFF_G2T + (size_t)2 * 512 * 96 * 2;
constexpr size_t WS_NEEDED = OFF_GGT + (size_t)2 * 256 * 32 * 2;
static_assert(OFF_RS + (size_t)8 * T * 384 * 4 - OFF_Z >= (size_t)MAXROWS * YLD * 2, "ybuf must fit in region Y");
static_assert(OFF_REGM_END <= OFF_OR, "region M");
static_assert(OFF_VTG == OFF_VTH + (size_t)512 * T * 2 && OFF_VT == OFF_VTG + (size_t)512 * T * 2, "prep writes VtH, VtG, Vt as one array of three");
__device__ __forceinline__ void ln_row(const float (&v)[32], float s, const float* __restrict__ w, const float* __restrict__ b, bf16_t* __restrict__ outlo, bf16_t* __restrict__ outb, int lane) {
    const float mu = wave_sum(s) * (1.0f / D);
    float q = 0.f;
#pragma unroll
    for (int i = 0; i < 32; ++i) { const float d = v[i] - mu; q += d * d; }
    const float rstd = rsqrtf(wave_sum(q) * (1.0f / D) + 1e-5f);
    float4 wv_[8], bv_[8];
#pragma unroll
    for (int i = 0; i < 8; ++i) { const unsigned c = (unsigned)(i * 256 + lane * 4); wv_[i] = *(const float4*)(w + c); bv_[i] = *(const float4*)(b + c); }
#pragma unroll
    for (int i = 0; i < 8; ++i) {
        const unsigned c = (unsigned)(i * 256 + lane * 4);
        const float4 ww = wv_[i], bb = bv_[i];
        float4 o; o.x = (v[4 * i] - mu) * rstd * ww.x + bb.x; o.y = (v[4 * i + 1] - mu) * rstd * ww.y + bb.y; o.z = (v[4 * i + 2] - mu) * rstd * ww.z + bb.z; o.w = (v[4 * i + 3] - mu) * rstd * ww.w + bb.w;
        pg8::u32x2 pk; pk.x = pg8::cvt_pk_bf16(o.x, o.y); pk.y = pg8::cvt_pk_bf16(o.z, o.w); *(pg8::u32x2*)(outb + c) = pk;
        { const float h0 = __uint_as_float(pk.x << 16), h1 = __uint_as_float(pk.x & 0xffff0000u), h2 = __uint_as_float(pk.y << 16), h3 = __uint_as_float(pk.y & 0xffff0000u);
          pg8::u32x2 pl; pl.x = pg8::cvt_pk_bf16(o.x - h0, o.y - h1); pl.y = pg8::cvt_pk_bf16(o.z - h2, o.w - h3); *(pg8::u32x2*)(outlo + c) = pl; }
    }
}
struct KArgs {
    const float* in[32]; char* ws; float* out;
};
struct MegaArgs {
    MixArgs mix;
    const float *x_in, *w_in, *w_br, *w_out, *ln1_w, *ln1_b, *w_router, *router_bias, *we_gate, *we_up, *we_down, *ws_gate, *ws_up, *ws_down, *ln2_w, *ln2_b;
    bf16_t *xb, *WinT, *WguT, *WdT, *WbrT, *WoutT, *mergedb, *x1b, *hbuf, *ybuf, *WrH, *WrL;
    float *merged, *x1, *out;
    int* idx; float* wsel; int *hist, *row_tok; float* row_w; int *slotpos, *panel_expert, *npanels;
    unsigned* bar;
};
__host__ __device__ __forceinline__ MegaArgs make_args(const KArgs& k) {
    MegaArgs a; char* ws = k.ws;
    a.x_in = k.in[0]; a.w_in = k.in[1];
    a.mix.hg_lb_logits = k.in[2]; a.mix.hg_norm_w = k.in[3]; a.mix.rw_mu = k.in[4]; a.mix.rw_w0 = k.in[5]; a.mix.rw_w2 = k.in[6]; a.mix.rw_a0 = k.in[7]; a.mix.rw_a2 = k.in[8]; a.mix.rw_g2 = k.in[9];
    a.mix.rw_kk = k.in[10]; a.mix.rw_ka = k.in[11]; a.mix.rw_rk = k.in[12]; a.mix.rw_ln_w = k.in[13]; a.mix.rw_ln_b = k.in[14]; a.mix.gla_g2 = k.in[15]; a.mix.gla_gb = k.in[16]; a.mix.gla_norm_w = k.in[17];
    a.w_br = k.in[18]; a.w_out = k.in[19]; a.ln1_w = k.in[20]; a.ln1_b = k.in[21]; a.w_router = k.in[22]; a.router_bias = k.in[23]; a.we_gate = k.in[24]; a.we_up = k.in[25]; a.we_down = k.in[26];
    a.ws_gate = k.in[27]; a.ws_up = k.in[28]; a.ws_down = k.in[29]; a.ln2_w = k.in[30]; a.ln2_b = k.in[31];
    a.bar = (unsigned*)(ws + OFF_BAR);
    a.mix.z = (const bf16_t*)(ws + OFF_Z); a.mix.RS = (float*)(ws + OFF_RS); a.ybuf = (bf16_t*)(ws + OFF_Z); a.xb = (bf16_t*)(ws + OFF_XB);
    a.mix.KH = (bf16_t*)(ws + OFF_KH); a.mix.KG = (bf16_t*)(ws + OFF_KG); a.mix.VtH = (bf16_t*)(ws + OFF_VTH); a.mix.VtG = (bf16_t*)(ws + OFF_VTG); a.mix.Vt = (bf16_t*)(ws + OFF_VT); a.mix.rGate = (bf16_t*)(ws + OFF_RGATE); a.mix.rBonus = (bf16_t*)(ws + OFF_RBONUS);
    a.hbuf = (bf16_t*)(ws + OFF_HBUF); a.x1 = (float*)(ws + OFF_X1);
    a.mix.oR = (float*)(ws + OFF_OR); a.mix.oH = (float*)(ws + OFF_OH); a.mix.oG = (float*)(ws + OFF_OG); a.mix.cR = (bf16_t*)(ws + OFF_CR); a.mix.cH = (bf16_t*)(ws + OFF_CH); a.mix.cG = (bf16_t*)(ws + OFF_CG);
    a.mix.SendR = (float*)(ws + OFF_SENDR); a.mix.PendR = (float*)(ws + OFF_PENDR); a.mix.SendH = (float*)(ws + OFF_SENDH); a.mix.SendG = (float*)(ws + OFF_SENDG); a.mix.GamH = (float*)(ws + OFF_GAMH); a.mix.GamG = (float*)(ws + OFF_GAMG);
    a.mix.SstR = (bf16_t*)(ws + OFF_SSTR); a.mix.SstH = (bf16_t*)(ws + OFF_SSTH); a.mix.SstG = (bf16_t*)(ws + OFF_SSTG);
    a.mix.bo = (bf16_t*)(ws + OFF_BO); a.merged = (float*)(ws + OFF_MERGED); a.mergedb = (bf16_t*)(ws + OFF_MERGEDB); a.x1b = (bf16_t*)(ws + OFF_X1B); a.out = k.out;
    a.WinT = (bf16_t*)(ws + OFF_WINT); a.WguT = (bf16_t*)(ws + OFF_WGUT); a.WdT = (bf16_t*)(ws + OFF_WDT); a.WbrT = (bf16_t*)(ws + OFF_WBRT); a.WoutT = (bf16_t*)(ws + OFF_WOUTT);
    a.idx = (int*)(ws + OFF_IDX); a.wsel = (float*)(ws + OFF_WSEL); a.hist = (int*)(ws + OFF_HIST); a.row_tok = (int*)(ws + OFF_ROWTOK); a.row_w = (float*)(ws + OFF_ROWW);
    a.slotpos = (int*)(ws + OFF_SLOTPOS); a.panel_expert = (int*)(ws + OFF_PANEXP); a.npanels = (int*)(ws + OFF_NPAN);
    a.WrH = (bf16_t*)(ws + OFF_WRH); a.WrL = (bf16_t*)(ws + OFF_WRL);
    a.mix.W2T = (const bf16_t*)(ws + OFF_W2T); a.mix.A2T = (const bf16_t*)(ws + OFF_A2T); a.mix.G2T = (const bf16_t*)(ws + OFF_G2T); a.mix.GGT = (const bf16_t*)(ws + OFF_GGT);
    a.mix.LW = (float*)(ws + OFF_MERGED); a.mix.LA = a.mix.LW + (size_t)T * 512; a.mix.LG = a.mix.LA + (size_t)T * 512; a.mix.LL = a.mix.LG + (size_t)T * 512;
    a.mix.layer = 0; a.mix.pad_ = 0;
    return a;
}
__device__ __forceinline__ void ln_router_phase(const MegaArgs& a, int L, LAS unsigned char* ldsraw) {
    LAS int* hs = (LAS int*)ldsraw;
    const int tid = phase_tid(), lane = tid & 63, wv = __builtin_amdgcn_readfirstlane(tid >> 6);
    const bf16_t* pre = (const bf16_t*)a.merged; const float* wr = a.w_router + (size_t)L * D * NE;
    const float bias = a.router_bias[L * NE + lane];
    for (int vb = blockIdx.x; vb < 256; vb += gridDim.x) {
        __syncthreads();
        if (tid < 64) hs[tid] = 0;
        pg8::u32x2 raw[8];
#pragma unroll
        for (int j = 0; j < 8; ++j) raw[j] = *(const pg8::u32x2*)(pre + ((size_t)vb * 64 + wv * 8) * D + j * 256 + lane * 4);
        for (int i = 0; i < 8; ++i) {
            const size_t row = (size_t)vb * 64 + wv * 8 + i;
            float v[32]; float s = 0.f;
#pragma unroll
            for (int j = 0; j < 8; ++j) { const pg8::u32x2 xx = raw[j]; float4 x; x.x = __uint_as_float(xx.x << 16); x.y = __uint_as_float(xx.x & 0xffff0000u); x.z = __uint_as_float(xx.y << 16); x.w = __uint_as_float(xx.y & 0xffff0000u);
                v[4 * j] = x.x; v[4 * j + 1] = x.y; v[4 * j + 2] = x.z; v[4 * j + 3] = x.w; s += (x.x + x.y) + (x.z + x.w); }
            { const size_t rown = (i < 7) ? row + 1 : row;
#pragma unroll
              for (int j = 0; j < 8; ++j) raw[j] = *(const pg8::u32x2*)(pre + rown * D + j * 256 + lane * 4); }
            ln_row(v, s, a.ln1_w + L * D, a.ln1_b + L * D, (bf16_t*)a.x1 + row * D, a.x1b + row * D, lane);
        }
        asm volatile("s_waitcnt vmcnt(0)" ::: "memory");
        __syncthreads();
        {
            typedef short bf16x8v __attribute__((ext_vector_type(8)));
            typedef __bf16 bf16x2n __attribute__((ext_vector_type(2)));
            const int tile = wv >> 1, khalf = wv & 1, r = lane & 15, q = lane >> 4;
            const bf16_t* xh = a.x1b + (size_t)(vb * 64 + tile * 16 + r) * D + khalf * 1024 + q * 8; const bf16_t* xl = (const bf16_t*)a.x1 + (size_t)(vb * 64 + tile * 16 + r) * D + khalf * 1024 + q * 8;
            const bf16_t* bh = a.WrH + (size_t)L * NE * D + (size_t)r * D + khalf * 1024 + q * 8; const bf16_t* bl = a.WrL + (size_t)L * NE * D + (size_t)r * D + khalf * 1024 + q * 8;
            f32x4v acc[4];
#pragma unroll
            for (int nb = 0; nb < 4; ++nb) acc[nb] = (f32x4v){0.f, 0.f, 0.f, 0.f};
#pragma unroll 2
            for (int ks = 0; ks < 32; ++ks) {
                union { bf16x2n h2[4]; bf16x8v v; } ah, al;
                ah.v = *(const bf16x8v*)(xh + ks * 32); al.v = *(const bf16x8v*)(xl + ks * 32);
#pragma unroll
                for (int nb = 0; nb < 4; ++nb) { const bf16x8v Bh = *(const bf16x8v*)(bh + (size_t)nb * 16 * D + ks * 32), Bl = *(const bf16x8v*)(bl + (size_t)nb * 16 * D + ks * 32);
                    acc[nb] = __builtin_amdgcn_mfma_f32_16x16x32_bf16(ah.v, Bh, acc[nb], 0, 0, 0);
                    acc[nb] = __builtin_amdgcn_mfma_f32_16x16x32_bf16(al.v, Bh, acc[nb], 0, 0, 0);
                    acc[nb] = __builtin_amdgcn_mfma_f32_16x16x32_bf16(ah.v, Bl, acc[nb], 0, 0, 0); }
            }
            LAS float* lg = (LAS float*)(ldsraw + 1024) + (size_t)((tile * 2 + khalf) * 16) * 64;
#pragma unroll
            for (int nb = 0; nb < 4; ++nb)
#pragma unroll
                for (int i = 0; i < 4; ++i) lg[(4 * q + i) * 64 + nb * 16 + r] = acc[nb][i];
        }
        __syncthreads();
        for (int it = 0; it < 8; ++it) {
            {
                const int tk = wv * 8 + it, t = vb * 64 + tk;
                const LAS float* lg = (const LAS float*)(ldsraw + 1024) + (size_t)(((tk >> 4) * 2) * 16 + (tk & 15)) * 64;
                const float logit = lg[lane] + lg[16 * 64 + lane];
                const float score = sigmoidf_(logit);
                const float biased = score + bias;
                float m1 = biased;
                m1 = fmaxf(m1, __shfl_xor(m1, 1)); m1 = fmaxf(m1, __shfl_xor(m1, 2)); m1 = fmaxf(m1, __shfl_xor(m1, 4));
                int am = (biased == m1) ? lane : 64;
                am = min(am, __shfl_xor(am, 1)); am = min(am, __shfl_xor(am, 2)); am = min(am, __shfl_xor(am, 4));
                float m2 = (lane == am) ? -INFINITY : biased;
                m2 = fmaxf(m2, __shfl_xor(m2, 1)); m2 = fmaxf(m2, __shfl_xor(m2, 2)); m2 = fmaxf(m2, __shfl_xor(m2, 4));
                const float gs = m1 + m2;
                const int g = lane >> 3;
                int grank = 0;
#pragma unroll
                for (int g2 = 0; g2 < 8; ++g2) { const float o = __shfl(gs, g2 * 8); grank += (o > gs || (o == gs && g2 < g)) ? 1 : 0; }
                const float masked = (grank < 4) ? biased : -INFINITY;
                int rank = 0;
                for (int e2 = 0; e2 < 64; ++e2) { const float o = rdlane(masked, e2); rank += (o > masked || (o == masked && e2 < lane)) ? 1 : 0; }
                const bool sel = rank < 8;
                const float ssum = wave_sum(sel ? score : 0.f);
                if (sel) { a.idx[(size_t)t * 8 + rank] = lane; a.wsel[(size_t)t * 8 + rank] = 2.5f * score / ssum; atomicAdd((int*)&hs[lane], 1); }
            }
        }
        __syncthreads();
        if (tid < 64) a.hist[vb * 64 + tid] = hs[tid];
    }
}
__device__ __forceinline__ void dispatch_phase(const MegaArgs& a, LAS unsigned char* ldsraw) {
    LAS int* tot = (LAS int*)ldsraw; LAS int* bef = tot + 64; LAS int* pstart = tot + 128; LAS int* es = tot + 192; LAS int* np_s = tot + 704; LAS int* ptot = tot + 768; LAS int* pbef = tot + 1280;
    const int tid = phase_tid();
    for (int blk = blockIdx.x; blk < 256; blk += gridDim.x) {
        __syncthreads();
        { const int part = tid >> 6, e = tid & 63; int b = 0, sm = 0;
#pragma unroll 8
          for (int j = part * 32; j < part * 32 + 32; ++j) { const int cc = a.hist[j * 64 + e]; if (j < blk) b += cc; sm += cc; }
          ptot[tid] = sm; pbef[tid] = b; }
        __syncthreads();
        if (tid < 64) { int sm = 0, b = 0;
#pragma unroll
            for (int pp = 0; pp < 8; ++pp) { sm += ptot[pp * 64 + tid]; b += pbef[pp * 64 + tid]; }
            tot[tid] = sm; bef[tid] = b; }
        __syncthreads();
        if (tid == 0) { int acc = 0; for (int e = 0; e < 64; ++e) { pstart[e] = acc; acc += (tot[e] + 255) / 256 * 256; } np_s[0] = acc / 256; }
        const int t = blk * 64 + (tid >> 3), k = tid & 7;
        const int e = a.idx[(size_t)t * 8 + k];
        es[tid] = e;
        __syncthreads();
        int rank = 0;
        for (int j = 0; j < tid; ++j) rank += (es[j] == e) ? 1 : 0;
        const int pos = pstart[e] + bef[e] + rank;
        a.row_tok[pos] = t; a.row_w[pos] = a.wsel[(size_t)t * 8 + k]; a.slotpos[(size_t)t * 8 + k] = pos;
        const int NP = np_s[0];
        if (blk < 64) {
            const int ee = blk, st = pstart[ee], cnt = tot[ee], pad = (cnt + 255) / 256 * 256;
            for (int r = st + cnt + tid; r < st + pad; r += 512) { a.row_tok[r] = 0; a.row_w[r] = 0.f; }
            for (int pp = st / 256 + tid; pp < (st + pad) / 256; pp += 512) a.panel_expert[pp] = ee;
        }
        if (tid < 64) { const int tt = blk * 64 + tid; a.row_tok[NP * 256 + tt] = tt; a.row_w[NP * 256 + tt] = 1.0f; }
        if (blk == 0) { if (tid < 64) a.panel_expert[NP + tid] = 64; if (tid == 0) a.npanels[0] = NP + 64; }
    }
}
__device__ __forceinline__ void combine_phase(const MegaArgs& a, int L, LAS unsigned char* ldsraw) {
    const int ptid = phase_tid(); const int lane = ptid & 63, wv = ptid >> 6, pair = wv >> 1, half = wv & 1;
    LAS float* part = (LAS float*)ldsraw;
    const unsigned shared_base = (unsigned)(a.npanels[0] - 64) * 256u;
    const float* lw = a.ln2_w + L * D; const float* lbp = a.ln2_b + L * D;
    int it = 0;
    int spn[8]; float wkn[8];
    { const unsigned tf = (unsigned)(blockIdx.x * 4 + pair);
#pragma unroll
      for (int k = 0; k < 8; ++k) { spn[k] = 0; wkn[k] = 0.f; if (tf < (unsigned)T) { spn[k] = a.slotpos[tf * 8 + k]; wkn[k] = a.wsel[tf * 8 + k]; } } }
    for (int t0 = blockIdx.x * 4; t0 < T; t0 += gridDim.x * 4, ++it) {
        const unsigned t = (unsigned)(t0 + pair);
        unsigned rows[9];
#pragma unroll
        for (int k = 0; k < 8; ++k) rows[k] = (unsigned)spn[k] * (unsigned)YLD;
        rows[8] = (shared_base + t) * (unsigned)YLD;
        float wk[9];
#pragma unroll
        for (int k = 0; k < 8; ++k) wk[k] = wkn[k];
        wk[8] = 1.0f;
        { const unsigned tn = t + (unsigned)gridDim.x * 4u; const unsigned tc = tn < (unsigned)T ? tn : t;
#pragma unroll
          for (int k = 0; k < 8; ++k) { spn[k] = a.slotpos[tc * 8 + k]; wkn[k] = a.wsel[tc * 8 + k]; } }
        float4 wv_[4], bv_[4];
#pragma unroll
        for (int i = 0; i < 4; ++i) { const unsigned c = (unsigned)(half * 1024 + i * 256 + lane * 4); wv_[i] = *(const float4*)(lw + c); bv_[i] = *(const float4*)(lbp + c); }
        float v[16]; float s1 = 0.f, s2 = 0.f;
#pragma unroll
        for (int i = 0; i < 4; ++i) {
            const unsigned c = (unsigned)(half * 1024 + i * 256 + lane * 4);
            float4 x; { const pg8::u32x2 xx = *(const pg8::u32x2*)(a.x1b + t * (unsigned)D + c); x.x = __uint_as_float(xx.x << 16); x.y = __uint_as_float(xx.x & 0xffff0000u); x.z = __uint_as_float(xx.y << 16); x.w = __uint_as_float(xx.y & 0xffff0000u); }
            float a0 = 0.f, a1 = 0.f, a2 = 0.f, a3 = 0.f;
#pragma unroll
            for (int k = 0; k < 9; ++k) { const uint2 u = *(const uint2*)(a.ybuf + (rows[k] + c));
                a0 += wk[k] * __uint_as_float(u.x << 16); a1 += wk[k] * __uint_as_float(u.x & 0xffff0000u); a2 += wk[k] * __uint_as_float(u.y << 16); a3 += wk[k] * __uint_as_float(u.y & 0xffff0000u); }
            v[4 * i] = ALPHA * x.x + a0; v[4 * i + 1] = ALPHA * x.y + a1; v[4 * i + 2] = ALPHA * x.z + a2; v[4 * i + 3] = ALPHA * x.w + a3;
#pragma unroll
            for (int j = 0; j < 4; ++j) { s1 += v[4 * i + j]; s2 += v[4 * i + j] * v[4 * i + j]; }
            if (i & 1) asm volatile("" ::: "memory");
        }
        s1 = wave_sum(s1); s2 = wave_sum(s2);
        LAS float* slot = part + (((it & 1) * 4 + pair) * 2) * 2;
        if (lane == 0) { slot[half * 2] = s1; slot[half * 2 + 1] = s2; }
        __syncthreads();
        const float S1 = slot[0] + slot[2], S2 = slot[1] + slot[3];
        const float mu = S1 * (1.0f / D);
        const float rstd = rsqrtf(fmaxf(S2 * (1.0f / D) - mu * mu, 0.f) + 1e-5f);
        float* outf = a.out + t * (unsigned)D; bf16_t* outb = a.xb + t * (unsigned)D;
#pragma unroll
        for (int i = 0; i < 4; ++i) {
            const unsigned c = (unsigned)(half * 1024 + i * 256 + lane * 4);
            const float4 ww = wv_[i], bb = bv_[i];
            float4 o; o.x = (v[4 * i] - mu) * rstd * ww.x + bb.x; o.y = (v[4 * i + 1] - mu) * rstd * ww.y + bb.y; o.z = (v[4 * i + 2] - mu) * rstd * ww.z + bb.z; o.w = (v[4 * i + 3] - mu) * rstd * ww.w + bb.w;
            *(float4*)(outf + c) = o;
            if (L == 0) { pg8::u32x2 pk; pk.x = pg8::cvt_pk_bf16(o.x, o.y); pk.y = pg8::cvt_pk_bf16(o.z, o.w); *(pg8::u32x2*)(outb + c) = pk; }
        }
    }
}

constexpr int NPHASE = 13;
constexpr int LDS_GEMM = pg8::STAGE_BYTES + pg8::GTAB_BYTES;
constexpr int LDS_BARW = LDS_GEMM;
constexpr int LDS_PETAB = LDS_GEMM + 64;
constexpr int LDS_ARGS = LDS_GEMM + 16;
constexpr int LDS_BYTES = LDS_GEMM + 512;
__device__ __forceinline__ void args_to_lds(const KArgs& ka, LAS unsigned char* lds) {
    const int t = (int)threadIdx.x;
    if (t < 34) { const unsigned long long v = (t < 32) ? (unsigned long long)ka.in[t] : (t == 32 ? (unsigned long long)ka.ws : (unsigned long long)ka.out);
        *(LAS unsigned long long*)(lds + LDS_ARGS + t * 8) = v; }
}
__device__ __forceinline__ unsigned long long lds_ptr_load(LAS unsigned char* lds, int i) {
    const LAS unsigned* p = (const LAS unsigned*)(lds + LDS_ARGS + i * 8);
    const unsigned lo = (unsigned)__builtin_amdgcn_readfirstlane((int)p[0]), hi = (unsigned)__builtin_amdgcn_readfirstlane((int)p[1]);
    return ((unsigned long long)hi << 32) | lo;
}
template <int PH> __device__ __forceinline__ void run_phase(const KArgs& kin, const int Lp, LAS unsigned char* lds_in) {
    const int L = Lp & 15, part = Lp >> 4;
    LAS unsigned char* lds = lds_in; asm volatile("" : "+s"(lds));
    size_t z0 = 0; asm volatile("" : "+s"(z0));
    KArgs ka;
#pragma unroll
    for (int i = 0; i < 32; ++i) ka.in[i] = (const float*)((const char*)kin.in[i] + z0);
    ka.ws = kin.ws + z0; ka.out = (float*)((char*)kin.out + z0);
    const MegaArgs a = make_args(ka);
    int G = (int)gridDim.x, c = (int)blockIdx.x; asm volatile("" : "+s"(G), "+s"(c));
    if constexpr (PH == 0) {
        if (L == 0) { const size_t n4 = (size_t)T * D / 4; const int ptid = phase_tid(); for (size_t i = (size_t)c * 512 + ptid; i < n4; i += (size_t)G * 512) { const float4 v = *(const float4*)(a.x_in + 4 * i);
            pg8::u32x2 pk; pk.x = pg8::cvt_pk_bf16(v.x, v.y); pk.y = pg8::cvt_pk_bf16(v.z, v.w); *(pg8::u32x2*)(a.xb + 4 * i) = pk; } }
        ConvArgs ca; ca.w_in = a.w_in; ca.we_gate = a.we_gate; ca.we_up = a.we_up; ca.we_down = a.we_down; ca.ws_gate = a.ws_gate; ca.ws_up = a.ws_up; ca.ws_down = a.ws_down; ca.w_br = a.w_br; ca.w_out = a.w_out;
        ca.WinT = a.WinT; ca.WguT = a.WguT; ca.WdT = a.WdT; ca.WbrT = a.WbrT; ca.WoutT = a.WoutT; ca.layer = L; ca.pad_ = 0;
        if (L == 0) convert_tiles(ca, 0, CV_SEG0, c, G, (LAS float (*)[65])lds);
        if (L == 0) { const int pt3 = phase_tid(); bf16_t* w2t = (bf16_t*)a.mix.W2T; bf16_t* a2t = (bf16_t*)a.mix.A2T; bf16_t* g2t = (bf16_t*)a.mix.G2T; bf16_t* ggt = (bf16_t*)a.mix.GGT;
          for (int i = c * 512 + pt3; i < 2 * 512 * 32; i += G * 512) { const int l2 = i >> 14, ch = (i >> 5) & 511, k = i & 31;
              w2t[i] = f2bf(a.mix.rw_w2[((size_t)l2 * 32 + k) * 512 + ch]); a2t[i] = f2bf(a.mix.rw_a2[((size_t)l2 * 32 + k) * 512 + ch]); }
          for (int i = c * 512 + pt3; i < 2 * 512 * 96; i += G * 512) { const int l2 = i / (512 * 96), rem = i - l2 * 512 * 96, ch = rem / 96, k = rem - ch * 96;
              g2t[i] = f2bf(a.mix.rw_g2[((size_t)l2 * 96 + k) * 512 + ch]); }
          for (int i = c * 512 + pt3; i < 2 * 256 * 32; i += G * 512) { const int l2 = i >> 13, ch = (i >> 5) & 255, k = i & 31;
              ggt[i] = (k < 16) ? f2bf(a.mix.gla_g2[((size_t)l2 * 16 + k) * 256 + ch]) : (bf16_t)0; } }
        if (L == 0) { const int ptid2 = phase_tid();
          for (int i = c * 512 + ptid2; i < 2 * NE * D; i += G * 512) { const int l2 = i >> 17, n = (i >> 11) & 63, k = i & 2047; const float v = a.w_router[(size_t)l2 * D * NE + (size_t)k * NE + n];
              const bf16_t hi = f2bf(v); a.WrH[i] = hi; a.WrL[i] = f2bf(v - bf2f(hi)); } }
    } else if constexpr (PH == 1) {
        pg8::StaticOrder S; S.init(a.xb, a.WinT, T, ZLD, D, G, c);
        pg8::EpiZ16 E; E.O = (bf16_t*)a.mix.z; E.ldc = ZLD; E.pad_ = 0;
        pg8::gemm_phase<pg8::EpiZ16, pg8::StaticOrder, false>(lds, D, S, E);
    } else if constexpr (PH == 2) { MixArgs m = a.mix; m.layer = L; prep_phase(m, lds);
    } else if constexpr (PH == 3) { MixArgs m = a.mix; m.layer = L;
        ConvArgs ca; ca.w_in = a.w_in; ca.we_gate = a.we_gate; ca.we_up = a.we_up; ca.we_down = a.we_down; ca.ws_gate = a.ws_gate; ca.ws_up = a.ws_up; ca.ws_down = a.ws_down; ca.w_br = a.w_br; ca.w_out = a.w_out;
        ca.WinT = a.WinT; ca.WguT = a.WguT; ca.WdT = a.WdT; ca.WbrT = a.WbrT; ca.WoutT = a.WoutT; ca.layer = L; ca.pad_ = 0;
        chains_phase(m, ca, a.bar + 8 + L, lds);
    } else if constexpr (PH == 4) { MixArgs m = a.mix; m.layer = L;
        carry_phase(m, lds, part);
        if (part == 0 && (c >= 32 || G <= 32)) sb_queue(m, a.bar + 12 + L, lds);
    } else if constexpr (PH == 5) { MixArgs m = a.mix; m.layer = L; mixfin_phase(m);
    } else if constexpr (PH == 6) {
        pg8::GateOrder S; S.init(a.mix.bo, a.WbrT, G, c);
        pg8::EpiGateAcc E; E.zg0 = a.mix.z + GATE0; E.mergedb = a.mergedb;
        pg8::gemm_phase<pg8::EpiGateAcc, pg8::GateOrder, false>(lds, FW, S, E);
    } else if constexpr (PH == 7) {
        pg8::StaticOrder S; S.init(a.mergedb, a.WoutT, T, D, D, G, c);
        pg8::EpiResid E; E.xin = (L == 0) ? a.x_in : a.out; E.pre = (bf16_t*)a.merged;
        pg8::gemm_phase<pg8::EpiResid, pg8::StaticOrder, false>(lds, D, S, E);
    } else if constexpr (PH == 8) { ln_router_phase(a, L, lds);
    } else if constexpr (PH == 9) { dispatch_phase(a, lds);
    } else if constexpr (PH == 10) {
        LAS int* petab = (LAS int*)(lds + LDS_PETAB); const int npan = a.npanels[0];
        pg8::MoeOrder::fill_table(petab, a.panel_expert, npan, 4, G, c, phase_tid());
        pg8::MoeOrder S; S.init(a.x1b, a.WguT, (size_t)1024 * D, petab, a.row_tok, npan, 4, D, G, c);
        pg8::EpiSwi E; E.h = a.hbuf;
        pg8::gemm_phase<pg8::EpiSwi, pg8::MoeOrder, true>(lds, D, S, E);
    } else if constexpr (PH == 11) {
        LAS int* petab = (LAS int*)(lds + LDS_PETAB); const int npan = a.npanels[0];
        pg8::MoeOrder::fill_table(petab, a.panel_expert, npan, 8, G, c, phase_tid());
        pg8::MoeOrder S; S.init(a.hbuf, a.WdT, (size_t)D * FW, petab, nullptr, npan, 8, FW, G, c);
        pg8::EpiDownW E; E.y = a.ybuf; E.ld = YLD; E.pad_ = 0;
        pg8::gemm_phase<pg8::EpiDownW, pg8::MoeOrder, false>(lds, FW, S, E);
    } else { combine_phase(a, L, lds); }
}
#ifndef MK_MULTI
#define MK_MULTI 0
#endif
#ifndef MK_PART
#define MK_PART 0
#endif
#ifndef MK_DBL
#define MK_DBL 0
#endif
#if MK_MULTI
template <int PH> __global__ __launch_bounds__(512, 2) void k_one(KArgs a, int L, int pad_) {
    extern __shared__ __attribute__((aligned(16))) unsigned char shm[];
    run_phase<PH>(a, L, (LAS unsigned char*)shm);
}
#else
__device__ __forceinline__ void run_layer(const KArgs& a, const int L, LAS unsigned char* lds, const XcdBarrier& bar) {
#define MK_RUN(PH) do { run_phase<PH>(a, L, lds); xcd_barrier(bar); if ((MK_DBL >> PH) & 1) { run_phase<PH>(a, L | (MK_PART << 4), lds); xcd_barrier(bar); } } while (0)
    if (L == 0) { MK_RUN(0); }
    MK_RUN(1); MK_RUN(2); MK_RUN(3); MK_RUN(4); MK_RUN(5); MK_RUN(6); MK_RUN(7); MK_RUN(8); MK_RUN(9); MK_RUN(10); MK_RUN(11); MK_RUN(12);
#undef MK_RUN
}
__global__ __launch_bounds__(512, 2) void k_mega(KArgs a) {
    extern __shared__ __attribute__((aligned(16))) unsigned char shm[];
    LAS unsigned char* lds = (LAS unsigned char*)shm;
    if (threadIdx.x < 4) ((LAS unsigned*)(lds + LDS_BARW))[threadIdx.x] = 0u;
    __syncthreads();
    const XcdBarrier bar = xcd_barrier_post((unsigned*)(a.ws + OFF_BAR), (volatile LAS unsigned*)(lds + LDS_BARW));
    run_layer(a, 0, lds, bar);
    run_layer(a, 1, lds, bar);
}
#endif

#if MK_MULTI
template <int PH> static void launch_one(const KArgs& a, int L, int grid, hipStream_t stream) {
    static bool attr = false; if (!attr) { (void)hipFuncSetAttribute((const void*)k_one<PH>, hipFuncAttributeMaxDynamicSharedMemorySize, LDS_BYTES); attr = true; }
    k_one<PH><<<grid, 512, LDS_BYTES, stream>>>(a, L, 0);
}
#endif
extern "C" void kernel_launch(void* const* d_in, const int* in_sizes, int n_in, void* d_out, int out_size, void* d_ws, size_t ws_size, hipStream_t stream) {
    KArgs a; memset(&a, 0, sizeof a);
    for (int i = 0; i < 32; ++i) a.in[i] = (const float*)d_in[i];
    a.ws = (char*)d_ws; a.out = (float*)d_out;
    if (WS_NEEDED > ws_size || n_in < 32) { fprintf(stderr, "workspace too small: need %zu MiB, have %zu MiB (n_in %d)\n", WS_NEEDED >> 20, ws_size >> 20, n_in); return; }

    static int grid = 0;
    if (!grid) { int dev = 0, cus = 0; (void)hipGetDevice(&dev); (void)hipDeviceGetAttribute(&cus, hipDeviceAttributeMultiprocessorCount, dev); grid = cus > 0 ? cus : 256; if (grid > 256) grid = 256; }
#if MK_MULTI
    for (int L = 0; L < 2; ++L) {
        launch_one<0>(a, L, grid, stream); launch_one<1>(a, L, grid, stream); launch_one<2>(a, L, grid, stream); launch_one<3>(a, L, grid, stream); launch_one<4>(a, L, grid, stream);
        launch_one<5>(a, L, grid, stream); launch_one<6>(a, L, grid, stream); launch_one<7>(a, L, grid, stream); launch_one<8>(a, L, grid, stream); launch_one<9>(a, L, grid, stream);
        launch_one<10>(a, L, grid, stream); launch_one<11>(a, L, grid, stream); launch_one<12>(a, L, grid, stream);
    }
#else
    static bool attr = false;
    if (!attr) {
        if (hipFuncSetAttribute((const void*)k_mega, hipFuncAttributeMaxDynamicSharedMemorySize, LDS_BYTES) != hipSuccess) { fprintf(stderr, "hipFuncSetAttribute failed\n"); return; }
        int per_cu = 0; (void)hipOccupancyMaxActiveBlocksPerMultiprocessor(&per_cu, (const void*)k_mega, 512, LDS_BYTES);
        if (per_cu < 1) fprintf(stderr, "occupancy query reports %d workgroups per CU\n", per_cu);
        attr = true;
    }
    (void)hipMemsetAsync(a.ws + OFF_BAR, 0, XCD_BAR_WORDS * sizeof(unsigned), stream);
    k_mega<<<grid, 512, LDS_BYTES, stream>>>(a);
#endif
}
```

```cpp
#include <hip/hip_runtime.h>
#include <stdint.h>
#include <stdio.h>
#include <string.h>

typedef unsigned short bf16_t;

constexpr int T = 16384, D = 2048, ZW = 15024, ZLD = 15104, NE = 64, FW = 512;
constexpr int HG_Q = 0, HG_F = 512, HG_I = 1024, HG_G = 1536;
constexpr int RW_R = 2048, RW_K = 2560, RW_V = 3072, RW_LW = 3584;
constexpr int SB_Q = 3744, SB_K = 4256, SB_V = 4768;
constexpr int GL_Q = 5280, GL_K = 5536, GL_V = 5792, GL_LG = 6304, GL_R = 6320;
constexpr int GATE0 = 6832;
constexpr float ALPHA = 1.4142135623730951f;
constexpr int MAXPANELS = 640;
constexpr int MAXROWS = MAXPANELS * 256;
constexpr int NSEG = 32, LSEG = T / NSEG;
constexpr int NCHK = T / 64;

__device__ __forceinline__ float bf2f(bf16_t v) { return __uint_as_float(((unsigned)v) << 16); }
__device__ __forceinline__ bf16_t f2bf(float f) { unsigned u = __float_as_uint(f); u += 0x7FFFu + ((u >> 16) & 1u); return (bf16_t)(u >> 16); }
__device__ __forceinline__ float sigmoidf_(float x) { return 1.0f / (1.0f + expf(-x)); }
__device__ __forceinline__ float softplusf_(float x) { return fmaxf(x, 0.f) + log1pf(expf(-fabsf(x))); }
__device__ __forceinline__ float siluf_(float x) { return x / (1.0f + expf(-x)); }
__device__ __forceinline__ float fsig(float x) { return __builtin_amdgcn_rcpf(1.0f + __expf(-x)); }
__device__ __forceinline__ float fsoftplus(float x) { return fmaxf(x, 0.f) + __logf(1.0f + __expf(-fabsf(x))); }

template <int CTRL> __device__ __forceinline__ float dppmov(float x) {
    return __builtin_bit_cast(float, __builtin_amdgcn_update_dpp(0, __builtin_bit_cast(int, x), CTRL, 0xF, 0xF, true));
}
__device__ __forceinline__ float rdlane(float x, int l) { return __builtin_bit_cast(float, __builtin_amdgcn_readlane(__builtin_bit_cast(int, x), l)); }
__device__ __forceinline__ int phase_tid() { int t = (int)threadIdx.x; asm volatile("" : "+v"(t)); return t & 511; }
__device__ __forceinline__ float wave_sum(float x) {
    x += dppmov<0xB1>(x);
    x += dppmov<0x4E>(x);
    x += dppmov<0x141>(x);
    x += dppmov<0x140>(x);
    return (rdlane(x, 0) + rdlane(x, 16)) + (rdlane(x, 32) + rdlane(x, 48));
}
#define LAS __attribute__((address_space(3)))
namespace pg8 {
typedef short bf16x8 __attribute__((ext_vector_type(8)));
typedef float f32x4 __attribute__((ext_vector_type(4)));
typedef unsigned u32x4 __attribute__((ext_vector_type(4)));
typedef unsigned u32x2 __attribute__((ext_vector_type(2)));
constexpr int BM = 256, BK = 64, HALF = 128, HTB = HALF * BK * 2, STAGE_BYTES = 8 * HTB, NXCD = 8, WGM = 8;
constexpr int GTAB_BYTES = 512 * 16;
__host__ __device__ __forceinline__ int lds_byte(int r, int c) { const int st = (r >> 4) * 2 + (c >> 5), rr = r & 15, cc = c & 31, ob = rr * 64 + cc * 2; return st * 1024 + (ob ^ (((ob >> 9) & 1) << 5)); }
__host__ __device__ __forceinline__ void stage_rc(int b, int& R, int& C) { const int st = b / 1024, sb = b % 1024, swz = sb ^ (((sb >> 9) & 1) << 5); R = (st >> 1) * 16 + swz / 64; C = (st & 1) * 32 + (swz % 64) / 2; }
__host__ __device__ __forceinline__ int perm32(int rho) { const int n = rho >> 4, i = rho & 15; return 8 * (i >> 2) + 4 * n + (i & 3); }
struct Unit { int pm, pn, e; };
__device__ __forceinline__ unsigned cvt_pk_bf16(float lo, float hi) { unsigned r; asm volatile("v_cvt_pk_bf16_f32 %0, %1, %2" : "=v"(r) : "v"(lo), "v"(hi)); return r; }

struct StaticOrder {
    const bf16_t* A; const bf16_t* Bt; int K; int nM, nN, nwg, G, c;
    __device__ void init(const bf16_t* A_, const bf16_t* Bt_, int M, int N, int K_, int G_, int c_) { A = A_; Bt = Bt_; K = K_; nM = M / BM; nN = N / BM; nwg = nM * nN; G = G_; c = c_; }
    __device__ bool next(int i, Unit& u) const {
        const int L = i * G + c; if (L >= nwg) return false;
        int wgid = L; { const int q = nwg / NXCD, r = nwg % NXCD, xcd = wgid % NXCD, off = wgid / NXCD; wgid = (xcd < r ? xcd * (q + 1) : r * (q + 1) + (xcd - r) * q) + off; }
        const int nig = WGM * nN, gid = wgid / nig, fm = gid * WGM, gsz = (nM - fm) < WGM ? (nM - fm) : WGM;
        u.pm = fm + ((wgid % nig) % gsz); u.pn = (wgid % nig) / gsz; u.e = 0; return true;
    }
    __device__ __forceinline__ const char* a_base(const Unit& u) const { return (const char*)A + (size_t)u.pm * 256 * K * 2; }
    __device__ __forceinline__ const char* b_base(const Unit& u) const { return (const char*)Bt + (size_t)u.pn * 256 * K * 2; }
    __device__ __forceinline__ const int* rowmap() const { return nullptr; }
};
struct GateOrder {
    StaticOrder so; const bf16_t* A; const bf16_t* Bt; int per;
    __device__ void init(const bf16_t* bo, const bf16_t* WbrT, int G_, int c_) { so.init(bo, WbrT, T, D, FW, G_, c_); A = bo; Bt = WbrT; Unit t; per = 0; while (so.next(per, t)) ++per; }
    __device__ bool next(int i, Unit& u) const { if (per == 0 || i >= 4 * per) return false; const int g = i / per; const bool ok = so.next(i - g * per, u); u.e = g; return ok; }
    __device__ __forceinline__ const char* a_base(const Unit& u) const { return (const char*)(A + (size_t)u.e * T * 512) + (size_t)u.pm * 256 * FW * 2; }
    __device__ __forceinline__ const char* b_base(const Unit& u) const { return (const char*)(Bt + (size_t)u.e * D * FW) + (size_t)u.pn * 256 * FW * 2; }
    __device__ __forceinline__ const int* rowmap() const { return nullptr; }
};
struct MoeOrder {
    const bf16_t* A; const bf16_t* Bt; const int* rmap; const LAS int* petab; size_t estride; int K, NT, total, G, c;
    __device__ void init(const bf16_t* A_, const bf16_t* Bt_, size_t estride_, const LAS int* petab_, const int* rmap_, int npanels, int NT_, int K_, int G_, int c_) {
        A = A_; Bt = Bt_; estride = estride_; petab = petab_; rmap = rmap_; K = K_; NT = NT_; total = npanels * NT_; G = G_;
        c = remap(c_, G_);
    }
    static __device__ __forceinline__ int remap(int c_, int G_) { return (c_ & 7) * (G_ >> 3) + (c_ >> 3); }
    static __device__ __forceinline__ void fill_table(LAS int* tab, const int* panel_expert, int npanels, int NT_, int G_, int c_, int tid) {
        const int cc = remap(c_, G_), tot = npanels * NT_;
        if (tid < 64) { const int Lu = tid * G_ + cc; tab[tid] = (Lu < tot) ? panel_expert[Lu / NT_] : 0; }
        __syncthreads();
    }
    __device__ bool next(int i, Unit& u) const {
        const int L = i * G + c; if (L >= total) return false;
        u.pm = L / NT; u.pn = L % NT; u.e = petab[i]; return true;
    }
    __device__ __forceinline__ const char* a_base(const Unit& u) const { return rmap ? (const char*)A : (const char*)A + (size_t)u.pm * 256 * K * 2; }
    __device__ __forceinline__ const char* b_base(const Unit& u) const { return (const char*)(Bt + (size_t)u.e * estride) + (size_t)u.pn * 256 * K * 2; }
    __device__ __forceinline__ const int* rowmap() const { return rmap; }
};

struct EpiZ16 {
    static constexpr bool PERM = true, W64 = false; static constexpr int NST = 16;
    bf16_t* O; int ldc; int pad_;
    __device__ __forceinline__ void operator()(const f32x4 (&acc)[2][2][4][2], const Unit& u, int wr, int wc, int fr, int fq) const {
        const int row0 = u.pm * BM + wr * 64 + fr, col0 = u.pn * BM + wc * 32 + 8 * fq;
#pragma unroll
        for (int ai = 0; ai < 2; ++ai)
#pragma unroll
            for (int m = 0; m < 4; ++m) { bf16_t* rowp = O + (size_t)(row0 + ai * HALF + m * 16) * ldc + col0;
#pragma unroll
                for (int bj = 0; bj < 2; ++bj) { const f32x4 v0 = acc[ai][bj][m][0], v1 = acc[ai][bj][m][1];
                    u32x4 w; w.x = cvt_pk_bf16(v0[0], v0[1]); w.y = cvt_pk_bf16(v0[2], v0[3]); w.z = cvt_pk_bf16(v1[0], v1[1]); w.w = cvt_pk_bf16(v1[2], v1[3]);
                    *(u32x4*)(rowp + bj * HALF) = w; } }
    }
};
struct EpiGateAcc {
    static constexpr bool PERM = true, W64 = false; static constexpr int NST = 8;
    const bf16_t* zg0; bf16_t* mergedb;
    __device__ __forceinline__ void operator()(const f32x4 (&acc)[2][2][4][2], const Unit& u, int wr, int wc, int fr, int fq) const {
        const int g = u.e; const bf16_t* zg = zg0 + g * D;
        const int row0 = u.pm * BM + wr * 64 + fr, col0 = u.pn * BM + wc * 32 + 8 * fq;
#pragma unroll
        for (int ai = 0; ai < 2; ++ai) {
            u32x4 gzv[4][2], pvv[4][2];
#pragma unroll
            for (int m = 0; m < 4; ++m)
#pragma unroll
                for (int bj = 0; bj < 2; ++bj) { const size_t row = (size_t)(row0 + ai * HALF + m * 16); const int col = col0 + bj * HALF;
                    gzv[m][bj] = *(const u32x4*)(zg + row * ZLD + col);
                    pvv[m][bj] = (u32x4){0u, 0u, 0u, 0u}; if (g > 0) pvv[m][bj] = *(const u32x4*)(mergedb + row * D + col); }
#pragma unroll
            for (int m = 0; m < 4; ++m) { const size_t row = (size_t)(row0 + ai * HALF + m * 16);
#pragma unroll
                for (int bj = 0; bj < 2; ++bj) { const int col = col0 + bj * HALF;
                    const u32x4 gz = gzv[m][bj], pv = pvv[m][bj];
                    f32x4 g0, g1; g0[0] = __uint_as_float(gz.x << 16); g0[1] = __uint_as_float(gz.x & 0xffff0000u); g0[2] = __uint_as_float(gz.y << 16); g0[3] = __uint_as_float(gz.y & 0xffff0000u);
                    g1[0] = __uint_as_float(gz.z << 16); g1[1] = __uint_as_float(gz.z & 0xffff0000u); g1[2] = __uint_as_float(gz.w << 16); g1[3] = __uint_as_float(gz.w & 0xffff0000u);
                    f32x4 v0 = acc[ai][bj][m][0], v1 = acc[ai][bj][m][1];
#pragma unroll
                    for (int j = 0; j < 4; ++j) { v0[j] *= __builtin_amdgcn_rcpf(1.0f + __expf(-g0[j])); v1[j] *= __builtin_amdgcn_rcpf(1.0f + __expf(-g1[j])); }
                    v0[0] += __uint_as_float(pv.x << 16); v0[1] += __uint_as_float(pv.x & 0xffff0000u); v0[2] += __uint_as_float(pv.y << 16); v0[3] += __uint_as_float(pv.y & 0xffff0000u);
                    v1[0] += __uint_as_float(pv.z << 16); v1[1] += __uint_as_float(pv.z & 0xffff0000u); v1[2] += __uint_as_float(pv.w << 16); v1[3] += __uint_as_float(pv.w & 0xffff0000u);
                    u32x4 w; w.x = cvt_pk_bf16(v0[0], v0[1]); w.y = cvt_pk_bf16(v0[2], v0[3]); w.z = cvt_pk_bf16(v1[0], v1[1]); w.w = cvt_pk_bf16(v1[2], v1[3]);
                    *(u32x4*)(mergedb + row * D + col) = w; } }
            asm volatile("" ::: "memory");
        }
    }
};
struct EpiResid {
    static constexpr bool PERM = true, W64 = false; static constexpr int NST = 8;
    const float* xin; bf16_t* pre;
    __device__ __forceinline__ void operator()(const f32x4 (&acc)[2][2][4][2], const Unit& u, int wr, int wc, int fr, int fq) const {
        const int row0 = u.pm * BM + wr * 64 + fr, col0 = u.pn * BM + wc * 32 + 8 * fq;
#pragma unroll
        for (int ai = 0; ai < 2; ++ai) {
            f32x4 xv[4][2][2];
#pragma unroll
            for (int m = 0; m < 4; ++m) { const size_t ro = (size_t)(row0 + ai * HALF + m * 16) * D + col0;
#pragma unroll
                for (int bj = 0; bj < 2; ++bj)
#pragma unroll
                    for (int n = 0; n < 2; ++n) xv[m][bj][n] = *(const f32x4*)(xin + ro + bj * HALF + n * 4); }
#pragma unroll
            for (int m = 0; m < 4; ++m) { const size_t ro = (size_t)(row0 + ai * HALF + m * 16) * D + col0;
#pragma unroll
                for (int bj = 0; bj < 2; ++bj) { const f32x4 v0 = xv[m][bj][0] * ALPHA + acc[ai][bj][m][0], v1 = xv[m][bj][1] * ALPHA + acc[ai][bj][m][1];
                    u32x4 w; w.x = cvt_pk_bf16(v0[0], v0[1]); w.y = cvt_pk_bf16(v0[2], v0[3]); w.z = cvt_pk_bf16(v1[0], v1[1]); w.w = cvt_pk_bf16(v1[2], v1[3]);
                    *(u32x4*)(pre + ro + bj * HALF) = w; } }
            asm volatile("" ::: "memory");
        }
    }
};
struct EpiSwi {
    static constexpr bool PERM = true, W64 = false; static constexpr int NST = 8;
    bf16_t* h;
    __device__ __forceinline__ void operator()(const f32x4 (&acc)[2][2][4][2], const Unit& u, int wr, int wc, int fr, int fq) const {
        const int row0 = u.pm * BM + wr * 64 + fr, col0 = u.pn * HALF + wc * 32 + 8 * fq;
#pragma unroll
        for (int ai = 0; ai < 2; ++ai)
#pragma unroll
            for (int m = 0; m < 4; ++m) { float o[8];
#pragma unroll
                for (int n = 0; n < 2; ++n)
#pragma unroll
                    for (int j = 0; j < 4; ++j) { const float gt = acc[ai][0][m][n][j], up = acc[ai][1][m][n][j]; o[4 * n + j] = gt / (1.0f + __expf(-gt)) * up; }
                u32x4 w; w.x = cvt_pk_bf16(o[0], o[1]); w.y = cvt_pk_bf16(o[2], o[3]); w.z = cvt_pk_bf16(o[4], o[5]); w.w = cvt_pk_bf16(o[6], o[7]);
                *(u32x4*)(h + (size_t)(row0 + ai * HALF + m * 16) * FW + col0) = w; }
    }
};
__device__ __forceinline__ u32x4 ror8x4(const u32x4 v) { u32x4 r;
    r.x = (unsigned)__builtin_amdgcn_update_dpp(0, (int)v.x, 0x128, 0xf, 0xf, false); r.y = (unsigned)__builtin_amdgcn_update_dpp(0, (int)v.y, 0x128, 0xf, 0xf, false);
    r.z = (unsigned)__builtin_amdgcn_update_dpp(0, (int)v.z, 0x128, 0xf, 0xf, false); r.w = (unsigned)__builtin_amdgcn_update_dpp(0, (int)v.w, 0x128, 0xf, 0xf, false); return r; }
struct EpiDownW {
    static constexpr bool PERM = true, W64 = true; static constexpr int NST = 16;
    bf16_t* y; int ld, pad_;
    __device__ __forceinline__ void operator()(const f32x4 (&acc)[2][2][4][2], const Unit& u, int wr, int wc, int fr, int fq) const {
        const bool hi = fr >= 8;
        const int row0 = u.pm * BM + wr * 64 + (fr & 7), col0 = u.pn * BM + wc * 64 + 8 * fq + (hi ? 32 : 0);
#pragma unroll
        for (int ai = 0; ai < 2; ++ai)
#pragma unroll
            for (int m = 0; m < 4; ++m) { bf16_t* rowp = y + (size_t)(row0 + ai * HALF + m * 16) * ld + col0;
                u32x4 w0, w1;
                { const f32x4 v0 = acc[ai][0][m][0], v1 = acc[ai][0][m][1]; w0.x = cvt_pk_bf16(v0[0], v0[1]); w0.y = cvt_pk_bf16(v0[2], v0[3]); w0.z = cvt_pk_bf16(v1[0], v1[1]); w0.w = cvt_pk_bf16(v1[2], v1[3]); }
                { const f32x4 v0 = acc[ai][1][m][0], v1 = acc[ai][1][m][1]; w1.x = cvt_pk_bf16(v0[0], v0[1]); w1.y = cvt_pk_bf16(v0[2], v0[3]); w1.z = cvt_pk_bf16(v1[0], v1[1]); w1.w = cvt_pk_bf16(v1[2], v1[3]); }
                const u32x4 snd = hi ? w0 : w1, rcv = ror8x4(snd);
                __builtin_nontemporal_store(hi ? rcv : w0, (u32x4*)rowp);
                __builtin_nontemporal_store(hi ? w1 : rcv, (u32x4*)(rowp + (size_t)8 * ld)); }
    }
};

template <class Epi, class Sched, bool GATHER>
__device__ __forceinline__ void gemm_phase(LAS unsigned char* lds, const int K, const Sched& S, const Epi& E) {
    const int tid = phase_tid(), wid = __builtin_amdgcn_readfirstlane(tid >> 6), wr = wid >> 2, wc = wid & 3, lane = tid & 63, fr = lane & 15, fq = lane >> 4;
    const int nt = K / BK;
    unsigned voffA[2], voffB[2], voffG[2][2]; int gR[2], gC[2];
#pragma unroll
    for (int i = 0; i < 2; ++i) { int R, C; stage_rc(tid * 16 + i * 8192, R, C); const int Rb = Epi::W64 ? (64 * (R >> 5) + perm32(R & 31)) : (Epi::PERM ? ((R & ~31) + perm32(R & 31)) : R);
        voffA[i] = (unsigned)(R * K + C) * 2u; voffB[i] = (unsigned)(Rb * K + C) * 2u; gR[i] = R; gC[i] = C; voffG[0][i] = 0u; voffG[1][i] = 0u; }
    const size_t kstep = (size_t)(BK * 2);
    const size_t hstep = (size_t)HALF * K * 2;
    const size_t hstepB = Epi::W64 ? (size_t)32 * K * 2 : hstep;
    const unsigned ldsw = (unsigned)wid * 1024u;
    const int aoff = lds_byte(wr * 64 + fr, fq * 8), boff = lds_byte(wc * 32 + fr, fq * 8);
    const LAS int* gtab = (const LAS int*)(lds + STAGE_BYTES) + tid;
#define PG8_SA(b, h) (((b) * 2 + (h)) * HTB)
#define PG8_SB(b, h) ((4 + (b) * 2 + (h)) * HTB)
#define PG8_STAGE(bufoff, gbase, voff) do { _Pragma("unroll") for (int _i = 0; _i < 2; ++_i) \
        __builtin_amdgcn_global_load_lds((const unsigned*)((const char*)(gbase) + (voff)[_i]), (LAS unsigned*)(lds + (bufoff) + ldsw + _i * 8192), 16, 0, 0); } while (0)
#define PG8_STAGE_A(bufoff, gbase, h) do { if constexpr (GATHER) PG8_STAGE(bufoff, gbase, voffG[h]); else PG8_STAGE(bufoff, (gbase) + (h) * hstep, voffA); } while (0)
#define PG8_LDA(dst, b, h) do { _Pragma("unroll") for (int m = 0; m < 4; ++m) _Pragma("unroll") for (int k = 0; k < 2; ++k) dst[m][k] = *(const LAS bf16x8*)(lds + PG8_SA(b, h) + aoff + m * 2048 + k * 1024); } while (0)
#define PG8_LDB(dst, b, h) do { _Pragma("unroll") for (int n = 0; n < 2; ++n) _Pragma("unroll") for (int k = 0; k < 2; ++k) dst[n][k] = *(const LAS bf16x8*)(lds + PG8_SB(b, h) + boff + n * 2048 + k * 1024); } while (0)
#define PG8_MMA(ai, bj, At, Bt) do { __builtin_amdgcn_s_setprio(1); _Pragma("unroll") for (int m = 0; m < 4; ++m) _Pragma("unroll") for (int n = 0; n < 2; ++n) _Pragma("unroll") for (int k = 0; k < 2; ++k) \
        acc[ai][bj][m][n] = __builtin_amdgcn_mfma_f32_16x16x32_bf16(Bt[n][k], At[m][k], acc[ai][bj][m][n], 0, 0, 0); __builtin_amdgcn_s_setprio(0); } while (0)
#define PG8_WAIT_V(n) asm volatile("s_waitcnt vmcnt(" #n ")" ::: "memory")
#define PG8_WAIT_VN(n) asm volatile("s_waitcnt vmcnt(%0)" :: "n"(n) : "memory")
#define PG8_WAIT_FRESH(f, n) asm volatile("v_cmp_ne_u32_e32 vcc, 0, %0\n\ts_cbranch_vccnz .Lpg8w%=\n\ts_waitcnt vmcnt(8)\n.Lpg8w%=:\n\ts_waitcnt vmcnt(%1)" :: "v"(f), "n"(n) : "memory", "vcc")
#define PG8_WAIT_L(n) asm volatile("s_waitcnt lgkmcnt(" #n ")" ::: "memory")
#define PG8_BAR __builtin_amdgcn_s_barrier()
#define PG8_SCHED __builtin_amdgcn_sched_barrier(0)
    auto gather_offs = [&](const Unit& u) -> u32x4 {
        const int* rm = S.rowmap(); u32x4 o;
        o.x = (unsigned)(rm[u.pm * 256 + gR[0]] * K + gC[0]) * 2u;       o.y = (unsigned)(rm[u.pm * 256 + gR[1]] * K + gC[1]) * 2u;
        o.z = (unsigned)(rm[u.pm * 256 + 128 + gR[0]] * K + gC[0]) * 2u; o.w = (unsigned)(rm[u.pm * 256 + 128 + gR[1]] * K + gC[1]) * 2u;
        return o; };
    auto gather_dma = [&](const Unit& u) { const int* rm = S.rowmap() + u.pm * 256;
#pragma unroll
        for (int k = 0; k < 4; ++k) __builtin_amdgcn_global_load_lds((const unsigned*)(rm + (k >> 1) * 128 + gR[k & 1]), (LAS unsigned*)(lds + STAGE_BYTES + k * 2048 + wid * 256), 4, 0, 0); };
    Unit cur, nxt, nn; int ui = 0;
    if (!S.next(0, cur)) return;
    f32x4 acc[2][2][4][2];
#pragma unroll
    for (int a = 0; a < 2; ++a)
#pragma unroll
        for (int b = 0; b < 2; ++b)
#pragma unroll
            for (int m = 0; m < 4; ++m)
#pragma unroll
                for (int n = 0; n < 2; ++n) acc[a][b][m][n] = (f32x4){0.f, 0.f, 0.f, 0.f};
    bf16x8 At[4][2], B0[2][2], B1[2][2];
    const char* cA = S.a_base(cur); const char* cB = S.b_base(cur);
    if constexpr (GATHER) {
        const u32x4 o = gather_offs(cur); voffG[0][0] = o.x; voffG[0][1] = o.y; voffG[1][0] = o.z; voffG[1][1] = o.w;
        if (S.next(1, nn)) gather_dma(nn);
        asm volatile("s_waitcnt vmcnt(0) lgkmcnt(0)" ::: "memory");
    }
    PG8_STAGE(PG8_SB(0, 0), cB, voffB); PG8_STAGE(PG8_SB(0, 1), cB + hstepB, voffB); PG8_STAGE_A(PG8_SA(0, 0), cA, 0); PG8_STAGE_A(PG8_SA(0, 1), cA, 1);
    if (wr == 1) PG8_BAR;
    PG8_WAIT_V(2); PG8_BAR;
    PG8_STAGE(PG8_SB(1, 0), cB + kstep, voffB); PG8_STAGE_A(PG8_SA(1, 0), cA + kstep, 0); PG8_STAGE(PG8_SB(1, 1), cB + hstepB + kstep, voffB);
    PG8_WAIT_V(6); PG8_BAR;
    for (;;) {
        const bool has_next = S.next(ui + 1, nxt);
        const char* nA = has_next ? S.a_base(nxt) : cA; const char* nB = has_next ? S.b_base(nxt) : cB;
        for (int t = 0; t < nt; t += 2) {
            const bool last = (t == nt - 2); const int fresh = (t == 0 && ui > 0) ? 1 : 0;
            const char* a1 = cA + (size_t)(t + 1) * kstep;
            const char* a2 = last ? nA : cA + (size_t)(t + 2) * kstep; const char* b2 = last ? nB : cB + (size_t)(t + 2) * kstep;
            const char* a3 = a2 + kstep; const char* b3 = b2 + kstep;
            PG8_LDB(B0, 0, 0); PG8_LDB(B1, 0, 1); PG8_SCHED; PG8_LDA(At, 0, 0); PG8_STAGE_A(PG8_SA(1, 1), a1, 1);
            if constexpr (GATHER) { if (last && has_next) {
#pragma unroll
                for (int k = 0; k < 4; ++k) voffG[k >> 1][k & 1] = (unsigned)(gtab[k * 512] * K + gC[k & 1]) * 2u; } }
            PG8_WAIT_FRESH(fresh, 8 + Epi::NST);
            PG8_WAIT_L(0); PG8_BAR; PG8_MMA(0, 0, At, B0); PG8_MMA(0, 1, At, B1); PG8_BAR; PG8_SCHED;
            PG8_LDA(At, 0, 1); PG8_STAGE(PG8_SB(0, 0), b2, voffB); PG8_STAGE(PG8_SB(0, 1), b2 + hstepB, voffB); PG8_STAGE_A(PG8_SA(0, 0), a2, 0);
            PG8_WAIT_FRESH(fresh, 8 + Epi::NST);
            PG8_WAIT_L(0); PG8_BAR; PG8_MMA(1, 0, At, B0); PG8_MMA(1, 1, At, B1); PG8_BAR; PG8_SCHED;
            PG8_LDB(B0, 1, 0); PG8_LDB(B1, 1, 1); PG8_SCHED; PG8_LDA(At, 1, 0); PG8_STAGE_A(PG8_SA(0, 1), a2, 1);
            PG8_WAIT_V(8); PG8_WAIT_L(0); PG8_BAR; PG8_MMA(0, 0, At, B0); PG8_MMA(0, 1, At, B1); PG8_BAR; PG8_SCHED;
            PG8_LDA(At, 1, 1); PG8_STAGE(PG8_SB(1, 0), b3, voffB); PG8_STAGE(PG8_SB(1, 1), b3 + hstepB, voffB); PG8_STAGE_A(PG8_SA(1, 0), a3, 0);
            PG8_WAIT_V(8); PG8_WAIT_L(0); PG8_BAR; PG8_MMA(1, 0, At, B0); PG8_MMA(1, 1, At, B1); PG8_BAR; PG8_SCHED;
        }
        if (wr == 0) PG8_BAR;
        if constexpr (GATHER) { if (has_next && S.next(ui + 2, nn)) gather_dma(nn); }
        E(acc, cur, wr, wc, fr, fq);
        if (!has_next) break;
#pragma unroll
        for (int a = 0; a < 2; ++a)
#pragma unroll
            for (int b = 0; b < 2; ++b)
#pragma unroll
                for (int m = 0; m < 4; ++m)
#pragma unroll
                    for (int n = 0; n < 2; ++n) acc[a][b][m][n] = (f32x4){0.f, 0.f, 0.f, 0.f};
        cur = nxt; cA = nA; cB = nB; ++ui;
        if (wr == 1) PG8_BAR;
    }
    PG8_WAIT_V(0);
    PG8_BAR;
#undef PG8_SA
#undef PG8_SB
#undef PG8_STAGE
#undef PG8_STAGE_A
#undef PG8_LDA
#undef PG8_LDB
#undef PG8_MMA
#undef PG8_WAIT_V
#undef PG8_WAIT_L
#undef PG8_BAR
#undef PG8_SCHED
}
}


struct ConvArgs { const float *w_in, *we_gate, *we_up, *we_down, *ws_gate, *ws_up, *ws_down, *w_br, *w_out; bf16_t *WinT, *WguT, *WdT, *WbrT, *WoutT; int layer, pad_; };
constexpr int CV_SEG0 = 32 * 236, CV_SEG1 = 65 * 2 * 32 * 8, CV_SEG2 = 65 * 8 * 32, CV_SEG3 = 4 * 8 * 32, CV_SEG4 = 32 * 32;
constexpr int CV_TOTAL = CV_SEG0 + CV_SEG1 + CV_SEG2 + CV_SEG3 + CV_SEG4;
struct CvJob { const float* src; bf16_t* dst; int ld, ldd, valid; };
__device__ __forceinline__ CvJob cv_decode(const ConvArgs& a, const int j, const int L) {
    CvJob o; o.valid = 64;
    if (j < CV_SEG0) { const int kb = j & 31, nb = j >> 5; o.ld = ZW; o.ldd = D;
        o.src = a.w_in + (size_t)L * D * ZW + (size_t)kb * 64 * ZW + nb * 64; int v = ZW - nb * 64; o.valid = v < 0 ? 0 : (v > 64 ? 64 : v);
        o.dst = a.WinT + (size_t)nb * 64 * D + kb * 64; }
    else if (j < CV_SEG0 + CV_SEG1) { int q = j - CV_SEG0; const int cb = q & 7; q >>= 3; const int kb = q & 31; q >>= 5; const int bj = q & 1; const int e = q >> 1; o.ld = FW; o.ldd = D;
        const float* m = (e < NE) ? ((bj ? a.we_up : a.we_gate) + ((size_t)L * NE + e) * D * FW) : ((bj ? a.ws_up : a.ws_gate) + (size_t)L * D * FW);
        o.src = m + (size_t)kb * 64 * FW + cb * 64;
        o.dst = a.WguT + ((size_t)e * 1024 + (cb >> 1) * 256 + bj * 128 + (cb & 1) * 64) * D + kb * 64; }
    else if (j < CV_SEG0 + CV_SEG1 + CV_SEG2) { int q = j - CV_SEG0 - CV_SEG1; const int nb = q & 31; q >>= 5; const int kb = q & 7; const int e = q >> 3; o.ld = D; o.ldd = FW;
        const float* m = (e < NE) ? (a.we_down + ((size_t)L * NE + e) * FW * D) : (a.ws_down + (size_t)L * FW * D);
        o.src = m + (size_t)kb * 64 * D + nb * 64; o.dst = a.WdT + ((size_t)e * D + nb * 64) * FW + kb * 64; }
    else if (j < CV_SEG0 + CV_SEG1 + CV_SEG2 + CV_SEG3) { int q = j - CV_SEG0 - CV_SEG1 - CV_SEG2; const int nb = q & 31; q >>= 5; const int kb = q & 7; const int g = q >> 3; o.ld = D; o.ldd = FW;
        o.src = a.w_br + ((size_t)L * 4 + g) * FW * D + (size_t)kb * 64 * D + nb * 64; o.dst = a.WbrT + ((size_t)g * D + nb * 64) * FW + kb * 64; }
    else { const int q = j - CV_SEG0 - CV_SEG1 - CV_SEG2 - CV_SEG3; const int nb = q & 31, kb = q >> 5; o.ld = D; o.ldd = D;
        o.src = a.w_out + (size_t)L * D * D + (size_t)kb * 64 * D + nb * 64; o.dst = a.WoutT + (size_t)nb * 64 * D + kb * 64; }
    return o;
}
__device__ __forceinline__ void convert_tiles(const ConvArgs& a, int j0, int j1, int jstart, int jstride, LAS float (*tile)[65]) {
    const int tid = phase_tid(), L = a.layer;
    for (int j = j0 + jstart; j < j1; j += jstride) {
        const CvJob jb = cv_decode(a, j, L);
        const float* src = jb.src; bf16_t* dst = jb.dst; const int ld = jb.ld, ldd = jb.ldd, valid = jb.valid;
        __syncthreads();
        { const int c4 = (tid & 15) * 4, k = tid >> 4;
#pragma unroll
          for (int h = 0; h < 2; ++h) { float4 v = make_float4(0.f, 0.f, 0.f, 0.f); if (c4 < valid) v = *(const float4*)(src + (size_t)(k + 32 * h) * ld + c4);
              tile[k + 32 * h][c4] = v.x; tile[k + 32 * h][c4 + 1] = v.y; tile[k + 32 * h][c4 + 2] = v.z; tile[k + 32 * h][c4 + 3] = v.w; } }
        __syncthreads();
        { const int n = tid >> 3, kc = (tid & 7) * 8; unsigned w[4];
#pragma unroll
          for (int q = 0; q < 4; ++q) w[q] = (unsigned)f2bf(tile[kc + 2 * q][n]) | ((unsigned)f2bf(tile[kc + 2 * q + 1][n]) << 16);
          *(uint4*)(dst + (size_t)n * ldd + kc) = make_uint4(w[0], w[1], w[2], w[3]); }
    }
}
constexpr int CVX_OWN = CV_TOTAL - CV_SEG0, CVX_TOTAL = CVX_OWN + CV_SEG0;
__device__ __forceinline__ bool cvx_job(const ConvArgs& a, const int n, const int L, CvJob& jb) {
    if (n < CVX_OWN) { jb = cv_decode(a, CV_SEG0 + n, L); return true; }
    if (n < CVX_TOTAL && L + 1 < 2) { jb = cv_decode(a, n - CVX_OWN, L + 1); return true; }
    return false;
}
typedef float f32x2v __attribute__((ext_vector_type(2)));
typedef float f32x4v __attribute__((ext_vector_type(4)));
struct MixArgs {
    const bf16_t* z;
    const float *hg_lb_logits, *hg_norm_w, *rw_mu, *rw_w0, *rw_w2, *rw_a0, *rw_a2, *rw_g2, *rw_kk, *rw_ka, *rw_rk, *rw_ln_w, *rw_ln_b, *gla_g2, *gla_gb, *gla_norm_w;
    float* RS; bf16_t *Vt, *KH, *KG, *VtH, *VtG; bf16_t *rGate, *rBonus;
    float *oR, *oH, *oG; bf16_t *cR, *cH, *cG;
    float *SendR, *PendR, *SendH, *SendG, *GamH, *GamG;
    bf16_t *SstR, *SstH, *SstG;
    bf16_t* bo;
    const bf16_t *W2T, *A2T, *G2T, *GGT;
    float *LW, *LA, *LG, *LL;
    int layer, pad_;
};
__device__ __forceinline__ float red8(float x) { x += dppmov<0xB1>(x); x += dppmov<0x4E>(x); x += dppmov<0x141>(x); return x; }
__device__ __forceinline__ float red16(float x) { x += dppmov<0xB1>(x); x += dppmov<0x4E>(x); x += dppmov<0x141>(x); x += dppmov<0x140>(x); return x; }

__device__ __forceinline__ void prep_phase(const MixArgs& p, LAS unsigned char* ldsraw) {
    LAS bf16_t (*vtile)[72] = (LAS bf16_t (*)[72])(ldsraw + 8192);
    LAS float* lW = (LAS float*)ldsraw; LAS float* lA = lW + 16 * 516; LAS float* lG = lA + 16 * 516; LAS float* lL = lG + 16 * 516;
    const int c = phase_tid(), L = p.layer;
    const float mu_r = p.rw_mu[L * 1696 + c], mu_k = p.rw_mu[L * 1696 + 512 + c], mu_v = p.rw_mu[L * 1696 + 1024 + c];
    const float w0 = p.rw_w0[L * 512 + c], a0 = p.rw_a0[L * 512 + c], kkc = p.rw_kk[L * 512 + c], kac = p.rw_ka[L * 512 + c], rkc = p.rw_rk[L * 512 + c];
    float lb = 0.f;
    if (L == 1) { const float l0 = p.hg_lb_logits[c], l1 = p.hg_lb_logits[512 + c]; const float m = fmaxf(l0, l1); const float e0 = expf(l0 - m), e1 = expf(l1 - m); lb = e1 / (e0 + e1); }
    const float gbc = (c < 256) ? p.gla_gb[L * 256 + c] : 0.f;
    for (int tile = blockIdx.x; tile < T / 64; tile += gridDim.x) {
        const int t0 = tile * 64;
        float bH = 0.f, bG = 0.f;
#pragma unroll 1
        for (int g16 = 0; g16 < 4; ++g16) {
            const int tg0 = t0 + 16 * g16;
            typedef short bf16x8v __attribute__((ext_vector_type(8)));
            typedef __bf16 bf16x2n __attribute__((ext_vector_type(2)));
            {
                const int wvu = __builtin_amdgcn_readfirstlane(c >> 6), lane = c & 63, r = lane & 15, q = lane >> 4;
                bf16x8v Af[6];
                { const int t = tg0 + r;
#pragma unroll
                    for (int ks = 0; ks < 5; ++ks) {
                        const pg8::u32x4 cu = *(const pg8::u32x4*)(p.z + (size_t)t * ZLD + RW_LW + 32 * ks + 8 * q);
                        pg8::u32x4 pv = (pg8::u32x4){0u, 0u, 0u, 0u}; if (t > 0) pv = *(const pg8::u32x4*)(p.z + (size_t)(t - 1) * ZLD + RW_LW + 32 * ks + 8 * q);
                        const float4 m0 = *(const float4*)(p.rw_mu + L * 1696 + 1536 + 32 * ks + 8 * q), m1 = *(const float4*)(p.rw_mu + L * 1696 + 1536 + 32 * ks + 8 * q + 4);
                        const float mu8[8] = {m0.x, m0.y, m0.z, m0.w, m1.x, m1.y, m1.z, m1.w};
                        const unsigned cw[4] = {cu.x, cu.y, cu.z, cu.w}, pw[4] = {pv.x, pv.y, pv.z, pv.w};
                        union { bf16x2n h2[4]; bf16x8v v; } pk;
#pragma unroll
                        for (int j = 0; j < 4; ++j) { f32x2v f;
                            { const float cur = __uint_as_float(cw[j] << 16), prv = __uint_as_float(pw[j] << 16); const float zs = cur + (prv - cur) * mu8[2 * j];
                              f.x = (ks == 0) ? (1.0f - 2.0f / (1.0f + __expf(2.0f * zs))) : (ks == 1 ? zs : fsig(zs)); }
                            { const float cur = __uint_as_float(cw[j] & 0xffff0000u), prv = __uint_as_float(pw[j] & 0xffff0000u); const float zs = cur + (prv - cur) * mu8[2 * j + 1];
                              f.y = (ks == 0) ? (1.0f - 2.0f / (1.0f + __expf(2.0f * zs))) : (ks == 1 ? zs : fsig(zs)); }
                            pk.h2[j] = __builtin_convertvector(f, bf16x2n); }
                        Af[ks] = pk.v; }
                    { pg8::u32x4 gl = (pg8::u32x4){0u, 0u, 0u, 0u}; if (q < 2) gl = *(const pg8::u32x4*)(p.z + (size_t)t * ZLD + GL_LG + 8 * q);
                      union { pg8::u32x4 u; bf16x8v v; } cvu; cvu.u = gl; Af[5] = cvu.v; } }
                const bf16_t* w2t = p.W2T + (size_t)L * 512 * 32; const bf16_t* a2t = p.A2T + (size_t)L * 512 * 32; const bf16_t* g2t = p.G2T + (size_t)L * 512 * 96; const bf16_t* ggt = p.GGT + (size_t)L * 256 * 32;
                __syncthreads();
#pragma unroll 2
                for (int nt = 0; nt < 4; ++nt) { const int ch = 64 * wvu + 16 * nt + r;
                    const bf16x8v Bw = *(const bf16x8v*)(w2t + ch * 32 + 8 * q), Ba = *(const bf16x8v*)(a2t + ch * 32 + 8 * q);
                    const bf16x8v Bg0 = *(const bf16x8v*)(g2t + ch * 96 + 8 * q), Bg1 = *(const bf16x8v*)(g2t + ch * 96 + 32 + 8 * q), Bg2 = *(const bf16x8v*)(g2t + ch * 96 + 64 + 8 * q);
                    const f32x4v zero = (f32x4v){0.f, 0.f, 0.f, 0.f};
                    const f32x4v aw = __builtin_amdgcn_mfma_f32_16x16x32_bf16(Af[0], Bw, zero, 0, 0, 0), aa = __builtin_amdgcn_mfma_f32_16x16x32_bf16(Af[1], Ba, zero, 0, 0, 0);
                    f32x4v ag = __builtin_amdgcn_mfma_f32_16x16x32_bf16(Af[2], Bg0, zero, 0, 0, 0); ag = __builtin_amdgcn_mfma_f32_16x16x32_bf16(Af[3], Bg1, ag, 0, 0, 0); ag = __builtin_amdgcn_mfma_f32_16x16x32_bf16(Af[4], Bg2, ag, 0, 0, 0);
#pragma unroll
                    for (int i = 0; i < 4; ++i) { const int o = (4 * q + i) * 516 + ch; lW[o] = aw[i]; lA[o] = aa[i]; lG[o] = ag[i]; } }
#pragma unroll
                for (int nt = 0; nt < 2; ++nt) { const int ch = 32 * wvu + 16 * nt + r;
                    const bf16x8v Bl = *(const bf16x8v*)(ggt + ch * 32 + 8 * q);
                    const f32x4v al = __builtin_amdgcn_mfma_f32_16x16x32_bf16(Af[5], Bl, (f32x4v){0.f, 0.f, 0.f, 0.f}, 0, 0, 0);
#pragma unroll
                    for (int i = 0; i < 4; ++i) lL[(4 * q + i) * 260 + ch] = al[i]; }
                __syncthreads();
            }
        for (int tb = 0; tb < 2; ++tb) {
            const int tt0 = tg0 + tb * 8;
            float accW[8], accA[8], accG[8], accL[8];
#pragma unroll
            for (int k = 0; k < 8; ++k) { const int o = (tb * 8 + k) * 516 + c; accW[k] = w0 + lW[o]; accA[k] = a0 + lA[o]; accG[k] = lG[o]; accL[k] = (c < 256) ? gbc + lL[(tb * 8 + k) * 260 + c] : 0.f; }
            float zr[9], zk[9], zv[9], zq[8], zf[8], zgq[8], zgk[8];
            { const bool has_prev = tt0 > 0; const bf16_t* zp0 = p.z + (size_t)(has_prev ? tt0 - 1 : 0) * ZLD;
              const float hp = has_prev ? 1.f : 0.f; zr[0] = bf2f(zp0[RW_R + c]) * hp; zk[0] = bf2f(zp0[RW_K + c]) * hp; zv[0] = bf2f(zp0[RW_V + c]) * hp; }
#pragma unroll
            for (int k = 0; k < 8; ++k) { const bf16_t* zc = p.z + (size_t)(tt0 + k) * ZLD;
                zr[k + 1] = bf2f(zc[RW_R + c]); zk[k + 1] = bf2f(zc[RW_K + c]); zv[k + 1] = bf2f(zc[RW_V + c]); zq[k] = bf2f(zc[HG_Q + c]); zf[k] = bf2f(zc[HG_F + c]);
                zgq[k] = bf2f(zc[GL_Q + (c & 255)]); zgk[k] = bf2f(zc[GL_K + (c & 255)]); }
            asm volatile("" ::: "memory");
            float sv[2][12];
#pragma unroll
            for (int k = 0; k < 8; ++k) {
                const int t = tt0 + k;
                const float cr = zr[k + 1], ck = zk[k + 1], cv = zv[k + 1];
                const float pr = zr[k], pk = zk[k], pv = zv[k];
                const float r = cr + (pr - cr) * mu_r, kx = ck + (pk - ck) * mu_k, v = cv + (pv - cv) * mu_v;
                const float w_raw = -fsoftplus(-accW[k]) - 0.5f;
                const float decay = __expf(-__expf(w_raw));
                const float iclr = fsig(accA[k]);
                const float kk = kx * kkc;
                const float nrm = sqrtf(wave_sum(kk * kk));
                const float kkn = kk / fmaxf(nrm, 1e-12f);
                const float kmod = kx * (1.0f + (iclr - 1.0f) * kac);
                const float bon = wave_sum(r * kmod * rkc) * v;
                float* svk = sv[k & 1];
                svk[0] = -kkn; svk[1] = kkn * iclr; svk[2] = decay; svk[3] = kmod; svk[4] = r; svk[5] = v; svk[6] = accG[k]; svk[7] = bon;
                { const float q = zq[k], f = zf[k];
                  const float omf = (1.0f - lb) * fsig(-f);
                  bH = fmaxf(bH + __logf(fmaxf(1.0f - omf, 1e-37f)), -85.0f);
                  svk[8] = q * fsig(q) * __expf(bH); svk[9] = omf * __expf(-bH); }
                svk[10] = 0.f; svk[11] = 0.f;
                if (c < 256) {
                  bG = fmaxf(bG - fsoftplus(-accL[k]) * (1.0f / 16.0f), -85.0f);
                  svk[10] = zgq[k] * 0.125f * __expf(bG); svk[11] = zgk[k] * __expf(-bG); }
                if (k & 1) {
                    const bool odd = (c & 1) != 0; const int cp = c & ~1; const size_t tp = (size_t)(t - 1 + (odd ? 1 : 0));
                    float lo[12], hi[12];
#pragma unroll
                    for (int st = 0; st < 12; ++st) { const float mine = odd ? sv[1][st] : sv[0][st], send = odd ? sv[0][st] : sv[1][st]; const float recv = dppmov<0xB1>(send);
                        lo[st] = odd ? recv : mine; hi[st] = odd ? mine : recv; }
                    { float* rs = p.RS + ((size_t)(c >> 6) * T + tp) * 384 + (cp & 63);
#pragma unroll
                      for (int st = 0; st < 6; ++st) *(f32x2v*)(rs + 64 * st) = (f32x2v){lo[st], hi[st]}; }
                    *(unsigned*)(p.rGate + tp * 512 + cp) = pg8::cvt_pk_bf16(lo[6], hi[6]); *(unsigned*)(p.rBonus + tp * 512 + cp) = pg8::cvt_pk_bf16(lo[7], hi[7]);
                    *(unsigned*)(p.cH + tp * 512 + cp) = pg8::cvt_pk_bf16(lo[8], hi[8]); *(unsigned*)(p.KH + tp * 512 + cp) = pg8::cvt_pk_bf16(lo[9], hi[9]);
                    if (c < 256) { *(unsigned*)(p.cG + tp * 256 + cp) = pg8::cvt_pk_bf16(lo[10], hi[10]); *(unsigned*)(p.KG + tp * 256 + cp) = pg8::cvt_pk_bf16(lo[11], hi[11]); }
                }
            }
        }
        }
        { const int h = c >> 7, j = c & 127; p.GamH[((size_t)tile * 4 + h) * 128 + j] = __expf(bH); }
        if (c < 256) { const int h = c >> 6, j = c & 63; p.GamG[((size_t)tile * 4 + h) * 64 + j] = __expf(bG); }
        __syncthreads();
        { const int wvt = c >> 6, lt = c & 63;
#pragma unroll 1
        for (int pass = 0; pass < 3; ++pass) {
            const int col0 = pass == 0 ? HG_I : (pass == 1 ? GL_V : SB_V); bf16_t* dstT = p.VtH + (size_t)pass * 512 * T;
            const bf16_t* src = p.z + (size_t)(t0 + lt) * ZLD + col0 + 64 * wvt;
            pg8::u32x4 xr[8];
#pragma unroll
            for (int j = 0; j < 8; ++j) xr[j] = *(const pg8::u32x4*)(src + 8 * j);
#pragma unroll
            for (int j = 0; j < 8; ++j) { const unsigned xw[4] = {xr[j].x, xr[j].y, xr[j].z, xr[j].w};
#pragma unroll
                for (int e = 0; e < 4; ++e) { vtile[64 * wvt + 8 * j + 2 * e][lt] = (bf16_t)(xw[e] & 0xffffu); vtile[64 * wvt + 8 * j + 2 * e + 1][lt] = (bf16_t)(xw[e] >> 16); } }
#pragma unroll
            for (int it = 0; it < 8; ++it) { const int row = 64 * wvt + it * 8 + (lt >> 3), sg = lt & 7;
                *(pg8::u32x4*)(dstT + (size_t)row * T + t0 + sg * 8) = *(const LAS pg8::u32x4*)&vtile[row][sg * 8]; }
        } }
    }
}

template <int KIND>
__device__ __forceinline__ void chain_unit(const MixArgs& p, const ConvArgs& cva, const int unit, const int seg, const int h, LAS float* lds) {
    constexpr int SF = KIND == 2 ? 512 : (KIND == 3 ? 320 : 384);
    constexpr int EPL = KIND == 2 ? 16 : 8, E2 = EPL / 2, DK = EPL * 8;
    constexpr int CH = 16, NP = CH * SF * 4 / 1024;
    static_assert(KIND == 0, "only the RWKV-7 chain is left (HGRN2 / GLA: intra_unit + chunk scan)");
    const float* stream = p.RS + ((size_t)h * T + (size_t)seg * LSEG) * SF;
    const int tid = phase_tid(), wv = __builtin_amdgcn_readfirstlane(tid >> 6), lane = tid & 63, rg = lane >> 3, lj = lane & 7;
    const bool isP = (KIND == 0) && (wv >= 4);
    const bool active = !(isP && seg == 0);
    const bool wantc = (KIND != 0) && (seg >= 1);
    const int rowA = ((KIND == 0) ? (wv & 3) : wv) * 16 + rg, rowB = rowA + 8;
    const int orow = (isP ? 64 : 0) + rowA;
    LAS float* ob = lds + 2 * CH * SF;
    LAS float* cb = ob;
    constexpr int NT = 8;
    const int jb0 = unit * (LSEG / 16) * NT;
    LAS bf16_t (*cvt)[64][66] = (LAS bf16_t (*)[64][66])(ob + 2 * 16 * 128);
    const int L = p.layer;
    f32x2v SA[E2], SB[E2];
#pragma unroll
    for (int e = 0; e < E2; ++e) { SA[e] = (f32x2v){0.f, 0.f}; SB[e] = (f32x2v){0.f, 0.f};
        if (isP) { if (lj * 8 + 2 * e == rowA) SA[e].x = 1.f; if (lj * 8 + 2 * e + 1 == rowA) SA[e].y = 1.f; if (lj * 8 + 2 * e == rowB) SB[e].x = 1.f; if (lj * 8 + 2 * e + 1 == rowB) SB[e].y = 1.f; } }
    f32x2v gam = (f32x2v){1.f, 1.f};
    auto stage = [&](int ci, LAS float* dst) {
        const char* g = (const char*)(stream + (size_t)ci * CH * SF) + lane * 16;
        for (int pc = wv; pc < NP; pc += 8) __builtin_amdgcn_global_load_lds((const unsigned*)(g + pc * 1024), (LAS unsigned*)((LAS char*)dst + pc * 1024), 16, 0, 0);
    };
    auto writeout = [&](int ci, const LAS float* o, const LAS float* cc) {
#pragma unroll
        for (int q = 0; q < 4; ++q) { const int idx = tid + 512 * q, s = idx >> 7, r = idx & 127; const size_t t = (size_t)seg * LSEG + ci * CH + s; const float v = o[idx];
            if (KIND == 0) { if (r < 64) p.oR[t * 512 + h * 64 + r] = v; else if (seg >= 1) p.cR[t * 512 + h * 64 + (r - 64)] = f2bf(v); }
            else if (KIND == 2) p.oH[t * 512 + h * 128 + r] = v;
            else p.oG[t * 512 + h * 128 + r] = v; }
        if (wantc) {
#pragma unroll
            for (int q = 0; q < (DK * 16) / 512; ++q) { const int idx = tid + 512 * q, s = idx / DK, k = idx % DK; const size_t t = (size_t)seg * LSEG + ci * CH + s;
                if (KIND == 2) p.cH[t * 512 + h * 128 + k] = f2bf(cc[s * 128 + k]); else p.cG[t * 256 + h * 64 + k] = f2bf(cc[s * 128 + k]); }
        }
    };
    constexpr int NCH = LSEG / CH;
    struct OpsR { f32x4v a0, a1, b0, b1, w0, w1, r0, r1, k0, k1; float vA, vB; };
    struct OpsG { f32x4v q[EPL / 4], w[EPL / 4], k[EPL / 4]; float vA, vB; f32x2v gw, gq; };
    const float vscale = isP ? 0.f : 1.f;
    const int goff = (EPL == 8) ? (lj * 8 + wv) : (lj * 16 + 2 * wv);
    stage(0, lds);
    for (int ci = 0; ci < NCH; ++ci) {
        asm volatile("s_waitcnt vmcnt(0)" ::: "memory"); __syncthreads();
        const LAS float* cur = lds + (ci & 1) * CH * SF;
        if (ci + 1 < NCH) stage(ci + 1, lds + ((ci + 1) & 1) * CH * SF);
        if (ci > 0) writeout(ci - 1, ob + ((ci - 1) & 1) * 2048, cb + ((ci - 1) & 1) * 2048);
        LAS float* oc = ob + (ci & 1) * 2048; LAS float* ccur = cb + (ci & 1) * 2048;
        if (ci > 0) {
#pragma unroll
            for (int k4 = 0; k4 < NT; ++k4) { CvJob jb; if (cvx_job(cva, jb0 + (ci - 1) * NT + k4, L, jb)) { const int n = tid >> 3, kc = (tid & 7) * 8;
                const LAS unsigned* tp = (const LAS unsigned*)&cvt[k4][n][kc]; pg8::u32x4 w; w.x = tp[0]; w.y = tp[1]; w.z = tp[2]; w.w = tp[3];
                *(pg8::u32x4*)(jb.dst + (size_t)n * jb.ldd + kc) = w; } }
        }
        float4 cvr[NT][2]; bool cvok[NT];
#pragma unroll
        for (int k4 = 0; k4 < NT; ++k4) { CvJob jb; cvok[k4] = cvx_job(cva, jb0 + ci * NT + k4, L, jb);
            cvr[k4][0] = make_float4(0.f, 0.f, 0.f, 0.f); cvr[k4][1] = cvr[k4][0];
            if (cvok[k4]) { const int c4 = (tid & 15) * 4, kr = tid >> 4;
                if (c4 < jb.valid) { cvr[k4][0] = *(const float4*)(jb.src + (size_t)(2 * kr) * jb.ld + c4); cvr[k4][1] = *(const float4*)(jb.src + (size_t)(2 * kr + 1) * jb.ld + c4); } } }
        if (active) {
            if constexpr (KIND == 0) {
                auto ld = [&](int s) { const LAS float* sp = cur + s * SF + lj * 8; OpsR o;
                    o.a0 = *(const LAS f32x4v*)(sp); o.a1 = *(const LAS f32x4v*)(sp + 4); o.b0 = *(const LAS f32x4v*)(sp + 64); o.b1 = *(const LAS f32x4v*)(sp + 68);
                    o.w0 = *(const LAS f32x4v*)(sp + 128); o.w1 = *(const LAS f32x4v*)(sp + 132); o.k0 = *(const LAS f32x4v*)(sp + 192); o.k1 = *(const LAS f32x4v*)(sp + 196);
                    o.r0 = *(const LAS f32x4v*)(sp + 256); o.r1 = *(const LAS f32x4v*)(sp + 260);
                    o.vA = cur[s * SF + 320 + rowA]; o.vB = cur[s * SF + 320 + rowB]; return o; };
                OpsR nx = ld(0);
#pragma unroll
                for (int s = 0; s < CH; ++s) {
                    const OpsR o = nx;
                    if (s + 1 < CH) nx = ld(s + 1);
                    f32x2v pa = SA[0] * o.a0.xy, pb = SB[0] * o.a0.xy; pa = SA[1] * o.a0.zw + pa; pb = SB[1] * o.a0.zw + pb;
                    f32x2v qa = SA[2] * o.a1.xy, qb = SB[2] * o.a1.xy; qa = SA[3] * o.a1.zw + qa; qb = SB[3] * o.a1.zw + qb; pa += qa; pb += qb;
                    float sA = pa.x + pa.y, sB = pb.x + pb.y;
                    sA += dppmov<0xB1>(sA); sB += dppmov<0xB1>(sB); sA += dppmov<0x4E>(sA); sB += dppmov<0x4E>(sB); sA += dppmov<0x141>(sA); sB += dppmov<0x141>(sB);
                    const f32x2v savA = (f32x2v){sA, sA}, savB = (f32x2v){sB, sB};
                    const float vA = o.vA * vscale, vB = o.vB * vscale; const f32x2v vvA = (f32x2v){vA, vA}, vvB = (f32x2v){vB, vB};
                    SA[0] = SA[0] * o.w0.xy + (savA * o.b0.xy + vvA * o.k0.xy); SB[0] = SB[0] * o.w0.xy + (savB * o.b0.xy + vvB * o.k0.xy);
                    SA[1] = SA[1] * o.w0.zw + (savA * o.b0.zw + vvA * o.k0.zw); SB[1] = SB[1] * o.w0.zw + (savB * o.b0.zw + vvB * o.k0.zw);
                    SA[2] = SA[2] * o.w1.xy + (savA * o.b1.xy + vvA * o.k1.xy); SB[2] = SB[2] * o.w1.xy + (savB * o.b1.xy + vvB * o.k1.xy);
                    SA[3] = SA[3] * o.w1.zw + (savA * o.b1.zw + vvA * o.k1.zw); SB[3] = SB[3] * o.w1.zw + (savB * o.b1.zw + vvB * o.k1.zw);
                    f32x2v oa = SA[0] * o.r0.xy, obb = SB[0] * o.r0.xy; oa = SA[1] * o.r0.zw + oa; obb = SB[1] * o.r0.zw + obb;
                    f32x2v oa2 = SA[2] * o.r1.xy, ob2 = SB[2] * o.r1.xy; oa2 = SA[3] * o.r1.zw + oa2; ob2 = SB[3] * o.r1.zw + ob2; oa += oa2; obb += ob2;
                    float oA = oa.x + oa.y, oB = obb.x + obb.y;
                    oA += dppmov<0xB1>(oA); oB += dppmov<0xB1>(oB); oA += dppmov<0x4E>(oA); oB += dppmov<0x4E>(oB); oA += dppmov<0x141>(oA); oB += dppmov<0x141>(oB);
                    if (lj == 0) { oc[s * 128 + orow] = oA; oc[s * 128 + orow + 8] = oB; }
                }
            } else {
                auto ld = [&](int s) { const LAS float* sp = cur + s * SF + lj * EPL; OpsG o;
#pragma unroll
                    for (int e4 = 0; e4 < EPL / 4; ++e4) { o.q[e4] = *(const LAS f32x4v*)(sp + e4 * 4); o.w[e4] = *(const LAS f32x4v*)(sp + DK + e4 * 4); o.k[e4] = *(const LAS f32x4v*)(sp + 2 * DK + e4 * 4); }
                    o.vA = cur[s * SF + 3 * DK + rowA]; o.vB = cur[s * SF + 3 * DK + rowB];
                    if constexpr (EPL == 8) { o.gw = (f32x2v){cur[s * SF + DK + goff], 1.f}; o.gq = (f32x2v){cur[s * SF + goff], 0.f}; }
                    else { o.gw = *(const LAS f32x2v*)(cur + s * SF + DK + goff); o.gq = *(const LAS f32x2v*)(cur + s * SF + goff); }
                    return o; };
                OpsG nx = ld(0);
#pragma unroll
                for (int s = 0; s < CH; ++s) {
                    const OpsG o = nx;
                    if (s + 1 < CH) nx = ld(s + 1);
                    const f32x2v vvA = (f32x2v){o.vA, o.vA}, vvB = (f32x2v){o.vB, o.vB};
                    f32x2v oa = (f32x2v){0.f, 0.f}, oa2 = oa, obb = oa, ob2 = oa;
#pragma unroll
                    for (int e4 = 0; e4 < EPL / 4; ++e4) {
                        SA[2 * e4] = SA[2 * e4] * o.w[e4].xy + vvA * o.k[e4].xy; SA[2 * e4 + 1] = SA[2 * e4 + 1] * o.w[e4].zw + vvA * o.k[e4].zw;
                        SB[2 * e4] = SB[2 * e4] * o.w[e4].xy + vvB * o.k[e4].xy; SB[2 * e4 + 1] = SB[2 * e4 + 1] * o.w[e4].zw + vvB * o.k[e4].zw;
                        oa = SA[2 * e4] * o.q[e4].xy + oa; oa2 = SA[2 * e4 + 1] * o.q[e4].zw + oa2; obb = SB[2 * e4] * o.q[e4].xy + obb; ob2 = SB[2 * e4 + 1] * o.q[e4].zw + ob2;
                    }
                    oa += oa2; obb += ob2;
                    float oA = oa.x + oa.y, oB = obb.x + obb.y;
                    oA += dppmov<0xB1>(oA); oB += dppmov<0xB1>(oB); oA += dppmov<0x4E>(oA); oB += dppmov<0x4E>(oB); oA += dppmov<0x141>(oA); oB += dppmov<0x141>(oB);
                    if (lj == 0) { oc[s * 128 + rowA] = oA; oc[s * 128 + rowB] = oB; }
                    gam *= o.gw; const f32x2v cq = o.gq * gam;
                    if (wantc && rg == 0) { if constexpr (EPL == 8) ccur[s * 128 + goff] = cq.x; else *(LAS f32x2v*)(ccur + s * 128 + goff) = cq; }
                }
            }
        }
        __syncthreads();
#pragma unroll
        for (int k4 = 0; k4 < NT; ++k4) if (cvok[k4]) { const int c4 = (tid & 15) * 4, kr = tid >> 4; const float4 v0 = cvr[k4][0], v1 = cvr[k4][1];
            *(LAS unsigned*)&cvt[k4][c4][2 * kr] = pg8::cvt_pk_bf16(v0.x, v1.x); *(LAS unsigned*)&cvt[k4][c4 + 1][2 * kr] = pg8::cvt_pk_bf16(v0.y, v1.y);
            *(LAS unsigned*)&cvt[k4][c4 + 2][2 * kr] = pg8::cvt_pk_bf16(v0.z, v1.z); *(LAS unsigned*)&cvt[k4][c4 + 3][2 * kr] = pg8::cvt_pk_bf16(v0.w, v1.w); }
    }
    __syncthreads();
#pragma unroll
    for (int k4 = 0; k4 < NT; ++k4) { CvJob jb; if (cvx_job(cva, jb0 + (NCH - 1) * NT + k4, L, jb)) { const int n = tid >> 3, kc = (tid & 7) * 8;
        const LAS unsigned* tp = (const LAS unsigned*)&cvt[k4][n][kc]; pg8::u32x4 w; w.x = tp[0]; w.y = tp[1]; w.z = tp[2]; w.w = tp[3];
        *(pg8::u32x4*)(jb.dst + (size_t)n * jb.ldd + kc) = w; } }
    writeout(NCH - 1, ob + ((NCH - 1) & 1) * 2048, cb + ((NCH - 1) & 1) * 2048);
    if (active) {
        float* dA;
        if (KIND == 0) dA = (isP ? p.PendR : p.SendR) + (((size_t)seg * 8 + h) * 64 + rowA) * 64 + lj * 8;
        else if (KIND == 2) dA = p.SendH + (((size_t)seg * 4 + h) * 128 + rowA) * 128 + lj * 16;
        else dA = p.SendG + (((size_t)seg * 4 + h) * 128 + rowA) * 64 + lj * 8;
        float* dB = dA + 8 * DK;
#pragma unroll
        for (int e = 0; e < E2; ++e) { dA[2 * e] = SA[e].x; dA[2 * e + 1] = SA[e].y; dB[2 * e] = SB[e].x; dB[2 * e + 1] = SB[e].y; }
    }
    if (wantc && rg == 0) {
        if constexpr (EPL == 8) p.GamG[(size_t)seg * 256 + h * 64 + lj * 8 + wv] = gam.x;
        else { p.GamH[(size_t)seg * 512 + h * 128 + lj * 16 + 2 * wv] = gam.x; p.GamH[(size_t)seg * 512 + h * 128 + lj * 16 + 2 * wv + 1] = gam.y; }
    }
    __syncthreads();
}
__device__ __forceinline__ void sb_phase(const MixArgs& p, const int wave0, const int W, const int uend);
template <int DK>
__device__ __forceinline__ void intra_unit(const MixArgs& p, const int h, const int chunk, LAS bf16_t* ktT, const int lane) {
    typedef short bf16x8v __attribute__((ext_vector_type(8)));
    typedef float f32x16v __attribute__((ext_vector_type(16)));
    typedef __bf16 bf16x2n __attribute__((ext_vector_type(2)));
    constexpr int QP = DK * 4, NKS = DK / 16, NKB = DK / 32;
    const bf16_t* Qb = (DK == 128 ? p.cH : p.cG) + h * DK; const bf16_t* Kb = (DK == 128 ? p.KH : p.KG) + h * DK;
    const bf16_t* Vt = (DK == 128 ? p.VtH : p.VtG) + (size_t)h * 128 * T;
    float* ol = (DK == 128 ? p.oH : p.oG) + h * 128; float* Send = (DK == 128 ? p.SendH : p.SendG) + ((size_t)chunk * 4 + h) * 128 * DK;
    const int r = lane & 31, hh = lane >> 5, t0 = chunk * 64;
#pragma unroll 1
    for (int tb = 0; tb < 2; ++tb) {
        bf16x8v Qf[NKS];
#pragma unroll
        for (int ks = 0; ks < NKS; ++ks) Qf[ks] = *(const bf16x8v*)(Qb + (unsigned)((t0 + 32 * tb + r) * QP + 16 * ks + 8 * hh));
#pragma unroll 1
        for (int vh = 0; vh < 2; ++vh) {
            f32x16v O[2];
#pragma unroll
            for (int vb = 0; vb < 2; ++vb)
#pragma unroll
                for (int i = 0; i < 16; ++i) O[vb][i] = 0.f;
            for (int sb = 0; sb <= tb; ++sb) {
                f32x16v P;
#pragma unroll
                for (int i = 0; i < 16; ++i) P[i] = 0.f;
#pragma unroll
                for (int ks = 0; ks < NKS; ++ks) { const bf16x8v Kf = *(const bf16x8v*)(Kb + (unsigned)((t0 + 32 * sb + r) * QP + 16 * ks + 8 * hh));
                    P = __builtin_amdgcn_mfma_f32_32x32x16_bf16(Kf, Qf[ks], P, 0, 0, 0); }
                const bool diag = (sb == tb);
                bf16x8v Pf[2];
#pragma unroll
                for (int s2 = 0; s2 < 2; ++s2) {
                    union { bf16x2n h2[4]; bf16x8v v; } pk;
#pragma unroll
                    for (int j = 0; j < 4; ++j) { f32x2v f;
                        { const int i = 8 * s2 + 2 * j, kr = (i & 3) + 8 * (i >> 2) + 4 * hh; f.x = (!diag || kr <= r) ? P[i] : 0.f; }
                        { const int i = 8 * s2 + 2 * j + 1, kr = (i & 3) + 8 * (i >> 2) + 4 * hh; f.y = (!diag || kr <= r) ? P[i] : 0.f; }
                        pk.h2[j] = __builtin_convertvector(f, bf16x2n); }
                    Pf[s2] = pk.v; }
#pragma unroll
                for (int vb = 0; vb < 2; ++vb)
#pragma unroll
                    for (int s2 = 0; s2 < 2; ++s2) { const bf16_t* vp = Vt + (unsigned)((32 * (2 * vh + vb) + r) * T + t0 + 32 * sb + 16 * s2 + 4 * hh);
                        union { pg8::u32x2 d[2]; bf16x8v v; } vf; vf.d[0] = *(const pg8::u32x2*)vp; vf.d[1] = *(const pg8::u32x2*)(vp + 8);
                        O[vb] = __builtin_amdgcn_mfma_f32_32x32x16_bf16(vf.v, Pf[s2], O[vb], 0, 0, 0); }
            }
#pragma unroll
            for (int vb = 0; vb < 2; ++vb)
#pragma unroll
                for (int g = 0; g < 4; ++g) { f32x4v w; w.x = O[vb][4 * g]; w.y = O[vb][4 * g + 1]; w.z = O[vb][4 * g + 2]; w.w = O[vb][4 * g + 3];
                    *(f32x4v*)(ol + (unsigned)((t0 + 32 * tb + r) * 512 + 32 * (2 * vh + vb) + 8 * g + 4 * hh)) = w; }
        }
    }
#pragma unroll 8
    for (int it = 0; it < DK / 8; ++it) { const int pidx = it * 64 + lane, srow = pidx / (DK / 8), cb8 = pidx % (DK / 8);
        const pg8::u32x4 w = *(const pg8::u32x4*)(Kb + (unsigned)((t0 + srow) * QP + cb8 * 8));
        const unsigned ww[4] = {w.x, w.y, w.z, w.w};
#pragma unroll
        for (int j = 0; j < 4; ++j) { ktT[(cb8 * 8 + 2 * j) * 66 + srow] = (bf16_t)(ww[j] & 0xffffu); ktT[(cb8 * 8 + 2 * j + 1) * 66 + srow] = (bf16_t)(ww[j] >> 16); } }
    bf16x8v AfAll[4][4];
#pragma unroll
    for (int vb = 0; vb < 4; ++vb)
#pragma unroll
        for (int ks = 0; ks < 4; ++ks) AfAll[vb][ks] = *(const bf16x8v*)(Vt + (unsigned)((32 * vb + r) * T + t0 + 16 * ks + 8 * hh));
#pragma unroll
    for (int vb = 0; vb < 4; ++vb) {
        const bf16x8v (&Af)[4] = AfAll[vb];
#pragma unroll 1
        for (int kb = 0; kb < NKB; ++kb) {
            f32x16v U;
#pragma unroll
            for (int i = 0; i < 16; ++i) U[i] = 0.f;
#pragma unroll
            for (int ks = 0; ks < 4; ++ks) { const LAS unsigned* tp = (const LAS unsigned*)(ktT + (32 * kb + r) * 66 + 16 * ks + 8 * hh);
                union { unsigned d[4]; bf16x8v v; } bf; bf.d[0] = tp[0]; bf.d[1] = tp[1]; bf.d[2] = tp[2]; bf.d[3] = tp[3];
                U = __builtin_amdgcn_mfma_f32_32x32x16_bf16(Af[ks], bf.v, U, 0, 0, 0); }
            float* sp = Send + (unsigned)((32 * vb + 4 * hh) * DK + 32 * kb + r);
#pragma unroll
            for (int i = 0; i < 16; ++i) sp[((i & 3) + 8 * (i >> 2)) * DK] = U[i];
        }
    }
}
__device__ __forceinline__ void chains_phase(const MixArgs& p, const ConvArgs& cva, unsigned* sbq, LAS unsigned char* ldsraw) {
    LAS float* lds = (LAS float*)ldsraw;
    for (int u = blockIdx.x; u < 8 * NSEG; u += gridDim.x) chain_unit<0>(p, cva, u, u >> 3, u & 7, lds);
    LAS int* slot = (LAS int*)(ldsraw + 8 * 128 * 66 * 2);
    const int ptid = phase_tid(), wv = ptid >> 6, lane = ptid & 63;
    LAS bf16_t* ktT = (LAS bf16_t*)ldsraw + (size_t)wv * 128 * 66;
    for (;;) {
        __syncthreads();
        if (ptid == 0) slot[0] = (int)__hip_atomic_fetch_add(sbq, 8u, __ATOMIC_RELAXED, __HIP_MEMORY_SCOPE_AGENT);
        __syncthreads();
        const int base = slot[0];
        if (base >= 2048) break;
        const int u = base + wv; if (u < 1024) intra_unit<128>(p, u & 3, u >> 2, ktT, lane); else intra_unit<64>(p, (u - 1024) & 3, (u - 1024) >> 2, ktT, lane);
    }
}
__device__ __forceinline__ void sb_queue(const MixArgs& p, unsigned* sbq2, LAS unsigned char* ldsraw) {
    LAS int* slot = (LAS int*)(ldsraw + 8 * 128 * 66 * 2);
    const int ptid = phase_tid();
    for (;;) {
        __syncthreads();
        if (ptid == 0) slot[0] = (int)__hip_atomic_fetch_add(sbq2, 8u, __ATOMIC_RELAXED, __HIP_MEMORY_SCOPE_AGENT);
        __syncthreads();
        const int base = slot[0];
        if (base >= 2048) break;
        sb_phase(p, base, 1 << 30, 2048);
    }
}

__device__ __forceinline__ void carry_phase(const MixArgs& p, LAS unsigned char* ldsraw, const int part) {
    const int tid = phase_tid();
    if (part != 2) for (int u = blockIdx.x; u < 32; u += gridDim.x) {
        const int h = u >> 2, vq = u & 3;
        LAS float (*cur)[68] = (LAS float (*)[68])ldsraw; LAS float (*Pm)[68] = (LAS float (*)[68])(ldsraw + 16 * 68 * 4);
        const int vl = tid >> 5, kb = (tid & 31) * 2;
        const int pv = tid >> 3, pk = (tid & 7) * 8;
        const size_t eoS = (size_t)(16 * vq + vl) * 64 + kb, eoP = (size_t)pv * 64 + pk;
        f32x2v nv; f32x4v rP0[4], rP1[4]; f32x2v rS[4];
        nv = *(const f32x2v*)(p.SendR + ((size_t)0 * 8 + h) * 4096 + eoS);
#pragma unroll
        for (int j = 1; j < 4; ++j) { rP0[j] = *(const f32x4v*)(p.PendR + ((size_t)j * 8 + h) * 4096 + eoP); rP1[j] = *(const f32x4v*)(p.PendR + ((size_t)j * 8 + h) * 4096 + eoP + 4);
            rS[j] = *(const f32x2v*)(p.SendR + ((size_t)j * 8 + h) * 4096 + eoS); }
        rP0[0] = rP0[1]; rP1[0] = rP1[1]; rS[0] = rS[1];
        for (int sb = 0; sb < NSEG; sb += 4) {
#pragma unroll
            for (int j = 0; j < 4; ++j) { const int s = sb + j;
                if (s >= 1) {
                    __syncthreads();
                    *(unsigned*)(p.SstR + ((size_t)s * 8 + h) * 4096 + eoS) = pg8::cvt_pk_bf16(nv.x, nv.y);
                    if (s < NSEG - 1) {
                        *(LAS f32x2v*)&cur[vl][kb] = nv;
                        *(LAS f32x4v*)&Pm[pv][pk] = rP0[j]; *(LAS f32x4v*)&Pm[pv][pk + 4] = rP1[j];
                        nv = rS[j];
                        __syncthreads();
                        if (s + 3 < NSEG - 1) { constexpr int dummy = 0; (void)dummy; const int jn = (j + 3) & 3;
                            rP0[jn] = *(const f32x4v*)(p.PendR + ((size_t)(s + 3) * 8 + h) * 4096 + eoP); rP1[jn] = *(const f32x4v*)(p.PendR + ((size_t)(s + 3) * 8 + h) * 4096 + eoP + 4);
                            rS[jn] = *(const f32x2v*)(p.SendR + ((size_t)(s + 3) * 8 + h) * 4096 + eoS); }
#pragma unroll 4
                        for (int i4 = 0; i4 < 64; i4 += 4) { const f32x4v c4 = *(const LAS f32x4v*)&cur[vl][i4];
#pragma unroll
                            for (int ii = 0; ii < 4; ++ii) { const f32x2v p2 = *(const LAS f32x2v*)&Pm[i4 + ii][kb]; const float c = c4[ii]; nv = (f32x2v){c, c} * p2 + nv; } }
                    }
                }
            }
        }
        __syncthreads();
    }
    if (part != 1) for (int u = blockIdx.x; u < 32 + 192; u += gridDim.x) {
        if (u < 32) continue;
        const bool isH = u < 32 + 128; const int idx = (isH ? (u - 32) : (u - 160)) * 512 + tid;
        const float* Ub = (isH ? p.SendH : p.SendG) + idx; bf16_t* Sb = (isH ? p.SstH : p.SstG) + idx; const size_t cstr = isH ? 65536 : 32768;
        const float* Gb = isH ? p.GamH + (idx >> 14) * 128 + (idx & 127) : p.GamG + (idx >> 13) * 64 + (idx & 63); const int gstr = isH ? 512 : 256;
        float S = 0.f;
        float uu[16], gg[16], un[16], gn[16];
#pragma unroll
        for (int j = 0; j < 16; ++j) { un[j] = Ub[(size_t)j * cstr]; gn[j] = Gb[(size_t)j * gstr]; }
        for (int c0 = 0; c0 < NCHK; c0 += 16) {
#pragma unroll
            for (int j = 0; j < 16; ++j) { uu[j] = un[j]; gg[j] = gn[j]; }
            if (c0 + 16 < NCHK) {
#pragma unroll
                for (int j = 0; j < 16; ++j) { un[j] = Ub[(size_t)(c0 + 16 + j) * cstr]; gn[j] = Gb[(size_t)(c0 + 16 + j) * gstr]; } }
#pragma unroll
            for (int j = 0; j < 16; ++j) { Sb[(size_t)(c0 + j) * cstr] = f2bf(S); S = gg[j] * (S + uu[j]); }
        }
    }
}

__device__ __forceinline__ void mixfin_phase(const MixArgs& p) {
    typedef short bf16x8v __attribute__((ext_vector_type(8)));
    const int tid = phase_tid(), wv = tid >> 6, lane = tid & 63, r = lane & 15, q = lane >> 4, L = p.layer;
    const int W = gridDim.x * 8;
    for (int u = blockIdx.x * 8 + wv; u < 16384; u += W) {
        if (u < 8192) {
            const int tt = u >> 3, h = u & 7, t0 = tt * 16, seg = t0 / LSEG;
            f32x4v acc[4];
#pragma unroll
            for (int nb = 0; nb < 4; ++nb) acc[nb] = (f32x4v){0.f, 0.f, 0.f, 0.f};
            if (seg >= 1) {
#pragma unroll
                for (int ks = 0; ks < 2; ++ks) { const bf16x8v A = *(const bf16x8v*)(p.cR + (size_t)(t0 + r) * 512 + h * 64 + ks * 32 + q * 8);
#pragma unroll
                    for (int nb = 0; nb < 4; ++nb) { const bf16x8v B = *(const bf16x8v*)(p.SstR + (((size_t)seg * 8 + h) * 64 + nb * 16 + r) * 64 + ks * 32 + q * 8);
                        acc[nb] = __builtin_amdgcn_mfma_f32_16x16x32_bf16(A, B, acc[nb], 0, 0, 0); } }
            }
            float oin[4][4], bon[4][4], gat[4][4], lnw[4], lnb[4];
#pragma unroll
            for (int nb = 0; nb < 4; ++nb) { const int c = h * 64 + nb * 16 + r; lnw[nb] = p.rw_ln_w[L * 512 + c]; lnb[nb] = p.rw_ln_b[L * 512 + c];
#pragma unroll
                for (int i = 0; i < 4; ++i) { const size_t t = (size_t)t0 + 4 * q + i; oin[i][nb] = p.oR[t * 512 + c]; bon[i][nb] = bf2f(p.rBonus[t * 512 + c]); gat[i][nb] = bf2f(p.rGate[t * 512 + c]); } }
#pragma unroll
            for (int i = 0; i < 4; ++i) { const size_t t = (size_t)t0 + 4 * q + i; float o[4]; float s = 0.f;
#pragma unroll
                for (int nb = 0; nb < 4; ++nb) { o[nb] = acc[nb][i] + oin[i][nb]; s += o[nb]; }
                const float mu = red16(s) * (1.0f / 64.0f); float d2 = 0.f;
#pragma unroll
                for (int nb = 0; nb < 4; ++nb) { o[nb] -= mu; d2 += o[nb] * o[nb]; }
                const float rstd = rsqrtf(red16(d2) * (1.0f / 64.0f) + 64e-5f);
#pragma unroll
                for (int nb = 0; nb < 4; ++nb) { const int c = h * 64 + nb * 16 + r; const float y = o[nb] * rstd * lnw[nb] + lnb[nb];
                    p.bo[(size_t)T * 512 + t * 512 + c] = f2bf((y + bon[i][nb]) * gat[i][nb]); } }
        } else {
            const bool isH = u < 12288; const int qq = isH ? u - 8192 : u - 12288;
            const int tt = qq >> 2, h = qq & 3, t0 = tt * 16, seg = t0 >> 6;
            f32x4v acc[8];
#pragma unroll
            for (int nb = 0; nb < 8; ++nb) acc[nb] = (f32x4v){0.f, 0.f, 0.f, 0.f};
            if (seg >= 1) {
                if (isH) {
#pragma unroll
                    for (int ks = 0; ks < 4; ++ks) { const bf16x8v A = *(const bf16x8v*)(p.cH + (size_t)(t0 + r) * 512 + h * 128 + ks * 32 + q * 8);
#pragma unroll
                        for (int nb = 0; nb < 8; ++nb) { const bf16x8v B = *(const bf16x8v*)(p.SstH + (((size_t)seg * 4 + h) * 128 + nb * 16 + r) * 128 + ks * 32 + q * 8);
                            acc[nb] = __builtin_amdgcn_mfma_f32_16x16x32_bf16(A, B, acc[nb], 0, 0, 0); } }
                } else {
#pragma unroll
                    for (int ks = 0; ks < 2; ++ks) { const bf16x8v A = *(const bf16x8v*)(p.cG + (size_t)(t0 + r) * 256 + h * 64 + ks * 32 + q * 8);
#pragma unroll
                        for (int nb = 0; nb < 8; ++nb) { const bf16x8v B = *(const bf16x8v*)(p.SstG + (((size_t)seg * 4 + h) * 128 + nb * 16 + r) * 64 + ks * 32 + q * 8);
                            acc[nb] = __builtin_amdgcn_mfma_f32_16x16x32_bf16(A, B, acc[nb], 0, 0, 0); } }
                }
            }
            const float* ol = isH ? p.oH : p.oG; const float* gain = (isH ? p.hg_norm_w : p.gla_norm_w) + L * 512; const int gcol = isH ? HG_G : GL_R;
            bf16_t* bo = p.bo + (isH ? (size_t)0 : (size_t)3 * T * 512);
            float oin[4][8], gin[4][8], gn[8];
#pragma unroll
            for (int nb = 0; nb < 8; ++nb) { const int c = h * 128 + nb * 16 + r; gn[nb] = gain[c];
#pragma unroll
                for (int i = 0; i < 4; ++i) { const size_t t = (size_t)t0 + 4 * q + i; oin[i][nb] = ol[t * 512 + c]; gin[i][nb] = bf2f(p.z[t * ZLD + gcol + c]); } }
#pragma unroll
            for (int i = 0; i < 4; ++i) { const size_t t = (size_t)t0 + 4 * q + i; float o[8]; float ss = 0.f;
#pragma unroll
                for (int nb = 0; nb < 8; ++nb) { o[nb] = acc[nb][i] + oin[i][nb]; ss += o[nb] * o[nb]; }
                const float rs = rsqrtf(red16(ss) * (1.0f / 128.0f) + 1e-5f);
#pragma unroll
                for (int nb = 0; nb < 8; ++nb) { const int c = h * 128 + nb * 16 + r;
                    bo[t * 512 + c] = f2bf(o[nb] * rs * gn[nb] * siluf_(gin[i][nb])); } }
        }
    }
}
__device__ __forceinline__ void sb_phase(const MixArgs& p, const int wave0, const int W, const int uend) {
    typedef short bf16x8v __attribute__((ext_vector_type(8)));
    typedef float f32x16v __attribute__((ext_vector_type(16)));
    typedef __bf16 bf16x2n __attribute__((ext_vector_type(2)));
    const int tid = phase_tid(), wv = tid >> 6, lane = tid & 63, r = lane & 31, hh = lane >> 5;
    const float scale = 0.08838834764831845f;
    for (int u = wave0 + wv; u < uend; u += W) {
        const int h = u & 3, qb = u >> 2, q0 = qb * 32;
        bf16x8v Qf[8];
#pragma unroll
        for (int s = 0; s < 8; ++s) Qf[s] = *(const bf16x8v*)(p.z + (size_t)(q0 + r) * ZLD + SB_Q + h * 128 + s * 16 + hh * 8);
        f32x16v O[4];
#pragma unroll
        for (int db = 0; db < 4; ++db)
#pragma unroll
            for (int i = 0; i < 16; ++i) O[db][i] = 0.f;
        float R = 0.f;
        bf16x8v Kn[8];
#pragma unroll
        for (int s = 0; s < 8; ++s) Kn[s] = *(const bf16x8v*)(p.z + (size_t)(qb * 32 + r) * ZLD + SB_K + h * 128 + s * 16 + hh * 8);
        for (int kb = qb; kb >= 0; --kb) {
            const int k0 = kb * 32;
            f32x16v Sacc;
#pragma unroll
            for (int i = 0; i < 16; ++i) Sacc[i] = 0.f;
#pragma unroll
            for (int s = 0; s < 8; ++s) Sacc = __builtin_amdgcn_mfma_f32_32x32x16_bf16(Kn[s], Qf[s], Sacc, 0, 0, 0);
            { const int kn0 = (kb > 0 ? kb - 1 : 0) * 32;
#pragma unroll
              for (int s = 0; s < 8; ++s) Kn[s] = *(const bf16x8v*)(p.z + (size_t)(kn0 + r) * ZLD + SB_K + h * 128 + s * 16 + hh * 8); }
            float lk[16], zz[16]; bool valid[16];
            const bool diag = (kb == qb);
#pragma unroll
            for (int i = 0; i < 16; ++i) { const int kr = (i & 3) + 8 * (i >> 2) + 4 * hh;
                valid[i] = !diag || (kr < r);
                zz[i] = Sacc[i] * scale;
                const float sp = fmaxf(zz[i], 0.f) + __logf(1.0f + __expf(-fabsf(zz[i])));
                lk[i] = valid[i] ? -sp : 0.f; }
            float G[4], Gp[4];
#pragma unroll
            for (int g = 0; g < 4; ++g) { G[g] = (lk[4 * g] + lk[4 * g + 1]) + (lk[4 * g + 2] + lk[4 * g + 3]); Gp[g] = __shfl_xor(G[g], 32); }
            float Tq[4]; float run = 0.f;
#pragma unroll
            for (int g = 3; g >= 0; --g) { Tq[g] = run + (hh == 0 ? Gp[g] : 0.f); run += G[g] + Gp[g]; }
            float wgt[16];
#pragma unroll
            for (int g = 0; g < 4; ++g) { float ing = 0.f;
#pragma unroll
                for (int j = 3; j >= 0; --j) { const int i = 4 * g + j;
                    const float logw = zz[i] + lk[i] + (R + Tq[g] + ing);
                    wgt[i] = valid[i] ? __expf(logw) : 0.f;
                    ing += lk[i]; } }
            R += run;
            bf16x8v Pf[2];
#pragma unroll
            for (int s2 = 0; s2 < 2; ++s2) {
                union { bf16x2n h2[4]; bf16x8v v; } pk;
#pragma unroll
                for (int j = 0; j < 4; ++j) { f32x2v f; f.x = wgt[8 * s2 + 2 * j]; f.y = wgt[8 * s2 + 2 * j + 1]; pk.h2[j] = __builtin_convertvector(f, bf16x2n); }
                Pf[s2] = pk.v; }
#pragma unroll
            for (int db = 0; db < 4; ++db)
#pragma unroll
                for (int s2 = 0; s2 < 2; ++s2) { const bf16_t* vp = p.Vt + (size_t)(h * 128 + db * 32 + r) * T + k0 + 16 * s2 + 4 * hh;
                    union { pg8::u32x2 d[2]; bf16x8v v; } vf; vf.d[0] = *(const pg8::u32x2*)vp; vf.d[1] = *(const pg8::u32x2*)(vp + 8);
                    O[db] = __builtin_amdgcn_mfma_f32_32x32x16_bf16(vf.v, Pf[s2], O[db], 0, 0, 0); }
            if (__all(R < -104.0f)) break;
        }
        bf16_t* bo2 = p.bo + (size_t)2 * T * 512 + (size_t)(q0 + r) * 512 + h * 128;
#pragma unroll
        for (int db = 0; db < 4; ++db)
#pragma unroll
            for (int g = 0; g < 4; ++g) { pg8::u32x2 w; w.x = (unsigned)f2bf(O[db][4 * g]) | ((unsigned)f2bf(O[db][4 * g + 1]) << 16); w.y = (unsigned)f2bf(O[db][4 * g + 2]) | ((unsigned)f2bf(O[db][4 * g + 3]) << 16);
                *(pg8::u32x2*)(bo2 + db * 32 + 8 * g + 4 * hh) = w; }
    }
}

#define XB_TMO      128
#define XB_XCNT(j)  (256  + 64 * (j))
#define XB_XSUB(j)  (1280 + 64 * (j))
#define XB_XGEN(j)  (2304 + 64 * (j))
#define XB_TOP      3328
#define XB_TOPGEN   3392
#define XCD_BAR_WORDS 3456
#define XB_SPIN_CAP (1u << 18)
__device__ __forceinline__ unsigned xb_ld(unsigned* p)              { return __hip_atomic_load(p, __ATOMIC_RELAXED, __HIP_MEMORY_SCOPE_AGENT); }
__device__ __forceinline__ unsigned xb_add(unsigned* p, unsigned v) { return __hip_atomic_fetch_add(p, v, __ATOMIC_RELAXED, __HIP_MEMORY_SCOPE_AGENT); }
__device__ __forceinline__ unsigned xb_xcc_id() { return (unsigned)__builtin_amdgcn_s_getreg((3 << 11) | 20) & 0xFu; }
#define XB_SPIN(cond, bar) do { unsigned _sp = 0; while (cond) { __builtin_amdgcn_s_sleep(1); \
    if ((++_sp & 255u) == 0u) { if (xb_ld(&(bar)[XB_TMO])) break; if (_sp > XB_SPIN_CAP) { atomicAdd(&(bar)[XB_TMO], 1u); break; } } } } while (0)
struct XcdBarrier { unsigned* bar; unsigned x; volatile LAS unsigned* st; };
__device__ __forceinline__ XcdBarrier xcd_barrier_post(unsigned* bar, volatile LAS unsigned* st) {
    XcdBarrier b; b.bar = bar; b.x = xb_xcc_id(); b.st = st;
    if (threadIdx.x == 0) (void)xb_add(&bar[XB_XCNT(b.x)], 1u);
    return b;
}
__device__ __forceinline__ void xcd_barrier_complete(unsigned* bar, unsigned x, unsigned& nloc, unsigned& nx) {
    const unsigned G = gridDim.x * gridDim.y * gridDim.z;
    unsigned sum, cnt, mine, sp = 0u;
    for (;;) {
        sum = 0u; cnt = 0u; mine = 0u;
#pragma unroll
        for (unsigned j = 0; j < 16; ++j) { const unsigned c = xb_ld(&bar[XB_XCNT(j)]); sum += c; cnt += (c > 0u) ? 1u : 0u; mine = (j == x) ? c : mine; }
        if (sum == G) break;
        __builtin_amdgcn_s_sleep(1);
        if ((++sp & 255u) == 0u) { if (xb_ld(&bar[XB_TMO])) break; if (sp > XB_SPIN_CAP) { atomicAdd(&bar[XB_TMO], 1u); break; } }
    }
    nloc = mine > 0u ? mine : 1u; nx = cnt > 0u ? cnt : 1u;
}
__device__ __forceinline__ void xcd_barrier(const XcdBarrier& b) {
    asm volatile("s_waitcnt vmcnt(0)" ::: "memory");
    __syncthreads();
    if (threadIdx.x == 0) {
        unsigned* bar = b.bar;
        __builtin_amdgcn_s_waitcnt(0);
        unsigned nloc = b.st[0], nx = b.st[1];
        if (nloc == 0u) { xcd_barrier_complete(bar, b.x, nloc, nx); b.st[0] = nloc; b.st[1] = nx; }
        const unsigned old = xb_add(&bar[XB_XSUB(b.x)], 1u);
        const unsigned gen = old / nloc;
        if (old + 1u == (gen + 1u) * nloc) {
            __builtin_amdgcn_fence(__ATOMIC_RELEASE, "agent");
            asm volatile("s_waitcnt vmcnt(0)" ::: "memory");
            const unsigned og = xb_add(&bar[XB_TOP], 1u);
            const unsigned tg = og / nx;
            if (og + 1u == (tg + 1u) * nx) xb_add(&bar[XB_TOPGEN], 1u);
            else XB_SPIN(xb_ld(&bar[XB_TOPGEN]) == tg, bar);
            __builtin_amdgcn_fence(__ATOMIC_ACQUIRE, "agent");
            xb_add(&bar[XB_XGEN(b.x)], 1u);
            asm volatile("s_waitcnt vmcnt(0)" ::: "memory");
        } else {
            XB_SPIN(xb_ld(&bar[XB_XGEN(b.x)]) == gen, bar);
            __builtin_amdgcn_fence(__ATOMIC_ACQUIRE, "agent");
            asm volatile("s_waitcnt vmcnt(0)" ::: "memory");
        }
    }
    __syncthreads();
}


constexpr size_t al256(size_t x) { return (x + 255) & ~(size_t)255; }
constexpr size_t TS_ = (size_t)T * 512 * 4;
constexpr int YLD = D + 64;
constexpr size_t OFF_BAR = 0;
constexpr size_t OFF_Z = al256(OFF_BAR + 3456 * 4);
constexpr size_t OFF_RS = OFF_Z + al256((size_t)T * ZLD * 2);
constexpr size_t OFF_XB = al256(OFF_RS + (size_t)8 * T * 384 * 4);
constexpr size_t OFF_REGM = al256(OFF_XB + (size_t)T * D * 2);
constexpr size_t OFF_KH = OFF_REGM, OFF_KG = OFF_KH + (size_t)T * 512 * 2, OFF_VTH = OFF_KG + (size_t)T * 256 * 2, OFF_VTG = OFF_VTH + (size_t)512 * T * 2, OFF_VT = OFF_VTG + (size_t)512 * T * 2;
constexpr size_t OFF_RGATE = OFF_VT + (size_t)512 * T * 2, OFF_RBONUS = OFF_RGATE + TS_;
constexpr size_t OFF_SENDH = OFF_RBONUS + TS_, OFF_SENDG = OFF_SENDH + (size_t)NCHK * 4 * 128 * 128 * 4, OFF_SSTH = OFF_SENDG + (size_t)NCHK * 4 * 128 * 64 * 4, OFF_SSTG = OFF_SSTH + (size_t)NCHK * 4 * 128 * 128 * 2;
constexpr size_t OFF_GAMH = OFF_SSTG + (size_t)NCHK * 4 * 128 * 64 * 2, OFF_GAMG = OFF_GAMH + (size_t)NCHK * 4 * 128 * 4, OFF_REGM_END = OFF_GAMG + (size_t)NCHK * 4 * 64 * 4;
constexpr size_t OFF_HBUF = OFF_REGM, OFF_X1 = OFF_REGM + (size_t)MAXROWS * FW * 2;
constexpr size_t OFF_OR = al256(OFF_REGM + (size_t)MAXROWS * FW * 2 + (size_t)T * D * 4);
constexpr size_t OFF_OH = OFF_OR + TS_, OFF_OG = OFF_OH + TS_, OFF_CR = OFF_OG + TS_, OFF_CH = OFF_CR + TS_ / 2, OFF_CG = OFF_CH + TS_ / 2;
constexpr size_t OFF_SENDR = OFF_CG + TS_ / 4, OFF_PENDR = OFF_SENDR + (size_t)NSEG * 8 * 64 * 64 * 4, OFF_SSTR = OFF_PENDR + (size_t)NSEG * 8 * 64 * 64 * 4;
constexpr size_t OFF_BO = al256(OFF_SSTR + (size_t)NSEG * 8 * 64 * 64 * 2);
constexpr size_t OFF_MERGED = OFF_BO + 4 * (size_t)T * 512 * 2, OFF_MERGEDB = OFF_MERGED + (size_t)T * D * 4, OFF_X1B = OFF_MERGEDB + (size_t)T * D * 2;
constexpr size_t OFF_WINT = OFF_X1B + (size_t)T * D * 2, OFF_WGUT = OFF_WINT + (size_t)ZLD * D * 2, OFF_WDT = OFF_WGUT + (size_t)65 * 1024 * D * 2, OFF_WBRT = OFF_WDT + (size_t)65 * D * FW * 2, OFF_WOUTT = OFF_WBRT + (size_t)4 * D * FW * 2;
constexpr size_t OFF_IDX = OFF_WOUTT + (size_t)D * D * 2, OFF_WSEL = OFF_IDX + (size_t)T * 8 * 4, OFF_HIST = OFF_WSEL + (size_t)T * 8 * 4, OFF_ROWTOK = OFF_HIST + 256 * 64 * 4;
constexpr size_t OFF_ROWW = OFF_ROWTOK + (size_t)MAXROWS * 4, OFF_SLOTPOS = OFF_ROWW + (size_t)MAXROWS * 4, OFF_PANEXP = OFF_SLOTPOS + (size_t)T * 8 * 4, OFF_NPAN = al256(OFF_PANEXP + MAXPANELS * 4);
constexpr size_t OFF_WRH = OFF_NPAN + 256, OFF_WRL = OFF_WRH + (size_t)2 * NE * D * 2;
constexpr size_t OFF_W2T = OFF_WRL + (size_t)2 * NE * D * 2, OFF_A2T = OFF_W2T + (size_t)2 * 512 * 32 * 2, OFF_G2T = OFF_A2T + (size_t)2 * 512 * 32 * 2, OFF_GGT = OFF_G2T + (size_t)2 * 512 * 96 * 2;
constexpr size_t WS_NEEDED = OFF_GGT + (size_t)2 * 256 * 32 * 2;
static_assert(OFF_RS + (size_t)8 * T * 384 * 4 - OFF_Z >= (size_t)MAXROWS * YLD * 2, "ybuf must fit in region Y");
static_assert(OFF_REGM_END <= OFF_OR, "region M");
static_assert(OFF_VTG == OFF_VTH + (size_t)512 * T * 2 && OFF_VT == OFF_VTG + (size_t)512 * T * 2, "prep writes VtH, VtG, Vt as one array of three");
__device__ __forceinline__ void ln_row(const float (&v)[32], float s, const float* __restrict__ w, const float* __restrict__ b, bf16_t* __restrict__ outlo, bf16_t* __restrict__ outb, int lane) {
    const float mu = wave_sum(s) * (1.0f / D);
    float q = 0.f;
#pragma unroll
    for (int i = 0; i < 32; ++i) { const float d = v[i] - mu; q += d * d; }
    const float rstd = rsqrtf(wave_sum(q) * (1.0f / D) + 1e-5f);
    float4 wv_[8], bv_[8];
#pragma unroll
    for (int i = 0; i < 8; ++i) { const unsigned c = (unsigned)(i * 256 + lane * 4); wv_[i] = *(const float4*)(w + c); bv_[i] = *(const float4*)(b + c); }
#pragma unroll
    for (int i = 0; i < 8; ++i) {
        const unsigned c = (unsigned)(i * 256 + lane * 4);
        const float4 ww = wv_[i], bb = bv_[i];
        float4 o; o.x = (v[4 * i] - mu) * rstd * ww.x + bb.x; o.y = (v[4 * i + 1] - mu) * rstd * ww.y + bb.y; o.z = (v[4 * i + 2] - mu) * rstd * ww.z + bb.z; o.w = (v[4 * i + 3] - mu) * rstd * ww.w + bb.w;
        pg8::u32x2 pk; pk.x = pg8::cvt_pk_bf16(o.x, o.y); pk.y = pg8::cvt_pk_bf16(o.z, o.w); *(pg8::u32x2*)(outb + c) = pk;
        { const float h0 = __uint_as_float(pk.x << 16), h1 = __uint_as_float(pk.x & 0xffff0000u), h2 = __uint_as_float(pk.y << 16), h3 = __uint_as_float(pk.y & 0xffff0000u);
          pg8::u32x2 pl; pl.x = pg8::cvt_pk_bf16(o.x - h0, o.y - h1); pl.y = pg8::cvt_pk_bf16(o.z - h2, o.w - h3); *(pg8::u32x2*)(outlo + c) = pl; }
    }
}
struct KArgs {
    const float* in[32]; char* ws; float* out;
};
struct MegaArgs {
    MixArgs mix;
    const float *x_in, *w_in, *w_br, *w_out, *ln1_w, *ln1_b, *w_router, *router_bias, *we_gate, *we_up, *we_down, *ws_gate, *ws_up, *ws_down, *ln2_w, *ln2_b;
    bf16_t *xb, *WinT, *WguT, *WdT, *WbrT, *WoutT, *mergedb, *x1b, *hbuf, *ybuf, *WrH, *WrL;
    float *merged, *x1, *out;
    int* idx; float* wsel; int *hist, *row_tok; float* row_w; int *slotpos, *panel_expert, *npanels;
    unsigned* bar;
};
__host__ __device__ __forceinline__ MegaArgs make_args(const KArgs& k) {
    MegaArgs a; char* ws = k.ws;
    a.x_in = k.in[0]; a.w_in = k.in[1];
    a.mix.hg_lb_logits = k.in[2]; a.mix.hg_norm_w = k.in[3]; a.mix.rw_mu = k.in[4]; a.mix.rw_w0 = k.in[5]; a.mix.rw_w2 = k.in[6]; a.mix.rw_a0 = k.in[7]; a.mix.rw_a2 = k.in[8]; a.mix.rw_g2 = k.in[9];
    a.mix.rw_kk = k.in[10]; a.mix.rw_ka = k.in[11]; a.mix.rw_rk = k.in[12]; a.mix.rw_ln_w = k.in[13]; a.mix.rw_ln_b = k.in[14]; a.mix.gla_g2 = k.in[15]; a.mix.gla_gb = k.in[16]; a.mix.gla_norm_w = k.in[17];
    a.w_br = k.in[18]; a.w_out = k.in[19]; a.ln1_w = k.in[20]; a.ln1_b = k.in[21]; a.w_router = k.in[22]; a.router_bias = k.in[23]; a.we_gate = k.in[24]; a.we_up = k.in[25]; a.we_down = k.in[26];
    a.ws_gate = k.in[27]; a.ws_up = k.in[28]; a.ws_down = k.in[29]; a.ln2_w = k.in[30]; a.ln2_b = k.in[31];
    a.bar = (unsigned*)(ws + OFF_BAR);
    a.mix.z = (const bf16_t*)(ws + OFF_Z); a.mix.RS = (float*)(ws + OFF_RS); a.ybuf = (bf16_t*)(ws + OFF_Z); a.xb = (bf16_t*)(ws + OFF_XB);
    a.mix.KH = (bf16_t*)(ws + OFF_KH); a.mix.KG = (bf16_t*)(ws + OFF_KG); a.mix.VtH = (bf16_t*)(ws + OFF_VTH); a.mix.VtG = (bf16_t*)(ws + OFF_VTG); a.mix.Vt = (bf16_t*)(ws + OFF_VT); a.mix.rGate = (bf16_t*)(ws + OFF_RGATE); a.mix.rBonus = (bf16_t*)(ws + OFF_RBONUS);
    a.hbuf = (bf16_t*)(ws + OFF_HBUF); a.x1 = (float*)(ws + OFF_X1);
    a.mix.oR = (float*)(ws + OFF_OR); a.mix.oH = (float*)(ws + OFF_OH); a.mix.oG = (float*)(ws + OFF_OG); a.mix.cR = (bf16_t*)(ws + OFF_CR); a.mix.cH = (bf16_t*)(ws + OFF_CH); a.mix.cG = (bf16_t*)(ws + OFF_CG);
    a.mix.SendR = (float*)(ws + OFF_SENDR); a.mix.PendR = (float*)(ws + OFF_PENDR); a.mix.SendH = (float*)(ws + OFF_SENDH); a.mix.SendG = (float*)(ws + OFF_SENDG); a.mix.GamH = (float*)(ws + OFF_GAMH); a.mix.GamG = (float*)(ws + OFF_GAMG);
    a.mix.SstR = (bf16_t*)(ws + OFF_SSTR); a.mix.SstH = (bf16_t*)(ws + OFF_SSTH); a.mix.SstG = (bf16_t*)(ws + OFF_SSTG);
    a.mix.bo = (bf16_t*)(ws + OFF_BO); a.merged = (float*)(ws + OFF_MERGED); a.mergedb = (bf16_t*)(ws + OFF_MERGEDB); a.x1b = (bf16_t*)(ws + OFF_X1B); a.out = k.out;
    a.WinT = (bf16_t*)(ws + OFF_WINT); a.WguT = (bf16_t*)(ws + OFF_WGUT); a.WdT = (bf16_t*)(ws + OFF_WDT); a.WbrT = (bf16_t*)(ws + OFF_WBRT); a.WoutT = (bf16_t*)(ws + OFF_WOUTT);
    a.idx = (int*)(ws + OFF_IDX); a.wsel = (float*)(ws + OFF_WSEL); a.hist = (int*)(ws + OFF_HIST); a.row_tok = (int*)(ws + OFF_ROWTOK); a.row_w = (float*)(ws + OFF_ROWW);
    a.slotpos = (int*)(ws + OFF_SLOTPOS); a.panel_expert = (int*)(ws + OFF_PANEXP); a.npanels = (int*)(ws + OFF_NPAN);
    a.WrH = (bf16_t*)(ws + OFF_WRH); a.WrL = (bf16_t*)(ws + OFF_WRL);
    a.mix.W2T = (const bf16_t*)(ws + OFF_W2T); a.mix.A2T = (const bf16_t*)(ws + OFF_A2T); a.mix.G2T = (const bf16_t*)(ws + OFF_G2T); a.mix.GGT = (const bf16_t*)(ws + OFF_GGT);
    a.mix.LW = (float*)(ws + OFF_MERGED); a.mix.LA = a.mix.LW + (size_t)T * 512; a.mix.LG = a.mix.LA + (size_t)T * 512; a.mix.LL = a.mix.LG + (size_t)T * 512;
    a.mix.layer = 0; a.mix.pad_ = 0;
    return a;
}
__device__ __forceinline__ void ln_router_phase(const MegaArgs& a, int L, LAS unsigned char* ldsraw) {
    LAS int* hs = (LAS int*)ldsraw;
    const int tid = phase_tid(), lane = tid & 63, wv = __builtin_amdgcn_readfirstlane(tid >> 6);
    const bf16_t* pre = (const bf16_t*)a.merged; const float* wr = a.w_router + (size_t)L * D * NE;
    const float bias = a.router_bias[L * NE + lane];
    for (int vb = blockIdx.x; vb < 256; vb += gridDim.x) {
        __syncthreads();
        if (tid < 64) hs[tid] = 0;
        pg8::u32x2 raw[8];
#pragma unroll
        for (int j = 0; j < 8; ++j) raw[j] = *(const pg8::u32x2*)(pre + ((size_t)vb * 64 + wv * 8) * D + j * 256 + lane * 4);
        for (int i = 0; i < 8; ++i) {
            const size_t row = (size_t)vb * 64 + wv * 8 + i;
            float v[32]; float s = 0.f;
#pragma unroll
            for (int j = 0; j < 8; ++j) { const pg8::u32x2 xx = raw[j]; float4 x; x.x = __uint_as_float(xx.x << 16); x.y = __uint_as_float(xx.x & 0xffff0000u); x.z = __uint_as_float(xx.y << 16); x.w = __uint_as_float(xx.y & 0xffff0000u);
                v[4 * j] = x.x; v[4 * j + 1] = x.y; v[4 * j + 2] = x.z; v[4 * j + 3] = x.w; s += (x.x + x.y) + (x.z + x.w); }
            { const size_t rown = (i < 7) ? row + 1 : row;
#pragma unroll
              for (int j = 0; j < 8; ++j) raw[j] = *(const pg8::u32x2*)(pre + rown * D + j * 256 + lane * 4); }
            ln_row(v, s, a.ln1_w + L * D, a.ln1_b + L * D, (bf16_t*)a.x1 + row * D, a.x1b + row * D, lane);
        }
        asm volatile("s_waitcnt vmcnt(0)" ::: "memory");
        __syncthreads();
        {
            typedef short bf16x8v __attribute__((ext_vector_type(8)));
            const int ke = wv, r = lane & 15, q = lane >> 4;
            const bf16_t* xh = a.x1b + (size_t)(vb * 64 + r) * D + ke * 256 + q * 8; const bf16_t* xl = (const bf16_t*)a.x1 + (size_t)(vb * 64 + r) * D + ke * 256 + q * 8;
            const bf16_t* bh = a.WrH + (size_t)L * NE * D + (size_t)r * D + ke * 256 + q * 8; const bf16_t* bl = a.WrL + (size_t)L * NE * D + (size_t)r * D + ke * 256 + q * 8;
            f32x4v acc[4][4];
#pragma unroll
            for (int tl = 0; tl < 4; ++tl)
#pragma unroll
                for (int nb = 0; nb < 4; ++nb) acc[tl][nb] = (f32x4v){0.f, 0.f, 0.f, 0.f};
#pragma unroll 2
            for (int ks = 0; ks < 8; ++ks) {
                bf16x8v Bh[4], Bl[4], ah[4], al[4];
#pragma unroll
                for (int nb = 0; nb < 4; ++nb) { Bh[nb] = *(const bf16x8v*)(bh + (size_t)nb * 16 * D + ks * 32); Bl[nb] = *(const bf16x8v*)(bl + (size_t)nb * 16 * D + ks * 32); }
#pragma unroll
                for (int tl = 0; tl < 4; ++tl) { ah[tl] = *(const bf16x8v*)(xh + (size_t)tl * 16 * D + ks * 32); al[tl] = *(const bf16x8v*)(xl + (size_t)tl * 16 * D + ks * 32); }
#pragma unroll
                for (int tl = 0; tl < 4; ++tl)
#pragma unroll
                    for (int nb = 0; nb < 4; ++nb) {
                        acc[tl][nb] = __builtin_amdgcn_mfma_f32_16x16x32_bf16(ah[tl], Bh[nb], acc[tl][nb], 0, 0, 0);
                        acc[tl][nb] = __builtin_amdgcn_mfma_f32_16x16x32_bf16(al[tl], Bh[nb], acc[tl][nb], 0, 0, 0);
                        acc[tl][nb] = __builtin_amdgcn_mfma_f32_16x16x32_bf16(ah[tl], Bl[nb], acc[tl][nb], 0, 0, 0); }
            }
            LAS float* lg = (LAS float*)(ldsraw + 1024) + (size_t)ke * 64 * 64;
#pragma unroll
            for (int tl = 0; tl < 4; ++tl)
#pragma unroll
                for (int nb = 0; nb < 4; ++nb)
#pragma unroll
                    for (int i = 0; i < 4; ++i) lg[(tl * 16 + 4 * q + i) * 64 + nb * 16 + r] = acc[tl][nb][i];
        }
        __syncthreads();
        for (int it = 0; it < 8; ++it) {
            {
                const int tk = wv * 8 + it, t = vb * 64 + tk;
                const LAS float* lg = (const LAS float*)(ldsraw + 1024) + (size_t)tk * 64;
                float logit = lg[lane];
#pragma unroll
                for (int kp = 1; kp < 8; ++kp) logit += lg[kp * 64 * 64 + lane];
                const float score = sigmoidf_(logit);
                const float biased = score + bias;
                float m1 = biased;
                m1 = fmaxf(m1, __shfl_xor(m1, 1)); m1 = fmaxf(m1, __shfl_xor(m1, 2)); m1 = fmaxf(m1, __shfl_xor(m1, 4));
                int am = (biased == m1) ? lane : 64;
                am = min(am, __shfl_xor(am, 1)); am = min(am, __shfl_xor(am, 2)); am = min(am, __shfl_xor(am, 4));
                float m2 = (lane == am) ? -INFINITY : biased;
                m2 = fmaxf(m2, __shfl_xor(m2, 1)); m2 = fmaxf(m2, __shfl_xor(m2, 2)); m2 = fmaxf(m2, __shfl_xor(m2, 4));
                const float gs = m1 + m2;
                const int g = lane >> 3;
                int grank = 0;
#pragma unroll
                for (int g2 = 0; g2 < 8; ++g2) { const float o = __shfl(gs, g2 * 8); grank += (o > gs || (o == gs && g2 < g)) ? 1 : 0; }
                const float masked = (grank < 4) ? biased : -INFINITY;
                int rank = 0;
                for (int e2 = 0; e2 < 64; ++e2) { const float o = rdlane(masked, e2); rank += (o > masked || (o == masked && e2 < lane)) ? 1 : 0; }
                const bool sel = rank < 8;
                const float ssum = wave_sum(sel ? score : 0.f);
                if (sel) { a.idx[(size_t)t * 8 + rank] = lane; a.wsel[(size_t)t * 8 + rank] = 2.5f * score / ssum; atomicAdd((int*)&hs[lane], 1); }
            }
        }
        __syncthreads();
        if (tid < 64) a.hist[vb * 64 + tid] = hs[tid];
    }
}
__device__ __forceinline__ void dispatch_phase(const MegaArgs& a, LAS unsigned char* ldsraw) {
    LAS int* tot = (LAS int*)ldsraw; LAS int* bef = tot + 64; LAS int* pstart = tot + 128; LAS int* es = tot + 192; LAS int* np_s = tot + 704; LAS int* ptot = tot + 768; LAS int* pbef = tot + 1280;
    const int tid = phase_tid();
    for (int blk = blockIdx.x; blk < 256; blk += gridDim.x) {
        __syncthreads();
        { const int part = tid >> 6, e = tid & 63; int b = 0, sm = 0;
#pragma unroll 8
          for (int j = part * 32; j < part * 32 + 32; ++j) { const int cc = a.hist[j * 64 + e]; if (j < blk) b += cc; sm += cc; }
          ptot[tid] = sm; pbef[tid] = b; }
        __syncthreads();
        if (tid < 64) { int sm = 0, b = 0;
#pragma unroll
            for (int pp = 0; pp < 8; ++pp) { sm += ptot[pp * 64 + tid]; b += pbef[pp * 64 + tid]; }
            tot[tid] = sm; bef[tid] = b; }
        __syncthreads();
        if (tid == 0) { int acc = 0; for (int e = 0; e < 64; ++e) { pstart[e] = acc; acc += (tot[e] + 255) / 256 * 256; } np_s[0] = acc / 256; }
        const int t = blk * 64 + (tid >> 3), k = tid & 7;
        const int e = a.idx[(size_t)t * 8 + k];
        es[tid] = e;
        __syncthreads();
        int rank = 0;
        for (int j = 0; j < tid; ++j) rank += (es[j] == e) ? 1 : 0;
        const int pos = pstart[e] + bef[e] + rank;
        a.row_tok[pos] = t; a.row_w[pos] = a.wsel[(size_t)t * 8 + k]; a.slotpos[(size_t)t * 8 + k] = pos;
        const int NP = np_s[0];
        if (blk < 64) {
            const int ee = blk, st = pstart[ee], cnt = tot[ee], pad = (cnt + 255) / 256 * 256;
            for (int r = st + cnt + tid; r < st + pad; r += 512) { a.row_tok[r] = 0; a.row_w[r] = 0.f; }
            for (int pp = st / 256 + tid; pp < (st + pad) / 256; pp += 512) a.panel_expert[pp] = ee;
        }
        if (tid < 64) { const int tt = blk * 64 + tid; a.row_tok[NP * 256 + tt] = tt; a.row_w[NP * 256 + tt] = 1.0f; }
        if (blk == 0) { if (tid < 64) a.panel_expert[NP + tid] = 64; if (tid == 0) a.npanels[0] = NP + 64; }
    }
}
__device__ __forceinline__ void combine_phase(const MegaArgs& a, int L, LAS unsigned char* ldsraw) {
    const int ptid = phase_tid(); const int lane = ptid & 63, wv = ptid >> 6, pair = wv >> 1, half = wv & 1;
    LAS float* part = (LAS float*)ldsraw;
    const unsigned shared_base = (unsigned)(a.npanels[0] - 64) * 256u;
    const float* lw = a.ln2_w + L * D; const float* lbp = a.ln2_b + L * D;
    int it = 0;
    int spn[8]; float wkn[8];
    { const unsigned tf = (unsigned)(blockIdx.x * 4 + pair);
#pragma unroll
      for (int k = 0; k < 8; ++k) { spn[k] = 0; wkn[k] = 0.f; if (tf < (unsigned)T) { spn[k] = a.slotpos[tf * 8 + k]; wkn[k] = a.wsel[tf * 8 + k]; } } }
    for (int t0 = blockIdx.x * 4; t0 < T; t0 += gridDim.x * 4, ++it) {
        const unsigned t = (unsigned)(t0 + pair);
        unsigned rows[9];
#pragma unroll
        for (int k = 0; k < 8; ++k) rows[k] = (unsigned)spn[k] * (unsigned)YLD;
        rows[8] = (shared_base + t) * (unsigned)YLD;
        float wk[9];
#pragma unroll
        for (int k = 0; k < 8; ++k) wk[k] = wkn[k];
        wk[8] = 1.0f;
        { const unsigned tn = t + (unsigned)gridDim.x * 4u; const unsigned tc = tn < (unsigned)T ? tn : t;
#pragma unroll
          for (int k = 0; k < 8; ++k) { spn[k] = a.slotpos[tc * 8 + k]; wkn[k] = a.wsel[tc * 8 + k]; } }
        float4 wv_[4], bv_[4];
#pragma unroll
        for (int i = 0; i < 4; ++i) { const unsigned c = (unsigned)(half * 1024 + i * 256 + lane * 4); wv_[i] = *(const float4*)(lw + c); bv_[i] = *(const float4*)(lbp + c); }
        float v[16]; float s1 = 0.f, s2 = 0.f;
#pragma unroll
        for (int i = 0; i < 4; ++i) {
            const unsigned c = (unsigned)(half * 1024 + i * 256 + lane * 4);
            float4 x; { const pg8::u32x2 xx = *(const pg8::u32x2*)(a.x1b + t * (unsigned)D + c); x.x = __uint_as_float(xx.x << 16); x.y = __uint_as_float(xx.x & 0xffff0000u); x.z = __uint_as_float(xx.y << 16); x.w = __uint_as_float(xx.y & 0xffff0000u); }
            float a0 = 0.f, a1 = 0.f, a2 = 0.f, a3 = 0.f;
#pragma unroll
            for (int k = 0; k < 9; ++k) { const uint2 u = *(const uint2*)(a.ybuf + (rows[k] + c));
                a0 += wk[k] * __uint_as_float(u.x << 16); a1 += wk[k] * __uint_as_float(u.x & 0xffff0000u); a2 += wk[k] * __uint_as_float(u.y << 16); a3 += wk[k] * __uint_as_float(u.y & 0xffff0000u); }
            v[4 * i] = ALPHA * x.x + a0; v[4 * i + 1] = ALPHA * x.y + a1; v[4 * i + 2] = ALPHA * x.z + a2; v[4 * i + 3] = ALPHA * x.w + a3;
#pragma unroll
            for (int j = 0; j < 4; ++j) { s1 += v[4 * i + j]; s2 += v[4 * i + j] * v[4 * i + j]; }
            if (i & 1) asm volatile("" ::: "memory");
        }
        s1 = wave_sum(s1); s2 = wave_sum(s2);
        LAS float* slot = part + (((it & 1) * 4 + pair) * 2) * 2;
        if (lane == 0) { slot[half * 2] = s1; slot[half * 2 + 1] = s2; }
        __syncthreads();
        const float S1 = slot[0] + slot[2], S2 = slot[1] + slot[3];
        const float mu = S1 * (1.0f / D);
        const float rstd = rsqrtf(fmaxf(S2 * (1.0f / D) - mu * mu, 0.f) + 1e-5f);
        float* outf = a.out + t * (unsigned)D; bf16_t* outb = a.xb + t * (unsigned)D;
#pragma unroll
        for (int i = 0; i < 4; ++i) {
            const unsigned c = (unsigned)(half * 1024 + i * 256 + lane * 4);
            const float4 ww = wv_[i], bb = bv_[i];
            float4 o; o.x = (v[4 * i] - mu) * rstd * ww.x + bb.x; o.y = (v[4 * i + 1] - mu) * rstd * ww.y + bb.y; o.z = (v[4 * i + 2] - mu) * rstd * ww.z + bb.z; o.w = (v[4 * i + 3] - mu) * rstd * ww.w + bb.w;
            *(float4*)(outf + c) = o;
            if (L == 0) { pg8::u32x2 pk; pk.x = pg8::cvt_pk_bf16(o.x, o.y); pk.y = pg8::cvt_pk_bf16(o.z, o.w); *(pg8::u32x2*)(outb + c) = pk; }
        }
    }
}

constexpr int NPHASE = 13;
constexpr int LDS_GEMM = pg8::STAGE_BYTES + pg8::GTAB_BYTES;
constexpr int LDS_BARW = LDS_GEMM;
constexpr int LDS_PETAB = LDS_GEMM + 64;
constexpr int LDS_ARGS = LDS_GEMM + 16;
constexpr int LDS_BYTES = LDS_GEMM + 512;
__device__ __forceinline__ void args_to_lds(const KArgs& ka, LAS unsigned char* lds) {
    const int t = (int)threadIdx.x;
    if (t < 34) { const unsigned long long v = (t < 32) ? (unsigned long long)ka.in[t] : (t == 32 ? (unsigned long long)ka.ws : (unsigned long long)ka.out);
        *(LAS unsigned long long*)(lds + LDS_ARGS + t * 8) = v; }
}
__device__ __forceinline__ unsigned long long lds_ptr_load(LAS unsigned char* lds, int i) {
    const LAS unsigned* p = (const LAS unsigned*)(lds + LDS_ARGS + i * 8);
    const unsigned lo = (unsigned)__builtin_amdgcn_readfirstlane((int)p[0]), hi = (unsigned)__builtin_amdgcn_readfirstlane((int)p[1]);
    return ((unsigned long long)hi << 32) | lo;
}
template <int PH> __device__ __forceinline__ void run_phase(const KArgs& kin, const int Lp, LAS unsigned char* lds_in) {
    const int L = Lp & 15, part = Lp >> 4;
    LAS unsigned char* lds = lds_in; asm volatile("" : "+s"(lds));
    size_t z0 = 0; asm volatile("" : "+s"(z0));
    KArgs ka;
#pragma unroll
    for (int i = 0; i < 32; ++i) ka.in[i] = (const float*)((const char*)kin.in[i] + z0);
    ka.ws = kin.ws + z0; ka.out = (float*)((char*)kin.out + z0);
    const MegaArgs a = make_args(ka);
    int G = (int)gridDim.x, c = (int)blockIdx.x; asm volatile("" : "+s"(G), "+s"(c));
    if constexpr (PH == 0) {
        if (L == 0) { const size_t n4 = (size_t)T * D / 4; const int ptid = phase_tid(); for (size_t i = (size_t)c * 512 + ptid; i < n4; i += (size_t)G * 512) { const float4 v = *(const float4*)(a.x_in + 4 * i);
            pg8::u32x2 pk; pk.x = pg8::cvt_pk_bf16(v.x, v.y); pk.y = pg8::cvt_pk_bf16(v.z, v.w); *(pg8::u32x2*)(a.xb + 4 * i) = pk; } }
        ConvArgs ca; ca.w_in = a.w_in; ca.we_gate = a.we_gate; ca.we_up = a.we_up; ca.we_down = a.we_down; ca.ws_gate = a.ws_gate; ca.ws_up = a.ws_up; ca.ws_down = a.ws_down; ca.w_br = a.w_br; ca.w_out = a.w_out;
        ca.WinT = a.WinT; ca.WguT = a.WguT; ca.WdT = a.WdT; ca.WbrT = a.WbrT; ca.WoutT = a.WoutT; ca.layer = L; ca.pad_ = 0;
        if (L == 0) convert_tiles(ca, 0, CV_SEG0, c, G, (LAS float (*)[65])lds);
        if (L == 0) { const int pt3 = phase_tid(); bf16_t* w2t = (bf16_t*)a.mix.W2T; bf16_t* a2t = (bf16_t*)a.mix.A2T; bf16_t* g2t = (bf16_t*)a.mix.G2T; bf16_t* ggt = (bf16_t*)a.mix.GGT;
          for (int i = c * 512 + pt3; i < 2 * 512 * 32; i += G * 512) { const int l2 = i >> 14, ch = (i >> 5) & 511, k = i & 31;
              w2t[i] = f2bf(a.mix.rw_w2[((size_t)l2 * 32 + k) * 512 + ch]); a2t[i] = f2bf(a.mix.rw_a2[((size_t)l2 * 32 + k) * 512 + ch]); }
          for (int i = c * 512 + pt3; i < 2 * 512 * 96; i += G * 512) { const int l2 = i / (512 * 96), rem = i - l2 * 512 * 96, ch = rem / 96, k = rem - ch * 96;
              g2t[i] = f2bf(a.mix.rw_g2[((size_t)l2 * 96 + k) * 512 + ch]); }
          for (int i = c * 512 + pt3; i < 2 * 256 * 32; i += G * 512) { const int l2 = i >> 13, ch = (i >> 5) & 255, k = i & 31;
              ggt[i] = (k < 16) ? f2bf(a.mix.gla_g2[((size_t)l2 * 16 + k) * 256 + ch]) : (bf16_t)0; } }
        if (L == 0) { const int ptid2 = phase_tid();
          for (int i = c * 512 + ptid2; i < 2 * NE * D; i += G * 512) { const int l2 = i >> 17, n = (i >> 11) & 63, k = i & 2047; const float v = a.w_router[(size_t)l2 * D * NE + (size_t)k * NE + n];
              const bf16_t hi = f2bf(v); a.WrH[i] = hi; a.WrL[i] = f2bf(v - bf2f(hi)); } }
    } else if constexpr (PH == 1) {
        pg8::StaticOrder S; S.init(a.xb, a.WinT, T, ZLD, D, G, c);
        pg8::EpiZ16 E; E.O = (bf16_t*)a.mix.z; E.ldc = ZLD; E.pad_ = 0;
        pg8::gemm_phase<pg8::EpiZ16, pg8::StaticOrder, false>(lds, D, S, E);
    } else if constexpr (PH == 2) { MixArgs m = a.mix; m.layer = L; prep_phase(m, lds);
    } else if constexpr (PH == 3) { MixArgs m = a.mix; m.layer = L;
        ConvArgs ca; ca.w_in = a.w_in; ca.we_gate = a.we_gate; ca.we_up = a.we_up; ca.we_down = a.we_down; ca.ws_gate = a.ws_gate; ca.ws_up = a.ws_up; ca.ws_down = a.ws_down; ca.w_br = a.w_br; ca.w_out = a.w_out;
        ca.WinT = a.WinT; ca.WguT = a.WguT; ca.WdT = a.WdT; ca.WbrT = a.WbrT; ca.WoutT = a.WoutT; ca.layer = L; ca.pad_ = 0;
        chains_phase(m, ca, a.bar + 8 + L, lds);
    } else if constexpr (PH == 4) { MixArgs m = a.mix; m.layer = L;
        carry_phase(m, lds, part);
        if (part == 0 && (c >= 32 || G <= 32)) sb_queue(m, a.bar + 12 + L, lds);
    } else if constexpr (PH == 5) { MixArgs m = a.mix; m.layer = L; mixfin_phase(m);
    } else if constexpr (PH == 6) {
        pg8::GateOrder S; S.init(a.mix.bo, a.WbrT, G, c);
        pg8::EpiGateAcc E; E.zg0 = a.mix.z + GATE0; E.mergedb = a.mergedb;
        pg8::gemm_phase<pg8::EpiGateAcc, pg8::GateOrder, false>(lds, FW, S, E);
    } else if constexpr (PH == 7) {
        pg8::StaticOrder S; S.init(a.mergedb, a.WoutT, T, D, D, G, c);
        pg8::EpiResid E; E.xin = (L == 0) ? a.x_in : a.out; E.pre = (bf16_t*)a.merged;
        pg8::gemm_phase<pg8::EpiResid, pg8::StaticOrder, false>(lds, D, S, E);
    } else if constexpr (PH == 8) { ln_router_phase(a, L, lds);
    } else if constexpr (PH == 9) { dispatch_phase(a, lds);
    } else if constexpr (PH == 10) {
        LAS int* petab = (LAS int*)(lds + LDS_PETAB); const int npan = a.npanels[0];
        pg8::MoeOrder::fill_table(petab, a.panel_expert, npan, 4, G, c, phase_tid());
        pg8::MoeOrder S; S.init(a.x1b, a.WguT, (size_t)1024 * D, petab, a.row_tok, npan, 4, D, G, c);
        pg8::EpiSwi E; E.h = a.hbuf;
        pg8::gemm_phase<pg8::EpiSwi, pg8::MoeOrder, true>(lds, D, S, E);
    } else if constexpr (PH == 11) {
        LAS int* petab = (LAS int*)(lds + LDS_PETAB); const int npan = a.npanels[0];
        pg8::MoeOrder::fill_table(petab, a.panel_expert, npan, 8, G, c, phase_tid());
        pg8::MoeOrder S; S.init(a.hbuf, a.WdT, (size_t)D * FW, petab, nullptr, npan, 8, FW, G, c);
        pg8::EpiDownW E; E.y = a.ybuf; E.ld = YLD; E.pad_ = 0;
        pg8::gemm_phase<pg8::EpiDownW, pg8::MoeOrder, false>(lds, FW, S, E);
    } else { combine_phase(a, L, lds); }
}
#ifndef MK_MULTI
#define MK_MULTI 0
#endif
#ifndef MK_PART
#define MK_PART 0
#endif
#ifndef MK_DBL
#define MK_DBL 0
#endif
#if MK_MULTI
template <int PH> __global__ __launch_bounds__(512, 2) void k_one(KArgs a, int L, int pad_) {
    extern __shared__ __attribute__((aligned(16))) unsigned char shm[];
    run_phase<PH>(a, L, (LAS unsigned char*)shm);
}
#else
__device__ __forceinline__ void run_layer(const KArgs& a, const int L, LAS unsigned char* lds, const XcdBarrier& bar) {
#define MK_RUN(PH) do { run_phase<PH>(a, L, lds); xcd_barrier(bar); if ((MK_DBL >> PH) & 1) { run_phase<PH>(a, L | (MK_PART << 4), lds); xcd_barrier(bar); } } while (0)
    if (L == 0) { MK_RUN(0); }
    MK_RUN(1); MK_RUN(2); MK_RUN(3); MK_RUN(4); MK_RUN(5); MK_RUN(6); MK_RUN(7); MK_RUN(8); MK_RUN(9); MK_RUN(10); MK_RUN(11); MK_RUN(12);
#undef MK_RUN
}
__global__ __launch_bounds__(512, 2) void k_mega(KArgs a) {
    extern __shared__ __attribute__((aligned(16))) unsigned char shm[];
    LAS unsigned char* lds = (LAS unsigned char*)shm;
    if (threadIdx.x < 4) ((LAS unsigned*)(lds + LDS_BARW))[threadIdx.x] = 0u;
    __syncthreads();
    const XcdBarrier bar = xcd_barrier_post((unsigned*)(a.ws + OFF_BAR), (volatile LAS unsigned*)(lds + LDS_BARW));
    run_layer(a, 0, lds, bar);
    run_layer(a, 1, lds, bar);
}
#endif

#if MK_MULTI
template <int PH> static void launch_one(const KArgs& a, int L, int grid, hipStream_t stream) {
    static bool attr = false; if (!attr) { (void)hipFuncSetAttribute((const void*)k_one<PH>, hipFuncAttributeMaxDynamicSharedMemorySize, LDS_BYTES); attr = true; }
    k_one<PH><<<grid, 512, LDS_BYTES, stream>>>(a, L, 0);
}
#endif
extern "C" void kernel_launch(void* const* d_in, const int* in_sizes, int n_in, void* d_out, int out_size, void* d_ws, size_t ws_size, hipStream_t stream) {
    KArgs a; memset(&a, 0, sizeof a);
    for (int i = 0; i < 32; ++i) a.in[i] = (const float*)d_in[i];
    a.ws = (char*)d_ws; a.out = (float*)d_out;
    if (WS_NEEDED > ws_size || n_in < 32) { fprintf(stderr, "workspace too small: need %zu MiB, have %zu MiB (n_in %d)\n", WS_NEEDED >> 20, ws_size >> 20, n_in); return; }

    static int grid = 0;
    if (!grid) { int dev = 0, cus = 0; (void)hipGetDevice(&dev); (void)hipDeviceGetAttribute(&cus, hipDeviceAttributeMultiprocessorCount, dev); grid = cus > 0 ? cus : 256; if (grid > 256) grid = 256; }
#if MK_MULTI
    for (int L = 0; L < 2; ++L) {
        launch_one<0>(a, L, grid, stream); launch_one<1>(a, L, grid, stream); launch_one<2>(a, L, grid, stream); launch_one<3>(a, L, grid, stream); launch_one<4>(a, L, grid, stream);
        launch_one<5>(a, L, grid, stream); launch_one<6>(a, L, grid, stream); launch_one<7>(a, L, grid, stream); launch_one<8>(a, L, grid, stream); launch_one<9>(a, L, grid, stream);
        launch_one<10>(a, L, grid, stream); launch_one<11>(a, L, grid, stream); launch_one<12>(a, L, grid, stream);
    }
#else
    static bool attr = false;
    if (!attr) {
        if (hipFuncSetAttribute((const void*)k_mega, hipFuncAttributeMaxDynamicSharedMemorySize, LDS_BYTES) != hipSuccess) { fprintf(stderr, "hipFuncSetAttribute failed\n"); return; }
        int per_cu = 0; (void)hipOccupancyMaxActiveBlocksPerMultiprocessor(&per_cu, (const void*)k_mega, 512, LDS_BYTES);
        if (per_cu < 1) fprintf(stderr, "occupancy query reports %d workgroups per CU\n", per_cu);
        attr = true;
    }
    (void)hipMemsetAsync(a.ws + OFF_BAR, 0, XCD_BAR_WORDS * sizeof(unsigned), stream);
    k_mega<<<grid, 512, LDS_BYTES, stream>>>(a);
#endif
}
```
